# Optimizing an MI355X kernel written in HIP

```python
import jax, jax.numpy as jnp
from jax import lax
import numpy as np

D_MODEL = 1024
BATCH = 1
SEQ = 16384
DEPTH = 1
DEC_BATCH = 128
DEC_SEQ = 1
PAST_LEN = 16384
PAGE_SIZE = 128

D_CONV = D_MODEL
CONV_W = 3
N_HEADS = 16
N_KV = 4
GROUP = N_HEADS // N_KV
HEAD_DIM = 64
WINDOW = 128
BLOCK = 128
D_FF = 2816
EPS = 1e-6
N_MOD = 6
ATTN_SCALE = HEAD_DIM ** -0.5
SPLIT_SIZES = (D_CONV, D_CONV, D_CONV, N_HEADS * HEAD_DIM, N_KV * HEAD_DIM, N_KV * HEAD_DIM, D_MODEL, D_MODEL)
IN_COLS = sum(SPLIT_SIZES)
SPLIT_POINTS = tuple(int(v) for v in np.cumsum(SPLIT_SIZES)[:-1])

kernel_name = 'adaln_hybrid_shortconv_swa_sink_convffn_step'


def rmsnorm(x, g):
    xf = x.astype(jnp.float32)
    y = xf * lax.rsqrt(jnp.mean(xf * xf, axis=-1, keepdims=True) + EPS)
    return (y * g.astype(jnp.float32)).astype(x.dtype)


def causal_dwconv(prev, u, w):
    t = u.shape[1]
    full = jnp.concatenate([prev.astype(u.dtype), u], axis=1)
    out = sum(w[i] * full[:, i:i + t] for i in range(CONV_W))
    return out, full[:, -(CONV_W - 1):]


def sink_softmax(s, mask, sink):
    s = jnp.where(mask, s, -jnp.inf)
    m = jnp.maximum(jnp.max(s, axis=-1, keepdims=True), sink)
    p = jnp.exp(s - m)
    return p / (jnp.sum(p, axis=-1, keepdims=True) + jnp.exp(sink - m))


def window_attn_prompt(q, k, v, sinks):
    n, s = q.shape[:2]
    nb = s // BLOCK
    qb = q.reshape(n, nb, BLOCK, N_KV, GROUP, HEAD_DIM)
    kb = k.reshape(n, nb, BLOCK, N_KV, HEAD_DIM)
    vb = v.reshape(n, nb, BLOCK, N_KV, HEAD_DIM)
    pad = ((0, 0), (1, 0), (0, 0), (0, 0), (0, 0))
    kk = jnp.concatenate([jnp.pad(kb, pad)[:, :-1], kb], axis=2)
    vv = jnp.concatenate([jnp.pad(vb, pad)[:, :-1], vb], axis=2)
    d = (jnp.arange(BLOCK) + BLOCK)[:, None] - jnp.arange(2 * BLOCK)[None, :]
    band = (d >= 0) & (d <= WINDOW)
    real = (jnp.arange(nb)[:, None] > 0) | (jnp.arange(2 * BLOCK)[None, :] >= BLOCK)
    mask = band[None] & real[:, None, :]
    sc = jnp.einsum('bnqkgd,bnskd->bnkgqs', qb, kk, preferred_element_type=jnp.float32) * ATTN_SCALE
    sink = sinks.astype(jnp.float32).reshape(N_KV, GROUP)[None, None, :, :, None, None]
    p = sink_softmax(sc, mask[None, :, None, None], sink)
    o = jnp.einsum('bnkgqs,bnskd->bnqkgd', p.astype(vv.dtype), vv)
    return o.reshape(n, s, N_HEADS, HEAD_DIM), k[:, -WINDOW:], v[:, -WINDOW:]


def window_attn_decode(q, k, v, k_prev, v_prev, sinks):
    n, t = q.shape[:2]
    r = k_prev.shape[1]
    kk = jnp.concatenate([k_prev.astype(k.dtype), k], axis=1)
    vv = jnp.concatenate([v_prev.astype(v.dtype), v], axis=1)
    qg = q.reshape(n, t, N_KV, GROUP, HEAD_DIM)
    sc = jnp.einsum('btkgd,bskd->bkgts', qg, kk, preferred_element_type=jnp.float32) * ATTN_SCALE
    d = (r + jnp.arange(t))[:, None] - jnp.arange(r + t)[None, :]
    mask = (d >= 0) & (d <= WINDOW)
    sink = sinks.astype(jnp.float32).reshape(N_KV, GROUP)[None, :, :, None, None]
    p = sink_softmax(sc, mask, sink)
    o = jnp.einsum('bkgts,bskd->btkgd', p.astype(vv.dtype), vv)
    return o.reshape(n, t, N_HEADS, HEAD_DIM), kk[:, -r:], vv[:, -r:]


def decoder_layer(x, c, conv_a_prev, k_prev, v_prev, ffn_prev, w_ada, b_ada, g_mix, w_in, conv_a_w,
                  sinks, w_a_out, w_b_out, w_o, g_ffn, w_up, ffn_conv_w, ffn_conv_b, w_down):
    n, t, _ = x.shape
    ada = jax.nn.silu(c) @ w_ada + b_ada
    sh1, sc1, gt1, sh2, sc2, gt2 = jnp.split(ada[:, None, :], N_MOD, axis=-1)
    h = rmsnorm(x, g_mix) * (1 + sc1) + sh1
    proj = h @ w_in
    xin, b_gate, c_gate, q, k, v, ga, gb = jnp.split(proj, SPLIT_POINTS, axis=-1)
    conv_out, conv_a_new = causal_dwconv(conv_a_prev, c_gate * xin, conv_a_w)
    y_a = (b_gate * conv_out) @ w_a_out
    q = q.reshape(n, t, N_HEADS, HEAD_DIM)
    k = k.reshape(n, t, N_KV, HEAD_DIM)
    v = v.reshape(n, t, N_KV, HEAD_DIM)
    if k_prev is None:
        att, k_new, v_new = window_attn_prompt(q, k, v, sinks)
    else:
        att, k_new, v_new = window_attn_decode(q, k, v, k_prev, v_prev, sinks)
    y_b = att.reshape(n, t, N_HEADS * HEAD_DIM) @ w_b_out
    x = x + gt1 * ((jax.nn.sigmoid(ga) * y_a + jax.nn.sigmoid(gb) * y_b) @ w_o)
    h = rmsnorm(x, g_ffn) * (1 + sc2) + sh2
    up, ffn_new = causal_dwconv(ffn_prev, h @ w_up, ffn_conv_w)
    a_g, a_v = jnp.split(up + ffn_conv_b, 2, axis=-1)
    x = x + gt2 * ((jax.nn.silu(a_g) * a_v) @ w_down)
    return x, conv_a_new, k_new, v_new, ffn_new


def setup_inputs(seed: int = 0) -> dict:
    key = jax.random.key(seed)
    ks = jax.random.split(key, 24)
    f32 = jnp.float32

    def nrm(k, shape, scale):
        return jax.random.normal(k, shape, f32) * scale

    rows = min(WINDOW, PAST_LEN)
    return {
        'x_prompt': nrm(ks[0], (BATCH, SEQ, D_MODEL), 1.0),
        'x_sample': nrm(ks[1], (DEC_BATCH, DEC_SEQ, D_MODEL), 1.0),
        'c_prompt': nrm(ks[2], (BATCH, D_MODEL), 1.0),
        'c_sample': nrm(ks[3], (DEC_BATCH, D_MODEL), 1.0),
        'state_conv_a': nrm(ks[4], (DEPTH, DEC_BATCH, CONV_W - 1, D_CONV), 1.0),
        'cache_k_win': nrm(ks[5], (DEPTH, DEC_BATCH, rows, N_KV, HEAD_DIM), 1.0),
        'cache_v_win': nrm(ks[6], (DEPTH, DEC_BATCH, rows, N_KV, HEAD_DIM), 1.0),
        'state_ffn_conv': nrm(ks[7], (DEPTH, DEC_BATCH, CONV_W - 1, 2 * D_FF), 1.0),
        'w_ada': nrm(ks[8], (DEPTH, D_MODEL, N_MOD * D_MODEL), D_MODEL ** -0.5),
        'b_ada': nrm(ks[9], (DEPTH, N_MOD * D_MODEL), 0.02),
        'g_mix': 1.0 + nrm(ks[10], (DEPTH, D_MODEL), 0.02),
        'w_in': nrm(ks[11], (DEPTH, D_MODEL, IN_COLS), D_MODEL ** -0.5),
        'conv_a_w': nrm(ks[12], (DEPTH, CONV_W, D_CONV), CONV_W ** -0.5),
        'attn_sinks': nrm(ks[13], (DEPTH, N_HEADS), 1.0),
        'w_a_out': nrm(ks[14], (DEPTH, D_CONV, D_MODEL), D_CONV ** -0.5),
        'w_b_out': nrm(ks[15], (DEPTH, N_HEADS * HEAD_DIM, D_MODEL), (N_HEADS * HEAD_DIM) ** -0.5),
        'w_o': nrm(ks[16], (DEPTH, D_MODEL, D_MODEL), D_MODEL ** -0.5),
        'g_ffn': 1.0 + nrm(ks[17], (DEPTH, D_MODEL), 0.02),
        'w_up': nrm(ks[18], (DEPTH, D_MODEL, 2 * D_FF), D_MODEL ** -0.5),
        'ffn_conv_w': nrm(ks[19], (DEPTH, CONV_W, 2 * D_FF), CONV_W ** -0.5),
        'ffn_conv_b': nrm(ks[20], (DEPTH, 2 * D_FF), 0.01),
        'w_down': nrm(ks[21], (DEPTH, D_FF, D_MODEL), D_FF ** -0.5),
        'g_final': 1.0 + nrm(ks[22], (D_MODEL,), 0.02),
    }


def reference(x_prompt, x_sample, c_prompt, c_sample, state_conv_a, cache_k_win, cache_v_win, state_ffn_conv,
              w_ada, b_ada, g_mix, w_in, conv_a_w, attn_sinks, w_a_out, w_b_out, w_o, g_ffn, w_up,
              ffn_conv_w, ffn_conv_b, w_down, g_final):
    xp, xs = x_prompt, x_sample
    nb_p = x_prompt.shape[0]
    ca_p, ca_s, kp, ks_, vp, vs, fp, fs = [], [], [], [], [], [], [], []
    for l in range(DEPTH):
        w = (w_ada[l], b_ada[l], g_mix[l], w_in[l], conv_a_w[l], attn_sinks[l], w_a_out[l], w_b_out[l],
             w_o[l], g_ffn[l], w_up[l], ffn_conv_w[l], ffn_conv_b[l], w_down[l])
        zero_a = jnp.zeros((nb_p, CONV_W - 1, D_CONV), xp.dtype)
        zero_f = jnp.zeros((nb_p, CONV_W - 1, 2 * D_FF), xp.dtype)
        xp, a1, k1, v1, f1 = decoder_layer(xp, c_prompt, zero_a, None, None, zero_f, *w)
        xs, a2, k2, v2, f2 = decoder_layer(xs, c_sample, state_conv_a[l], cache_k_win[l], cache_v_win[l],
                                           state_ffn_conv[l], *w)
        ca_p.append(a1); ca_s.append(a2); kp.append(k1); ks_.append(k2)
        vp.append(v1); vs.append(v2); fp.append(f1); fs.append(f2)
    y_prompt = rmsnorm(xp, g_final)
    y_sample = rmsnorm(xs, g_final)
    return (y_prompt, y_sample, jnp.stack(ca_p), jnp.stack(ca_s), jnp.stack(kp), jnp.stack(ks_),
            jnp.stack(vp), jnp.stack(vs), jnp.stack(fp), jnp.stack(fs))
```

```cpp
#ifndef SELFCHECK
#define SELFCHECK 0
#endif
#include <hip/hip_runtime.h>
#include <hip/hip_cooperative_groups.h>
#include <cstdio>
#include <cstdint>
namespace cg = cooperative_groups;

constexpr int D = 1024, SEQ = 16384, NS = 128, MROWS = SEQ + NS, MPAD = 16640;
constexpr int NIN = 6656, FF = 2816, FF2 = 5632, NADA = 6144;
constexpr int NMT = MPAD / 256;
constexpr int NPT5 = 65;
constexpr float EPS = 1e-6f;

constexpr size_t MiB = 1u << 20;
constexpr size_t RB = (size_t)MPAD * 1024 * 2;
constexpr size_t KBB = (size_t)MPAD * 256 * 2;
constexpr size_t WS_AADA = 1 * MiB;
constexpr size_t WS_ADA = 2 * MiB;
constexpr size_t WS_WA = 8 * MiB, WS_WB = 10 * MiB, WS_WO = 12 * MiB;
constexpr size_t WS_WADA = 14 * MiB;
constexpr size_t WS_WIN = 26 * MiB;
constexpr size_t WS_WUP = 14 * MiB;
constexpr size_t WS_WDN = 25 * MiB;
constexpr size_t WS_H = 39 * MiB;
constexpr size_t WS_U = 72 * MiB;
constexpr size_t WS_BG = 105 * MiB;
constexpr size_t WS_Q = 138 * MiB;
constexpr size_t WS_KB = WS_Q + RB, WS_VB = WS_KB + KBB, WS_GA = WS_VB + KBB, WS_GB = WS_GA + RB;
constexpr size_t WS_G = WS_Q;
constexpr size_t WS_END = WS_GB + RB;
static_assert(WS_END <= 256 * MiB, "ws map");
static_assert(WS_G + (size_t)MPAD * FF * 2 <= WS_END, "G overlay");
static_assert(WS_WDN + (size_t)1024 * FF * 2 <= WS_H && WS_WUP + (size_t)FF2 * 1024 * 2 <= WS_WDN, "weights");
static_assert(WS_U + RB + 4096 <= WS_BG && WS_H + RB <= WS_U && WS_BG + RB <= WS_Q, "row buffers");

constexpr size_t O_YP = 0, O_YS = 16777216, O_CAP = 16908288, O_CAS = 16910336, O_KP = 17172480, O_KS = 17205248,
                 O_VP = 21399552, O_VS = 21432320, O_FP = 25626624, O_FS = 25637888;

constexpr int LDS_BYTES = 147456;
constexpr int HALO_OFF = 131072;

typedef unsigned short bf16_t;
typedef short bf16x8 __attribute__((ext_vector_type(8)));
typedef float f32x4 __attribute__((ext_vector_type(4)));
typedef float f32x16 __attribute__((ext_vector_type(16)));
typedef float f32x2 __attribute__((ext_vector_type(2)));
typedef unsigned u32x4 __attribute__((ext_vector_type(4)));
typedef unsigned u32x2 __attribute__((ext_vector_type(2)));

__device__ __forceinline__ float bf2f(unsigned b) { return __uint_as_float(b << 16); }
__device__ __forceinline__ unsigned cvt_pk_bf16(float lo, float hi) { unsigned r; asm volatile("v_cvt_pk_bf16_f32 %0, %1, %2" : "=v"(r) : "v"(lo), "v"(hi)); return r; }
__device__ __forceinline__ float bperm_f(float v, int byte_addr) { return __int_as_float(__builtin_amdgcn_ds_bpermute(byte_addr, __float_as_int(v))); }
__device__ __forceinline__ float sigmoidf_(float x) { return __builtin_amdgcn_rcpf(1.0f + __expf(-x)); }
__device__ __forceinline__ float siluf_(float x) { return x * __builtin_amdgcn_rcpf(1.0f + __expf(-x)); }
__device__ __forceinline__ float wave_sum(float v) {
#pragma unroll
    for (int o = 1; o < 64; o <<= 1) v += __shfl_xor(v, o);
    return v;
}
__device__ __forceinline__ float wave_max(float v) {
#pragma unroll
    for (int o = 1; o < 64; o <<= 1) v = fmaxf(v, __shfl_xor(v, o));
    return v;
}
__device__ __forceinline__ void unpack8(u32x4 w, float* f) {
    f[0] = bf2f(w.x & 0xffffu); f[1] = bf2f(w.x >> 16); f[2] = bf2f(w.y & 0xffffu); f[3] = bf2f(w.y >> 16);
    f[4] = bf2f(w.z & 0xffffu); f[5] = bf2f(w.z >> 16); f[6] = bf2f(w.w & 0xffffu); f[7] = bf2f(w.w >> 16);
}
__device__ __forceinline__ u32x4 pack8(const float* f) {
    u32x4 w; w.x = cvt_pk_bf16(f[0], f[1]); w.y = cvt_pk_bf16(f[2], f[3]); w.z = cvt_pk_bf16(f[4], f[5]); w.w = cvt_pk_bf16(f[6], f[7]); return w;
}

namespace pg8 {
#define PG8_LAS __attribute__((address_space(3)))
constexpr int BM = 256, BK = 64, HALF = 128, HTB = HALF * BK * 2, STAGE_BYTES = 8 * HTB, NXCD = 8, WGM = 8;
__host__ __device__ __forceinline__ int lds_byte(int r, int c) { const int st = (r >> 4) * 2 + (c >> 5), rr = r & 15, cc = c & 31, ob = rr * 64 + cc * 2; return st * 1024 + (ob ^ (((ob >> 9) & 1) << 5)); }
__host__ __device__ __forceinline__ void stage_rc(int b, int& R, int& C) { const int st = b / 1024, sb = b % 1024, swz = sb ^ (((sb >> 9) & 1) << 5); R = (st >> 1) * 16 + swz / 64; C = (st & 1) * 32 + (swz % 64) / 2; }
__host__ __device__ __forceinline__ int perm32(int rho) { const int n = rho >> 4, i = rho & 15; return 8 * (i >> 2) + 4 * n + (i & 3); }

struct Unit { int pm, pn, aux; const char* a; const char* b; };

struct TileOrder {
    int nM, nN, nwg;
    __device__ __forceinline__ void init(int nM_, int nN_) { nM = nM_; nN = nN_; nwg = nM * nN; }
    __device__ __forceinline__ bool tile(long L, int& pm, int& pn) const {
        if (L >= nwg) return false;
        int wgid = (int)L; { const int q = nwg / NXCD, r = nwg % NXCD, xcd = wgid % NXCD, off = wgid / NXCD; wgid = (xcd < r ? xcd * (q + 1) : r * (q + 1) + (xcd - r) * q) + off; }
        const int nig = WGM * nN, gid = wgid / nig, fm = gid * WGM, gsz = (nM - fm) < WGM ? (nM - fm) : WGM;
        pm = fm + ((wgid % nig) % gsz); pn = (wgid % nig) / gsz; return true;
    }
};

template <class Epi, class Sched, int lda, int ldb, int K, bool ALIGN_EPI, bool SP2>
__device__ __forceinline__ void gemm_phase(PG8_LAS unsigned char* lds, const int wave0, const Sched& S, const Epi& E) {
    int tid_ = wave0 * 64 + (int)__builtin_amdgcn_mbcnt_hi(~0u, __builtin_amdgcn_mbcnt_lo(~0u, 0u)); asm volatile("" : "+v"(tid_));
    const int tid = tid_, wid = __builtin_amdgcn_readfirstlane(tid >> 6), lane = tid & 63, wr = wid >> 2, wc = wid & 3, fr = lane & 15, fq = lane >> 4;
    const int nt = K / BK;
    unsigned voffA[2], voffB[2];
#pragma unroll
    for (int i = 0; i < 2; ++i) { int R, C; stage_rc(tid * 16 + i * 8192, R, C); const int Rb = Epi::PERM ? ((R & ~31) + perm32(R & 31)) : R;
        voffA[i] = (unsigned)(R * lda + C) * 2u; voffB[i] = (unsigned)(Rb * ldb + C) * 2u; }
    const size_t kstep = (size_t)(BK * 2);
    const size_t hstepA = (size_t)HALF * lda * 2, hstepB = (size_t)HALF * ldb * 2;
    const unsigned ldsw = (unsigned)wid * 1024u;
    const int aoff = lds_byte(wr * 64 + fr, fq * 8), boff = lds_byte(wc * 32 + fr, fq * 8);
#define PG8_SA(b, h) (((b) * 2 + (h)) * HTB)
#define PG8_SB(b, h) ((4 + (b) * 2 + (h)) * HTB)
#define PG8_STAGE(bufoff, gbase, voff) do { _Pragma("unroll") for (int _i = 0; _i < 2; ++_i) \
        __builtin_amdgcn_global_load_lds((const unsigned*)((const char*)(gbase) + (voff)[_i]), (PG8_LAS unsigned*)(lds + (bufoff) + ldsw + _i * 8192), 16, 0, 0); } while (0)
#define PG8_LDA(dst, b, h) do { _Pragma("unroll") for (int m = 0; m < 4; ++m) _Pragma("unroll") for (int k = 0; k < 2; ++k) dst[m][k] = *(const PG8_LAS bf16x8*)(lds + PG8_SA(b, h) + aoff + m * 2048 + k * 1024); } while (0)
#define PG8_LDB(dst, b, h) do { _Pragma("unroll") for (int n = 0; n < 2; ++n) _Pragma("unroll") for (int k = 0; k < 2; ++k) dst[n][k] = *(const PG8_LAS bf16x8*)(lds + PG8_SB(b, h) + boff + n * 2048 + k * 1024); } while (0)
#define PG8_MMA(ai, bj, At, Bt) do { __builtin_amdgcn_s_setprio(1); _Pragma("unroll") for (int m = 0; m < 4; ++m) _Pragma("unroll") for (int n = 0; n < 2; ++n) _Pragma("unroll") for (int k = 0; k < 2; ++k) \
        acc[ai][bj][m][n] = __builtin_amdgcn_mfma_f32_16x16x32_bf16(Bt[n][k], At[m][k], acc[ai][bj][m][n], 0, 0, 0); __builtin_amdgcn_s_setprio(0); } while (0)
#define PG8_WAIT_V(n) asm volatile("s_waitcnt vmcnt(" #n ")" ::: "memory")
#define PG8_WAIT_L(n) asm volatile("s_waitcnt lgkmcnt(" #n ")" ::: "memory")
#define PG8_BAR __builtin_amdgcn_s_barrier()
#define PG8_SCHED __builtin_amdgcn_sched_barrier(0)
    Unit cur, nxt; int ui = 0;
    if (!S.next(0, cur)) return;
    f32x4 acc[2][2][4][2];
#pragma unroll
    for (int a = 0; a < 2; ++a)
#pragma unroll
        for (int b = 0; b < 2; ++b)
#pragma unroll
            for (int m = 0; m < 4; ++m)
#pragma unroll
                for (int n = 0; n < 2; ++n) acc[a][b][m][n] = (f32x4){0.f, 0.f, 0.f, 0.f};
    bf16x8 At[4][2], B0[2][2], B1[2][2];
    const char* cA = cur.a; const char* cB = cur.b;
    if constexpr (SP2) {
        PG8_STAGE(PG8_SB(0, 0), cB, voffB); PG8_STAGE(PG8_SB(0, 1), cB + hstepB, voffB); PG8_STAGE(PG8_SA(0, 0), cA, voffA); PG8_STAGE(PG8_SA(0, 1), cA + hstepA, voffA);
        if (wr == 1) PG8_BAR;
        PG8_WAIT_V(2); PG8_BAR;
        PG8_STAGE(PG8_SB(1, 0), cB + kstep, voffB); PG8_STAGE(PG8_SA(1, 0), cA + kstep, voffA); PG8_STAGE(PG8_SB(1, 1), cB + hstepB + kstep, voffB);
        PG8_WAIT_V(6); PG8_BAR;
    } else {
        PG8_STAGE(PG8_SB(0, 0), cB, voffB); PG8_STAGE(PG8_SA(0, 0), cA, voffA); PG8_STAGE(PG8_SB(0, 1), cB + hstepB, voffB); PG8_STAGE(PG8_SA(0, 1), cA + hstepA, voffA);
        if (wr == 1) PG8_BAR;
        PG8_WAIT_V(4); PG8_BAR;
        PG8_STAGE(PG8_SB(1, 0), cB + kstep, voffB); PG8_STAGE(PG8_SA(1, 0), cA + kstep, voffA); PG8_STAGE(PG8_SB(1, 1), cB + hstepB + kstep, voffB);
        PG8_WAIT_V(6); PG8_BAR;
    }
    for (;;) {
        const bool has_next = S.next(ui + 1, nxt);
        const char* nA = has_next ? nxt.a : cA; const char* nB = has_next ? nxt.b : cB;
        for (int t = 0; t < nt; t += 2) {
            const bool last = (t == nt - 2);
            const char* a1 = cA + (size_t)(t + 1) * kstep;
            const char* a2 = last ? nA : cA + (size_t)(t + 2) * kstep; const char* b2 = last ? nB : cB + (size_t)(t + 2) * kstep;
            const char* a3 = a2 + kstep; const char* b3 = b2 + kstep;
            if constexpr (SP2) {
            PG8_LDB(B0, 0, 0); PG8_LDB(B1, 0, 1); PG8_SCHED; PG8_LDA(At, 0, 0); PG8_STAGE(PG8_SA(1, 1), a1 + hstepA, voffA);
            PG8_WAIT_V(8); PG8_WAIT_L(0); PG8_BAR; PG8_MMA(0, 0, At, B0); PG8_MMA(0, 1, At, B1); PG8_BAR; PG8_SCHED;
            PG8_LDA(At, 0, 1); PG8_STAGE(PG8_SB(0, 0), b2, voffB); PG8_STAGE(PG8_SB(0, 1), b2 + hstepB, voffB); PG8_STAGE(PG8_SA(0, 0), a2, voffA);
            PG8_WAIT_V(8); PG8_WAIT_L(0); PG8_BAR; PG8_MMA(1, 0, At, B0); PG8_MMA(1, 1, At, B1); PG8_BAR; PG8_SCHED;
            PG8_LDB(B0, 1, 0); PG8_LDB(B1, 1, 1); PG8_SCHED; PG8_LDA(At, 1, 0); PG8_STAGE(PG8_SA(0, 1), a2 + hstepA, voffA);
            PG8_WAIT_V(8); PG8_WAIT_L(0); PG8_BAR; PG8_MMA(0, 0, At, B0); PG8_MMA(0, 1, At, B1); PG8_BAR; PG8_SCHED;
            PG8_LDA(At, 1, 1); PG8_STAGE(PG8_SB(1, 0), b3, voffB); PG8_STAGE(PG8_SB(1, 1), b3 + hstepB, voffB); PG8_STAGE(PG8_SA(1, 0), a3, voffA);
            PG8_WAIT_V(8); PG8_WAIT_L(0); PG8_BAR; PG8_MMA(1, 0, At, B0); PG8_MMA(1, 1, At, B1); PG8_BAR; PG8_SCHED;
            } else {
            PG8_LDB(B0, 0, 0); PG8_SCHED; PG8_LDA(At, 0, 0); PG8_STAGE(PG8_SA(1, 1), a1 + hstepA, voffA);
            PG8_WAIT_L(8); PG8_BAR; PG8_WAIT_L(0); PG8_MMA(0, 0, At, B0); PG8_BAR; PG8_SCHED;
            PG8_LDB(B1, 0, 1); PG8_STAGE(PG8_SB(0, 0), b2, voffB);
            PG8_BAR; PG8_WAIT_L(0); PG8_MMA(0, 1, At, B1); PG8_BAR;
            PG8_LDA(At, 0, 1); PG8_STAGE(PG8_SA(0, 0), a2, voffA);
            PG8_BAR; PG8_WAIT_L(0); PG8_MMA(1, 0, At, B0); PG8_BAR; PG8_SCHED;
            PG8_STAGE(PG8_SB(0, 1), b2 + hstepB, voffB);
            PG8_WAIT_V(6); PG8_BAR; PG8_MMA(1, 1, At, B1); PG8_BAR;
            PG8_LDB(B0, 1, 0); PG8_SCHED; PG8_LDA(At, 1, 0); PG8_STAGE(PG8_SA(0, 1), a2 + hstepA, voffA);
            PG8_WAIT_L(8); PG8_BAR; PG8_WAIT_L(0); PG8_MMA(0, 0, At, B0); PG8_BAR; PG8_SCHED;
            PG8_LDB(B1, 1, 1); PG8_STAGE(PG8_SB(1, 0), b3, voffB);
            PG8_BAR; PG8_WAIT_L(0); PG8_MMA(0, 1, At, B1); PG8_BAR;
            PG8_LDA(At, 1, 1); PG8_STAGE(PG8_SA(1, 0), a3, voffA);
            PG8_BAR; PG8_WAIT_L(0); PG8_MMA(1, 0, At, B0); PG8_BAR; PG8_SCHED;
            PG8_STAGE(PG8_SB(1, 1), b3 + hstepB, voffB);
            PG8_WAIT_V(6); PG8_BAR; PG8_MMA(1, 1, At, B1); PG8_BAR;
            }
        }
        if constexpr (ALIGN_EPI) { if (wr == 0) PG8_BAR; }
        E(acc, cur, wr, wc, fr, fq);
        if (!has_next) break;
#pragma unroll
        for (int a = 0; a < 2; ++a)
#pragma unroll
            for (int b = 0; b < 2; ++b)
#pragma unroll
                for (int m = 0; m < 4; ++m)
#pragma unroll
                    for (int n = 0; n < 2; ++n) acc[a][b][m][n] = (f32x4){0.f, 0.f, 0.f, 0.f};
        cur = nxt; cA = nA; cB = nB; ++ui;
        if constexpr (ALIGN_EPI) { if (wr == 1) PG8_BAR; }
    }
    PG8_WAIT_V(0);
    if constexpr (!ALIGN_EPI) { if (wr == 0) PG8_BAR; }
    PG8_BAR;
#undef PG8_SA
#undef PG8_SB
#undef PG8_STAGE
#undef PG8_LDA
#undef PG8_LDB
#undef PG8_MMA
#undef PG8_WAIT_V
#undef PG8_WAIT_L
#undef PG8_BAR
#undef PG8_SCHED
}
}
using pg8::Unit;

template <int MODE, int LDA_B, int LDB_B> struct Sched {
    pg8::TileOrder to; int G, c;
    const char* A0; const char* B0; const char* A1; const char* B1;
    __device__ __forceinline__ bool next(int i, Unit& u) const {
        if (MODE == 1) {
            const long L = (long)(i >> 1) * G + c; if (!to.tile(L, u.pm, u.pn)) return false;
            u.aux = i & 1;
            u.a = (u.aux ? A1 : A0) + (size_t)u.pm * 256 * LDA_B; u.b = (u.aux ? B1 : B0) + (size_t)u.pn * 256 * LDB_B; return true;
        } else {
            const long L = (long)i * G + c; if (!to.tile(L, u.pm, u.pn)) return false;
            u.aux = 0;
            if (MODE == 2) { const long r0 = (u.pm < NPT5) ? (254L * u.pm - 2) : (long)SEQ; u.a = A0 + r0 * (long)LDA_B; }
            else u.a = A0 + (size_t)u.pm * 256 * LDA_B;
            u.b = B0 + (size_t)u.pn * 256 * LDB_B; return true;
        }
    }
};

#define EPI_ARGS const f32x4 (&acc)[2][2][4][2], const Unit& u, int wr, int wc, int fr, int fq
struct EpiAda {
    static constexpr bool PERM = true;
    float* ADA; const float* bias;
    __device__ __forceinline__ void operator()(EPI_ARGS) const {
#pragma unroll
        for (int ai = 0; ai < 2; ++ai)
#pragma unroll
            for (int m = 0; m < 4; ++m) { const int row = 128 * ai + 64 * wr + 16 * m + fr;
#pragma unroll
                for (int bj = 0; bj < 2; ++bj) { const int col = 256 * u.pn + 128 * bj + 32 * wc + 8 * fq;
#pragma unroll
                    for (int n = 0; n < 2; ++n) { const f32x4 b = *(const f32x4*)(bias + col + 4 * n); *(f32x4*)(ADA + (size_t)row * NADA + col + 4 * n) = acc[ai][bj][m][n] + b; } } }
    }
};
struct EpiProj {
    static constexpr bool PERM = true;
    bf16_t *U, *BG, *Q, *KB, *VB, *GA, *GB;
    __device__ __forceinline__ void operator()(EPI_ARGS) const {
        const int row0 = u.pm * 256 + wr * 64 + fr;
        if (u.pn < 8) {
#pragma unroll
            for (int ai = 0; ai < 2; ++ai)
#pragma unroll
                for (int m = 0; m < 4; ++m) { const int row = row0 + 128 * ai + 16 * m;
                    const f32x4 v0 = acc[ai][0][m][0] * acc[ai][1][m][0], v1 = acc[ai][0][m][1] * acc[ai][1][m][1];
                    u32x4 w; w.x = cvt_pk_bf16(v0[0], v0[1]); w.y = cvt_pk_bf16(v0[2], v0[3]); w.z = cvt_pk_bf16(v1[0], v1[1]); w.w = cvt_pk_bf16(v1[2], v1[3]);
                    *(u32x4*)(U + (size_t)row * 1024 + 128 * u.pn + 32 * wc + 8 * fq) = w; }
        } else {
            bf16_t* dst; int ld, cb; const int pn = u.pn;
            if (pn < 12) { dst = BG; ld = 1024; cb = 256 * (pn - 8); }
            else if (pn < 16) { dst = Q; ld = 1024; cb = 256 * (pn - 12); }
            else if (pn == 16) { dst = KB; ld = 256; cb = 0; }
            else if (pn == 17) { dst = VB; ld = 256; cb = 0; }
            else if (pn < 22) { dst = GA; ld = 1024; cb = 256 * (pn - 18); }
            else { dst = GB; ld = 1024; cb = 256 * (pn - 22); }
#pragma unroll
            for (int ai = 0; ai < 2; ++ai)
#pragma unroll
                for (int m = 0; m < 4; ++m) { const int row = row0 + 128 * ai + 16 * m;
#pragma unroll
                    for (int bj = 0; bj < 2; ++bj) { const f32x4 v0 = acc[ai][bj][m][0], v1 = acc[ai][bj][m][1];
                        u32x4 w; w.x = cvt_pk_bf16(v0[0], v0[1]); w.y = cvt_pk_bf16(v0[2], v0[3]); w.z = cvt_pk_bf16(v1[0], v1[1]); w.w = cvt_pk_bf16(v1[2], v1[3]);
                        *(u32x4*)(dst + (size_t)row * ld + cb + 128 * bj + 32 * wc + 8 * fq) = w; } }
        }
    }
};
struct EpiMix {
    static constexpr bool PERM = true;
    const bf16_t *GA, *GB; float* T; bf16_t* Z;
    __device__ __forceinline__ void operator()(EPI_ARGS) const {
        const int row0 = u.pm * 256 + wr * 64 + fr;
        const bf16_t* gate = u.aux ? GB : GA;
#pragma unroll
        for (int ai = 0; ai < 2; ++ai)
#pragma unroll
            for (int m = 0; m < 4; ++m) { const int row = row0 + 128 * ai + 16 * m;
                if (row < MROWS) {
#pragma unroll
                for (int bj = 0; bj < 2; ++bj) { const int col = 256 * u.pn + 128 * bj + 32 * wc + 8 * fq;
                    float gv[8]; unpack8(*(const u32x4*)(gate + (size_t)row * 1024 + col), gv);
                    float o[8];
#pragma unroll
                    for (int i = 0; i < 8; ++i) o[i] = sigmoidf_(gv[i]) * acc[ai][bj][m][i >> 2][i & 3];
                    float* tp = T + (size_t)row * 1024 + col;
                    if (u.aux == 0) { *(f32x4*)tp = (f32x4){o[0], o[1], o[2], o[3]}; *(f32x4*)(tp + 4) = (f32x4){o[4], o[5], o[6], o[7]}; }
                    else { const f32x4 t0 = *(const f32x4*)tp, t1 = *(const f32x4*)(tp + 4);
                        o[0] += t0[0]; o[1] += t0[1]; o[2] += t0[2]; o[3] += t0[3]; o[4] += t1[0]; o[5] += t1[1]; o[6] += t1[2]; o[7] += t1[3];
                        *(u32x4*)(Z + (size_t)row * 1024 + col) = pack8(o); } } } }
    }
};
struct EpiRes {
    static constexpr bool PERM = true;
    const float* xp; const float* xs; float* out; const float* ADA; int goff;
    __device__ __forceinline__ void operator()(EPI_ARGS) const {
        const int row0 = u.pm * 256 + wr * 64 + fr;
#pragma unroll
        for (int ai = 0; ai < 2; ++ai)
#pragma unroll
            for (int m = 0; m < 4; ++m) { const int row = row0 + 128 * ai + 16 * m;
                if (row < MROWS) {
                const float* base = (row < SEQ) ? xp + (size_t)row * 1024 : xs + (size_t)(row - SEQ) * 1024;
                const float* gt = ADA + (size_t)((row < SEQ) ? 128 : row - SEQ) * NADA + goff;
#pragma unroll
                for (int bj = 0; bj < 2; ++bj) { const int col = 256 * u.pn + 128 * bj + 32 * wc + 8 * fq;
#pragma unroll
                    for (int n = 0; n < 2; ++n) { const f32x4 b = *(const f32x4*)(base + col + 4 * n), g = *(const f32x4*)(gt + col + 4 * n);
                        *(f32x4*)(out + (size_t)row * 1024 + col + 4 * n) = b + g * acc[ai][bj][m][n]; } } } }
    }
};
struct EpiFfn {
    static constexpr bool PERM = true;
    bf16_t* G; const float* cw; const float* cb; const float* st; float* ofp; float* ofs; PG8_LAS float* halo;
    __device__ __forceinline__ void operator()(const f32x4 (&acc)[2][2][4][2], const Unit& u, int wr, int wc, int fr_, int fq_) const {
        int oz; asm volatile("v_mov_b32 %0, 0" : "=v"(oz));
        const int fr = fr_ + oz, fq = fq_ + oz;
        const int wid = wr * 4 + wc, lane = fq * 16 + fr;
        const int f0 = 128 * u.pn + 32 * wc + 8 * fq;
        if (u.pm < NPT5) {
            if (fr >= 14) {
#pragma unroll
                for (int ai = 0; ai < 2; ++ai)
#pragma unroll
                    for (int bj = 0; bj < 2; ++bj)
#pragma unroll
                        for (int n = 0; n < 2; ++n) *(PG8_LAS f32x4*)(halo + ((wid * 2 + ai) * 2 + (fr - 14)) * 64 + bj * 32 + fq * 8 + n * 4) = acc[ai][bj][3][n];
            }
            asm volatile("s_waitcnt lgkmcnt(0)" ::: "memory"); __builtin_amdgcn_s_barrier(); asm volatile("" ::: "memory");
            const int l1 = ((fq << 4) | ((fr - 1) & 15)) << 2, l2 = ((fq << 4) | ((fr - 2) & 15)) << 2;
#define BPERM(v, a) bperm_f((v), (a))
#pragma unroll
            for (int ai = 0; ai < 2; ++ai) {
                const int swr = (ai == 0) ? 0 : (wr == 0 ? 1 : 0), sai = (ai == 1 && wr == 1) ? 1 : 0;
                const PG8_LAS float* hp = halo + (((swr * 4 + wc) * 2 + sai) * 2) * 64 + fq * 8;
#pragma unroll
                for (int n = 0; n < 2; ++n) {
                    unsigned wlo[4];
#pragma unroll
                    for (int c2 = 0; c2 < 2; ++c2) {
                        const int fg = f0 + 4 * n + 2 * c2, fv = FF + fg;
                        f32x2 cvv[4];
                        {
                            const f32x2 w0 = *(const f32x2*)(cw + fv), w1 = *(const f32x2*)(cw + FF2 + fv), w2 = *(const f32x2*)(cw + 2 * FF2 + fv), bb = *(const f32x2*)(cb + fv);
                            const f32x2 h2 = *(const PG8_LAS f32x2*)(hp + 32 + n * 4 + 2 * c2), h1 = *(const PG8_LAS f32x2*)(hp + 64 + 32 + n * 4 + 2 * c2);
                            f32x2 p1 = h1, p2 = (fr == 1) ? h1 : h2;
#pragma unroll
                            for (int m = 0; m < 4; ++m) {
                                const float xa = acc[ai][1][m][n][2 * c2], xb = acc[ai][1][m][n][2 * c2 + 1];
                                const f32x2 x = (f32x2){xa, xb}; f32x2 r1, r2;
                                r1[0] = BPERM(xa, l1); r1[1] = BPERM(xb, l1); r2[0] = BPERM(xa, l2); r2[1] = BPERM(xb, l2);
                                const f32x2 q1 = (fr >= 1) ? r1 : p1, q2 = (fr >= 2) ? r2 : p2; p1 = r1; p2 = r2;
                                cvv[m] = w0 * q2 + w1 * q1 + w2 * x + bb;
                                __builtin_amdgcn_sched_barrier(0);
                            }
                        }
                        asm volatile("" ::: "memory"); __builtin_amdgcn_sched_barrier(0);
                        {
                            const f32x2 w0 = *(const f32x2*)(cw + fg), w1 = *(const f32x2*)(cw + FF2 + fg), w2 = *(const f32x2*)(cw + 2 * FF2 + fg), bb = *(const f32x2*)(cb + fg);
                            const f32x2 h2 = *(const PG8_LAS f32x2*)(hp + n * 4 + 2 * c2), h1 = *(const PG8_LAS f32x2*)(hp + 64 + n * 4 + 2 * c2);
                            f32x2 p1 = h1, p2 = (fr == 1) ? h1 : h2;
#pragma unroll
                            for (int m = 0; m < 4; ++m) {
                                const float xa = acc[ai][0][m][n][2 * c2], xb = acc[ai][0][m][n][2 * c2 + 1];
                                const f32x2 x = (f32x2){xa, xb}; f32x2 r1, r2;
                                r1[0] = BPERM(xa, l1); r1[1] = BPERM(xb, l1); r2[0] = BPERM(xa, l2); r2[1] = BPERM(xb, l2);
                                const f32x2 q1 = (fr >= 1) ? r1 : p1, q2 = (fr >= 2) ? r2 : p2; p1 = r1; p2 = r2;
                                const f32x2 cgv = w0 * q2 + w1 * q1 + w2 * x + bb;
                                const unsigned pk = cvt_pk_bf16(siluf_(cgv[0]) * cvv[m][0], siluf_(cgv[1]) * cvv[m][1]);
                                if (c2 == 0) wlo[m] = pk;
                                else {
                                    const int tr = 128 * ai + 64 * wr + 16 * m + fr; const int grow = 254 * u.pm - 2 + tr;
                                    if (tr >= 2 && grow < SEQ) {
                                        u32x2 w; w.x = wlo[m]; w.y = pk;
                                        *(u32x2*)(G + (size_t)grow * FF + f0 + 4 * n) = w;
                                        if (grow >= SEQ - 2) { *(f32x4*)(ofp + (size_t)(grow - (SEQ - 2)) * FF2 + f0 + 4 * n) = acc[ai][0][m][n]; *(f32x4*)(ofp + (size_t)(grow - (SEQ - 2)) * FF2 + FF + f0 + 4 * n) = acc[ai][1][m][n]; }
                                    }
                                }
                                asm volatile("" ::: "memory"); __builtin_amdgcn_sched_barrier(0);
                            }
                        }
                        asm volatile("" ::: "memory"); __builtin_amdgcn_sched_barrier(0);
                    }
                }
            }
        } else {
#pragma unroll
            for (int n = 0; n < 2; ++n) {
                const int fg = f0 + 4 * n, fv = FF + fg;
#pragma unroll
                for (int m = 0; m < 4; ++m) {
                    const int b = 64 * wr + 16 * m + fr;
                    const float* s0 = st + (size_t)(b * 2) * FF2; const float* s1 = s0 + FF2;
                    float* o0 = ofs + (size_t)(b * 2) * FF2; float* o1 = o0 + FF2;
                    f32x4 cvv;
                    { const f32x4 x = acc[0][1][m][n];
                      const f32x4 w0 = *(const f32x4*)(cw + fv), w1 = *(const f32x4*)(cw + FF2 + fv), w2 = *(const f32x4*)(cw + 2 * FF2 + fv), bb = *(const f32x4*)(cb + fv);
                      const f32x4 t0 = *(const f32x4*)(s0 + fv), t1 = *(const f32x4*)(s1 + fv);
                      cvv = w0 * t0 + w1 * t1 + w2 * x + bb; *(f32x4*)(o0 + fv) = t1; *(f32x4*)(o1 + fv) = x; }
                    asm volatile("" ::: "memory"); __builtin_amdgcn_sched_barrier(0);
                    { const f32x4 x = acc[0][0][m][n];
                      const f32x4 w0 = *(const f32x4*)(cw + fg), w1 = *(const f32x4*)(cw + FF2 + fg), w2 = *(const f32x4*)(cw + 2 * FF2 + fg), bb = *(const f32x4*)(cb + fg);
                      const f32x4 t0 = *(const f32x4*)(s0 + fg), t1 = *(const f32x4*)(s1 + fg);
                      const f32x4 cgv = w0 * t0 + w1 * t1 + w2 * x + bb; *(f32x4*)(o0 + fg) = t1; *(f32x4*)(o1 + fg) = x;
                      u32x2 w; w.x = cvt_pk_bf16(siluf_(cgv[0]) * cvv[0], siluf_(cgv[1]) * cvv[1]); w.y = cvt_pk_bf16(siluf_(cgv[2]) * cvv[2], siluf_(cgv[3]) * cvv[3]);
                      *(u32x2*)(G + (size_t)(SEQ + b) * FF + fg) = w; }
                    asm volatile("" ::: "memory"); __builtin_amdgcn_sched_barrier(0);
                }
            }
        }
    }
};

__device__ __forceinline__ void transpose_item(const float* W, int K, int N, bf16_t* WT, int k0, int n0, int drow0, float* scr, int lane) {
#pragma unroll 8
    for (int i = 0; i < 32; ++i) { const int kk = 2 * i + (lane >> 5); scr[kk * 33 + (lane & 31)] = W[(size_t)(k0 + kk) * N + n0 + (lane & 31)]; }
    asm volatile("s_waitcnt lgkmcnt(0)" ::: "memory");
    const int c = lane & 7;
#pragma unroll
    for (int j = 0; j < 4; ++j) { const int n = (lane >> 3) + 8 * j; const float* s = scr + (8 * c) * 33 + n;
        u32x4 o; o.x = cvt_pk_bf16(s[0 * 33], s[1 * 33]); o.y = cvt_pk_bf16(s[2 * 33], s[3 * 33]); o.z = cvt_pk_bf16(s[4 * 33], s[5 * 33]); o.w = cvt_pk_bf16(s[6 * 33], s[7 * 33]);
        *(u32x4*)(WT + (size_t)(drow0 + n) * K + k0 + 8 * c) = o; }
    asm volatile("s_waitcnt lgkmcnt(0)" ::: "memory");
}
__device__ __forceinline__ int win_drow(int n) {
    if (n < 1024) return 256 * (n >> 7) + (n & 127);
    if (n < 2048) return 2048 + (n - 1024);
    if (n < 3072) { const int f = n - 2048; return 256 * (f >> 7) + 128 + (f & 127); }
    return n;
}
__device__ __forceinline__ int wup_drow(int n) { const int f = (n < FF) ? n : n - FF; return 256 * (f >> 7) + ((n < FF) ? 0 : 128) + (f & 127); }

__device__ __forceinline__ void modnorm_row(const float* xrow, const float* g, const float* sc, const float* sh, bf16_t* orow, int lane) {
    f32x4 v[4]; float s = 0.f;
#pragma unroll
    for (int j = 0; j < 4; ++j) { v[j] = ((const f32x4*)xrow)[lane + 64 * j]; s += (v[j][0] * v[j][0] + v[j][1] * v[j][1]) + (v[j][2] * v[j][2] + v[j][3] * v[j][3]); }
    const float rstd = rsqrtf(wave_sum(s) * (1.0f / 1024.0f) + EPS);
#pragma unroll
    for (int j = 0; j < 4; ++j) { const int col = 4 * (lane + 64 * j);
        const f32x4 gg = *(const f32x4*)(g + col), ss = *(const f32x4*)(sc + col), hh = *(const f32x4*)(sh + col);
        const f32x4 o = v[j] * rstd * gg * (ss + 1.0f) + hh;
        u32x2 w; w.x = cvt_pk_bf16(o[0], o[1]); w.y = cvt_pk_bf16(o[2], o[3]); *(u32x2*)(orow + col) = w; }
}

__device__ __forceinline__ void attn_prompt_unit(unsigned char* lds, bf16_t* Q, const bf16_t* KB, const bf16_t* VB, const float* sinks, int j, int g, int tid) {
    bf16_t* Ks = (bf16_t*)lds;
    bf16_t* Vt = (bf16_t*)(lds + 36864);
    for (int c = tid; c < 2048; c += 512) {
        const int s = c >> 3, ch = c & 7; const int tok = 128 * (j - 1) + s;
        u32x4 kv = (u32x4){0u, 0u, 0u, 0u}, vv = (u32x4){0u, 0u, 0u, 0u};
        if (tok >= 0) { kv = *(const u32x4*)(KB + (size_t)tok * 256 + 64 * g + 8 * ch); vv = *(const u32x4*)(VB + (size_t)tok * 256 + 64 * g + 8 * ch); }
        *(u32x4*)(Ks + s * 72 + 8 * ch) = kv;
        bf16_t* vd = Vt + (8 * ch) * 264 + s;
        vd[0 * 264] = (bf16_t)(vv.x & 0xffffu); vd[1 * 264] = (bf16_t)(vv.x >> 16); vd[2 * 264] = (bf16_t)(vv.y & 0xffffu); vd[3 * 264] = (bf16_t)(vv.y >> 16);
        vd[4 * 264] = (bf16_t)(vv.z & 0xffffu); vd[5 * 264] = (bf16_t)(vv.z >> 16); vd[6 * 264] = (bf16_t)(vv.w & 0xffffu); vd[7 * 264] = (bf16_t)(vv.w >> 16);
    }
    __syncthreads();
    const int wave = tid >> 6, lane = tid & 63, ql = lane & 31, hi = lane >> 5;
    for (int tt = 0; tt < 2; ++tt) {
        const int t = wave * 2 + tt, hq = t >> 2, qg = t & 3, head = 4 * g + hq;
        bf16_t* qp = Q + (size_t)(128 * j + 32 * qg + ql) * 1024 + head * 64;
        bf16x8 qf[4];
#pragma unroll
        for (int d0 = 0; d0 < 4; ++d0) qf[d0] = *(const bf16x8*)(qp + 16 * d0 + 8 * hi);
        f32x16 p[5];
#pragma unroll
        for (int kt = 0; kt < 5; ++kt) {
#pragma unroll
            for (int r = 0; r < 16; ++r) p[kt][r] = 0.f;
#pragma unroll
            for (int d0 = 0; d0 < 4; ++d0) { const bf16x8 kf = *(const bf16x8*)(Ks + (32 * qg + 32 * kt + ql) * 72 + 16 * d0 + 8 * hi);
                p[kt] = __builtin_amdgcn_mfma_f32_32x32x16_bf16(kf, qf[d0], p[kt], 0, 0, 0); }
        }
        const float sink = sinks[head];
        float mx = -INFINITY;
#pragma unroll
        for (int kt = 0; kt < 5; ++kt)
#pragma unroll
            for (int r = 0; r < 16; ++r) { const int kk = (r & 3) + 8 * (r >> 2) + 4 * hi; bool valid = true;
                if (kt == 0) valid = kk >= ql; if (kt == 4) valid = kk <= ql; if (j == 0) valid = valid && (32 * qg + 32 * kt + kk >= 128);
                const float v = valid ? p[kt][r] * 0.125f : -INFINITY; p[kt][r] = v; mx = fmaxf(mx, v); }
        mx = fmaxf(mx, __shfl_xor(mx, 32)); mx = fmaxf(mx, sink);
        float l = 0.f;
#pragma unroll
        for (int kt = 0; kt < 5; ++kt)
#pragma unroll
            for (int r = 0; r < 16; ++r) { const float e = __expf(p[kt][r] - mx); p[kt][r] = e; l += e; }
        l += __shfl_xor(l, 32);
        const float inv = 1.0f / (l + __expf(sink - mx));
        f32x16 o0, o1;
#pragma unroll
        for (int r = 0; r < 16; ++r) { o0[r] = 0.f; o1[r] = 0.f; }
#pragma unroll
        for (int kt = 0; kt < 5; ++kt)
#pragma unroll
            for (int hf = 0; hf < 2; ++hf) {
                u32x4 pw; pw.x = cvt_pk_bf16(p[kt][8 * hf + 0], p[kt][8 * hf + 1]); pw.y = cvt_pk_bf16(p[kt][8 * hf + 2], p[kt][8 * hf + 3]);
                pw.z = cvt_pk_bf16(p[kt][8 * hf + 4], p[kt][8 * hf + 5]); pw.w = cvt_pk_bf16(p[kt][8 * hf + 6], p[kt][8 * hf + 7]);
                const bf16x8 pf = __builtin_bit_cast(bf16x8, pw);
                const int sk = 32 * qg + 32 * kt + 16 * hf + 4 * hi;
                { const bf16_t* vp = Vt + ql * 264 + sk; const u32x2 a = *(const u32x2*)vp, b = *(const u32x2*)(vp + 8);
                  const bf16x8 vf = __builtin_bit_cast(bf16x8, ((u32x4){a.x, a.y, b.x, b.y})); o0 = __builtin_amdgcn_mfma_f32_32x32x16_bf16(vf, pf, o0, 0, 0, 0); }
                { const bf16_t* vp = Vt + (32 + ql) * 264 + sk; const u32x2 a = *(const u32x2*)vp, b = *(const u32x2*)(vp + 8);
                  const bf16x8 vf = __builtin_bit_cast(bf16x8, ((u32x4){a.x, a.y, b.x, b.y})); o1 = __builtin_amdgcn_mfma_f32_32x32x16_bf16(vf, pf, o1, 0, 0, 0); }
            }
#pragma unroll
        for (int c4 = 0; c4 < 4; ++c4) {
            u32x2 w0, w1;
            w0.x = cvt_pk_bf16(o0[4 * c4 + 0] * inv, o0[4 * c4 + 1] * inv); w0.y = cvt_pk_bf16(o0[4 * c4 + 2] * inv, o0[4 * c4 + 3] * inv);
            w1.x = cvt_pk_bf16(o1[4 * c4 + 0] * inv, o1[4 * c4 + 1] * inv); w1.y = cvt_pk_bf16(o1[4 * c4 + 2] * inv, o1[4 * c4 + 3] * inv);
            *(u32x2*)(qp + 8 * c4 + 4 * hi) = w0; *(u32x2*)(qp + 32 + 8 * c4 + 4 * hi) = w1;
        }
    }
    __syncthreads();
}
__device__ __forceinline__ void attn_sample_task(float* wl, bf16_t* Q, const bf16_t* KB, const bf16_t* VB, const float* ck, const float* cv, const float* sinks, int b, int g, int lane) {
    float* qs = wl; float* pp = wl + 256;
    bf16_t* qrow = Q + (size_t)(SEQ + b) * 1024 + 4 * g * 64;
#pragma unroll
    for (int h = 0; h < 4; ++h) qs[h * 64 + lane] = bf2f(qrow[h * 64 + lane]) * 0.125f;
    const float knew = bf2f(KB[(size_t)(SEQ + b) * 256 + 64 * g + lane]), vnew = bf2f(VB[(size_t)(SEQ + b) * 256 + 64 * g + lane]);
    asm volatile("s_waitcnt lgkmcnt(0)" ::: "memory");
    float sc[2][4];
#pragma unroll
    for (int kk = 0; kk < 2; ++kk) { const int s = lane + 64 * kk; const f32x4* kp = (const f32x4*)(ck + ((size_t)(b * 128 + s) * 4 + g) * 64);
        float a0 = 0.f, a1 = 0.f, a2 = 0.f, a3 = 0.f;
#pragma unroll 4
        for (int c = 0; c < 16; ++c) { const f32x4 kv = kp[c];
            const f32x4 q0 = *(const f32x4*)(qs + 4 * c), q1 = *(const f32x4*)(qs + 64 + 4 * c), q2 = *(const f32x4*)(qs + 128 + 4 * c), q3 = *(const f32x4*)(qs + 192 + 4 * c);
            a0 += kv[0] * q0[0] + kv[1] * q0[1] + kv[2] * q0[2] + kv[3] * q0[3]; a1 += kv[0] * q1[0] + kv[1] * q1[1] + kv[2] * q1[2] + kv[3] * q1[3];
            a2 += kv[0] * q2[0] + kv[1] * q2[1] + kv[2] * q2[2] + kv[3] * q2[3]; a3 += kv[0] * q3[0] + kv[1] * q3[1] + kv[2] * q3[2] + kv[3] * q3[3]; }
        sc[kk][0] = a0; sc[kk][1] = a1; sc[kk][2] = a2; sc[kk][3] = a3; }
#pragma unroll
    for (int h = 0; h < 4; ++h) {
        const float sn = wave_sum(qs[h * 64 + lane] * knew), sink = sinks[4 * g + h];
        float m = wave_max(fmaxf(sc[0][h], sc[1][h])); m = fmaxf(fmaxf(m, sn), sink);
        const float e0 = __expf(sc[0][h] - m), e1 = __expf(sc[1][h] - m), en = __expf(sn - m);
        const float inv = 1.0f / (wave_sum(e0 + e1) + en + __expf(sink - m));
        pp[lane * 4 + h] = e0 * inv; pp[(64 + lane) * 4 + h] = e1 * inv; if (lane == 0) pp[512 + h] = en * inv;
    }
    asm volatile("s_waitcnt lgkmcnt(0)" ::: "memory");
    float o0 = 0.f, o1 = 0.f, o2 = 0.f, o3 = 0.f;
    const float* vp = cv + ((size_t)(b * 128) * 4 + g) * 64 + lane;
#pragma unroll 8
    for (int s = 0; s < 128; ++s) { const float v = vp[(size_t)s * 256]; const f32x4 pv = *(const f32x4*)(pp + 4 * s); o0 += pv[0] * v; o1 += pv[1] * v; o2 += pv[2] * v; o3 += pv[3] * v; }
    { const f32x4 pv = *(const f32x4*)(pp + 512); o0 += pv[0] * vnew; o1 += pv[1] * vnew; o2 += pv[2] * vnew; o3 += pv[3] * vnew; }
    qrow[lane] = (bf16_t)(cvt_pk_bf16(o0, 0.f) & 0xffffu); qrow[64 + lane] = (bf16_t)(cvt_pk_bf16(o1, 0.f) & 0xffffu);
    qrow[128 + lane] = (bf16_t)(cvt_pk_bf16(o2, 0.f) & 0xffffu); qrow[192 + lane] = (bf16_t)(cvt_pk_bf16(o3, 0.f) & 0xffffu);
    asm volatile("s_waitcnt lgkmcnt(0)" ::: "memory");
}


#if SELFCHECK
constexpr size_t WS_CHK = 512 * 1024;
__device__ __forceinline__ unsigned hsh(unsigned x) { x ^= x >> 16; x *= 0x7feb352du; x ^= x >> 15; x *= 0x846ca68bu; x ^= x >> 16; return x; }
__device__ __forceinline__ int samp_row(int s) {
    if ((s & 3) == 0) { switch ((s >> 2) & 7) { case 0: return 0; case 1: return 1; case 2: return 255; case 3: return 256; case 4: return SEQ - 1; case 5: return SEQ; case 6: return SEQ + 100; default: return 8191; } }
    if ((s & 3) == 1) return SEQ + (int)(hsh(s) % NS);
    return (int)(hsh(s * 3 + 1) % SEQ);
}
__device__ __forceinline__ bool chk_bad(float got, float ref) { return !(fabsf(got - ref) <= 0.05f * fabsf(ref) + 0.04f); }
__device__ __forceinline__ float wdot_bf(const bf16_t* a, const float* W, int ldw, int col, int K, int lane) {
    float s = 0.f; for (int k = lane; k < K; k += 64) s += bf2f(a[k]) * W[(size_t)k * ldw + col]; return wave_sum(s); }
#define CHK_FAIL(bit) do { if (lane == 0) atomicOr(mask, 1u << (bit)); } while (0)
#endif
struct Args { const float* in[23]; float* out; unsigned char* ws; };
enum { I_XP = 0, I_XS, I_CP, I_CS, I_SCA, I_CK, I_CV, I_SFF, I_WADA, I_BADA, I_GMIX, I_WIN, I_CAW, I_SINK, I_WAO, I_WBO, I_WO, I_GFFN, I_WUP, I_FCW, I_FCB, I_WDN, I_GFIN };

__global__ void __launch_bounds__(512, 2) mega(Args a) {
    extern __shared__ __attribute__((aligned(16))) unsigned char lds[];
    PG8_LAS unsigned char* ldsl = (PG8_LAS unsigned char*)lds;
    const int G = gridDim.x, bid = blockIdx.x, NGW = G * 8;
    const int wave0 = __builtin_amdgcn_readfirstlane((int)threadIdx.x >> 6);
    const long NGT = (long)G * 512;
#define PHASE_IDS() int tid = wave0 * 64 + (int)__builtin_amdgcn_mbcnt_hi(~0u, __builtin_amdgcn_mbcnt_lo(~0u, 0u)); asm volatile("" : "+v"(tid)); const int lane = tid & 63, wave = wave0; \
    const int gw = bid * 8 + wave; const long gt = (long)bid * 512 + tid; float* const scr = (float*)(lds + wave * 16384); (void)lane; (void)gw; (void)gt; (void)scr;
    typedef const __attribute__((address_space(4))) Args* KArgs;
    const KArgs ap0 = (KArgs)__builtin_amdgcn_kernarg_segment_ptr();
#define ARGS() ({ KArgs p_ = ap0; asm volatile("" : "+s"(p_)); p_; })
#define IN(i) (ARGS()->in[i])
#define WS(off) (ARGS()->ws + (off))
#define OUT() (ARGS()->out)
#define AADA ((bf16_t*)WS(WS_AADA))
#define ADA ((float*)WS(WS_ADA))
#define WA ((bf16_t*)WS(WS_WA))
#define WB ((bf16_t*)WS(WS_WB))
#define WO ((bf16_t*)WS(WS_WO))
#define WADA ((bf16_t*)WS(WS_WADA))
#define WIN ((bf16_t*)WS(WS_WIN))
#define WUP ((bf16_t*)WS(WS_WUP))
#define WDN ((bf16_t*)WS(WS_WDN))
#define H ((bf16_t*)WS(WS_H))
#define U ((bf16_t*)WS(WS_U))
#define BG ((bf16_t*)WS(WS_BG))
#define Q ((bf16_t*)WS(WS_Q))
#define KB ((bf16_t*)WS(WS_KB))
#define VB ((bf16_t*)WS(WS_VB))
#define GA ((bf16_t*)WS(WS_GA))
#define GB ((bf16_t*)WS(WS_GB))
#define GG ((bf16_t*)WS(WS_G))
#define AIN H
#define Z U
#define H2 BG

    {
        PHASE_IDS();
#if SELFCHECK
        if (gt == 0) *(unsigned*)WS(WS_CHK) = 0u;
#endif
        constexpr int I_ADA = 16 * (NADA / 32), I_IN = 16 * (NIN / 32), I_SQ = 16 * 32;
        constexpr int NIT = I_ADA + I_IN + 3 * I_SQ;
        for (int it = gw; it < NIT; it += NGW) {
            int r = it;
            if (r < I_ADA) { const int nb = NADA / 32, kb = r / nb, n0 = 32 * (r % nb); transpose_item(IN(I_WADA), 1024, NADA, WADA, 64 * kb, n0, n0, scr, lane); continue; } r -= I_ADA;
            if (r < I_IN) { const int nb = NIN / 32, kb = r / nb, n0 = 32 * (r % nb); transpose_item(IN(I_WIN), 1024, NIN, WIN, 64 * kb, n0, win_drow(n0), scr, lane); continue; } r -= I_IN;
            const int which = r / I_SQ; r -= which * I_SQ; const int kb = r / 32, n0 = 32 * (r % 32);
            transpose_item(which == 0 ? IN(I_WAO) : (which == 1 ? IN(I_WBO) : IN(I_WO)), 1024, 1024, which == 0 ? WA : (which == 1 ? WB : WO), 64 * kb, n0, n0, scr, lane);
        }
        const float* const cs = IN(I_CS); const float* const cp = IN(I_CP); bf16_t* const aada = AADA;
        for (long i = gt; i < 256 * 1024 / 4; i += NGT) { const int row = (int)(i >> 8), c4 = (int)(i & 255) * 4;
            f32x4 v = (f32x4){0.f, 0.f, 0.f, 0.f};
            if (row < 128) v = *(const f32x4*)(cs + (size_t)row * 1024 + c4); else if (row == 128) v = *(const f32x4*)(cp + c4);
            u32x2 w; w.x = cvt_pk_bf16(siluf_(v[0]), siluf_(v[1])); w.y = cvt_pk_bf16(siluf_(v[2]), siluf_(v[3])); *(u32x2*)(aada + (size_t)row * 1024 + c4) = w; }
    }
    cg::this_grid().sync();
    {
        typedef Sched<0, 2048, 2048> SC; SC S; S.to.init(1, NADA / 256); S.G = G; S.c = bid; S.A0 = (const char*)AADA; S.B0 = (const char*)WADA;
        EpiAda E{ADA, IN(I_BADA)};
        pg8::gemm_phase<EpiAda, SC, 1024, 1024, 1024, true, true>(ldsl, wave0, S, E);
    }
#if SELFCHECK
    cg::this_grid().sync();
    if (bid == 0) { PHASE_IDS(); unsigned* mask = (unsigned*)WS(WS_CHK); (void)tid;
        for (int sm = wave; sm < 32; sm += 8) {
            const int r = (int)(hsh(sm) % 129u), n = (int)(hsh(sm + 77) % NADA);
            const float* c = (r < 128) ? IN(I_CS) + (size_t)r * 1024 : IN(I_CP); const float* W = IN(I_WADA);
            float a = 0.f; for (int k = lane; k < 1024; k += 64) a += siluf_(c[k]) * W[(size_t)k * NADA + n];
            const float ref = wave_sum(a) + IN(I_BADA)[n];
            if (chk_bad(ADA[(size_t)r * NADA + n], ref)) CHK_FAIL(0);
        }
    }
#endif
    cg::this_grid().sync();
    {
        PHASE_IDS();
        const float* const xp = IN(I_XP); const float* const xs = IN(I_XS); const float* const gm = IN(I_GMIX); const float* const ada = ADA; bf16_t* const h = H;
        for (int row = gw; row < MROWS; row += NGW) {
            const float* xr = (row < SEQ) ? xp + (size_t)row * 1024 : xs + (size_t)(row - SEQ) * 1024;
            const float* ad = ada + (size_t)((row < SEQ) ? 128 : row - SEQ) * NADA;
            modnorm_row(xr, gm, ad + 1024, ad, h + (size_t)row * 1024, lane);
        }
    }
#if SELFCHECK
    cg::this_grid().sync();
    if (bid == 0) { PHASE_IDS(); unsigned* mask = (unsigned*)WS(WS_CHK); (void)tid;
        for (int sm = wave; sm < 32; sm += 8) {
            const int row = samp_row(sm), col = (int)(hsh(sm + 5) % 1024u), ar = (row < SEQ) ? 128 : row - SEQ;
            const float* xr = (row < SEQ) ? IN(I_XP) + (size_t)row * 1024 : IN(I_XS) + (size_t)(row - SEQ) * 1024;
            float a = 0.f; for (int k = lane; k < 1024; k += 64) a += xr[k] * xr[k];
            const float rstd = rsqrtf(wave_sum(a) * (1.f / 1024.f) + EPS); const float* ad = ADA + (size_t)ar * NADA;
            const float ref = xr[col] * rstd * IN(I_GMIX)[col] * (1.f + ad[1024 + col]) + ad[col];
            if (chk_bad(bf2f(H[(size_t)row * 1024 + col]), ref)) CHK_FAIL(1);
        }
    }
#endif
    cg::this_grid().sync();
    {
        typedef Sched<0, 2048, 2048> SC; SC S; S.to.init(NMT, NIN / 256); S.G = G; S.c = bid; S.A0 = (const char*)H; S.B0 = (const char*)WIN;
        EpiProj E{U, BG, Q, KB, VB, GA, GB};
        pg8::gemm_phase<EpiProj, SC, 1024, 1024, 1024, true, true>(ldsl, wave0, S, E);
    }
#if SELFCHECK
    cg::this_grid().sync();
    if (bid == 0) { PHASE_IDS(); unsigned* mask = (unsigned*)WS(WS_CHK); (void)tid;
        for (int sm = wave; sm < 32; sm += 8) {
            const int row = samp_row(sm), f = (int)(hsh(sm + 9) % 1024u); const bf16_t* hr = H + (size_t)row * 1024; const float* W = IN(I_WIN);
            { const float ref = wdot_bf(hr, W, NIN, f, 1024, lane) * wdot_bf(hr, W, NIN, 2048 + f, 1024, lane); if (chk_bad(bf2f(U[(size_t)row * 1024 + f]), ref)) CHK_FAIL(2); }
            { const float r1 = wdot_bf(hr, W, NIN, 1024 + f, 1024, lane), r2 = wdot_bf(hr, W, NIN, 3072 + f, 1024, lane);
              if (chk_bad(bf2f(BG[(size_t)row * 1024 + f]), r1) || chk_bad(bf2f(Q[(size_t)row * 1024 + f]), r2)) CHK_FAIL(3); }
            { const int f2 = f & 255; const float r1 = wdot_bf(hr, W, NIN, 4096 + f2, 1024, lane), r2 = wdot_bf(hr, W, NIN, 4352 + f2, 1024, lane);
              if (chk_bad(bf2f(KB[(size_t)row * 256 + f2]), r1) || chk_bad(bf2f(VB[(size_t)row * 256 + f2]), r2)) CHK_FAIL(4); }
            { const float r1 = wdot_bf(hr, W, NIN, 4608 + f, 1024, lane), r2 = wdot_bf(hr, W, NIN, 5632 + f, 1024, lane);
              if (chk_bad(bf2f(GA[(size_t)row * 1024 + f]), r1) || chk_bad(bf2f(GB[(size_t)row * 1024 + f]), r2)) CHK_FAIL(5); }
            { const int head = (int)(hsh(sm + 21) % 16u); ((float*)WS(WS_CHK + 4096))[sm * 64 + lane] = bf2f(Q[(size_t)row * 1024 + head * 64 + lane]); }
        }
    }
#endif
    cg::this_grid().sync();
    {
        PHASE_IDS();
        {   bf16_t* const q_ = Q; const bf16_t* const kb_ = KB; const bf16_t* const vb_ = VB; const float* const sinks = IN(I_SINK);
            for (int un = bid; un < 512; un += G) attn_prompt_unit(lds, q_, kb_, vb_, sinks, un >> 2, un & 3, tid); }
        {   bf16_t* const q_ = Q; const bf16_t* const kb_ = KB; const bf16_t* const vb_ = VB; const float* const sinks = IN(I_SINK);
            const float* const ck_ = IN(I_CK); const float* const cv_ = IN(I_CV);
            float* wl = (float*)(lds + 73728 + wave * 4096);
            for (int t = gw; t < 512; t += NGW) attn_sample_task(wl, q_, kb_, vb_, ck_, cv_, sinks, t >> 2, t & 3, lane); }
        {
        float* const out = OUT();
        const float* caw = IN(I_CAW); const float* sca = IN(I_SCA); const bf16_t* const u_ = U; const bf16_t* const bg_ = BG; bf16_t* const ain_ = AIN;
        for (long it = gt; it < (long)MROWS * 128; it += NGT) {
            const int row = (int)(it >> 7), c8 = (int)(it & 127) * 8;
            float w0[8], w1[8], w2[8], u0[8], u1[8], u2[8], bg[8], o[8];
            *(f32x4*)w0 = *(const f32x4*)(caw + c8); *(f32x4*)(w0 + 4) = *(const f32x4*)(caw + c8 + 4);
            *(f32x4*)w1 = *(const f32x4*)(caw + 1024 + c8); *(f32x4*)(w1 + 4) = *(const f32x4*)(caw + 1024 + c8 + 4);
            *(f32x4*)w2 = *(const f32x4*)(caw + 2048 + c8); *(f32x4*)(w2 + 4) = *(const f32x4*)(caw + 2048 + c8 + 4);
            unpack8(*(const u32x4*)(u_ + (size_t)row * 1024 + c8), u2);
            unpack8(*(const u32x4*)(bg_ + (size_t)row * 1024 + c8), bg);
            if (row < SEQ) {
                if (row >= 1) unpack8(*(const u32x4*)(u_ + (size_t)(row - 1) * 1024 + c8), u1); else { for (int i = 0; i < 8; ++i) u1[i] = 0.f; }
                if (row >= 2) unpack8(*(const u32x4*)(u_ + (size_t)(row - 2) * 1024 + c8), u0); else { for (int i = 0; i < 8; ++i) u0[i] = 0.f; }
                if (row >= SEQ - 2) { float* op = out + O_CAP + (size_t)(row - (SEQ - 2)) * 1024 + c8; *(f32x4*)op = *(f32x4*)u2; *(f32x4*)(op + 4) = *(f32x4*)(u2 + 4); }
            } else {
                const int b = row - SEQ; const float* s0 = sca + (size_t)(b * 2) * 1024 + c8; const float* s1 = s0 + 1024;
                *(f32x4*)u0 = *(const f32x4*)s0; *(f32x4*)(u0 + 4) = *(const f32x4*)(s0 + 4); *(f32x4*)u1 = *(const f32x4*)s1; *(f32x4*)(u1 + 4) = *(const f32x4*)(s1 + 4);
                float* op = out + O_CAS + (size_t)(b * 2) * 1024 + c8;
                *(f32x4*)op = *(f32x4*)u1; *(f32x4*)(op + 4) = *(f32x4*)(u1 + 4); *(f32x4*)(op + 1024) = *(f32x4*)u2; *(f32x4*)(op + 1024 + 4) = *(f32x4*)(u2 + 4);
            }
#pragma unroll
            for (int i = 0; i < 8; ++i) o[i] = bg[i] * (w0[i] * u0[i] + w1[i] * u1[i] + w2[i] * u2[i]);
            *(u32x4*)(ain_ + (size_t)row * 1024 + c8) = pack8(o);
        }
        }
        {
        float* const out = OUT(); const float* const ck_ = IN(I_CK); const float* const cv_ = IN(I_CV); const bf16_t* const kb_ = KB; const bf16_t* const vb_ = VB;
        for (long i = gt; i < 2L * 128 * 128 * 64; i += NGT) {
            const int which = (int)(i >> 20); const int r2 = (int)(i & 1048575); const int b = r2 >> 13, r = (r2 >> 6) & 127, c = r2 & 63;
            const float* cache = which ? cv_ : ck_; const bf16_t* nb = which ? vb_ : kb_;
            f32x4 v;
            if (r < 127) v = *(const f32x4*)(cache + ((size_t)(b * 128 + r + 1) * 256 + 4 * c));
            else { const u32x2 w = *(const u32x2*)(nb + (size_t)(SEQ + b) * 256 + 4 * c); v = (f32x4){bf2f(w.x & 0xffffu), bf2f(w.x >> 16), bf2f(w.y & 0xffffu), bf2f(w.y >> 16)}; }
            *(f32x4*)(out + (which ? O_VS : O_KS) + (size_t)r2 * 4) = v;
        }
        for (long i = gt; i < 2L * 128 * 64; i += NGT) {
            const int which = (int)(i >> 13); const int r2 = (int)(i & 8191); const int r = r2 >> 6, c = r2 & 63; const bf16_t* nb = which ? vb_ : kb_;
            const u32x2 w = *(const u32x2*)(nb + (size_t)(SEQ - 128 + r) * 256 + 4 * c);
            *(f32x4*)(out + (which ? O_VP : O_KP) + (size_t)r2 * 4) = (f32x4){bf2f(w.x & 0xffffu), bf2f(w.x >> 16), bf2f(w.y & 0xffffu), bf2f(w.y >> 16)};
        }
        }
        __syncthreads();
        constexpr int I_UP = 16 * (FF2 / 32), I_DN = (FF / 64) * 32;
        for (int it = gw; it < I_UP + I_DN; it += NGW) {
            if (it < I_UP) { const int nb = FF2 / 32, kb = it / nb, n0 = 32 * (it % nb); transpose_item(IN(I_WUP), 1024, FF2, WUP, 64 * kb, n0, wup_drow(n0), scr, lane); }
            else { const int r = it - I_UP, kb = r / 32, n0 = 32 * (r % 32); transpose_item(IN(I_WDN), FF, 1024, WDN, 64 * kb, n0, n0, scr, lane); }
        }
    }
#if SELFCHECK
    cg::this_grid().sync();
    if (bid == 0) { PHASE_IDS(); unsigned* mask = (unsigned*)WS(WS_CHK); (void)tid;
        for (int sm = wave; sm < 32; sm += 8) {
            const int row = samp_row(sm), f = (int)(hsh(sm + 9) % 1024u);
            {   const float* cw_ = IN(I_CAW); float u0, u1; const float u2 = bf2f(U[(size_t)row * 1024 + f]);
                if (row < SEQ) { u1 = (row >= 1) ? bf2f(U[(size_t)(row - 1) * 1024 + f]) : 0.f; u0 = (row >= 2) ? bf2f(U[(size_t)(row - 2) * 1024 + f]) : 0.f; }
                else { const float* st = IN(I_SCA) + (size_t)((row - SEQ) * 2) * 1024; u0 = st[f]; u1 = st[1024 + f]; }
                const float ref = bf2f(BG[(size_t)row * 1024 + f]) * (cw_[f] * u0 + cw_[1024 + f] * u1 + cw_[2048 + f] * u2);
                if (chk_bad(bf2f(AIN[(size_t)row * 1024 + f]), ref)) CHK_FAIL(6); }
            {   const int head = (int)(hsh(sm + 21) % 16u), g = head >> 2; const float qv = ((const float*)WS(WS_CHK + 4096))[sm * 64 + lane] * 0.125f;
                const float sink = IN(I_SINK)[head]; const int nk = 129;
                float mx = sink, l = 0.f, o = 0.f;
                for (int pass = 0; pass < 2; ++pass)
                    for (int i = 0; i < nk; ++i) {
                        float kv, vv; bool ok = true;
                        if (row < SEQ) { const int tk = row - 128 + i; ok = tk >= 0; kv = ok ? bf2f(KB[(size_t)tk * 256 + g * 64 + lane]) : 0.f; vv = ok ? bf2f(VB[(size_t)tk * 256 + g * 64 + lane]) : 0.f; }
                        else { const int b = row - SEQ; if (i < 128) { kv = IN(I_CK)[((size_t)(b * 128 + i) * 4 + g) * 64 + lane]; vv = IN(I_CV)[((size_t)(b * 128 + i) * 4 + g) * 64 + lane]; }
                               else { kv = bf2f(KB[(size_t)row * 256 + g * 64 + lane]); vv = bf2f(VB[(size_t)row * 256 + g * 64 + lane]); } }
                        const float sc = wave_sum(qv * kv);
                        if (ok) { if (pass == 0) mx = fmaxf(mx, sc); else { const float e = __expf(sc - mx); l += e; o += e * vv; } }
                    }
                const float ref = o / (l + __expf(sink - mx));
                if (chk_bad(bf2f(Q[(size_t)row * 1024 + head * 64 + lane]), ref)) { if (__ballot(1)) { if (lane == 0 || true) atomicOr(mask, 1u << 7); } } }
        }
    }
#endif
    cg::this_grid().sync();
    {
        typedef Sched<1, 2048, 2048> SC; SC S; S.to.init(NMT, 4); S.G = G; S.c = bid; S.A0 = (const char*)AIN; S.B0 = (const char*)WA; S.A1 = (const char*)Q; S.B1 = (const char*)WB;
        EpiMix E{GA, GB, OUT(), Z};
        pg8::gemm_phase<EpiMix, SC, 1024, 1024, 1024, true, true>(ldsl, wave0, S, E);
    }
#if SELFCHECK
    cg::this_grid().sync();
    if (bid == 0) { PHASE_IDS(); unsigned* mask = (unsigned*)WS(WS_CHK); (void)tid;
        for (int sm = wave; sm < 32; sm += 8) {
            const int row = samp_row(sm), f = (int)(hsh(sm + 9) % 1024u);
            const float ya = wdot_bf(AIN + (size_t)row * 1024, IN(I_WAO), 1024, f, 1024, lane), yb = wdot_bf(Q + (size_t)row * 1024, IN(I_WBO), 1024, f, 1024, lane);
            const float ref = sigmoidf_(bf2f(GA[(size_t)row * 1024 + f])) * ya + sigmoidf_(bf2f(GB[(size_t)row * 1024 + f])) * yb;
            if (chk_bad(bf2f(Z[(size_t)row * 1024 + f]), ref)) CHK_FAIL(8);
        }
    }
#endif
    cg::this_grid().sync();
    {
        typedef Sched<0, 2048, 2048> SC; SC S; S.to.init(NMT, 4); S.G = G; S.c = bid; S.A0 = (const char*)Z; S.B0 = (const char*)WO;
        EpiRes E{IN(I_XP), IN(I_XS), OUT(), ADA, 2048};
        pg8::gemm_phase<EpiRes, SC, 1024, 1024, 1024, true, true>(ldsl, wave0, S, E);
    }
#if SELFCHECK
    cg::this_grid().sync();
    if (bid == 0) { PHASE_IDS(); unsigned* mask = (unsigned*)WS(WS_CHK); (void)tid;
        for (int sm = wave; sm < 32; sm += 8) {
            const int row = samp_row(sm), f = (int)(hsh(sm + 9) % 1024u), ar = (row < SEQ) ? 128 : row - SEQ;
            const float xv = (row < SEQ) ? IN(I_XP)[(size_t)row * 1024 + f] : IN(I_XS)[(size_t)(row - SEQ) * 1024 + f];
            const float ref = xv + ADA[(size_t)ar * NADA + 2048 + f] * wdot_bf(Z + (size_t)row * 1024, IN(I_WO), 1024, f, 1024, lane);
            if (chk_bad(OUT()[(size_t)row * 1024 + f], ref)) CHK_FAIL(9);
        }
    }
#endif
    cg::this_grid().sync();
    {
        PHASE_IDS();
        float* const out = OUT(); const float* const ada = ADA; const float* const gf = IN(I_GFFN); bf16_t* const h2 = H2;
        if (gt < 256) *(u32x4*)((unsigned char*)h2 - 4096 + gt * 16) = (u32x4){0u, 0u, 0u, 0u};
        for (int row = gw; row < MROWS; row += NGW) {
            const float* ad = ada + (size_t)((row < SEQ) ? 128 : row - SEQ) * NADA;
            modnorm_row(out + (size_t)row * 1024, gf, ad + 4096, ad + 3072, h2 + (size_t)row * 1024, lane);
        }
    }
#if SELFCHECK
    cg::this_grid().sync();
    if (bid == 0) { PHASE_IDS(); unsigned* mask = (unsigned*)WS(WS_CHK); (void)tid;
        for (int sm = wave; sm < 32; sm += 8) {
            const int row = samp_row(sm), col = (int)(hsh(sm + 5) % 1024u), ar = (row < SEQ) ? 128 : row - SEQ;
            const float* xr = OUT() + (size_t)row * 1024;
            float a = 0.f; for (int k = lane; k < 1024; k += 64) a += xr[k] * xr[k];
            const float rstd = rsqrtf(wave_sum(a) * (1.f / 1024.f) + EPS); const float* ad = ADA + (size_t)ar * NADA;
            const float ref = xr[col] * rstd * IN(I_GFFN)[col] * (1.f + ad[4096 + col]) + ad[3072 + col];
            if (chk_bad(bf2f(H2[(size_t)row * 1024 + col]), ref)) CHK_FAIL(10);
        }
    }
#endif
    cg::this_grid().sync();
    {
        typedef Sched<2, 2048, 2048> SC; SC S; S.to.init(NPT5 + 1, FF2 / 256); S.G = G; S.c = bid; S.A0 = (const char*)H2; S.B0 = (const char*)WUP;
        float* const out = OUT(); EpiFfn E{GG, IN(I_FCW), IN(I_FCB), IN(I_SFF), out + O_FP, out + O_FS, (PG8_LAS float*)(ldsl + HALO_OFF)};
        pg8::gemm_phase<EpiFfn, SC, 1024, 1024, 1024, true, true>(ldsl, wave0, S, E);
    }
#if SELFCHECK
    cg::this_grid().sync();
    if (bid == 0) { PHASE_IDS(); unsigned* mask = (unsigned*)WS(WS_CHK); (void)tid;
        for (int sm = wave; sm < 32; sm += 8) {
            const int row = samp_row(sm), f = (int)(hsh(sm + 13) % (unsigned)FF); const float* W = IN(I_WUP); const float* cw_ = IN(I_FCW); const float* cb_ = IN(I_FCB);
            float cg = cb_[f], cv = cb_[FF + f];
            for (int tap = 0; tap < 3; ++tap) {
                float ug, uv;
                if (row < SEQ) { const int t = row - 2 + tap; if (t >= 0) { ug = wdot_bf(H2 + (size_t)t * 1024, W, FF2, f, 1024, lane); uv = wdot_bf(H2 + (size_t)t * 1024, W, FF2, FF + f, 1024, lane); } else { ug = 0.f; uv = 0.f; } }
                else { if (tap < 2) { const float* st = IN(I_SFF) + (size_t)((row - SEQ) * 2 + tap) * FF2; ug = st[f]; uv = st[FF + f]; } else { ug = wdot_bf(H2 + (size_t)row * 1024, W, FF2, f, 1024, lane); uv = wdot_bf(H2 + (size_t)row * 1024, W, FF2, FF + f, 1024, lane); } }
                cg += cw_[tap * FF2 + f] * ug; cv += cw_[tap * FF2 + FF + f] * uv;
                if (tap == 2) {
                    if (row >= SEQ) { const float* o = OUT() + O_FS + (size_t)((row - SEQ) * 2 + 1) * FF2; if (chk_bad(o[f], ug) || chk_bad(o[FF + f], uv)) CHK_FAIL(13); }
                    if (row >= SEQ - 2 && row < SEQ) { const float* o = OUT() + O_FP + (size_t)(row - (SEQ - 2)) * FF2; if (chk_bad(o[f], ug) || chk_bad(o[FF + f], uv)) CHK_FAIL(13); }
                }
            }
            const float ref = siluf_(cg) * cv;
            if (chk_bad(bf2f(GG[(size_t)row * FF + f]), ref)) CHK_FAIL(row < SEQ ? 11 : 12);
            if (lane == 0) ((float*)WS(WS_CHK + 16384))[sm] = OUT()[(size_t)row * 1024 + (f & 1023)];
        }
    }
#endif
    cg::this_grid().sync();
    {
        typedef Sched<0, FF * 2, FF * 2> SC; SC S; S.to.init(NMT, 4); S.G = G; S.c = bid; S.A0 = (const char*)GG; S.B0 = (const char*)WDN;
        float* const out = OUT(); EpiRes E{out, out + O_YS, out, ADA, 5120};
        pg8::gemm_phase<EpiRes, SC, FF, FF, FF, true, true>(ldsl, wave0, S, E);
    }
#if SELFCHECK
    cg::this_grid().sync();
    if (bid == 0) { PHASE_IDS(); unsigned* mask = (unsigned*)WS(WS_CHK); (void)tid;
        for (int sm = wave; sm < 32; sm += 8) {
            const int row = samp_row(sm), f = (int)(hsh(sm + 13) % (unsigned)FF) & 1023, ar = (row < SEQ) ? 128 : row - SEQ;
            const float ref = ((const float*)WS(WS_CHK + 16384))[sm] + ADA[(size_t)ar * NADA + 5120 + f] * wdot_bf(GG + (size_t)row * FF, IN(I_WDN), 1024, f, FF, lane);
            if (chk_bad(OUT()[(size_t)row * 1024 + f], ref)) CHK_FAIL(14);
        }
    }
#endif
    cg::this_grid().sync();
    {
    PHASE_IDS();
    float* const out = OUT(); const float* const gf = IN(I_GFIN);
    for (int row = gw; row < MROWS; row += NGW) {
        float* xr = out + (size_t)row * 1024;
        f32x4 v[4]; float s = 0.f;
#pragma unroll
        for (int j = 0; j < 4; ++j) { v[j] = ((const f32x4*)xr)[lane + 64 * j]; s += (v[j][0] * v[j][0] + v[j][1] * v[j][1]) + (v[j][2] * v[j][2] + v[j][3] * v[j][3]); }
        const float rstd = rsqrtf(wave_sum(s) * (1.0f / 1024.0f) + EPS);
#pragma unroll
        for (int j = 0; j < 4; ++j) { const f32x4 gg = *(const f32x4*)(gf + 4 * (lane + 64 * j)); ((f32x4*)xr)[lane + 64 * j] = v[j] * rstd * gg; }
    }
    }
#if SELFCHECK
    cg::this_grid().sync();
    {   PHASE_IDS(); const unsigned m = *(volatile unsigned*)WS(WS_CHK);
        if (m != 0u) { const int code = __builtin_ctz(m); const float sc = 1.5f + 0.1f * (float)code; float* o = OUT() + O_KS;
            for (long i = gt; i < 128L * 128 * 256; i += NGT) o[i] *= sc; } }
#endif
}

extern "C" void kernel_launch(void* const* d_in, const int* in_sizes, int n_in, void* d_out, int out_size, void* d_ws, size_t ws_size, hipStream_t stream) {
    static int grid = 0;
    if (grid == 0) {
        if (n_in != 23 || ws_size < WS_END) { fprintf(stderr, "kernel_launch: unexpected n_in %d / ws %zu\n", n_in, ws_size); grid = -1; return; }
        int dev = 0, cus = 0, per_cu = 0;
        hipGetDevice(&dev); hipDeviceGetAttribute(&cus, hipDeviceAttributeMultiprocessorCount, dev);
        if (hipFuncSetAttribute((const void*)mega, hipFuncAttributeMaxDynamicSharedMemorySize, LDS_BYTES) != hipSuccess) { fprintf(stderr, "kernel_launch: hipFuncSetAttribute failed\n"); }
        hipOccupancyMaxActiveBlocksPerMultiprocessor(&per_cu, (const void*)mega, 512, LDS_BYTES);
        (void)hipGetLastError();
        if (per_cu < 1) per_cu = 1;
        grid = cus * 1;
        if (grid <= 0) grid = 256;
    }
    if (grid < 0) return;
    Args a{};
    for (int i = 0; i < 23; ++i) a.in[i] = (const float*)d_in[i];
    a.out = (float*)d_out; a.ws = (unsigned char*)d_ws;
    void* args[] = {&a};
    hipError_t e = hipLaunchCooperativeKernel((const void*)mega, dim3(grid), dim3(512), args, LDS_BYTES, stream);
    if (e != hipSuccess) fprintf(stderr, "cooperative launch failed: %s (grid %d)\n", hipGetErrorString(e), grid);
}
```

```cpp
#ifndef SELFCHECK
#define SELFCHECK 0
#endif
#include <hip/hip_runtime.h>
#include <hip/hip_cooperative_groups.h>
#include <cstdio>
#include <cstdint>
namespace cg = cooperative_groups;

constexpr int D = 1024, SEQ = 16384, NS = 128, MROWS = SEQ + NS, MPAD = 16640;
constexpr int NIN = 6656, FF = 2816, FF2 = 5632, NADA = 6144;
constexpr int NMT = MPAD / 256;
constexpr int NPT5 = 65;
constexpr float EPS = 1e-6f;

constexpr size_t MiB = 1u << 20;
constexpr size_t RB = (size_t)MPAD * 1024 * 2;
constexpr size_t KBB = (size_t)MPAD * 256 * 2;
constexpr size_t WS_AADA = 1 * MiB;
constexpr size_t WS_ADA = 2 * MiB;
constexpr size_t WS_WA = 8 * MiB, WS_WB = 10 * MiB, WS_WO = 12 * MiB;
constexpr size_t WS_WADA = 14 * MiB;
constexpr size_t WS_WIN = 26 * MiB;
constexpr size_t WS_WUP = 14 * MiB;
constexpr size_t WS_WDN = 25 * MiB;
constexpr size_t WS_H = 39 * MiB;
constexpr size_t WS_U = 72 * MiB;
constexpr size_t WS_BG = 105 * MiB;
constexpr size_t WS_Q = 138 * MiB;
constexpr size_t WS_KB = WS_Q + RB, WS_VB = WS_KB + KBB, WS_GA = WS_VB + KBB, WS_GB = WS_GA + RB;
constexpr size_t WS_G = WS_Q;
constexpr size_t WS_END = WS_GB + RB;
static_assert(WS_END <= 256 * MiB, "ws map");
static_assert(WS_G + (size_t)MPAD * FF * 2 <= WS_END, "G overlay");
static_assert(WS_WDN + (size_t)1024 * FF * 2 <= WS_H && WS_WUP + (size_t)FF2 * 1024 * 2 <= WS_WDN, "weights");
static_assert(WS_U + RB + 4096 <= WS_BG && WS_H + RB <= WS_U && WS_BG + RB <= WS_Q, "row buffers");

constexpr size_t O_YP = 0, O_YS = 16777216, O_CAP = 16908288, O_CAS = 16910336, O_KP = 17172480, O_KS = 17205248,
                 O_VP = 21399552, O_VS = 21432320, O_FP = 25626624, O_FS = 25637888;

constexpr int LDS_BYTES = 147456;
constexpr int HALO_OFF = 131072;

typedef unsigned short bf16_t;
typedef short bf16x8 __attribute__((ext_vector_type(8)));
typedef float f32x4 __attribute__((ext_vector_type(4)));
typedef float f32x16 __attribute__((ext_vector_type(16)));
typedef float f32x2 __attribute__((ext_vector_type(2)));
typedef unsigned u32x4 __attribute__((ext_vector_type(4)));
typedef unsigned u32x2 __attribute__((ext_vector_type(2)));

__device__ __forceinline__ float bf2f(unsigned b) { return __uint_as_float(b << 16); }
__device__ __forceinline__ unsigned cvt_pk_bf16(float lo, float hi) { unsigned r; asm volatile("v_cvt_pk_bf16_f32 %0, %1, %2" : "=v"(r) : "v"(lo), "v"(hi)); return r; }
__device__ __forceinline__ float bperm_f(float v, int byte_addr) { return __int_as_float(__builtin_amdgcn_ds_bpermute(byte_addr, __float_as_int(v))); }
__device__ __forceinline__ float sigmoidf_(float x) { return __builtin_amdgcn_rcpf(1.0f + __expf(-x)); }
__device__ __forceinline__ float siluf_(float x) { return x * __builtin_amdgcn_rcpf(1.0f + __expf(-x)); }
__device__ __forceinline__ float wave_sum(float v) {
#pragma unroll
    for (int o = 1; o < 64; o <<= 1) v += __shfl_xor(v, o);
    return v;
}
__device__ __forceinline__ float wave_max(float v) {
#pragma unroll
    for (int o = 1; o < 64; o <<= 1) v = fmaxf(v, __shfl_xor(v, o));
    return v;
}
__device__ __forceinline__ void unpack8(u32x4 w, float* f) {
    f[0] = bf2f(w.x & 0xffffu); f[1] = bf2f(w.x >> 16); f[2] = bf2f(w.y & 0xffffu); f[3] = bf2f(w.y >> 16);
    f[4] = bf2f(w.z & 0xffffu); f[5] = bf2f(w.z >> 16); f[6] = bf2f(w.w & 0xffffu); f[7] = bf2f(w.w >> 16);
}
__device__ __forceinline__ u32x4 pack8(const float* f) {
    u32x4 w; w.x = cvt_pk_bf16(f[0], f[1]); w.y = cvt_pk_bf16(f[2], f[3]); w.z = cvt_pk_bf16(f[4], f[5]); w.w = cvt_pk_bf16(f[6], f[7]); return w;
}

namespace pg8 {
#define PG8_LAS __attribute__((address_space(3)))
constexpr int BM = 256, BK = 64, HALF = 128, HTB = HALF * BK * 2, STAGE_BYTES = 8 * HTB, NXCD = 8, WGM = 8;
__host__ __device__ __forceinline__ int lds_byte(int r, int c) { const int st = (r >> 4) * 2 + (c >> 5), rr = r & 15, cc = c & 31, ob = rr * 64 + cc * 2; return st * 1024 + (ob ^ (((ob >> 9) & 1) << 5)); }
__host__ __device__ __forceinline__ void stage_rc(int b, int& R, int& C) { const int st = b / 1024, sb = b % 1024, swz = sb ^ (((sb >> 9) & 1) << 5); R = (st >> 1) * 16 + swz / 64; C = (st & 1) * 32 + (swz % 64) / 2; }
__host__ __device__ __forceinline__ int perm32(int rho) { const int n = rho >> 4, i = rho & 15; return 8 * (i >> 2) + 4 * n + (i & 3); }

struct Unit { int pm, pn, aux; const char* a; const char* b; };

struct TileOrder {
    int nM, nN, nwg;
    __device__ __forceinline__ void init(int nM_, int nN_) { nM = nM_; nN = nN_; nwg = nM * nN; }
    __device__ __forceinline__ bool tile(long L, int& pm, int& pn) const {
        if (L >= nwg) return false;
        int wgid = (int)L; { const int q = nwg / NXCD, r = nwg % NXCD, xcd = wgid % NXCD, off = wgid / NXCD; wgid = (xcd < r ? xcd * (q + 1) : r * (q + 1) + (xcd - r) * q) + off; }
        const int nig = WGM * nN, gid = wgid / nig, fm = gid * WGM, gsz = (nM - fm) < WGM ? (nM - fm) : WGM;
        pm = fm + ((wgid % nig) % gsz); pn = (wgid % nig) / gsz; return true;
    }
};

template <class Epi, class Sched, int lda, int ldb, int K, bool ALIGN_EPI, bool SP2>
__device__ __forceinline__ void gemm_phase(PG8_LAS unsigned char* lds, const int wave0, const Sched& S, const Epi& E) {
    int tid_ = wave0 * 64 + (int)__builtin_amdgcn_mbcnt_hi(~0u, __builtin_amdgcn_mbcnt_lo(~0u, 0u)); asm volatile("" : "+v"(tid_));
    const int tid = tid_, wid = __builtin_amdgcn_readfirstlane(tid >> 6), lane = tid & 63, wr = wid >> 2, wc = wid & 3, fr = lane & 15, fq = lane >> 4;
    const int nt = K / BK;
    unsigned voffA[2], voffB[2];
#pragma unroll
    for (int i = 0; i < 2; ++i) { int R, C; stage_rc(tid * 16 + i * 8192, R, C); const int Rb = Epi::PERM ? ((R & ~31) + perm32(R & 31)) : R;
        voffA[i] = (unsigned)(R * lda + C) * 2u; voffB[i] = (unsigned)(Rb * ldb + C) * 2u; }
    const size_t kstep = (size_t)(BK * 2);
    const size_t hstepA = (size_t)HALF * lda * 2, hstepB = (size_t)HALF * ldb * 2;
    const unsigned ldsw = (unsigned)wid * 1024u;
    const int aoff = lds_byte(wr * 64 + fr, fq * 8), boff = lds_byte(wc * 32 + fr, fq * 8);
#define PG8_SA(b, h) (((b) * 2 + (h)) * HTB)
#define PG8_SB(b, h) ((4 + (b) * 2 + (h)) * HTB)
#define PG8_STAGE(bufoff, gbase, voff) do { _Pragma("unroll") for (int _i = 0; _i < 2; ++_i) \
        __builtin_amdgcn_global_load_lds((const unsigned*)((const char*)(gbase) + (voff)[_i]), (PG8_LAS unsigned*)(lds + (bufoff) + ldsw + _i * 8192), 16, 0, 0); } while (0)
#define PG8_LDA(dst, b, h) do { _Pragma("unroll") for (int m = 0; m < 4; ++m) _Pragma("unroll") for (int k = 0; k < 2; ++k) dst[m][k] = *(const PG8_LAS bf16x8*)(lds + PG8_SA(b, h) + aoff + m * 2048 + k * 1024); } while (0)
#define PG8_LDB(dst, b, h) do { _Pragma("unroll") for (int n = 0; n < 2; ++n) _Pragma("unroll") for (int k = 0; k < 2; ++k) dst[n][k] = *(const PG8_LAS bf16x8*)(lds + PG8_SB(b, h) + boff + n * 2048 + k * 1024); } while (0)
#define PG8_MMA(ai, bj, At, Bt) do { __builtin_amdgcn_s_setprio(1); _Pragma("unroll") for (int m = 0; m < 4; ++m) _Pragma("unroll") for (int n = 0; n < 2; ++n) _Pragma("unroll") for (int k = 0; k < 2; ++k) \
        acc[ai][bj][m][n] = __builtin_amdgcn_mfma_f32_16x16x32_bf16(Bt[n][k], At[m][k], acc[ai][bj][m][n], 0, 0, 0); __builtin_amdgcn_s_setprio(0); } while (0)
#define PG8_WAIT_V(n) asm volatile("s_waitcnt vmcnt(" #n ")" ::: "memory")
#define PG8_WAIT_L(n) asm volatile("s_waitcnt lgkmcnt(" #n ")" ::: "memory")
#define PG8_BAR __builtin_amdgcn_s_barrier()
#define PG8_SCHED __builtin_amdgcn_sched_barrier(0)
    Unit cur, nxt; int ui = 0;
    if (!S.next(0, cur)) return;
    f32x4 acc[2][2][4][2];
#pragma unroll
    for (int a = 0; a < 2; ++a)
#pragma unroll
        for (int b = 0; b < 2; ++b)
#pragma unroll
            for (int m = 0; m < 4; ++m)
#pragma unroll
                for (int n = 0; n < 2; ++n) acc[a][b][m][n] = (f32x4){0.f, 0.f, 0.f, 0.f};
    bf16x8 At[4][2], B0[2][2], B1[2][2];
    const char* cA = cur.a; const char* cB = cur.b;
    if constexpr (SP2) {
        PG8_STAGE(PG8_SB(0, 0), cB, voffB); PG8_STAGE(PG8_SB(0, 1), cB + hstepB, voffB); PG8_STAGE(PG8_SA(0, 0), cA, voffA); PG8_STAGE(PG8_SA(0, 1), cA + hstepA, voffA);
        if (wr == 1) PG8_BAR;
        PG8_WAIT_V(2); PG8_BAR;
        PG8_STAGE(PG8_SB(1, 0), cB + kstep, voffB); PG8_STAGE(PG8_SA(1, 0), cA + kstep, voffA); PG8_STAGE(PG8_SB(1, 1), cB + hstepB + kstep, voffB);
        PG8_WAIT_V(6); PG8_BAR;
    } else {
        PG8_STAGE(PG8_SB(0, 0), cB, voffB); PG8_STAGE(PG8_SA(0, 0), cA, voffA); PG8_STAGE(PG8_SB(0, 1), cB + hstepB, voffB); PG8_STAGE(PG8_SA(0, 1), cA + hstepA, voffA);
        if (wr == 1) PG8_BAR;
        PG8_WAIT_V(4); PG8_BAR;
        PG8_STAGE(PG8_SB(1, 0), cB + kstep, voffB); PG8_STAGE(PG8_SA(1, 0), cA + kstep, voffA); PG8_STAGE(PG8_SB(1, 1), cB + hstepB + kstep, voffB);
        PG8_WAIT_V(6); PG8_BAR;
    }
    for (;;) {
        const bool has_next = S.next(ui + 1, nxt);
        const char* nA = has_next ? nxt.a : cA; const char* nB = has_next ? nxt.b : cB;
        for (int t = 0; t < nt; t += 2) {
            const bool last = (t == nt - 2);
            const char* a1 = cA + (size_t)(t + 1) * kstep;
            const char* a2 = last ? nA : cA + (size_t)(t + 2) * kstep; const char* b2 = last ? nB : cB + (size_t)(t + 2) * kstep;
            const char* a3 = a2 + kstep; const char* b3 = b2 + kstep;
            if constexpr (SP2) {
            PG8_LDB(B0, 0, 0); PG8_LDB(B1, 0, 1); PG8_SCHED; PG8_LDA(At, 0, 0); PG8_STAGE(PG8_SA(1, 1), a1 + hstepA, voffA);
            PG8_WAIT_V(8); PG8_WAIT_L(0); PG8_BAR; PG8_MMA(0, 0, At, B0); PG8_MMA(0, 1, At, B1); PG8_BAR; PG8_SCHED;
            PG8_LDA(At, 0, 1); PG8_STAGE(PG8_SB(0, 0), b2, voffB); PG8_STAGE(PG8_SB(0, 1), b2 + hstepB, voffB); PG8_STAGE(PG8_SA(0, 0), a2, voffA);
            PG8_WAIT_V(8); PG8_WAIT_L(0); PG8_BAR; PG8_MMA(1, 0, At, B0); PG8_MMA(1, 1, At, B1); PG8_BAR; PG8_SCHED;
            PG8_LDB(B0, 1, 0); PG8_LDB(B1, 1, 1); PG8_SCHED; PG8_LDA(At, 1, 0); PG8_STAGE(PG8_SA(0, 1), a2 + hstepA, voffA);
            PG8_WAIT_V(8); PG8_WAIT_L(0); PG8_BAR; PG8_MMA(0, 0, At, B0); PG8_MMA(0, 1, At, B1); PG8_BAR; PG8_SCHED;
            PG8_LDA(At, 1, 1); PG8_STAGE(PG8_SB(1, 0), b3, voffB); PG8_STAGE(PG8_SB(1, 1), b3 + hstepB, voffB); PG8_STAGE(PG8_SA(1, 0), a3, voffA);
            PG8_WAIT_V(8); PG8_WAIT_L(0); PG8_BAR; PG8_MMA(1, 0, At, B0); PG8_MMA(1, 1, At, B1); PG8_BAR; PG8_SCHED;
            } else {
            PG8_LDB(B0, 0, 0); PG8_SCHED; PG8_LDA(At, 0, 0); PG8_STAGE(PG8_SA(1, 1), a1 + hstepA, voffA);
            PG8_WAIT_L(8); PG8_BAR; PG8_WAIT_L(0); PG8_MMA(0, 0, At, B0); PG8_BAR; PG8_SCHED;
            PG8_LDB(B1, 0, 1); PG8_STAGE(PG8_SB(0, 0), b2, voffB);
            PG8_BAR; PG8_WAIT_L(0); PG8_MMA(0, 1, At, B1); PG8_BAR;
            PG8_LDA(At, 0, 1); PG8_STAGE(PG8_SA(0, 0), a2, voffA);
            PG8_BAR; PG8_WAIT_L(0); PG8_MMA(1, 0, At, B0); PG8_BAR; PG8_SCHED;
            PG8_STAGE(PG8_SB(0, 1), b2 + hstepB, voffB);
            PG8_WAIT_V(6); PG8_BAR; PG8_MMA(1, 1, At, B1); PG8_BAR;
            PG8_LDB(B0, 1, 0); PG8_SCHED; PG8_LDA(At, 1, 0); PG8_STAGE(PG8_SA(0, 1), a2 + hstepA, voffA);
            PG8_WAIT_L(8); PG8_BAR; PG8_WAIT_L(0); PG8_MMA(0, 0, At, B0); PG8_BAR; PG8_SCHED;
            PG8_LDB(B1, 1, 1); PG8_STAGE(PG8_SB(1, 0), b3, voffB);
            PG8_BAR; PG8_WAIT_L(0); PG8_MMA(0, 1, At, B1); PG8_BAR;
            PG8_LDA(At, 1, 1); PG8_STAGE(PG8_SA(1, 0), a3, voffA);
            PG8_BAR; PG8_WAIT_L(0); PG8_MMA(1, 0, At, B0); PG8_BAR; PG8_SCHED;
            PG8_STAGE(PG8_SB(1, 1), b3 + hstepB, voffB);
            PG8_WAIT_V(6); PG8_BAR; PG8_MMA(1, 1, At, B1); PG8_BAR;
            }
        }
        if constexpr (ALIGN_EPI) { if (wr == 0) PG8_BAR; }
        E(acc, cur, wr, wc, fr, fq);
        if (!has_next) break;
#pragma unroll
        for (int a = 0; a < 2; ++a)
#pragma unroll
            for (int b = 0; b < 2; ++b)
#pragma unroll
                for (int m = 0; m < 4; ++m)
#pragma unroll
                    for (int n = 0; n < 2; ++n) acc[a][b][m][n] = (f32x4){0.f, 0.f, 0.f, 0.f};
        cur = nxt; cA = nA; cB = nB; ++ui;
        if constexpr (ALIGN_EPI) { if (wr == 1) PG8_BAR; }
    }
    PG8_WAIT_V(0);
    if constexpr (!ALIGN_EPI) { if (wr == 0) PG8_BAR; }
    PG8_BAR;
#undef PG8_SA
#undef PG8_SB
#undef PG8_STAGE
#undef PG8_LDA
#undef PG8_LDB
#undef PG8_MMA
#undef PG8_WAIT_V
#undef PG8_WAIT_L
#undef PG8_BAR
#undef PG8_SCHED
}
}
using pg8::Unit;

template <int MODE, int LDA_B, int LDB_B> struct Sched {
    pg8::TileOrder to; int G, c;
    const char* A0; const char* B0; const char* A1; const char* B1;
    __device__ __forceinline__ bool next(int i, Unit& u) const {
        if (MODE == 1) {
            const long L = (long)(i >> 1) * G + c; if (!to.tile(L, u.pm, u.pn)) return false;
            u.aux = i & 1;
            u.a = (u.aux ? A1 : A0) + (size_t)u.pm * 256 * LDA_B; u.b = (u.aux ? B1 : B0) + (size_t)u.pn * 256 * LDB_B; return true;
        } else {
            const long L = (long)i * G + c; if (!to.tile(L, u.pm, u.pn)) return false;
            u.aux = 0;
            if (MODE == 2) { const long r0 = (u.pm < NPT5) ? (254L * u.pm - 2) : (long)SEQ; u.a = A0 + r0 * (long)LDA_B; }
            else u.a = A0 + (size_t)u.pm * 256 * LDA_B;
            u.b = B0 + (size_t)u.pn * 256 * LDB_B; return true;
        }
    }
};

#define EPI_ARGS const f32x4 (&acc)[2][2][4][2], const Unit& u, int wr, int wc, int fr, int fq
struct EpiAda {
    static constexpr bool PERM = true;
    float* ADA; const float* bias;
    __device__ __forceinline__ void operator()(EPI_ARGS) const {
#pragma unroll
        for (int ai = 0; ai < 2; ++ai)
#pragma unroll
            for (int m = 0; m < 4; ++m) { const int row = 128 * ai + 64 * wr + 16 * m + fr;
#pragma unroll
                for (int bj = 0; bj < 2; ++bj) { const int col = 256 * u.pn + 128 * bj + 32 * wc + 8 * fq;
#pragma unroll
                    for (int n = 0; n < 2; ++n) { const f32x4 b = *(const f32x4*)(bias + col + 4 * n); *(f32x4*)(ADA + (size_t)row * NADA + col + 4 * n) = acc[ai][bj][m][n] + b; } } }
    }
};
struct EpiProj {
    static constexpr bool PERM = true;
    bf16_t *U, *BG, *Q, *KB, *VB, *GA, *GB;
    __device__ __forceinline__ void operator()(EPI_ARGS) const {
        const int row0 = u.pm * 256 + wr * 64 + fr;
        if (u.pn < 8) {
#pragma unroll
            for (int ai = 0; ai < 2; ++ai)
#pragma unroll
                for (int m = 0; m < 4; ++m) { const int row = row0 + 128 * ai + 16 * m;
                    const f32x4 v0 = acc[ai][0][m][0] * acc[ai][1][m][0], v1 = acc[ai][0][m][1] * acc[ai][1][m][1];
                    u32x4 w; w.x = cvt_pk_bf16(v0[0], v0[1]); w.y = cvt_pk_bf16(v0[2], v0[3]); w.z = cvt_pk_bf16(v1[0], v1[1]); w.w = cvt_pk_bf16(v1[2], v1[3]);
                    *(u32x4*)(U + (size_t)row * 1024 + 128 * u.pn + 32 * wc + 8 * fq) = w; }
        } else {
            bf16_t* dst; int ld, cb; const int pn = u.pn;
            if (pn < 12) { dst = BG; ld = 1024; cb = 256 * (pn - 8); }
            else if (pn < 16) { dst = Q; ld = 1024; cb = 256 * (pn - 12); }
            else if (pn == 16) { dst = KB; ld = 256; cb = 0; }
            else if (pn == 17) { dst = VB; ld = 256; cb = 0; }
            else if (pn < 22) { dst = GA; ld = 1024; cb = 256 * (pn - 18); }
            else { dst = GB; ld = 1024; cb = 256 * (pn - 22); }
#pragma unroll
            for (int ai = 0; ai < 2; ++ai)
#pragma unroll
                for (int m = 0; m < 4; ++m) { const int row = row0 + 128 * ai + 16 * m;
#pragma unroll
                    for (int bj = 0; bj < 2; ++bj) { const f32x4 v0 = acc[ai][bj][m][0], v1 = acc[ai][bj][m][1];
                        u32x4 w; w.x = cvt_pk_bf16(v0[0], v0[1]); w.y = cvt_pk_bf16(v0[2], v0[3]); w.z = cvt_pk_bf16(v1[0], v1[1]); w.w = cvt_pk_bf16(v1[2], v1[3]);
                        *(u32x4*)(dst + (size_t)row * ld + cb + 128 * bj + 32 * wc + 8 * fq) = w; } }
        }
    }
};
struct EpiMix {
    static constexpr bool PERM = true;
    const bf16_t *GA, *GB; float* T; bf16_t* Z;
    __device__ __forceinline__ void operator()(EPI_ARGS) const {
        const int row0 = u.pm * 256 + wr * 64 + fr;
        const bf16_t* gate = u.aux ? GB : GA;
#pragma unroll
        for (int ai = 0; ai < 2; ++ai)
#pragma unroll
            for (int m = 0; m < 4; ++m) { const int row = row0 + 128 * ai + 16 * m;
                if (row < MROWS) {
#pragma unroll
                for (int bj = 0; bj < 2; ++bj) { const int col = 256 * u.pn + 128 * bj + 32 * wc + 8 * fq;
                    float gv[8]; unpack8(*(const u32x4*)(gate + (size_t)row * 1024 + col), gv);
                    float o[8];
#pragma unroll
                    for (int i = 0; i < 8; ++i) o[i] = sigmoidf_(gv[i]) * acc[ai][bj][m][i >> 2][i & 3];
                    float* tp = T + (size_t)row * 1024 + col;
                    if (u.aux == 0) { *(f32x4*)tp = (f32x4){o[0], o[1], o[2], o[3]}; *(f32x4*)(tp + 4) = (f32x4){o[4], o[5], o[6], o[7]}; }
                    else { const f32x4 t0 = *(const f32x4*)tp, t1 = *(const f32x4*)(tp + 4);
                        o[0] += t0[0]; o[1] += t0[1]; o[2] += t0[2]; o[3] += t0[3]; o[4] += t1[0]; o[5] += t1[1]; o[6] += t1[2]; o[7] += t1[3];
                        *(u32x4*)(Z + (size_t)row * 1024 + col) = pack8(o); } } } }
    }
};
struct EpiRes {
    static constexpr bool PERM = true;
    const float* xp; const float* xs; float* out; const float* ADA; int goff;
    __device__ __forceinline__ void operator()(EPI_ARGS) const {
        const int row0 = u.pm * 256 + wr * 64 + fr;
#pragma unroll
        for (int ai = 0; ai < 2; ++ai)
#pragma unroll
            for (int m = 0; m < 4; ++m) { const int row = row0 + 128 * ai + 16 * m;
                if (row < MROWS) {
                const float* base = (row < SEQ) ? xp + (size_t)row * 1024 : xs + (size_t)(row - SEQ) * 1024;
                const float* gt = ADA + (size_t)((row < SEQ) ? 128 : row - SEQ) * NADA + goff;
#pragma unroll
                for (int bj = 0; bj < 2; ++bj) { const int col = 256 * u.pn + 128 * bj + 32 * wc + 8 * fq;
#pragma unroll
                    for (int n = 0; n < 2; ++n) { const f32x4 b = *(const f32x4*)(base + col + 4 * n), g = *(const f32x4*)(gt + col + 4 * n);
                        *(f32x4*)(out + (size_t)row * 1024 + col + 4 * n) = b + g * acc[ai][bj][m][n]; } } } }
    }
};
struct EpiFfn {
    static constexpr bool PERM = true;
    bf16_t* G; const float* cw; const float* cb; const float* st; float* ofp; float* ofs; PG8_LAS float* halo;
    __device__ __forceinline__ void operator()(const f32x4 (&acc)[2][2][4][2], const Unit& u, int wr, int wc, int fr_, int fq_) const {
        int oz; asm volatile("v_mov_b32 %0, 0" : "=v"(oz));
        const int fr = fr_ + oz, fq = fq_ + oz;
        const int wid = wr * 4 + wc, lane = fq * 16 + fr;
        const int f0 = 128 * u.pn + 32 * wc + 8 * fq;
        if (u.pm < NPT5) {
            if (fr >= 14) {
#pragma unroll
                for (int ai = 0; ai < 2; ++ai)
#pragma unroll
                    for (int bj = 0; bj < 2; ++bj)
#pragma unroll
                        for (int n = 0; n < 2; ++n) *(PG8_LAS f32x4*)(halo + ((wid * 2 + ai) * 2 + (fr - 14)) * 64 + bj * 32 + fq * 8 + n * 4) = acc[ai][bj][3][n];
            }
            asm volatile("s_waitcnt lgkmcnt(0)" ::: "memory"); __builtin_amdgcn_s_barrier(); asm volatile("" ::: "memory");
            const int l1 = ((fq << 4) | ((fr - 1) & 15)) << 2, l2 = ((fq << 4) | ((fr - 2) & 15)) << 2;
#define BPERM(v, a) bperm_f((v), (a))
#pragma unroll
            for (int ai = 0; ai < 2; ++ai) {
                const int swr = (ai == 0) ? 0 : (wr == 0 ? 1 : 0), sai = (ai == 1 && wr == 1) ? 1 : 0;
                const PG8_LAS float* hp = halo + (((swr * 4 + wc) * 2 + sai) * 2) * 64 + fq * 8;
#pragma unroll
                for (int n = 0; n < 2; ++n) {
                    unsigned wlo[4];
#pragma unroll
                    for (int c2 = 0; c2 < 2; ++c2) {
                        const int fg = f0 + 4 * n + 2 * c2, fv = FF + fg;
                        f32x2 cvv[4];
                        {
                            const f32x2 w0 = *(const f32x2*)(cw + fv), w1 = *(const f32x2*)(cw + FF2 + fv), w2 = *(const f32x2*)(cw + 2 * FF2 + fv), bb = *(const f32x2*)(cb + fv);
                            const f32x2 h2 = *(const PG8_LAS f32x2*)(hp + 32 + n * 4 + 2 * c2), h1 = *(const PG8_LAS f32x2*)(hp + 64 + 32 + n * 4 + 2 * c2);
                            f32x2 p1 = h1, p2 = (fr == 1) ? h1 : h2;
#pragma unroll
                            for (int m = 0; m < 4; ++m) {
                                const float xa = acc[ai][1][m][n][2 * c2], xb = acc[ai][1][m][n][2 * c2 + 1];
                                const f32x2 x = (f32x2){xa, xb}; f32x2 r1, r2;
                                r1[0] = BPERM(xa, l1); r1[1] = BPERM(xb, l1); r2[0] = BPERM(xa, l2); r2[1] = BPERM(xb, l2);
                                const f32x2 q1 = (fr >= 1) ? r1 : p1, q2 = (fr >= 2) ? r2 : p2; p1 = r1; p2 = r2;
                                cvv[m] = w0 * q2 + w1 * q1 + w2 * x + bb;
                                __builtin_amdgcn_sched_barrier(0);
                            }
                        }
                        asm volatile("" ::: "memory"); __builtin_amdgcn_sched_barrier(0);
                        {
                            const f32x2 w0 = *(const f32x2*)(cw + fg), w1 = *(const f32x2*)(cw + FF2 + fg), w2 = *(const f32x2*)(cw + 2 * FF2 + fg), bb = *(const f32x2*)(cb + fg);
                            const f32x2 h2 = *(const PG8_LAS f32x2*)(hp + n * 4 + 2 * c2), h1 = *(const PG8_LAS f32x2*)(hp + 64 + n * 4 + 2 * c2);
                            f32x2 p1 = h1, p2 = (fr == 1) ? h1 : h2;
#pragma unroll
                            for (int m = 0; m < 4; ++m) {
                                const float xa = acc[ai][0][m][n][2 * c2], xb = acc[ai][0][m][n][2 * c2 + 1];
                                const f32x2 x = (f32x2){xa, xb}; f32x2 r1, r2;
                                r1[0] = BPERM(xa, l1); r1[1] = BPERM(xb, l1); r2[0] = BPERM(xa, l2); r2[1] = BPERM(xb, l2);
                                const f32x2 q1 = (fr >= 1) ? r1 : p1, q2 = (fr >= 2) ? r2 : p2; p1 = r1; p2 = r2;
                                const f32x2 cgv = w0 * q2 + w1 * q1 + w2 * x + bb;
                                const unsigned pk = cvt_pk_bf16(siluf_(cgv[0]) * cvv[m][0], siluf_(cgv[1]) * cvv[m][1]);
                                if (c2 == 0) wlo[m] = pk;
                                else {
                                    const int tr = 128 * ai + 64 * wr + 16 * m + fr; const int grow = 254 * u.pm - 2 + tr;
                                    if (tr >= 2 && grow < SEQ) {
                                        u32x2 w; w.x = wlo[m]; w.y = pk;
                                        *(u32x2*)(G + (size_t)grow * FF + f0 + 4 * n) = w;
                                        if (grow >= SEQ - 2) { *(f32x4*)(ofp + (size_t)(grow - (SEQ - 2)) * FF2 + f0 + 4 * n) = acc[ai][0][m][n]; *(f32x4*)(ofp + (size_t)(grow - (SEQ - 2)) * FF2 + FF + f0 + 4 * n) = acc[ai][1][m][n]; }
                                    }
                                }
                                asm volatile("" ::: "memory"); __builtin_amdgcn_sched_barrier(0);
                            }
                        }
                        asm volatile("" ::: "memory"); __builtin_amdgcn_sched_barrier(0);
                    }
                }
            }
        } else {
#pragma unroll
            for (int n = 0; n < 2; ++n) {
                const int fg = f0 + 4 * n, fv = FF + fg;
#pragma unroll
                for (int m = 0; m < 4; ++m) {
                    const int b = 64 * wr + 16 * m + fr;
                    const float* s0 = st + (size_t)(b * 2) * FF2; const float* s1 = s0 + FF2;
                    float* o0 = ofs + (size_t)(b * 2) * FF2; float* o1 = o0 + FF2;
                    f32x4 cvv;
                    { const f32x4 x = acc[0][1][m][n];
                      const f32x4 w0 = *(const f32x4*)(cw + fv), w1 = *(const f32x4*)(cw + FF2 + fv), w2 = *(const f32x4*)(cw + 2 * FF2 + fv), bb = *(const f32x4*)(cb + fv);
                      const f32x4 t0 = *(const f32x4*)(s0 + fv), t1 = *(const f32x4*)(s1 + fv);
                      cvv = w0 * t0 + w1 * t1 + w2 * x + bb; *(f32x4*)(o0 + fv) = t1; *(f32x4*)(o1 + fv) = x; }
                    asm volatile("" ::: "memory"); __builtin_amdgcn_sched_barrier(0);
                    { const f32x4 x = acc[0][0][m][n];
                      const f32x4 w0 = *(const f32x4*)(cw + fg), w1 = *(const f32x4*)(cw + FF2 + fg), w2 = *(const f32x4*)(cw + 2 * FF2 + fg), bb = *(const f32x4*)(cb + fg);
                      const f32x4 t0 = *(const f32x4*)(s0 + fg), t1 = *(const f32x4*)(s1 + fg);
                      const f32x4 cgv = w0 * t0 + w1 * t1 + w2 * x + bb; *(f32x4*)(o0 + fg) = t1; *(f32x4*)(o1 + fg) = x;
                      u32x2 w; w.x = cvt_pk_bf16(siluf_(cgv[0]) * cvv[0], siluf_(cgv[1]) * cvv[1]); w.y = cvt_pk_bf16(siluf_(cgv[2]) * cvv[2], siluf_(cgv[3]) * cvv[3]);
                      *(u32x2*)(G + (size_t)(SEQ + b) * FF + fg) = w; }
                    asm volatile("" ::: "memory"); __builtin_amdgcn_sched_barrier(0);
                }
            }
        }
    }
};

__device__ __forceinline__ void transpose_item(const float* W, int K, int N, bf16_t* WT, int k0, int n0, int drow0, float* scr, int lane) {
#pragma unroll 8
    for (int i = 0; i < 32; ++i) { const int kk = 2 * i + (lane >> 5); scr[kk * 33 + (lane & 31)] = W[(size_t)(k0 + kk) * N + n0 + (lane & 31)]; }
    asm volatile("s_waitcnt lgkmcnt(0)" ::: "memory");
    const int c = lane & 7;
#pragma unroll
    for (int j = 0; j < 4; ++j) { const int n = (lane >> 3) + 8 * j; const float* s = scr + (8 * c) * 33 + n;
        u32x4 o; o.x = cvt_pk_bf16(s[0 * 33], s[1 * 33]); o.y = cvt_pk_bf16(s[2 * 33], s[3 * 33]); o.z = cvt_pk_bf16(s[4 * 33], s[5 * 33]); o.w = cvt_pk_bf16(s[6 * 33], s[7 * 33]);
        *(u32x4*)(WT + (size_t)(drow0 + n) * K + k0 + 8 * c) = o; }
    asm volatile("s_waitcnt lgkmcnt(0)" ::: "memory");
}
__device__ __forceinline__ int win_drow(int n) {
    if (n < 1024) return 256 * (n >> 7) + (n & 127);
    if (n < 2048) return 2048 + (n - 1024);
    if (n < 3072) { const int f = n - 2048; return 256 * (f >> 7) + 128 + (f & 127); }
    return n;
}
__device__ __forceinline__ int wup_drow(int n) { const int f = (n < FF) ? n : n - FF; return 256 * (f >> 7) + ((n < FF) ? 0 : 128) + (f & 127); }

__device__ __forceinline__ void modnorm_row(const float* xrow, const float* g, const float* sc, const float* sh, bf16_t* orow, int lane) {
    f32x4 v[4]; float s = 0.f;
#pragma unroll
    for (int j = 0; j < 4; ++j) { v[j] = ((const f32x4*)xrow)[lane + 64 * j]; s += (v[j][0] * v[j][0] + v[j][1] * v[j][1]) + (v[j][2] * v[j][2] + v[j][3] * v[j][3]); }
    const float rstd = rsqrtf(wave_sum(s) * (1.0f / 1024.0f) + EPS);
#pragma unroll
    for (int j = 0; j < 4; ++j) { const int col = 4 * (lane + 64 * j);
        const f32x4 gg = *(const f32x4*)(g + col), ss = *(const f32x4*)(sc + col), hh = *(const f32x4*)(sh + col);
        const f32x4 o = v[j] * rstd * gg * (ss + 1.0f) + hh;
        u32x2 w; w.x = cvt_pk_bf16(o[0], o[1]); w.y = cvt_pk_bf16(o[2], o[3]); *(u32x2*)(orow + col) = w; }
}

__device__ __forceinline__ void attn_prompt_unit(unsigned char* lds, bf16_t* Q, const bf16_t* KB, const bf16_t* VB, const float* sinks, int j, int g, int tid) {
    bf16_t* Ks = (bf16_t*)lds;
    bf16_t* Vt = (bf16_t*)(lds + 36864);
    for (int c = tid; c < 2048; c += 512) {
        const int s = c >> 3, ch = c & 7; const int tok = 128 * (j - 1) + s;
        u32x4 kv = (u32x4){0u, 0u, 0u, 0u}, vv = (u32x4){0u, 0u, 0u, 0u};
        if (tok >= 0) { kv = *(const u32x4*)(KB + (size_t)tok * 256 + 64 * g + 8 * ch); vv = *(const u32x4*)(VB + (size_t)tok * 256 + 64 * g + 8 * ch); }
        *(u32x4*)(Ks + s * 72 + 8 * ch) = kv;
        bf16_t* vd = Vt + (8 * ch) * 264 + s;
        vd[0 * 264] = (bf16_t)(vv.x & 0xffffu); vd[1 * 264] = (bf16_t)(vv.x >> 16); vd[2 * 264] = (bf16_t)(vv.y & 0xffffu); vd[3 * 264] = (bf16_t)(vv.y >> 16);
        vd[4 * 264] = (bf16_t)(vv.z & 0xffffu); vd[5 * 264] = (bf16_t)(vv.z >> 16); vd[6 * 264] = (bf16_t)(vv.w & 0xffffu); vd[7 * 264] = (bf16_t)(vv.w >> 16);
    }
    __syncthreads();
    const int wave = tid >> 6, lane = tid & 63, ql = lane & 31, hi = lane >> 5;
    for (int tt = 0; tt < 2; ++tt) {
        const int t = wave * 2 + tt, hq = t >> 2, qg = t & 3, head = 4 * g + hq;
        bf16_t* qp = Q + (size_t)(128 * j + 32 * qg + ql) * 1024 + head * 64;
        bf16x8 qf[4];
#pragma unroll
        for (int d0 = 0; d0 < 4; ++d0) qf[d0] = *(const bf16x8*)(qp + 16 * d0 + 8 * hi);
        f32x16 p[5];
#pragma unroll
        for (int kt = 0; kt < 5; ++kt) {
#pragma unroll
            for (int r = 0; r < 16; ++r) p[kt][r] = 0.f;
#pragma unroll
            for (int d0 = 0; d0 < 4; ++d0) { const bf16x8 kf = *(const bf16x8*)(Ks + (32 * qg + 32 * kt + ql) * 72 + 16 * d0 + 8 * hi);
                p[kt] = __builtin_amdgcn_mfma_f32_32x32x16_bf16(kf, qf[d0], p[kt], 0, 0, 0); }
        }
        const float sink = sinks[head];
        float mx = -INFINITY;
#pragma unroll
        for (int kt = 0; kt < 5; ++kt)
#pragma unroll
            for (int r = 0; r < 16; ++r) { const int kk = (r & 3) + 8 * (r >> 2) + 4 * hi; bool valid = true;
                if (kt == 0) valid = kk >= ql; if (kt == 4) valid = kk <= ql; if (j == 0) valid = valid && (32 * qg + 32 * kt + kk >= 128);
                const float v = valid ? p[kt][r] * 0.125f : -INFINITY; p[kt][r] = v; mx = fmaxf(mx, v); }
        mx = fmaxf(mx, __shfl_xor(mx, 32)); mx = fmaxf(mx, sink);
        float l = 0.f;
#pragma unroll
        for (int kt = 0; kt < 5; ++kt)
#pragma unroll
            for (int r = 0; r < 16; ++r) { const float e = __expf(p[kt][r] - mx); p[kt][r] = e; l += e; }
        l += __shfl_xor(l, 32);
        const float inv = 1.0f / (l + __expf(sink - mx));
        f32x16 o0, o1;
#pragma unroll
        for (int r = 0; r < 16; ++r) { o0[r] = 0.f; o1[r] = 0.f; }
#pragma unroll
        for (int kt = 0; kt < 5; ++kt)
#pragma unroll
            for (int hf = 0; hf < 2; ++hf) {
                u32x4 pw; pw.x = cvt_pk_bf16(p[kt][8 * hf + 0], p[kt][8 * hf + 1]); pw.y = cvt_pk_bf16(p[kt][8 * hf + 2], p[kt][8 * hf + 3]);
                pw.z = cvt_pk_bf16(p[kt][8 * hf + 4], p[kt][8 * hf + 5]); pw.w = cvt_pk_bf16(p[kt][8 * hf + 6], p[kt][8 * hf + 7]);
                const bf16x8 pf = __builtin_bit_cast(bf16x8, pw);
                const int sk = 32 * qg + 32 * kt + 16 * hf + 4 * hi;
                { const bf16_t* vp = Vt + ql * 264 + sk; const u32x2 a = *(const u32x2*)vp, b = *(const u32x2*)(vp + 8);
                  const bf16x8 vf = __builtin_bit_cast(bf16x8, ((u32x4){a.x, a.y, b.x, b.y})); o0 = __builtin_amdgcn_mfma_f32_32x32x16_bf16(vf, pf, o0, 0, 0, 0); }
                { const bf16_t* vp = Vt + (32 + ql) * 264 + sk; const u32x2 a = *(const u32x2*)vp, b = *(const u32x2*)(vp + 8);
                  const bf16x8 vf = __builtin_bit_cast(bf16x8, ((u32x4){a.x, a.y, b.x, b.y})); o1 = __builtin_amdgcn_mfma_f32_32x32x16_bf16(vf, pf, o1, 0, 0, 0); }
            }
#pragma unroll
        for (int c4 = 0; c4 < 4; ++c4) {
            u32x2 w0, w1;
            w0.x = cvt_pk_bf16(o0[4 * c4 + 0] * inv, o0[4 * c4 + 1] * inv); w0.y = cvt_pk_bf16(o0[4 * c4 + 2] * inv, o0[4 * c4 + 3] * inv);
            w1.x = cvt_pk_bf16(o1[4 * c4 + 0] * inv, o1[4 * c4 + 1] * inv); w1.y = cvt_pk_bf16(o1[4 * c4 + 2] * inv, o1[4 * c4 + 3] * inv);
            *(u32x2*)(qp + 8 * c4 + 4 * hi) = w0; *(u32x2*)(qp + 32 + 8 * c4 + 4 * hi) = w1;
        }
    }
    __syncthreads();
}
__device__ __forceinline__ void attn_sample_task(float* wl, bf16_t* Q, const bf16_t* KB, const bf16_t* VB, const float* ck, const float* cv, const float* sinks, int b, int g, int lane) {
    float* qs = wl; float* pp = wl + 256;
    bf16_t* qrow = Q + (size_t)(SEQ + b) * 1024 + 4 * g * 64;
#pragma unroll
    for (int h = 0; h < 4; ++h) qs[h * 64 + lane] = bf2f(qrow[h * 64 + lane]) * 0.125f;
    const float knew = bf2f(KB[(size_t)(SEQ + b) * 256 + 64 * g + lane]), vnew = bf2f(VB[(size_t)(SEQ + b) * 256 + 64 * g + lane]);
    asm volatile("s_waitcnt lgkmcnt(0)" ::: "memory");
    float sc[2][4];
#pragma unroll
    for (int kk = 0; kk < 2; ++kk) { const int s = lane + 64 * kk; const f32x4* kp = (const f32x4*)(ck + ((size_t)(b * 128 + s) * 4 + g) * 64);
        float a0 = 0.f, a1 = 0.f, a2 = 0.f, a3 = 0.f;
#pragma unroll 4
        for (int c = 0; c < 16; ++c) { const f32x4 kv = kp[c];
            const f32x4 q0 = *(const f32x4*)(qs + 4 * c), q1 = *(const f32x4*)(qs + 64 + 4 * c), q2 = *(const f32x4*)(qs + 128 + 4 * c), q3 = *(const f32x4*)(qs + 192 + 4 * c);
            a0 += kv[0] * q0[0] + kv[1] * q0[1] + kv[2] * q0[2] + kv[3] * q0[3]; a1 += kv[0] * q1[0] + kv[1] * q1[1] + kv[2] * q1[2] + kv[3] * q1[3];
            a2 += kv[0] * q2[0] + kv[1] * q2[1] + kv[2] * q2[2] + kv[3] * q2[3]; a3 += kv[0] * q3[0] + kv[1] * q3[1] + kv[2] * q3[2] + kv[3] * q3[3]; }
        sc[kk][0] = a0; sc[kk][1] = a1; sc[kk][2] = a2; sc[kk][3] = a3; }
#pragma unroll
    for (int h = 0; h < 4; ++h) {
        const float sn = wave_sum(qs[h * 64 + lane] * knew), sink = sinks[4 * g + h];
        float m = wave_max(fmaxf(sc[0][h], sc[1][h])); m = fmaxf(fmaxf(m, sn), sink);
        const float e0 = __expf(sc[0][h] - m), e1 = __expf(sc[1][h] - m), en = __expf(sn - m);
        const float inv = 1.0f / (wave_sum(e0 + e1) + en + __expf(sink - m));
        pp[lane * 4 + h] = e0 * inv; pp[(64 + lane) * 4 + h] = e1 * inv; if (lane == 0) pp[512 + h] = en * inv;
    }
    asm volatile("s_waitcnt lgkmcnt(0)" ::: "memory");
    float o0 = 0.f, o1 = 0.f, o2 = 0.f, o3 = 0.f;
    const float* vp = cv + ((size_t)(b * 128) * 4 + g) * 64 + lane;
#pragma unroll 8
    for (int s = 0; s < 128; ++s) { const float v = vp[(size_t)s * 256]; const f32x4 pv = *(const f32x4*)(pp + 4 * s); o0 += pv[0] * v; o1 += pv[1] * v; o2 += pv[2] * v; o3 += pv[3] * v; }
    { const f32x4 pv = *(const f32x4*)(pp + 512); o0 += pv[0] * vnew; o1 += pv[1] * vnew; o2 += pv[2] * vnew; o3 += pv[3] * vnew; }
    qrow[lane] = (bf16_t)(cvt_pk_bf16(o0, 0.f) & 0xffffu); qrow[64 + lane] = (bf16_t)(cvt_pk_bf16(o1, 0.f) & 0xffffu);
    qrow[128 + lane] = (bf16_t)(cvt_pk_bf16(o2, 0.f) & 0xffffu); qrow[192 + lane] = (bf16_t)(cvt_pk_bf16(o3, 0.f) & 0xffffu);
    asm volatile("s_waitcnt lgkmcnt(0)" ::: "memory");
}


#if SELFCHECK
constexpr size_t WS_CHK = 512 * 1024;
__device__ __forceinline__ unsigned hsh(unsigned x) { x ^= x >> 16; x *= 0x7feb352du; x ^= x >> 15; x *= 0x846ca68bu; x ^= x >> 16; return x; }
__device__ __forceinline__ int samp_row(int s) {
    if ((s & 3) == 0) { switch ((s >> 2) & 7) { case 0: return 0; case 1: return 1; case 2: return 255; case 3: return 256; case 4: return SEQ - 1; case 5: return SEQ; case 6: return SEQ + 100; default: return 8191; } }
    if ((s & 3) == 1) return SEQ + (int)(hsh(s) % NS);
    return (int)(hsh(s * 3 + 1) % SEQ);
}
__device__ __forceinline__ bool chk_bad(float got, float ref) { return !(fabsf(got - ref) <= 0.05f * fabsf(ref) + 0.04f); }
__device__ __forceinline__ float wdot_bf(const bf16_t* a, const float* W, int ldw, int col, int K, int lane) {
    float s = 0.f; for (int k = lane; k < K; k += 64) s += bf2f(a[k]) * W[(size_t)k * ldw + col]; return wave_sum(s); }
#define CHK_FAIL(bit) do { if (lane == 0) atomicOr(mask, 1u << (bit)); } while (0)
#endif

template <int KLEN>
__device__ __forceinline__ f32x4 mini_kloop(const bf16_t* Arow, const bf16_t* Brow, f32x4 acc) {
    constexpr int NS_ = KLEN / 32;
    static_assert(KLEN % 32 == 0, "K quarter");
#pragma unroll 1
    for (int s0 = 0; s0 < NS_; s0 += 8) {
        bf16x8 a[8], b[8];
#pragma unroll
        for (int i = 0; i < 8; ++i) if (s0 + i < NS_) { a[i] = *(const bf16x8*)(Arow + (s0 + i) * 32); b[i] = *(const bf16x8*)(Brow + (s0 + i) * 32); }
#pragma unroll
        for (int i = 0; i < 8; ++i) if (s0 + i < NS_) acc = __builtin_amdgcn_mfma_f32_16x16x32_bf16(b[i], a[i], acc, 0, 0, 0);
    }
    return acc;
}
struct MiniArgs { const bf16_t* A0; const bf16_t* B0; const bf16_t* A1; const bf16_t* B1; const bf16_t* GA; const bf16_t* GB; bf16_t* Z; const float* base; float* out; const float* ADA; int goff; };
template <int MODE, int K>
__device__ __forceinline__ void mini_sample_gemm(unsigned char* lds, const MiniArgs& P, int bid, int G, int wave, int lane) {
    const int fr = lane & 15, fq = lane >> 4, tl = wave >> 2, kq = wave & 3;
    f32x4* red = (f32x4*)lds;
    for (int T0 = 2 * bid; T0 < 512; T0 += 2 * G) {
        const int T = T0 + tl, rt = T & 7, ct = T >> 3;
        const int row = SEQ + 16 * rt + fr, colb = 16 * ct + fr;
        const size_t ko = (size_t)kq * (K / 4) + 8 * fq;
        f32x4 acc0 = (f32x4){0.f, 0.f, 0.f, 0.f}, acc1 = acc0;
        acc0 = mini_kloop<K / 4>(P.A0 + (size_t)row * K + ko, P.B0 + (size_t)colb * K + ko, acc0);
        if (MODE == 0) acc1 = mini_kloop<K / 4>(P.A1 + (size_t)row * K + ko, P.B1 + (size_t)colb * K + ko, acc1);
        red[wave * 64 + lane] = acc0; if (MODE == 0) red[512 + wave * 64 + lane] = acc1;
        __syncthreads();
        if (kq == 0) {
            f32x4 s0 = red[wave * 64 + lane] + red[(wave + 1) * 64 + lane] + red[(wave + 2) * 64 + lane] + red[(wave + 3) * 64 + lane];
            const int col = 16 * ct + 4 * fq;
            if (MODE == 0) {
                const f32x4 s1 = red[512 + wave * 64 + lane] + red[512 + (wave + 1) * 64 + lane] + red[512 + (wave + 2) * 64 + lane] + red[512 + (wave + 3) * 64 + lane];
                const u32x2 ga = *(const u32x2*)(P.GA + (size_t)row * 1024 + col), gb = *(const u32x2*)(P.GB + (size_t)row * 1024 + col);
                const float z0 = sigmoidf_(bf2f(ga.x & 0xffffu)) * s0[0] + sigmoidf_(bf2f(gb.x & 0xffffu)) * s1[0], z1 = sigmoidf_(bf2f(ga.x >> 16)) * s0[1] + sigmoidf_(bf2f(gb.x >> 16)) * s1[1];
                const float z2 = sigmoidf_(bf2f(ga.y & 0xffffu)) * s0[2] + sigmoidf_(bf2f(gb.y & 0xffffu)) * s1[2], z3 = sigmoidf_(bf2f(ga.y >> 16)) * s0[3] + sigmoidf_(bf2f(gb.y >> 16)) * s1[3];
                u32x2 w; w.x = cvt_pk_bf16(z0, z1); w.y = cvt_pk_bf16(z2, z3); *(u32x2*)(P.Z + (size_t)row * 1024 + col) = w;
            } else {
                const int b = row - SEQ;
                const f32x4 bs = *(const f32x4*)(P.base + (size_t)b * 1024 + col), g = *(const f32x4*)(P.ADA + (size_t)b * NADA + P.goff + col);
                *(f32x4*)(P.out + (size_t)row * 1024 + col) = bs + g * s0;
            }
        }
        __syncthreads();
    }
}
struct Args { const float* in[23]; float* out; unsigned char* ws; };
enum { I_XP = 0, I_XS, I_CP, I_CS, I_SCA, I_CK, I_CV, I_SFF, I_WADA, I_BADA, I_GMIX, I_WIN, I_CAW, I_SINK, I_WAO, I_WBO, I_WO, I_GFFN, I_WUP, I_FCW, I_FCB, I_WDN, I_GFIN };

__global__ void __launch_bounds__(512, 2) mega(Args a) {
    extern __shared__ __attribute__((aligned(16))) unsigned char lds[];
    PG8_LAS unsigned char* ldsl = (PG8_LAS unsigned char*)lds;
    const int G = gridDim.x, bid = blockIdx.x, NGW = G * 8;
    const int wave0 = __builtin_amdgcn_readfirstlane((int)threadIdx.x >> 6);
    const long NGT = (long)G * 512;
#define PHASE_IDS() int tid = wave0 * 64 + (int)__builtin_amdgcn_mbcnt_hi(~0u, __builtin_amdgcn_mbcnt_lo(~0u, 0u)); asm volatile("" : "+v"(tid)); const int lane = tid & 63, wave = wave0; \
    const int gw = bid * 8 + wave; const long gt = (long)bid * 512 + tid; float* const scr = (float*)(lds + wave * 16384); (void)lane; (void)gw; (void)gt; (void)scr;
    typedef const __attribute__((address_space(4))) Args* KArgs;
    const KArgs ap0 = (KArgs)__builtin_amdgcn_kernarg_segment_ptr();
#define ARGS() ({ KArgs p_ = ap0; asm volatile("" : "+s"(p_)); p_; })
#define IN(i) (ARGS()->in[i])
#define WS(off) (ARGS()->ws + (off))
#define OUT() (ARGS()->out)
#define AADA ((bf16_t*)WS(WS_AADA))
#define ADA ((float*)WS(WS_ADA))
#define WA ((bf16_t*)WS(WS_WA))
#define WB ((bf16_t*)WS(WS_WB))
#define WO ((bf16_t*)WS(WS_WO))
#define WADA ((bf16_t*)WS(WS_WADA))
#define WIN ((bf16_t*)WS(WS_WIN))
#define WUP ((bf16_t*)WS(WS_WUP))
#define WDN ((bf16_t*)WS(WS_WDN))
#define H ((bf16_t*)WS(WS_H))
#define U ((bf16_t*)WS(WS_U))
#define BG ((bf16_t*)WS(WS_BG))
#define Q ((bf16_t*)WS(WS_Q))
#define KB ((bf16_t*)WS(WS_KB))
#define VB ((bf16_t*)WS(WS_VB))
#define GA ((bf16_t*)WS(WS_GA))
#define GB ((bf16_t*)WS(WS_GB))
#define GG ((bf16_t*)WS(WS_G))
#define AIN H
#define Z U
#define H2 BG

    {
        PHASE_IDS();
#if SELFCHECK
        if (gt == 0) *(unsigned*)WS(WS_CHK) = 0u;
#endif
        constexpr int I_ADA = 16 * (NADA / 32), I_IN = 16 * (NIN / 32), I_SQ = 16 * 32;
        constexpr int NIT = I_ADA + I_IN + 3 * I_SQ;
        for (int it = gw; it < NIT; it += NGW) {
            int r = it;
            if (r < I_ADA) { const int nb = NADA / 32, kb = r / nb, n0 = 32 * (r % nb); transpose_item(IN(I_WADA), 1024, NADA, WADA, 64 * kb, n0, n0, scr, lane); continue; } r -= I_ADA;
            if (r < I_IN) { const int nb = NIN / 32, kb = r / nb, n0 = 32 * (r % nb); transpose_item(IN(I_WIN), 1024, NIN, WIN, 64 * kb, n0, win_drow(n0), scr, lane); continue; } r -= I_IN;
            const int which = r / I_SQ; r -= which * I_SQ; const int kb = r / 32, n0 = 32 * (r % 32);
            transpose_item(which == 0 ? IN(I_WAO) : (which == 1 ? IN(I_WBO) : IN(I_WO)), 1024, 1024, which == 0 ? WA : (which == 1 ? WB : WO), 64 * kb, n0, n0, scr, lane);
        }
        const float* const cs = IN(I_CS); const float* const cp = IN(I_CP); bf16_t* const aada = AADA;
        for (long i = gt; i < 256 * 1024 / 4; i += NGT) { const int row = (int)(i >> 8), c4 = (int)(i & 255) * 4;
            f32x4 v = (f32x4){0.f, 0.f, 0.f, 0.f};
            if (row < 128) v = *(const f32x4*)(cs + (size_t)row * 1024 + c4); else if (row == 128) v = *(const f32x4*)(cp + c4);
            u32x2 w; w.x = cvt_pk_bf16(siluf_(v[0]), siluf_(v[1])); w.y = cvt_pk_bf16(siluf_(v[2]), siluf_(v[3])); *(u32x2*)(aada + (size_t)row * 1024 + c4) = w; }
    }
    cg::this_grid().sync();
    {
        typedef Sched<0, 2048, 2048> SC; SC S; S.to.init(1, NADA / 256); S.G = G; S.c = bid; S.A0 = (const char*)AADA; S.B0 = (const char*)WADA;
        EpiAda E{ADA, IN(I_BADA)};
        pg8::gemm_phase<EpiAda, SC, 1024, 1024, 1024, true, true>(ldsl, wave0, S, E);
    }
#if SELFCHECK
    cg::this_grid().sync();
    if (bid == 0) { PHASE_IDS(); unsigned* mask = (unsigned*)WS(WS_CHK); (void)tid;
        for (int sm = wave; sm < 32; sm += 8) {
            const int r = (int)(hsh(sm) % 129u), n = (int)(hsh(sm + 77) % NADA);
            const float* c = (r < 128) ? IN(I_CS) + (size_t)r * 1024 : IN(I_CP); const float* W = IN(I_WADA);
            float a = 0.f; for (int k = lane; k < 1024; k += 64) a += siluf_(c[k]) * W[(size_t)k * NADA + n];
            const float ref = wave_sum(a) + IN(I_BADA)[n];
            if (chk_bad(ADA[(size_t)r * NADA + n], ref)) CHK_FAIL(0);
        }
    }
#endif
    cg::this_grid().sync();
    {
        PHASE_IDS();
        const float* const xp = IN(I_XP); const float* const xs = IN(I_XS); const float* const gm = IN(I_GMIX); const float* const ada = ADA; bf16_t* const h = H;
        for (int row = gw; row < MROWS; row += NGW) {
            const float* xr = (row < SEQ) ? xp + (size_t)row * 1024 : xs + (size_t)(row - SEQ) * 1024;
            const float* ad = ada + (size_t)((row < SEQ) ? 128 : row - SEQ) * NADA;
            modnorm_row(xr, gm, ad + 1024, ad, h + (size_t)row * 1024, lane);
        }
    }
#if SELFCHECK
    cg::this_grid().sync();
    if (bid == 0) { PHASE_IDS(); unsigned* mask = (unsigned*)WS(WS_CHK); (void)tid;
        for (int sm = wave; sm < 32; sm += 8) {
            const int row = samp_row(sm), col = (int)(hsh(sm + 5) % 1024u), ar = (row < SEQ) ? 128 : row - SEQ;
            const float* xr = (row < SEQ) ? IN(I_XP) + (size_t)row * 1024 : IN(I_XS) + (size_t)(row - SEQ) * 1024;
            float a = 0.f; for (int k = lane; k < 1024; k += 64) a += xr[k] * xr[k];
            const float rstd = rsqrtf(wave_sum(a) * (1.f / 1024.f) + EPS); const float* ad = ADA + (size_t)ar * NADA;
            const float ref = xr[col] * rstd * IN(I_GMIX)[col] * (1.f + ad[1024 + col]) + ad[col];
            if (chk_bad(bf2f(H[(size_t)row * 1024 + col]), ref)) CHK_FAIL(1);
        }
    }
#endif
    cg::this_grid().sync();
    {
        typedef Sched<0, 2048, 2048> SC; SC S; S.to.init(NMT, NIN / 256); S.G = G; S.c = bid; S.A0 = (const char*)H; S.B0 = (const char*)WIN;
        EpiProj E{U, BG, Q, KB, VB, GA, GB};
        pg8::gemm_phase<EpiProj, SC, 1024, 1024, 1024, true, true>(ldsl, wave0, S, E);
    }
#if SELFCHECK
    cg::this_grid().sync();
    if (bid == 0) { PHASE_IDS(); unsigned* mask = (unsigned*)WS(WS_CHK); (void)tid;
        for (int sm = wave; sm < 32; sm += 8) {
            const int row = samp_row(sm), f = (int)(hsh(sm + 9) % 1024u); const bf16_t* hr = H + (size_t)row * 1024; const float* W = IN(I_WIN);
            { const float ref = wdot_bf(hr, W, NIN, f, 1024, lane) * wdot_bf(hr, W, NIN, 2048 + f, 1024, lane); if (chk_bad(bf2f(U[(size_t)row * 1024 + f]), ref)) CHK_FAIL(2); }
            { const float r1 = wdot_bf(hr, W, NIN, 1024 + f, 1024, lane), r2 = wdot_bf(hr, W, NIN, 3072 + f, 1024, lane);
              if (chk_bad(bf2f(BG[(size_t)row * 1024 + f]), r1) || chk_bad(bf2f(Q[(size_t)row * 1024 + f]), r2)) CHK_FAIL(3); }
            { const int f2 = f & 255; const float r1 = wdot_bf(hr, W, NIN, 4096 + f2, 1024, lane), r2 = wdot_bf(hr, W, NIN, 4352 + f2, 1024, lane);
              if (chk_bad(bf2f(KB[(size_t)row * 256 + f2]), r1) || chk_bad(bf2f(VB[(size_t)row * 256 + f2]), r2)) CHK_FAIL(4); }
            { const float r1 = wdot_bf(hr, W, NIN, 4608 + f, 1024, lane), r2 = wdot_bf(hr, W, NIN, 5632 + f, 1024, lane);
              if (chk_bad(bf2f(GA[(size_t)row * 1024 + f]), r1) || chk_bad(bf2f(GB[(size_t)row * 1024 + f]), r2)) CHK_FAIL(5); }
            { const int head = (int)(hsh(sm + 21) % 16u); ((float*)WS(WS_CHK + 4096))[sm * 64 + lane] = bf2f(Q[(size_t)row * 1024 + head * 64 + lane]); }
        }
    }
#endif
    cg::this_grid().sync();
    {
        PHASE_IDS();
        {   bf16_t* const q_ = Q; const bf16_t* const kb_ = KB; const bf16_t* const vb_ = VB; const float* const sinks = IN(I_SINK);
            for (int un = bid; un < 512; un += G) attn_prompt_unit(lds, q_, kb_, vb_, sinks, un >> 2, un & 3, tid); }
        {   bf16_t* const q_ = Q; const bf16_t* const kb_ = KB; const bf16_t* const vb_ = VB; const float* const sinks = IN(I_SINK);
            const float* const ck_ = IN(I_CK); const float* const cv_ = IN(I_CV);
            float* wl = (float*)(lds + 73728 + wave * 4096);
            for (int t = gw; t < 512; t += NGW) attn_sample_task(wl, q_, kb_, vb_, ck_, cv_, sinks, t >> 2, t & 3, lane); }
        {
        float* const out = OUT();
        const float* caw = IN(I_CAW); const float* sca = IN(I_SCA); const bf16_t* const u_ = U; const bf16_t* const bg_ = BG; bf16_t* const ain_ = AIN;
        for (long it = gt; it < (long)MROWS * 128; it += NGT) {
            const int row = (int)(it >> 7), c8 = (int)(it & 127) * 8;
            float w0[8], w1[8], w2[8], u0[8], u1[8], u2[8], bg[8], o[8];
            *(f32x4*)w0 = *(const f32x4*)(caw + c8); *(f32x4*)(w0 + 4) = *(const f32x4*)(caw + c8 + 4);
            *(f32x4*)w1 = *(const f32x4*)(caw + 1024 + c8); *(f32x4*)(w1 + 4) = *(const f32x4*)(caw + 1024 + c8 + 4);
            *(f32x4*)w2 = *(const f32x4*)(caw + 2048 + c8); *(f32x4*)(w2 + 4) = *(const f32x4*)(caw + 2048 + c8 + 4);
            unpack8(*(const u32x4*)(u_ + (size_t)row * 1024 + c8), u2);
            unpack8(*(const u32x4*)(bg_ + (size_t)row * 1024 + c8), bg);
            if (row < SEQ) {
                if (row >= 1) unpack8(*(const u32x4*)(u_ + (size_t)(row - 1) * 1024 + c8), u1); else { for (int i = 0; i < 8; ++i) u1[i] = 0.f; }
                if (row >= 2) unpack8(*(const u32x4*)(u_ + (size_t)(row - 2) * 1024 + c8), u0); else { for (int i = 0; i < 8; ++i) u0[i] = 0.f; }
                if (row >= SEQ - 2) { float* op = out + O_CAP + (size_t)(row - (SEQ - 2)) * 1024 + c8; *(f32x4*)op = *(f32x4*)u2; *(f32x4*)(op + 4) = *(f32x4*)(u2 + 4); }
            } else {
                const int b = row - SEQ; const float* s0 = sca + (size_t)(b * 2) * 1024 + c8; const float* s1 = s0 + 1024;
                *(f32x4*)u0 = *(const f32x4*)s0; *(f32x4*)(u0 + 4) = *(const f32x4*)(s0 + 4); *(f32x4*)u1 = *(const f32x4*)s1; *(f32x4*)(u1 + 4) = *(const f32x4*)(s1 + 4);
                float* op = out + O_CAS + (size_t)(b * 2) * 1024 + c8;
                *(f32x4*)op = *(f32x4*)u1; *(f32x4*)(op + 4) = *(f32x4*)(u1 + 4); *(f32x4*)(op + 1024) = *(f32x4*)u2; *(f32x4*)(op + 1024 + 4) = *(f32x4*)(u2 + 4);
            }
#pragma unroll
            for (int i = 0; i < 8; ++i) o[i] = bg[i] * (w0[i] * u0[i] + w1[i] * u1[i] + w2[i] * u2[i]);
            *(u32x4*)(ain_ + (size_t)row * 1024 + c8) = pack8(o);
        }
        }
        {
        float* const out = OUT(); const float* const ck_ = IN(I_CK); const float* const cv_ = IN(I_CV); const bf16_t* const kb_ = KB; const bf16_t* const vb_ = VB;
        for (long i = gt; i < 2L * 128 * 128 * 64; i += NGT) {
            const int which = (int)(i >> 20); const int r2 = (int)(i & 1048575); const int b = r2 >> 13, r = (r2 >> 6) & 127, c = r2 & 63;
            const float* cache = which ? cv_ : ck_; const bf16_t* nb = which ? vb_ : kb_;
            f32x4 v;
            if (r < 127) v = *(const f32x4*)(cache + ((size_t)(b * 128 + r + 1) * 256 + 4 * c));
            else { const u32x2 w = *(const u32x2*)(nb + (size_t)(SEQ + b) * 256 + 4 * c); v = (f32x4){bf2f(w.x & 0xffffu), bf2f(w.x >> 16), bf2f(w.y & 0xffffu), bf2f(w.y >> 16)}; }
            *(f32x4*)(out + (which ? O_VS : O_KS) + (size_t)r2 * 4) = v;
        }
        for (long i = gt; i < 2L * 128 * 64; i += NGT) {
            const int which = (int)(i >> 13); const int r2 = (int)(i & 8191); const int r = r2 >> 6, c = r2 & 63; const bf16_t* nb = which ? vb_ : kb_;
            const u32x2 w = *(const u32x2*)(nb + (size_t)(SEQ - 128 + r) * 256 + 4 * c);
            *(f32x4*)(out + (which ? O_VP : O_KP) + (size_t)r2 * 4) = (f32x4){bf2f(w.x & 0xffffu), bf2f(w.x >> 16), bf2f(w.y & 0xffffu), bf2f(w.y >> 16)};
        }
        }
        __syncthreads();
        constexpr int I_UP = 16 * (FF2 / 32), I_DN = (FF / 64) * 32;
        for (int it = gw; it < I_UP + I_DN; it += NGW) {
            if (it < I_UP) { const int nb = FF2 / 32, kb = it / nb, n0 = 32 * (it % nb); transpose_item(IN(I_WUP), 1024, FF2, WUP, 64 * kb, n0, wup_drow(n0), scr, lane); }
            else { const int r = it - I_UP, kb = r / 32, n0 = 32 * (r % 32); transpose_item(IN(I_WDN), FF, 1024, WDN, 64 * kb, n0, n0, scr, lane); }
        }
    }
#if SELFCHECK
    cg::this_grid().sync();
    if (bid == 0) { PHASE_IDS(); unsigned* mask = (unsigned*)WS(WS_CHK); (void)tid;
        for (int sm = wave; sm < 32; sm += 8) {
            const int row = samp_row(sm), f = (int)(hsh(sm + 9) % 1024u);
            {   const float* cw_ = IN(I_CAW); float u0, u1; const float u2 = bf2f(U[(size_t)row * 1024 + f]);
                if (row < SEQ) { u1 = (row >= 1) ? bf2f(U[(size_t)(row - 1) * 1024 + f]) : 0.f; u0 = (row >= 2) ? bf2f(U[(size_t)(row - 2) * 1024 + f]) : 0.f; }
                else { const float* st = IN(I_SCA) + (size_t)((row - SEQ) * 2) * 1024; u0 = st[f]; u1 = st[1024 + f]; }
                const float ref = bf2f(BG[(size_t)row * 1024 + f]) * (cw_[f] * u0 + cw_[1024 + f] * u1 + cw_[2048 + f] * u2);
                if (chk_bad(bf2f(AIN[(size_t)row * 1024 + f]), ref)) CHK_FAIL(6); }
            {   const int head = (int)(hsh(sm + 21) % 16u), g = head >> 2; const float qv = ((const float*)WS(WS_CHK + 4096))[sm * 64 + lane] * 0.125f;
                const float sink = IN(I_SINK)[head]; const int nk = 129;
                float mx = sink, l = 0.f, o = 0.f;
                for (int pass = 0; pass < 2; ++pass)
                    for (int i = 0; i < nk; ++i) {
                        float kv, vv; bool ok = true;
                        if (row < SEQ) { const int tk = row - 128 + i; ok = tk >= 0; kv = ok ? bf2f(KB[(size_t)tk * 256 + g * 64 + lane]) : 0.f; vv = ok ? bf2f(VB[(size_t)tk * 256 + g * 64 + lane]) : 0.f; }
                        else { const int b = row - SEQ; if (i < 128) { kv = IN(I_CK)[((size_t)(b * 128 + i) * 4 + g) * 64 + lane]; vv = IN(I_CV)[((size_t)(b * 128 + i) * 4 + g) * 64 + lane]; }
                               else { kv = bf2f(KB[(size_t)row * 256 + g * 64 + lane]); vv = bf2f(VB[(size_t)row * 256 + g * 64 + lane]); } }
                        const float sc = wave_sum(qv * kv);
                        if (ok) { if (pass == 0) mx = fmaxf(mx, sc); else { const float e = __expf(sc - mx); l += e; o += e * vv; } }
                    }
                const float ref = o / (l + __expf(sink - mx));
                if (chk_bad(bf2f(Q[(size_t)row * 1024 + head * 64 + lane]), ref)) { if (__ballot(1)) { if (lane == 0 || true) atomicOr(mask, 1u << 7); } } }
        }
    }
#endif
    cg::this_grid().sync();
    {
        typedef Sched<1, 2048, 2048> SC; SC S; S.to.init(SEQ / 256, 4); S.G = G; S.c = bid; S.A0 = (const char*)AIN; S.B0 = (const char*)WA; S.A1 = (const char*)Q; S.B1 = (const char*)WB;
        EpiMix E{GA, GB, OUT(), Z};
        pg8::gemm_phase<EpiMix, SC, 1024, 1024, 1024, true, true>(ldsl, wave0, S, E);
        { PHASE_IDS(); MiniArgs P{AIN, WA, Q, WB, GA, GB, Z, nullptr, nullptr, nullptr, 0}; mini_sample_gemm<0, 1024>(lds, P, bid, G, wave, lane); }
    }
#if SELFCHECK
    cg::this_grid().sync();
    if (bid == 0) { PHASE_IDS(); unsigned* mask = (unsigned*)WS(WS_CHK); (void)tid;
        for (int sm = wave; sm < 32; sm += 8) {
            const int row = samp_row(sm), f = (int)(hsh(sm + 9) % 1024u);
            const float ya = wdot_bf(AIN + (size_t)row * 1024, IN(I_WAO), 1024, f, 1024, lane), yb = wdot_bf(Q + (size_t)row * 1024, IN(I_WBO), 1024, f, 1024, lane);
            const float ref = sigmoidf_(bf2f(GA[(size_t)row * 1024 + f])) * ya + sigmoidf_(bf2f(GB[(size_t)row * 1024 + f])) * yb;
            if (chk_bad(bf2f(Z[(size_t)row * 1024 + f]), ref)) CHK_FAIL(8);
        }
    }
#endif
    cg::this_grid().sync();
    {
        typedef Sched<0, 2048, 2048> SC; SC S; S.to.init(SEQ / 256, 4); S.G = G; S.c = bid; S.A0 = (const char*)Z; S.B0 = (const char*)WO;
        EpiRes E{IN(I_XP), IN(I_XS), OUT(), ADA, 2048};
        pg8::gemm_phase<EpiRes, SC, 1024, 1024, 1024, true, true>(ldsl, wave0, S, E);
        { PHASE_IDS(); MiniArgs P{Z, WO, nullptr, nullptr, nullptr, nullptr, nullptr, IN(I_XS), OUT(), ADA, 2048}; mini_sample_gemm<1, 1024>(lds, P, bid, G, wave, lane); }
    }
#if SELFCHECK
    cg::this_grid().sync();
    if (bid == 0) { PHASE_IDS(); unsigned* mask = (unsigned*)WS(WS_CHK); (void)tid;
        for (int sm = wave; sm < 32; sm += 8) {
            const int row = samp_row(sm), f = (int)(hsh(sm + 9) % 1024u), ar = (row < SEQ) ? 128 : row - SEQ;
            const float xv = (row < SEQ) ? IN(I_XP)[(size_t)row * 1024 + f] : IN(I_XS)[(size_t)(row - SEQ) * 1024 + f];
            const float ref = xv + ADA[(size_t)ar * NADA + 2048 + f] * wdot_bf(Z + (size_t)row * 1024, IN(I_WO), 1024, f, 1024, lane);
            if (chk_bad(OUT()[(size_t)row * 1024 + f], ref)) CHK_FAIL(9);
        }
    }
#endif
    cg::this_grid().sync();
    {
        PHASE_IDS();
        float* const out = OUT(); const float* const ada = ADA; const float* const gf = IN(I_GFFN); bf16_t* const h2 = H2;
        if (gt < 256) *(u32x4*)((unsigned char*)h2 - 4096 + gt * 16) = (u32x4){0u, 0u, 0u, 0u};
        for (int row = gw; row < MROWS; row += NGW) {
            const float* ad = ada + (size_t)((row < SEQ) ? 128 : row - SEQ) * NADA;
            modnorm_row(out + (size_t)row * 1024, gf, ad + 4096, ad + 3072, h2 + (size_t)row * 1024, lane);
        }
    }
#if SELFCHECK
    cg::this_grid().sync();
    if (bid == 0) { PHASE_IDS(); unsigned* mask = (unsigned*)WS(WS_CHK); (void)tid;
        for (int sm = wave; sm < 32; sm += 8) {
            const int row = samp_row(sm), col = (int)(hsh(sm + 5) % 1024u), ar = (row < SEQ) ? 128 : row - SEQ;
            const float* xr = OUT() + (size_t)row * 1024;
            float a = 0.f; for (int k = lane; k < 1024; k += 64) a += xr[k] * xr[k];
            const float rstd = rsqrtf(wave_sum(a) * (1.f / 1024.f) + EPS); const float* ad = ADA + (size_t)ar * NADA;
            const float ref = xr[col] * rstd * IN(I_GFFN)[col] * (1.f + ad[4096 + col]) + ad[3072 + col];
            if (chk_bad(bf2f(H2[(size_t)row * 1024 + col]), ref)) CHK_FAIL(10);
        }
    }
#endif
    cg::this_grid().sync();
    {
        typedef Sched<2, 2048, 2048> SC; SC S; S.to.init(NPT5 + 1, FF2 / 256); S.G = G; S.c = bid; S.A0 = (const char*)H2; S.B0 = (const char*)WUP;
        float* const out = OUT(); EpiFfn E{GG, IN(I_FCW), IN(I_FCB), IN(I_SFF), out + O_FP, out + O_FS, (PG8_LAS float*)(ldsl + HALO_OFF)};
        pg8::gemm_phase<EpiFfn, SC, 1024, 1024, 1024, true, true>(ldsl, wave0, S, E);
    }
#if SELFCHECK
    cg::this_grid().sync();
    if (bid == 0) { PHASE_IDS(); unsigned* mask = (unsigned*)WS(WS_CHK); (void)tid;
        for (int sm = wave; sm < 32; sm += 8) {
            const int row = samp_row(sm), f = (int)(hsh(sm + 13) % (unsigned)FF); const float* W = IN(I_WUP); const float* cw_ = IN(I_FCW); const float* cb_ = IN(I_FCB);
            float cg = cb_[f], cv = cb_[FF + f];
            for (int tap = 0; tap < 3; ++tap) {
                float ug, uv;
                if (row < SEQ) { const int t = row - 2 + tap; if (t >= 0) { ug = wdot_bf(H2 + (size_t)t * 1024, W, FF2, f, 1024, lane); uv = wdot_bf(H2 + (size_t)t * 1024, W, FF2, FF + f, 1024, lane); } else { ug = 0.f; uv = 0.f; } }
                else { if (tap < 2) { const float* st = IN(I_SFF) + (size_t)((row - SEQ) * 2 + tap) * FF2; ug = st[f]; uv = st[FF + f]; } else { ug = wdot_bf(H2 + (size_t)row * 1024, W, FF2, f, 1024, lane); uv = wdot_bf(H2 + (size_t)row * 1024, W, FF2, FF + f, 1024, lane); } }
                cg += cw_[tap * FF2 + f] * ug; cv += cw_[tap * FF2 + FF + f] * uv;
                if (tap == 2) {
                    if (row >= SEQ) { const float* o = OUT() + O_FS + (size_t)((row - SEQ) * 2 + 1) * FF2; if (chk_bad(o[f], ug) || chk_bad(o[FF + f], uv)) CHK_FAIL(13); }
                    if (row >= SEQ - 2 && row < SEQ) { const float* o = OUT() + O_FP + (size_t)(row - (SEQ - 2)) * FF2; if (chk_bad(o[f], ug) || chk_bad(o[FF + f], uv)) CHK_FAIL(13); }
                }
            }
            const float ref = siluf_(cg) * cv;
            if (chk_bad(bf2f(GG[(size_t)row * FF + f]), ref)) CHK_FAIL(row < SEQ ? 11 : 12);
            if (lane == 0) ((float*)WS(WS_CHK + 16384))[sm] = OUT()[(size_t)row * 1024 + (f & 1023)];
        }
    }
#endif
    cg::this_grid().sync();
    {
        typedef Sched<0, FF * 2, FF * 2> SC; SC S; S.to.init(SEQ / 256, 4); S.G = G; S.c = bid; S.A0 = (const char*)GG; S.B0 = (const char*)WDN;
        { float* const out = OUT(); EpiRes E{out, out + O_YS, out, ADA, 5120};
        pg8::gemm_phase<EpiRes, SC, FF, FF, FF, true, true>(ldsl, wave0, S, E); }
        { PHASE_IDS(); float* const out = OUT(); MiniArgs P{GG, WDN, nullptr, nullptr, nullptr, nullptr, nullptr, out + O_YS, out, ADA, 5120}; mini_sample_gemm<1, FF>(lds, P, bid, G, wave, lane); }
    }
#if SELFCHECK
    cg::this_grid().sync();
    if (bid == 0) { PHASE_IDS(); unsigned* mask = (unsigned*)WS(WS_CHK); (void)tid;
        for (int sm = wave; sm < 32; sm += 8) {
            const int row = samp_row(sm), f = (int)(hsh(sm + 13) % (unsigned)FF) & 1023, ar = (row < SEQ) ? 128 : row - SEQ;
            const float ref = ((const float*)WS(WS_CHK + 16384))[sm] + ADA[(size_t)ar * NADA + 5120 + f] * wdot_bf(GG + (size_t)row * FF, IN(I_WDN), 1024, f, FF, lane);
            if (chk_bad(OUT()[(size_t)row * 1024 + f], ref)) CHK_FAIL(14);
        }
    }
#endif
    cg::this_grid().sync();
    {
    PHASE_IDS();
    float* const out = OUT(); const float* const gf = IN(I_GFIN);
    for (int row = gw; row < MROWS; row += NGW) {
        float* xr = out + (size_t)row * 1024;
        f32x4 v[4]; float s = 0.f;
#pragma unroll
        for (int j = 0; j < 4; ++j) { v[j] = ((const f32x4*)xr)[lane + 64 * j]; s += (v[j][0] * v[j][0] + v[j][1] * v[j][1]) + (v[j][2] * v[j][2] + v[j][3] * v[j][3]); }
        const float rstd = rsqrtf(wave_sum(s) * (1.0f / 1024.0f) + EPS);
#pragma unroll
        for (int j = 0; j < 4; ++j) { const f32x4 gg = *(const f32x4*)(gf + 4 * (lane + 64 * j)); ((f32x4*)xr)[lane + 64 * j] = v[j] * rstd * gg; }
    }
    }
#if SELFCHECK
    cg::this_grid().sync();
    {   PHASE_IDS(); const unsigned m = *(volatile unsigned*)WS(WS_CHK);
        if (m != 0u) { const int code = __builtin_ctz(m); const float sc = 1.5f + 0.1f * (float)code; float* o = OUT() + O_KS;
            for (long i = gt; i < 128L * 128 * 256; i += NGT) o[i] *= sc; } }
#endif
}

extern "C" void kernel_launch(void* const* d_in, const int* in_sizes, int n_in, void* d_out, int out_size, void* d_ws, size_t ws_size, hipStream_t stream) {
    static int grid = 0;
    if (grid == 0) {
        if (n_in != 23 || ws_size < WS_END) { fprintf(stderr, "kernel_launch: unexpected n_in %d / ws %zu\n", n_in, ws_size); grid = -1; return; }
        int dev = 0, cus = 0, per_cu = 0;
        hipGetDevice(&dev); hipDeviceGetAttribute(&cus, hipDeviceAttributeMultiprocessorCount, dev);
        if (hipFuncSetAttribute((const void*)mega, hipFuncAttributeMaxDynamicSharedMemorySize, LDS_BYTES) != hipSuccess) { fprintf(stderr, "kernel_launch: hipFuncSetAttribute failed\n"); }
        hipOccupancyMaxActiveBlocksPerMultiprocessor(&per_cu, (const void*)mega, 512, LDS_BYTES);
        (void)hipGetLastError();
        if (per_cu < 1) per_cu = 1;
        grid = cus * 1;
        if (grid <= 0) grid = 256;
    }
    if (grid < 0) return;
    Args a{};
    for (int i = 0; i < 23; ++i) a.in[i] = (const float*)d_in[i];
    a.out = (float*)d_out; a.ws = (unsigned char*)d_ws;
    void* args[] = {&a};
    hipError_t e = hipLaunchCooperativeKernel((const void*)mega, dim3(grid), dim3(512), args, LDS_BYTES, stream);
    if (e != hipSuccess) fprintf(stderr, "cooperative launch failed: %s (grid %d)\n", hipGetErrorString(e), grid);
}
```

```cpp
#ifndef SELFCHECK
#define SELFCHECK 0
#endif
#ifndef TIMESEL
#define TIMESEL -1
#define TIMESPAN 1
#endif
#ifndef TIMESPAN
#define TIMESPAN 1
#endif
#include <hip/hip_runtime.h>
#include <hip/hip_cooperative_groups.h>
#include <cstdio>
#include <cstdint>
namespace cg = cooperative_groups;

constexpr int D = 1024, SEQ = 16384, NS = 128, MROWS = SEQ + NS, MPAD = 16640;
constexpr int NIN = 6656, FF = 2816, FF2 = 5632, NADA = 6144;
constexpr int NMT = MPAD / 256;
constexpr int NPT5 = 65;
constexpr float EPS = 1e-6f;

constexpr size_t MiB = 1u << 20;
constexpr size_t RB = (size_t)MPAD * 1024 * 2;
constexpr size_t KBB = (size_t)MPAD * 256 * 2;
constexpr size_t WS_AADA = 1 * MiB;
constexpr size_t WS_ADA = 2 * MiB;
constexpr size_t WS_WA = 8 * MiB, WS_WB = 10 * MiB, WS_WO = 12 * MiB;
constexpr size_t WS_WADA = 14 * MiB;
constexpr size_t WS_WIN = 26 * MiB;
constexpr size_t WS_WUP = 14 * MiB;
constexpr size_t WS_WDN = 25 * MiB;
constexpr size_t WS_H = 39 * MiB;
constexpr size_t WS_U = 72 * MiB;
constexpr size_t WS_BG = 105 * MiB;
constexpr size_t WS_Q = 138 * MiB;
constexpr size_t WS_KB = WS_Q + RB, WS_VB = WS_KB + KBB, WS_GA = WS_VB + KBB, WS_GB = WS_GA + RB;
constexpr size_t WS_G = WS_Q;
constexpr size_t WS_END = WS_GB + RB;
static_assert(WS_END <= 256 * MiB, "ws map");
static_assert(WS_G + (size_t)MPAD * FF * 2 <= WS_END, "G overlay");
static_assert(WS_WDN + (size_t)1024 * FF * 2 <= WS_H && WS_WUP + (size_t)FF2 * 1024 * 2 <= WS_WDN, "weights");
static_assert(WS_U + RB + 4096 <= WS_BG && WS_H + RB <= WS_U && WS_BG + RB <= WS_Q, "row buffers");

constexpr size_t O_YP = 0, O_YS = 16777216, O_CAP = 16908288, O_CAS = 16910336, O_KP = 17172480, O_KS = 17205248,
                 O_VP = 21399552, O_VS = 21432320, O_FP = 25626624, O_FS = 25637888;

constexpr int LDS_BYTES = 147456;
constexpr int HALO_OFF = 131072;

typedef unsigned short bf16_t;
typedef short bf16x8 __attribute__((ext_vector_type(8)));
typedef float f32x4 __attribute__((ext_vector_type(4)));
typedef float f32x16 __attribute__((ext_vector_type(16)));
typedef float f32x2 __attribute__((ext_vector_type(2)));
typedef unsigned u32x4 __attribute__((ext_vector_type(4)));
typedef unsigned u32x2 __attribute__((ext_vector_type(2)));

__device__ __forceinline__ float bf2f(unsigned b) { return __uint_as_float(b << 16); }
__device__ __forceinline__ unsigned cvt_pk_bf16(float lo, float hi) { unsigned r; asm volatile("v_cvt_pk_bf16_f32 %0, %1, %2" : "=v"(r) : "v"(lo), "v"(hi)); return r; }
__device__ __forceinline__ unsigned lane_id_now() { unsigned l; asm volatile("v_mbcnt_lo_u32_b32 %0, -1, 0\n\tv_mbcnt_hi_u32_b32 %0, -1, %0" : "=v"(l)); return l; }
__device__ __forceinline__ float bperm_f(float v, int byte_addr) { return __int_as_float(__builtin_amdgcn_ds_bpermute(byte_addr, __float_as_int(v))); }
__device__ __forceinline__ float sigmoidf_(float x) { return __builtin_amdgcn_rcpf(1.0f + __expf(-x)); }
__device__ __forceinline__ float siluf_(float x) { return x * __builtin_amdgcn_rcpf(1.0f + __expf(-x)); }
__device__ __forceinline__ float wave_sum(float v) {
#pragma unroll
    for (int o = 1; o < 64; o <<= 1) v += __shfl_xor(v, o);
    return v;
}
__device__ __forceinline__ float wave_max(float v) {
#pragma unroll
    for (int o = 1; o < 64; o <<= 1) v = fmaxf(v, __shfl_xor(v, o));
    return v;
}
__device__ __forceinline__ void unpack8(u32x4 w, float* f) {
    f[0] = bf2f(w.x & 0xffffu); f[1] = bf2f(w.x >> 16); f[2] = bf2f(w.y & 0xffffu); f[3] = bf2f(w.y >> 16);
    f[4] = bf2f(w.z & 0xffffu); f[5] = bf2f(w.z >> 16); f[6] = bf2f(w.w & 0xffffu); f[7] = bf2f(w.w >> 16);
}
__device__ __forceinline__ u32x4 pack8(const float* f) {
    u32x4 w; w.x = cvt_pk_bf16(f[0], f[1]); w.y = cvt_pk_bf16(f[2], f[3]); w.z = cvt_pk_bf16(f[4], f[5]); w.w = cvt_pk_bf16(f[6], f[7]); return w;
}

namespace pg8 {
#define PG8_LAS __attribute__((address_space(3)))
constexpr int BM = 256, BK = 64, HALF = 128, HTB = HALF * BK * 2, STAGE_BYTES = 8 * HTB, NXCD = 8, WGM = 8;
__host__ __device__ __forceinline__ int lds_byte(int r, int c) { const int st = (r >> 4) * 2 + (c >> 5), rr = r & 15, cc = c & 31, ob = rr * 64 + cc * 2; return st * 1024 + (ob ^ (((ob >> 9) & 1) << 5)); }
__host__ __device__ __forceinline__ void stage_rc(int b, int& R, int& C) { const int st = b / 1024, sb = b % 1024, swz = sb ^ (((sb >> 9) & 1) << 5); R = (st >> 1) * 16 + swz / 64; C = (st & 1) * 32 + (swz % 64) / 2; }
__host__ __device__ __forceinline__ int perm32(int rho) { const int n = rho >> 4, i = rho & 15; return 8 * (i >> 2) + 4 * n + (i & 3); }

struct Unit { int pm, pn, aux; const char* a; const char* b; };

struct TileOrder {
    int nM, nN, nwg;
    __device__ __forceinline__ void init(int nM_, int nN_) { nM = nM_; nN = nN_; nwg = nM * nN; }
    __device__ __forceinline__ bool tile(long L, int& pm, int& pn) const {
        if (L >= nwg) return false;
        int wgid = (int)L; { const int q = nwg / NXCD, r = nwg % NXCD, xcd = wgid % NXCD, off = wgid / NXCD; wgid = (xcd < r ? xcd * (q + 1) : r * (q + 1) + (xcd - r) * q) + off; }
        const int nig = WGM * nN, gid = wgid / nig, fm = gid * WGM, gsz = (nM - fm) < WGM ? (nM - fm) : WGM;
        pm = fm + ((wgid % nig) % gsz); pn = (wgid % nig) / gsz; return true;
    }
};

template <class Epi, class Sched, int lda, int ldb, int K, bool ALIGN_EPI, bool SP2>
__device__ __forceinline__ void gemm_phase(PG8_LAS unsigned char* lds, const int wave0, const Sched& S, const Epi& E) {
    int tid_ = wave0 * 64 + (int)lane_id_now(); asm volatile("" : "+v"(tid_));
    const int tid = tid_, wid = __builtin_amdgcn_readfirstlane(tid >> 6), lane = tid & 63, wr = wid >> 2, wc = wid & 3, fr = lane & 15, fq = lane >> 4;
    const int nt = K / BK;
    unsigned voffA[2], voffB[2];
#pragma unroll
    for (int i = 0; i < 2; ++i) { int R, C; stage_rc(tid * 16 + i * 8192, R, C); const int Rb = Epi::PERM ? ((R & ~31) + perm32(R & 31)) : R;
        voffA[i] = (unsigned)(R * lda + C) * 2u; voffB[i] = (unsigned)(Rb * ldb + C) * 2u; }
    const size_t kstep = (size_t)(BK * 2);
    const size_t hstepA = (size_t)HALF * lda * 2, hstepB = (size_t)HALF * ldb * 2;
    const unsigned ldsw = (unsigned)wid * 1024u;
    const int aoff = lds_byte(wr * 64 + fr, fq * 8), boff = lds_byte(wc * 32 + fr, fq * 8);
#define PG8_SA(b, h) (((b) * 2 + (h)) * HTB)
#define PG8_SB(b, h) ((4 + (b) * 2 + (h)) * HTB)
#define PG8_STAGE(bufoff, gbase, voff) do { _Pragma("unroll") for (int _i = 0; _i < 2; ++_i) \
        __builtin_amdgcn_global_load_lds((const unsigned*)((const char*)(gbase) + (voff)[_i]), (PG8_LAS unsigned*)(lds + (bufoff) + ldsw + _i * 8192), 16, 0, 0); } while (0)
#define PG8_LDA(dst, b, h) do { _Pragma("unroll") for (int m = 0; m < 4; ++m) _Pragma("unroll") for (int k = 0; k < 2; ++k) dst[m][k] = *(const PG8_LAS bf16x8*)(lds + PG8_SA(b, h) + aoff + m * 2048 + k * 1024); } while (0)
#define PG8_LDB(dst, b, h) do { _Pragma("unroll") for (int n = 0; n < 2; ++n) _Pragma("unroll") for (int k = 0; k < 2; ++k) dst[n][k] = *(const PG8_LAS bf16x8*)(lds + PG8_SB(b, h) + boff + n * 2048 + k * 1024); } while (0)
#define PG8_MMA(ai, bj, At, Bt) do { __builtin_amdgcn_s_setprio(1); _Pragma("unroll") for (int m = 0; m < 4; ++m) _Pragma("unroll") for (int n = 0; n < 2; ++n) _Pragma("unroll") for (int k = 0; k < 2; ++k) \
        acc[ai][bj][m][n] = __builtin_amdgcn_mfma_f32_16x16x32_bf16(Bt[n][k], At[m][k], acc[ai][bj][m][n], 0, 0, 0); __builtin_amdgcn_s_setprio(0); } while (0)
#define PG8_WAIT_V(n) asm volatile("s_waitcnt vmcnt(" #n ")" ::: "memory")
#define PG8_WAIT_L(n) asm volatile("s_waitcnt lgkmcnt(" #n ")" ::: "memory")
#define PG8_BAR __builtin_amdgcn_s_barrier()
#define PG8_SCHED __builtin_amdgcn_sched_barrier(0)
    Unit cur, nxt; int ui = 0;
    if (!S.next(0, cur)) return;
    f32x4 acc[2][2][4][2];
#pragma unroll
    for (int a = 0; a < 2; ++a)
#pragma unroll
        for (int b = 0; b < 2; ++b)
#pragma unroll
            for (int m = 0; m < 4; ++m)
#pragma unroll
                for (int n = 0; n < 2; ++n) acc[a][b][m][n] = (f32x4){0.f, 0.f, 0.f, 0.f};
    bf16x8 At[4][2], B0[2][2], B1[2][2];
    const char* cA = cur.a; const char* cB = cur.b;
    if constexpr (SP2) {
        PG8_STAGE(PG8_SB(0, 0), cB, voffB); PG8_STAGE(PG8_SB(0, 1), cB + hstepB, voffB); PG8_STAGE(PG8_SA(0, 0), cA, voffA); PG8_STAGE(PG8_SA(0, 1), cA + hstepA, voffA);
        if (wr == 1) PG8_BAR;
        PG8_WAIT_V(2); PG8_BAR;
        PG8_STAGE(PG8_SB(1, 0), cB + kstep, voffB); PG8_STAGE(PG8_SA(1, 0), cA + kstep, voffA); PG8_STAGE(PG8_SB(1, 1), cB + hstepB + kstep, voffB);
        PG8_WAIT_V(6); PG8_BAR;
    } else {
        PG8_STAGE(PG8_SB(0, 0), cB, voffB); PG8_STAGE(PG8_SA(0, 0), cA, voffA); PG8_STAGE(PG8_SB(0, 1), cB + hstepB, voffB); PG8_STAGE(PG8_SA(0, 1), cA + hstepA, voffA);
        if (wr == 1) PG8_BAR;
        PG8_WAIT_V(4); PG8_BAR;
        PG8_STAGE(PG8_SB(1, 0), cB + kstep, voffB); PG8_STAGE(PG8_SA(1, 0), cA + kstep, voffA); PG8_STAGE(PG8_SB(1, 1), cB + hstepB + kstep, voffB);
        PG8_WAIT_V(6); PG8_BAR;
    }
    for (;;) {
        const bool has_next = S.next(ui + 1, nxt);
        const char* nA = has_next ? nxt.a : cA; const char* nB = has_next ? nxt.b : cB;
        for (int t = 0; t < nt; t += 2) {
            const bool last = (t == nt - 2);
            const char* a1 = cA + (size_t)(t + 1) * kstep;
            const char* a2 = last ? nA : cA + (size_t)(t + 2) * kstep; const char* b2 = last ? nB : cB + (size_t)(t + 2) * kstep;
            const char* a3 = a2 + kstep; const char* b3 = b2 + kstep;
            if constexpr (SP2) {
            PG8_LDB(B0, 0, 0); PG8_LDB(B1, 0, 1); PG8_SCHED; PG8_LDA(At, 0, 0); PG8_STAGE(PG8_SA(1, 1), a1 + hstepA, voffA);
            PG8_WAIT_V(8); PG8_WAIT_L(0); PG8_BAR; PG8_MMA(0, 0, At, B0); PG8_MMA(0, 1, At, B1); PG8_BAR; PG8_SCHED;
            PG8_LDA(At, 0, 1); PG8_STAGE(PG8_SB(0, 0), b2, voffB); PG8_STAGE(PG8_SB(0, 1), b2 + hstepB, voffB); PG8_STAGE(PG8_SA(0, 0), a2, voffA);
            PG8_WAIT_V(8); PG8_WAIT_L(0); PG8_BAR; PG8_MMA(1, 0, At, B0); PG8_MMA(1, 1, At, B1); PG8_BAR; PG8_SCHED;
            PG8_LDB(B0, 1, 0); PG8_LDB(B1, 1, 1); PG8_SCHED; PG8_LDA(At, 1, 0); PG8_STAGE(PG8_SA(0, 1), a2 + hstepA, voffA);
            PG8_WAIT_V(8); PG8_WAIT_L(0); PG8_BAR; PG8_MMA(0, 0, At, B0); PG8_MMA(0, 1, At, B1); PG8_BAR; PG8_SCHED;
            PG8_LDA(At, 1, 1); PG8_STAGE(PG8_SB(1, 0), b3, voffB); PG8_STAGE(PG8_SB(1, 1), b3 + hstepB, voffB); PG8_STAGE(PG8_SA(1, 0), a3, voffA);
            PG8_WAIT_V(8); PG8_WAIT_L(0); PG8_BAR; PG8_MMA(1, 0, At, B0); PG8_MMA(1, 1, At, B1); PG8_BAR; PG8_SCHED;
            } else {
            PG8_LDB(B0, 0, 0); PG8_SCHED; PG8_LDA(At, 0, 0); PG8_STAGE(PG8_SA(1, 1), a1 + hstepA, voffA);
            PG8_WAIT_L(8); PG8_BAR; PG8_WAIT_L(0); PG8_MMA(0, 0, At, B0); PG8_BAR; PG8_SCHED;
            PG8_LDB(B1, 0, 1); PG8_STAGE(PG8_SB(0, 0), b2, voffB);
            PG8_BAR; PG8_WAIT_L(0); PG8_MMA(0, 1, At, B1); PG8_BAR;
            PG8_LDA(At, 0, 1); PG8_STAGE(PG8_SA(0, 0), a2, voffA);
            PG8_BAR; PG8_WAIT_L(0); PG8_MMA(1, 0, At, B0); PG8_BAR; PG8_SCHED;
            PG8_STAGE(PG8_SB(0, 1), b2 + hstepB, voffB);
            PG8_WAIT_V(6); PG8_BAR; PG8_MMA(1, 1, At, B1); PG8_BAR;
            PG8_LDB(B0, 1, 0); PG8_SCHED; PG8_LDA(At, 1, 0); PG8_STAGE(PG8_SA(0, 1), a2 + hstepA, voffA);
            PG8_WAIT_L(8); PG8_BAR; PG8_WAIT_L(0); PG8_MMA(0, 0, At, B0); PG8_BAR; PG8_SCHED;
            PG8_LDB(B1, 1, 1); PG8_STAGE(PG8_SB(1, 0), b3, voffB);
            PG8_BAR; PG8_WAIT_L(0); PG8_MMA(0, 1, At, B1); PG8_BAR;
            PG8_LDA(At, 1, 1); PG8_STAGE(PG8_SA(1, 0), a3, voffA);
            PG8_BAR; PG8_WAIT_L(0); PG8_MMA(1, 0, At, B0); PG8_BAR; PG8_SCHED;
            PG8_STAGE(PG8_SB(1, 1), b3 + hstepB, voffB);
            PG8_WAIT_V(6); PG8_BAR; PG8_MMA(1, 1, At, B1); PG8_BAR;
            }
        }
        if constexpr (ALIGN_EPI) { if (wr == 0) PG8_BAR; }
        E(acc, cur, wr, wc, fr, fq);
        if (!has_next) break;
#pragma unroll
        for (int a = 0; a < 2; ++a)
#pragma unroll
            for (int b = 0; b < 2; ++b)
#pragma unroll
                for (int m = 0; m < 4; ++m)
#pragma unroll
                    for (int n = 0; n < 2; ++n) acc[a][b][m][n] = (f32x4){0.f, 0.f, 0.f, 0.f};
        cur = nxt; cA = nA; cB = nB; ++ui;
        if constexpr (ALIGN_EPI) { if (wr == 1) PG8_BAR; }
    }
    PG8_WAIT_V(0);
    if constexpr (!ALIGN_EPI) { if (wr == 0) PG8_BAR; }
    PG8_BAR;
#undef PG8_SA
#undef PG8_SB
#undef PG8_STAGE
#undef PG8_LDA
#undef PG8_LDB
#undef PG8_MMA
#undef PG8_WAIT_V
#undef PG8_WAIT_L
#undef PG8_BAR
#undef PG8_SCHED
}
}
using pg8::Unit;

template <int MODE, int LDA_B, int LDB_B> struct Sched {
    pg8::TileOrder to; int G, c;
    const char* A0; const char* B0; const char* A1; const char* B1;
    __device__ __forceinline__ bool next(int i, Unit& u) const {
        if (MODE == 1) {
            const long L = (long)(i >> 1) * G + c; if (!to.tile(L, u.pm, u.pn)) return false;
            u.aux = i & 1;
            u.a = (u.aux ? A1 : A0) + (size_t)u.pm * 256 * LDA_B; u.b = (u.aux ? B1 : B0) + (size_t)u.pn * 256 * LDB_B; return true;
        } else {
            const long L = (long)i * G + c; if (!to.tile(L, u.pm, u.pn)) return false;
            u.aux = 0;
            if (MODE == 2) { const long r0 = (u.pm < NPT5) ? (254L * u.pm - 2) : (long)SEQ; u.a = A0 + r0 * (long)LDA_B; }
            else u.a = A0 + (size_t)u.pm * 256 * LDA_B;
            u.b = B0 + (size_t)u.pn * 256 * LDB_B; return true;
        }
    }
};

#define EPI_ARGS const f32x4 (&acc)[2][2][4][2], const Unit& u, int wr, int wc, int fr, int fq
struct EpiAda {
    static constexpr bool PERM = true;
    float* ADA; const float* bias;
    __device__ __forceinline__ void operator()(EPI_ARGS) const {
#pragma unroll
        for (int ai = 0; ai < 2; ++ai)
#pragma unroll
            for (int m = 0; m < 4; ++m) { const int row = 128 * ai + 64 * wr + 16 * m + fr;
#pragma unroll
                for (int bj = 0; bj < 2; ++bj) { const int col = 256 * u.pn + 128 * bj + 32 * wc + 8 * fq;
#pragma unroll
                    for (int n = 0; n < 2; ++n) { const f32x4 b = *(const f32x4*)(bias + col + 4 * n); *(f32x4*)(ADA + (size_t)row * NADA + col + 4 * n) = acc[ai][bj][m][n] + b; } } }
    }
};
struct EpiProj {
    static constexpr bool PERM = true;
    bf16_t *U, *BG, *Q, *KB, *VB, *GA, *GB;
    __device__ __forceinline__ void operator()(EPI_ARGS) const {
        const int row0 = u.pm * 256 + wr * 64 + fr;
        if (u.pn < 8) {
#pragma unroll
            for (int ai = 0; ai < 2; ++ai)
#pragma unroll
                for (int m = 0; m < 4; ++m) { const int row = row0 + 128 * ai + 16 * m;
                    const f32x4 v0 = acc[ai][0][m][0] * acc[ai][1][m][0], v1 = acc[ai][0][m][1] * acc[ai][1][m][1];
                    u32x4 w; w.x = cvt_pk_bf16(v0[0], v0[1]); w.y = cvt_pk_bf16(v0[2], v0[3]); w.z = cvt_pk_bf16(v1[0], v1[1]); w.w = cvt_pk_bf16(v1[2], v1[3]);
                    *(u32x4*)(U + (size_t)row * 1024 + 128 * u.pn + 32 * wc + 8 * fq) = w; }
        } else {
            bf16_t* dst; int ld, cb; const int pn = u.pn;
            if (pn < 12) { dst = BG; ld = 1024; cb = 256 * (pn - 8); }
            else if (pn < 16) { dst = Q; ld = 1024; cb = 256 * (pn - 12); }
            else if (pn == 16) { dst = KB; ld = 256; cb = 0; }
            else if (pn == 17) { dst = VB; ld = 256; cb = 0; }
            else if (pn < 22) { dst = GA; ld = 1024; cb = 256 * (pn - 18); }
            else { dst = GB; ld = 1024; cb = 256 * (pn - 22); }
#pragma unroll
            for (int ai = 0; ai < 2; ++ai)
#pragma unroll
                for (int m = 0; m < 4; ++m) { const int row = row0 + 128 * ai + 16 * m;
#pragma unroll
                    for (int bj = 0; bj < 2; ++bj) { const f32x4 v0 = acc[ai][bj][m][0], v1 = acc[ai][bj][m][1];
                        u32x4 w; w.x = cvt_pk_bf16(v0[0], v0[1]); w.y = cvt_pk_bf16(v0[2], v0[3]); w.z = cvt_pk_bf16(v1[0], v1[1]); w.w = cvt_pk_bf16(v1[2], v1[3]);
                        *(u32x4*)(dst + (size_t)row * ld + cb + 128 * bj + 32 * wc + 8 * fq) = w; } }
        }
    }
};
struct EpiMix {
    static constexpr bool PERM = true;
    const bf16_t *GA, *GB; float* T; bf16_t* Z;
    __device__ __forceinline__ void operator()(EPI_ARGS) const {
        const int row0 = u.pm * 256 + wr * 64 + fr;
        const bf16_t* gate = u.aux ? GB : GA;
#pragma unroll
        for (int ai = 0; ai < 2; ++ai)
#pragma unroll
            for (int m = 0; m < 4; ++m) { const int row = row0 + 128 * ai + 16 * m;
                if (row < MROWS) {
#pragma unroll
                for (int bj = 0; bj < 2; ++bj) { const int col = 256 * u.pn + 128 * bj + 32 * wc + 8 * fq;
                    float gv[8]; unpack8(*(const u32x4*)(gate + (size_t)row * 1024 + col), gv);
                    float o[8];
#pragma unroll
                    for (int i = 0; i < 8; ++i) o[i] = sigmoidf_(gv[i]) * acc[ai][bj][m][i >> 2][i & 3];
                    bf16_t* zp = Z + (size_t)row * 1024 + col;
                    if (u.aux == 0) *(u32x4*)zp = pack8(o);
                    else { float t[8]; unpack8(*(const u32x4*)zp, t);
#pragma unroll
                        for (int i = 0; i < 8; ++i) o[i] += t[i];
                        *(u32x4*)zp = pack8(o); } } } }
    }
};
struct EpiRes {
    static constexpr bool PERM = true;
    const float* xp; const float* xs; float* out; const float* ADA; int goff;
    __device__ __forceinline__ void operator()(EPI_ARGS) const {
        const int row0 = u.pm * 256 + wr * 64 + fr;
#pragma unroll
        for (int ai = 0; ai < 2; ++ai)
#pragma unroll
            for (int m = 0; m < 4; ++m) { const int row = row0 + 128 * ai + 16 * m;
                if (row < MROWS) {
                const float* base = (row < SEQ) ? xp + (size_t)row * 1024 : xs + (size_t)(row - SEQ) * 1024;
                const float* gt = ADA + (size_t)((row < SEQ) ? 128 : row - SEQ) * NADA + goff;
#pragma unroll
                for (int bj = 0; bj < 2; ++bj) { const int col = 256 * u.pn + 128 * bj + 32 * wc + 8 * fq;
#pragma unroll
                    for (int n = 0; n < 2; ++n) { const f32x4 b = *(const f32x4*)(base + col + 4 * n), g = *(const f32x4*)(gt + col + 4 * n);
                        *(f32x4*)(out + (size_t)row * 1024 + col + 4 * n) = b + g * acc[ai][bj][m][n]; } } } }
    }
};
struct EpiDelta {
    static constexpr bool PERM = true;
    bf16_t* Dd; const float* ADA; int goff;
    __device__ __forceinline__ void operator()(EPI_ARGS) const {
        const int row0 = u.pm * 256 + wr * 64 + fr;
#pragma unroll
        for (int ai = 0; ai < 2; ++ai)
#pragma unroll
            for (int m = 0; m < 4; ++m) { const int row = row0 + 128 * ai + 16 * m;
                if (row < MROWS) {
                const float* gt = ADA + (size_t)((row < SEQ) ? 128 : row - SEQ) * NADA + goff;
#pragma unroll
                for (int bj = 0; bj < 2; ++bj) { const int col = 256 * u.pn + 128 * bj + 32 * wc + 8 * fq;
                    const f32x4 g0 = *(const f32x4*)(gt + col), g1 = *(const f32x4*)(gt + col + 4); const f32x4 a0 = g0 * acc[ai][bj][m][0], a1 = g1 * acc[ai][bj][m][1];
                    u32x4 w; w.x = cvt_pk_bf16(a0[0], a0[1]); w.y = cvt_pk_bf16(a0[2], a0[3]); w.z = cvt_pk_bf16(a1[0], a1[1]); w.w = cvt_pk_bf16(a1[2], a1[3]);
                    *(u32x4*)(Dd + (size_t)row * 1024 + col) = w; } } }
    }
};
struct EpiFfn {
    static constexpr bool PERM = true;
    bf16_t* G; const float* cw; const float* cb; const float* st; float* ofp; float* ofs; PG8_LAS float* halo;
    template <int CTRL> static __device__ __forceinline__ float dppf(float oldv, float src) {
        return __int_as_float(__builtin_amdgcn_update_dpp(__float_as_int(oldv), __float_as_int(src), CTRL, 0xf, 0xf, false)); }
    __device__ __forceinline__ void operator()(const f32x4 (&acc)[2][2][4][2], const Unit& u, int wr, int wc, int fr_, int fq_) const {
        const int l_ = (int)lane_id_now();
        const int fr = l_ & 15, fq = l_ >> 4; (void)fr_; (void)fq_;
        const int wid = wr * 4 + wc;
        const int f0 = 128 * u.pn + 32 * wc + 8 * fq;
        if (u.pm < NPT5) {
            PG8_LAS float* par = halo + 2048;
            {
                const int t = wid * 64 + l_;
#pragma unroll
                for (int k = 0; k < 2; ++k) { const int idx = t + 512 * k, p = idx >> 8, c = idx & 255; const int gc = (c < 128) ? 128 * u.pn + c : FF + 128 * u.pn + (c - 128);
                    par[idx] = (p < 3) ? cw[p * FF2 + gc] : cb[gc]; }
            }
            if (fr >= 14) {
#pragma unroll
                for (int ai = 0; ai < 2; ++ai)
#pragma unroll
                    for (int bj = 0; bj < 2; ++bj)
#pragma unroll
                        for (int n = 0; n < 2; ++n) *(PG8_LAS f32x4*)(halo + ((wid * 2 + ai) * 2 + (fr - 14)) * 64 + bj * 32 + fq * 8 + n * 4) = acc[ai][bj][3][n];
            }
            asm volatile("s_waitcnt vmcnt(0) lgkmcnt(0)" ::: "memory"); __builtin_amdgcn_s_barrier(); asm volatile("" ::: "memory");
#pragma unroll
            for (int ai = 0; ai < 2; ++ai) {
                const int swr = (ai == 0) ? 0 : (wr == 0 ? 1 : 0), sai = (ai == 1 && wr == 1) ? 1 : 0;
                const PG8_LAS float* hp = halo + (((swr * 4 + wc) * 2 + sai) * 2) * 64 + fq * 8;
                u32x2 pk0[4];
#pragma unroll
                for (int n = 0; n < 2; ++n) {
                    const int cg0 = 32 * wc + 8 * fq + 4 * n, cv0 = 128 + cg0;
                    f32x4 cvv[4];
                    {
                        const f32x4 w0 = *(const PG8_LAS f32x4*)(par + cv0), w1 = *(const PG8_LAS f32x4*)(par + 256 + cv0), w2 = *(const PG8_LAS f32x4*)(par + 512 + cv0), bb = *(const PG8_LAS f32x4*)(par + 768 + cv0);
                        const f32x4 h2 = *(const PG8_LAS f32x4*)(hp + 32 + n * 4), h1 = *(const PG8_LAS f32x4*)(hp + 64 + 32 + n * 4);
                        f32x4 p1 = h1, p2 = (fr == 1) ? h1 : h2;
#pragma unroll
                        for (int m = 0; m < 4; ++m) {
                            const f32x4 x = acc[ai][1][m][n]; f32x4 q1, q2, n1, n2;
#pragma unroll
                            for (int i = 0; i < 4; ++i) { q1[i] = dppf<0x111>(p1[i], x[i]); q2[i] = dppf<0x112>(p2[i], x[i]); n1[i] = dppf<0x121>(x[i], x[i]); n2[i] = dppf<0x122>(x[i], x[i]); }
                            p1 = n1; p2 = n2;
                            cvv[m] = w0 * q2 + w1 * q1 + w2 * x + bb;
                        }
                    }
                    {
                        const f32x4 w0 = *(const PG8_LAS f32x4*)(par + cg0), w1 = *(const PG8_LAS f32x4*)(par + 256 + cg0), w2 = *(const PG8_LAS f32x4*)(par + 512 + cg0), bb = *(const PG8_LAS f32x4*)(par + 768 + cg0);
                        const f32x4 h2 = *(const PG8_LAS f32x4*)(hp + n * 4), h1 = *(const PG8_LAS f32x4*)(hp + 64 + n * 4);
                        f32x4 p1 = h1, p2 = (fr == 1) ? h1 : h2;
#pragma unroll
                        for (int m = 0; m < 4; ++m) {
                            const f32x4 x = acc[ai][0][m][n]; f32x4 q1, q2, n1, n2;
#pragma unroll
                            for (int i = 0; i < 4; ++i) { q1[i] = dppf<0x111>(p1[i], x[i]); q2[i] = dppf<0x112>(p2[i], x[i]); n1[i] = dppf<0x121>(x[i], x[i]); n2[i] = dppf<0x122>(x[i], x[i]); }
                            p1 = n1; p2 = n2;
                            const f32x4 cgv = w0 * q2 + w1 * q1 + w2 * x + bb;
                            u32x2 pk; pk.x = cvt_pk_bf16(siluf_(cgv[0]) * cvv[m][0], siluf_(cgv[1]) * cvv[m][1]); pk.y = cvt_pk_bf16(siluf_(cgv[2]) * cvv[m][2], siluf_(cgv[3]) * cvv[m][3]);
                            if (n == 0) pk0[m] = pk;
                            else {
                                const int tr = 128 * ai + 64 * wr + 16 * m + fr; const int grow = 254 * u.pm - 2 + tr;
                                if (tr >= 2 && grow < SEQ) {
                                    *(u32x4*)(G + (size_t)grow * FF + f0) = (u32x4){pk0[m].x, pk0[m].y, pk.x, pk.y};
                                    if (grow >= SEQ - 2) { float* o = ofp + (size_t)(grow - (SEQ - 2)) * FF2 + f0;
                                        *(f32x4*)o = acc[ai][0][m][0]; *(f32x4*)(o + 4) = acc[ai][0][m][1]; *(f32x4*)(o + FF) = acc[ai][1][m][0]; *(f32x4*)(o + FF + 4) = acc[ai][1][m][1]; }
                                }
                            }
                        }
                    }
                }
                asm volatile("" ::: "memory"); __builtin_amdgcn_sched_barrier(0);
            }
        } else {
#pragma unroll
            for (int n = 0; n < 2; ++n) {
                const int fg = f0 + 4 * n, fv = FF + fg;
#pragma unroll
                for (int m = 0; m < 4; ++m) {
                    const int b = 64 * wr + 16 * m + fr;
                    const float* s0 = st + (size_t)(b * 2) * FF2; const float* s1 = s0 + FF2;
                    float* o0 = ofs + (size_t)(b * 2) * FF2; float* o1 = o0 + FF2;
                    f32x4 cvv;
                    { const f32x4 x = acc[0][1][m][n];
                      const f32x4 w0 = *(const f32x4*)(cw + fv), w1 = *(const f32x4*)(cw + FF2 + fv), w2 = *(const f32x4*)(cw + 2 * FF2 + fv), bb = *(const f32x4*)(cb + fv);
                      const f32x4 t0 = *(const f32x4*)(s0 + fv), t1 = *(const f32x4*)(s1 + fv);
                      cvv = w0 * t0 + w1 * t1 + w2 * x + bb; *(f32x4*)(o0 + fv) = t1; *(f32x4*)(o1 + fv) = x; }
                    asm volatile("" ::: "memory"); __builtin_amdgcn_sched_barrier(0);
                    { const f32x4 x = acc[0][0][m][n];
                      const f32x4 w0 = *(const f32x4*)(cw + fg), w1 = *(const f32x4*)(cw + FF2 + fg), w2 = *(const f32x4*)(cw + 2 * FF2 + fg), bb = *(const f32x4*)(cb + fg);
                      const f32x4 t0 = *(const f32x4*)(s0 + fg), t1 = *(const f32x4*)(s1 + fg);
                      const f32x4 cgv = w0 * t0 + w1 * t1 + w2 * x + bb; *(f32x4*)(o0 + fg) = t1; *(f32x4*)(o1 + fg) = x;
                      u32x2 w; w.x = cvt_pk_bf16(siluf_(cgv[0]) * cvv[0], siluf_(cgv[1]) * cvv[1]); w.y = cvt_pk_bf16(siluf_(cgv[2]) * cvv[2], siluf_(cgv[3]) * cvv[3]);
                      *(u32x2*)(G + (size_t)(SEQ + b) * FF + fg) = w; }
                    asm volatile("" ::: "memory"); __builtin_amdgcn_sched_barrier(0);
                }
            }
        }
    }
};

__device__ __forceinline__ void transpose_item(const float* W, int K, int N, bf16_t* WT, int k0, int n0, int drow0, float* scr, int lane) {
    float tv[32];
#pragma unroll
    for (int i = 0; i < 32; ++i) tv[i] = W[(size_t)(k0 + 2 * i + (lane >> 5)) * N + n0 + (lane & 31)];
#pragma unroll
    for (int i = 0; i < 32; ++i) scr[(2 * i + (lane >> 5)) * 33 + (lane & 31)] = tv[i];
    asm volatile("s_waitcnt lgkmcnt(0)" ::: "memory");
    const int c = lane & 7;
#pragma unroll
    for (int j = 0; j < 4; ++j) { const int n = (lane >> 3) + 8 * j; const float* s = scr + (8 * c) * 33 + n;
        u32x4 o; o.x = cvt_pk_bf16(s[0 * 33], s[1 * 33]); o.y = cvt_pk_bf16(s[2 * 33], s[3 * 33]); o.z = cvt_pk_bf16(s[4 * 33], s[5 * 33]); o.w = cvt_pk_bf16(s[6 * 33], s[7 * 33]);
        *(u32x4*)(WT + (size_t)(drow0 + n) * K + k0 + 8 * c) = o; }
    asm volatile("s_waitcnt lgkmcnt(0)" ::: "memory");
}
__device__ __forceinline__ int win_drow(int n) {
    if (n < 1024) return 256 * (n >> 7) + (n & 127);
    if (n < 2048) return 2048 + (n - 1024);
    if (n < 3072) { const int f = n - 2048; return 256 * (f >> 7) + 128 + (f & 127); }
    return n;
}
__device__ __forceinline__ int wup_drow(int n) { const int f = (n < FF) ? n : n - FF; return 256 * (f >> 7) + ((n < FF) ? 0 : 128) + (f & 127); }

__device__ __forceinline__ void modnorm_row(const float* xrow, const float* g, const float* sc, const float* sh, bf16_t* orow, int lane) {
    f32x4 v[4]; float s = 0.f;
#pragma unroll
    for (int j = 0; j < 4; ++j) { v[j] = ((const f32x4*)xrow)[lane + 64 * j]; s += (v[j][0] * v[j][0] + v[j][1] * v[j][1]) + (v[j][2] * v[j][2] + v[j][3] * v[j][3]); }
    const float rstd = rsqrtf(wave_sum(s) * (1.0f / 1024.0f) + EPS);
#pragma unroll
    for (int j = 0; j < 4; ++j) { const int col = 4 * (lane + 64 * j);
        const f32x4 gg = *(const f32x4*)(g + col), ss = *(const f32x4*)(sc + col), hh = *(const f32x4*)(sh + col);
        const f32x4 o = v[j] * rstd * gg * (ss + 1.0f) + hh;
        u32x2 w; w.x = cvt_pk_bf16(o[0], o[1]); w.y = cvt_pk_bf16(o[2], o[3]); *(u32x2*)(orow + col) = w; }
}


template <int MODE>
__device__ __forceinline__ void norm_phase(const float* xp, const float* xs, const float* gvec, const float* ada, int scoff, int shoff, bf16_t* ob, float* of, int gw, int NGW, int lane, const bf16_t* dadd = nullptr) {
    f32x4 gmP[4], shP[4];
#pragma unroll
    for (int j = 0; j < 4; ++j) { const int col = 4 * (lane + 64 * j); const f32x4 g = *(const f32x4*)(gvec + col);
        if (MODE == 2) { gmP[j] = g; shP[j] = (f32x4){0.f, 0.f, 0.f, 0.f}; }
        else { const float* ad = ada + (size_t)128 * NADA; gmP[j] = g * (*(const f32x4*)(ad + scoff + col) + 1.0f); shP[j] = *(const f32x4*)(ad + shoff + col); } }
#pragma unroll 1
    for (int base = gw; base < MROWS; base += 4 * NGW) {
        f32x4 v[4][4];
#pragma unroll
        for (int r = 0; r < 4; ++r) { const int row = base + r * NGW;
            if (row < MROWS) { const float* xr = (MODE == 0) ? ((row < SEQ) ? xp + (size_t)row * 1024 : xs + (size_t)(row - SEQ) * 1024) : xp + (size_t)row * 1024;
#pragma unroll
                for (int j = 0; j < 4; ++j) v[r][j] = ((const f32x4*)xr)[lane + 64 * j];
                if (MODE == 2) {
#pragma unroll
                    for (int j = 0; j < 4; ++j) { const u32x2 w = *(const u32x2*)(dadd + (size_t)row * 1024 + 4 * (lane + 64 * j));
                        v[r][j] += (f32x4){bf2f(w.x & 0xffffu), bf2f(w.x >> 16), bf2f(w.y & 0xffffu), bf2f(w.y >> 16)}; } } } }
#pragma unroll
        for (int r = 0; r < 4; ++r) { const int row = base + r * NGW;
            if (row < MROWS) {
                float s = 0.f;
#pragma unroll
                for (int j = 0; j < 4; ++j) s += (v[r][j][0] * v[r][j][0] + v[r][j][1] * v[r][j][1]) + (v[r][j][2] * v[r][j][2] + v[r][j][3] * v[r][j][3]);
                const float rstd = rsqrtf(wave_sum(s) * (1.0f / 1024.0f) + EPS);
#pragma unroll
                for (int j = 0; j < 4; ++j) { const int col = 4 * (lane + 64 * j);
                    f32x4 gm = gmP[j], sh = shP[j];
                    if (MODE != 2 && row >= SEQ) { const float* ad = ada + (size_t)(row - SEQ) * NADA; gm = *(const f32x4*)(gvec + col) * (*(const f32x4*)(ad + scoff + col) + 1.0f); sh = *(const f32x4*)(ad + shoff + col); }
                    const f32x4 o = v[r][j] * rstd * gm + sh;
                    if (MODE == 2) *(f32x4*)(of + (size_t)row * 1024 + col) = o;
                    else { u32x2 w; w.x = cvt_pk_bf16(o[0], o[1]); w.y = cvt_pk_bf16(o[2], o[3]); *(u32x2*)(ob + (size_t)row * 1024 + col) = w; } }
            } }
    }
}
struct AttnKV { u32x4 k[4], v[4]; };
__device__ __forceinline__ void attn_fetch(AttnKV& r, const bf16_t* KB, const bf16_t* VB, int j, int g, int tid) {
#pragma unroll
    for (int it = 0; it < 4; ++it) { const int c = tid + 512 * it, s = c >> 3, ch = c & 7; const int tok = 128 * (j - 1) + s;
        r.k[it] = (u32x4){0u, 0u, 0u, 0u}; r.v[it] = (u32x4){0u, 0u, 0u, 0u};
        if (tok >= 0) { r.k[it] = *(const u32x4*)(KB + (size_t)tok * 256 + 64 * g + 8 * ch); r.v[it] = *(const u32x4*)(VB + (size_t)tok * 256 + 64 * g + 8 * ch); } }
}
__device__ __forceinline__ void attn_prompt_unit(unsigned char* lds, bf16_t* Q, const AttnKV& r, const float* sinks, int j, int g, int tid) {
    bf16_t* Ks = (bf16_t*)lds;
    bf16_t* Vt = (bf16_t*)(lds + 36864);
    bf16x8 qpre[2][4];
    {   const int wave_ = tid >> 6, ql_ = tid & 31, hi_ = (tid >> 5) & 1;
#pragma unroll
        for (int tt = 0; tt < 2; ++tt) { const int t = wave_ * 2 + tt, hq = t >> 2, qg = t & 3; const bf16_t* qp = Q + (size_t)(128 * j + 32 * qg + ql_) * 1024 + (4 * g + hq) * 64;
#pragma unroll
            for (int d0 = 0; d0 < 4; ++d0) qpre[tt][d0] = *(const bf16x8*)(qp + 16 * d0 + 8 * hi_); } }
#pragma unroll
    for (int it = 0; it < 4; ++it) { const int c = tid + 512 * it, s = c >> 3, ch = c & 7; const u32x4 kv = r.k[it], vv = r.v[it];
        *(u32x4*)(Ks + s * 72 + 8 * ch) = kv;
        bf16_t* vd = Vt + (8 * ch) * 264 + s;
        vd[0 * 264] = (bf16_t)(vv.x & 0xffffu); vd[1 * 264] = (bf16_t)(vv.x >> 16); vd[2 * 264] = (bf16_t)(vv.y & 0xffffu); vd[3 * 264] = (bf16_t)(vv.y >> 16);
        vd[4 * 264] = (bf16_t)(vv.z & 0xffffu); vd[5 * 264] = (bf16_t)(vv.z >> 16); vd[6 * 264] = (bf16_t)(vv.w & 0xffffu); vd[7 * 264] = (bf16_t)(vv.w >> 16);
    }
    __syncthreads();
    const int wave = tid >> 6, lane = tid & 63, ql = lane & 31, hi = lane >> 5;
#pragma unroll
    for (int tt = 0; tt < 2; ++tt) {
        const int t = wave * 2 + tt, hq = t >> 2, qg = t & 3, head = 4 * g + hq;
        bf16_t* qp = Q + (size_t)(128 * j + 32 * qg + ql) * 1024 + head * 64;
        bf16x8 qf[4];
#pragma unroll
        for (int d0 = 0; d0 < 4; ++d0) qf[d0] = qpre[tt][d0];
        f32x16 p[5];
#pragma unroll
        for (int kt = 0; kt < 5; ++kt) {
#pragma unroll
            for (int r = 0; r < 16; ++r) p[kt][r] = 0.f;
#pragma unroll
            for (int d0 = 0; d0 < 4; ++d0) { const bf16x8 kf = *(const bf16x8*)(Ks + (32 * qg + 32 * kt + ql) * 72 + 16 * d0 + 8 * hi);
                p[kt] = __builtin_amdgcn_mfma_f32_32x32x16_bf16(kf, qf[d0], p[kt], 0, 0, 0); }
        }
        const float sink = sinks[head];
        float mx = -INFINITY;
#pragma unroll
        for (int kt = 0; kt < 5; ++kt)
#pragma unroll
            for (int r = 0; r < 16; ++r) { const int kk = (r & 3) + 8 * (r >> 2) + 4 * hi; bool valid = true;
                if (kt == 0) valid = kk >= ql; if (kt == 4) valid = kk <= ql; if (j == 0) valid = valid && (32 * qg + 32 * kt + kk >= 128);
                const float v = valid ? p[kt][r] * 0.125f : -INFINITY; p[kt][r] = v; mx = fmaxf(mx, v); }
        mx = fmaxf(mx, __shfl_xor(mx, 32)); mx = fmaxf(mx, sink);
        float l = 0.f;
#pragma unroll
        for (int kt = 0; kt < 5; ++kt)
#pragma unroll
            for (int r = 0; r < 16; ++r) { const float e = __expf(p[kt][r] - mx); p[kt][r] = e; l += e; }
        l += __shfl_xor(l, 32);
        const float inv = 1.0f / (l + __expf(sink - mx));
        f32x16 o0, o1;
#pragma unroll
        for (int r = 0; r < 16; ++r) { o0[r] = 0.f; o1[r] = 0.f; }
#pragma unroll
        for (int kt = 0; kt < 5; ++kt)
#pragma unroll
            for (int hf = 0; hf < 2; ++hf) {
                u32x4 pw; pw.x = cvt_pk_bf16(p[kt][8 * hf + 0], p[kt][8 * hf + 1]); pw.y = cvt_pk_bf16(p[kt][8 * hf + 2], p[kt][8 * hf + 3]);
                pw.z = cvt_pk_bf16(p[kt][8 * hf + 4], p[kt][8 * hf + 5]); pw.w = cvt_pk_bf16(p[kt][8 * hf + 6], p[kt][8 * hf + 7]);
                const bf16x8 pf = __builtin_bit_cast(bf16x8, pw);
                const int sk = 32 * qg + 32 * kt + 16 * hf + 4 * hi;
                { const bf16_t* vp = Vt + ql * 264 + sk; const u32x2 a = *(const u32x2*)vp, b = *(const u32x2*)(vp + 8);
                  const bf16x8 vf = __builtin_bit_cast(bf16x8, ((u32x4){a.x, a.y, b.x, b.y})); o0 = __builtin_amdgcn_mfma_f32_32x32x16_bf16(vf, pf, o0, 0, 0, 0); }
                { const bf16_t* vp = Vt + (32 + ql) * 264 + sk; const u32x2 a = *(const u32x2*)vp, b = *(const u32x2*)(vp + 8);
                  const bf16x8 vf = __builtin_bit_cast(bf16x8, ((u32x4){a.x, a.y, b.x, b.y})); o1 = __builtin_amdgcn_mfma_f32_32x32x16_bf16(vf, pf, o1, 0, 0, 0); }
            }
#pragma unroll
        for (int c4 = 0; c4 < 4; ++c4) {
            u32x2 w0, w1;
            w0.x = cvt_pk_bf16(o0[4 * c4 + 0] * inv, o0[4 * c4 + 1] * inv); w0.y = cvt_pk_bf16(o0[4 * c4 + 2] * inv, o0[4 * c4 + 3] * inv);
            w1.x = cvt_pk_bf16(o1[4 * c4 + 0] * inv, o1[4 * c4 + 1] * inv); w1.y = cvt_pk_bf16(o1[4 * c4 + 2] * inv, o1[4 * c4 + 3] * inv);
            *(u32x2*)(qp + 8 * c4 + 4 * hi) = w0; *(u32x2*)(qp + 32 + 8 * c4 + 4 * hi) = w1;
        }
    }
    __syncthreads();
}
__device__ __forceinline__ void attn_sample_task(float* wl, bf16_t* Q, const bf16_t* KB, const bf16_t* VB, const float* ck, const float* cv, const float* sinks, int b, int g, int lane) {
    float* qs = wl; float* pp = wl + 256;
    bf16_t* qrow = Q + (size_t)(SEQ + b) * 1024 + 4 * g * 64;
#pragma unroll
    for (int h = 0; h < 4; ++h) qs[h * 64 + lane] = bf2f(qrow[h * 64 + lane]) * 0.125f;
    const float knew = bf2f(KB[(size_t)(SEQ + b) * 256 + 64 * g + lane]), vnew = bf2f(VB[(size_t)(SEQ + b) * 256 + 64 * g + lane]);
    asm volatile("s_waitcnt lgkmcnt(0)" ::: "memory");
    float sc[2][4];
#pragma unroll
    for (int kk = 0; kk < 2; ++kk) { const int s = lane + 64 * kk; const f32x4* kp = (const f32x4*)(ck + ((size_t)(b * 128 + s) * 4 + g) * 64);
        float a0 = 0.f, a1 = 0.f, a2 = 0.f, a3 = 0.f;
#pragma unroll 4
        for (int c = 0; c < 16; ++c) { const f32x4 kv = kp[c];
            const f32x4 q0 = *(const f32x4*)(qs + 4 * c), q1 = *(const f32x4*)(qs + 64 + 4 * c), q2 = *(const f32x4*)(qs + 128 + 4 * c), q3 = *(const f32x4*)(qs + 192 + 4 * c);
            a0 += kv[0] * q0[0] + kv[1] * q0[1] + kv[2] * q0[2] + kv[3] * q0[3]; a1 += kv[0] * q1[0] + kv[1] * q1[1] + kv[2] * q1[2] + kv[3] * q1[3];
            a2 += kv[0] * q2[0] + kv[1] * q2[1] + kv[2] * q2[2] + kv[3] * q2[3]; a3 += kv[0] * q3[0] + kv[1] * q3[1] + kv[2] * q3[2] + kv[3] * q3[3]; }
        sc[kk][0] = a0; sc[kk][1] = a1; sc[kk][2] = a2; sc[kk][3] = a3; }
#pragma unroll
    for (int h = 0; h < 4; ++h) {
        const float sn = wave_sum(qs[h * 64 + lane] * knew), sink = sinks[4 * g + h];
        float m = wave_max(fmaxf(sc[0][h], sc[1][h])); m = fmaxf(fmaxf(m, sn), sink);
        const float e0 = __expf(sc[0][h] - m), e1 = __expf(sc[1][h] - m), en = __expf(sn - m);
        const float inv = 1.0f / (wave_sum(e0 + e1) + en + __expf(sink - m));
        pp[lane * 4 + h] = e0 * inv; pp[(64 + lane) * 4 + h] = e1 * inv; if (lane == 0) pp[512 + h] = en * inv;
    }
    asm volatile("s_waitcnt lgkmcnt(0)" ::: "memory");
    float o0 = 0.f, o1 = 0.f, o2 = 0.f, o3 = 0.f;
    const float* vp = cv + ((size_t)(b * 128) * 4 + g) * 64 + lane;
#pragma unroll 8
    for (int s = 0; s < 128; ++s) { const float v = vp[(size_t)s * 256]; const f32x4 pv = *(const f32x4*)(pp + 4 * s); o0 += pv[0] * v; o1 += pv[1] * v; o2 += pv[2] * v; o3 += pv[3] * v; }
    { const f32x4 pv = *(const f32x4*)(pp + 512); o0 += pv[0] * vnew; o1 += pv[1] * vnew; o2 += pv[2] * vnew; o3 += pv[3] * vnew; }
    qrow[lane] = (bf16_t)(cvt_pk_bf16(o0, 0.f) & 0xffffu); qrow[64 + lane] = (bf16_t)(cvt_pk_bf16(o1, 0.f) & 0xffffu);
    qrow[128 + lane] = (bf16_t)(cvt_pk_bf16(o2, 0.f) & 0xffffu); qrow[192 + lane] = (bf16_t)(cvt_pk_bf16(o3, 0.f) & 0xffffu);
    asm volatile("s_waitcnt lgkmcnt(0)" ::: "memory");
}


#if SELFCHECK
constexpr size_t WS_CHK = 512 * 1024;
__device__ __forceinline__ unsigned hsh(unsigned x) { x ^= x >> 16; x *= 0x7feb352du; x ^= x >> 15; x *= 0x846ca68bu; x ^= x >> 16; return x; }
__device__ __forceinline__ int samp_row(int s) {
    if ((s & 3) == 0) { switch ((s >> 2) & 7) { case 0: return 0; case 1: return 1; case 2: return 255; case 3: return 256; case 4: return SEQ - 1; case 5: return SEQ; case 6: return SEQ + 100; default: return 8191; } }
    if ((s & 3) == 1) return SEQ + (int)(hsh(s) % NS);
    return (int)(hsh(s * 3 + 1) % SEQ);
}
__device__ __forceinline__ bool chk_bad(float got, float ref) { return !(fabsf(got - ref) <= 0.05f * fabsf(ref) + 0.04f); }
__device__ __forceinline__ float wdot_bf(const bf16_t* a, const float* W, int ldw, int col, int K, int lane) {
    float s = 0.f; for (int k = lane; k < K; k += 64) s += bf2f(a[k]) * W[(size_t)k * ldw + col]; return wave_sum(s); }
#define CHK_FAIL(bit) do { if (lane == 0) atomicOr(mask, 1u << (bit)); } while (0)
#endif

template <int KLEN>
__device__ __forceinline__ f32x4 mini_kloop(const bf16_t* Arow, const bf16_t* Brow, f32x4 acc) {
    constexpr int NS_ = KLEN / 32;
    static_assert(KLEN % 32 == 0, "K quarter");
#pragma unroll 1
    for (int s0 = 0; s0 < NS_; s0 += 8) {
        bf16x8 a[8], b[8];
#pragma unroll
        for (int i = 0; i < 8; ++i) if (s0 + i < NS_) { a[i] = *(const bf16x8*)(Arow + (s0 + i) * 32); b[i] = *(const bf16x8*)(Brow + (s0 + i) * 32); }
#pragma unroll
        for (int i = 0; i < 8; ++i) if (s0 + i < NS_) acc = __builtin_amdgcn_mfma_f32_16x16x32_bf16(b[i], a[i], acc, 0, 0, 0);
    }
    return acc;
}
struct MiniArgs { const bf16_t* A0; const bf16_t* B0; const bf16_t* A1; const bf16_t* B1; const bf16_t* GA; const bf16_t* GB; bf16_t* Z; const float* base; float* out; const float* ADA; int goff; };
template <int MODE, int K>
__device__ __forceinline__ void mini_sample_gemm(unsigned char* lds, const MiniArgs& P, int bid, int G, int wave, int lane) {
    const int fr = lane & 15, fq = lane >> 4, tl = wave >> 2, kq = wave & 3;
    f32x4* red = (f32x4*)lds;
    for (int T0 = 2 * bid; T0 < 512; T0 += 2 * G) {
        const int T = T0 + tl, rt = T & 7, ct = T >> 3;
        const int row = SEQ + 16 * rt + fr, colb = 16 * ct + fr;
        const size_t ko = (size_t)kq * (K / 4) + 8 * fq;
        f32x4 acc0 = (f32x4){0.f, 0.f, 0.f, 0.f}, acc1 = acc0;
        acc0 = mini_kloop<K / 4>(P.A0 + (size_t)row * K + ko, P.B0 + (size_t)colb * K + ko, acc0);
        if (MODE == 0) acc1 = mini_kloop<K / 4>(P.A1 + (size_t)row * K + ko, P.B1 + (size_t)colb * K + ko, acc1);
        red[wave * 64 + lane] = acc0; if (MODE == 0) red[512 + wave * 64 + lane] = acc1;
        __syncthreads();
        if (kq == 0) {
            f32x4 s0 = red[wave * 64 + lane] + red[(wave + 1) * 64 + lane] + red[(wave + 2) * 64 + lane] + red[(wave + 3) * 64 + lane];
            const int col = 16 * ct + 4 * fq;
            if (MODE == 0) {
                const f32x4 s1 = red[512 + wave * 64 + lane] + red[512 + (wave + 1) * 64 + lane] + red[512 + (wave + 2) * 64 + lane] + red[512 + (wave + 3) * 64 + lane];
                const u32x2 ga = *(const u32x2*)(P.GA + (size_t)row * 1024 + col), gb = *(const u32x2*)(P.GB + (size_t)row * 1024 + col);
                const float z0 = sigmoidf_(bf2f(ga.x & 0xffffu)) * s0[0] + sigmoidf_(bf2f(gb.x & 0xffffu)) * s1[0], z1 = sigmoidf_(bf2f(ga.x >> 16)) * s0[1] + sigmoidf_(bf2f(gb.x >> 16)) * s1[1];
                const float z2 = sigmoidf_(bf2f(ga.y & 0xffffu)) * s0[2] + sigmoidf_(bf2f(gb.y & 0xffffu)) * s1[2], z3 = sigmoidf_(bf2f(ga.y >> 16)) * s0[3] + sigmoidf_(bf2f(gb.y >> 16)) * s1[3];
                u32x2 w; w.x = cvt_pk_bf16(z0, z1); w.y = cvt_pk_bf16(z2, z3); *(u32x2*)(P.Z + (size_t)row * 1024 + col) = w;
            } else if (MODE == 2) {
                const int b = row - SEQ; const f32x4 g = *(const f32x4*)(P.ADA + (size_t)b * NADA + P.goff + col); const f32x4 d = g * s0;
                u32x2 w; w.x = cvt_pk_bf16(d[0], d[1]); w.y = cvt_pk_bf16(d[2], d[3]); *(u32x2*)(P.Z + (size_t)row * 1024 + col) = w;
            } else {
                const int b = row - SEQ;
                const f32x4 bs = *(const f32x4*)(P.base + (size_t)b * 1024 + col), g = *(const f32x4*)(P.ADA + (size_t)b * NADA + P.goff + col);
                *(f32x4*)(P.out + (size_t)row * 1024 + col) = bs + g * s0;
            }
        }
        __syncthreads();
    }
}

__device__ __forceinline__ void ada_block(unsigned char* lds, const float* cs, const float* cp, const float* W, const float* bias, float* ADAo, int pair, int wave, int lane) {
    const int fr = lane & 15, fq = lane >> 4, tl = wave >> 2, kq = wave & 3, c0 = 16 * (2 * pair + tl);
    f32x4 acc[9];
#pragma unroll
    for (int rt = 0; rt < 9; ++rt) acc[rt] = (f32x4){0.f, 0.f, 0.f, 0.f};
#pragma unroll 1
    for (int ks = 0; ks < 8; ++ks) {
        const int k0 = 256 * kq + 32 * ks + 8 * fq;
        float wv[8];
#pragma unroll
        for (int j = 0; j < 8; ++j) wv[j] = W[(size_t)(k0 + j) * NADA + c0 + fr];
        f32x4 a0[9], a1[9];
#pragma unroll
        for (int rt = 0; rt < 9; ++rt) { const int row = 16 * rt + fr; const float* cr = (row < 128) ? cs + (size_t)row * 1024 : cp;
            a0[rt] = *(const f32x4*)(cr + k0); a1[rt] = *(const f32x4*)(cr + k0 + 4); }
        u32x4 bw; bw.x = cvt_pk_bf16(wv[0], wv[1]); bw.y = cvt_pk_bf16(wv[2], wv[3]); bw.z = cvt_pk_bf16(wv[4], wv[5]); bw.w = cvt_pk_bf16(wv[6], wv[7]);
        const bf16x8 bfrag = __builtin_bit_cast(bf16x8, bw);
#pragma unroll
        for (int rt = 0; rt < 9; ++rt) { const bool ok = (16 * rt + fr) <= 128;
            u32x4 aw; aw.x = cvt_pk_bf16(siluf_(a0[rt][0]), siluf_(a0[rt][1])); aw.y = cvt_pk_bf16(siluf_(a0[rt][2]), siluf_(a0[rt][3]));
            aw.z = cvt_pk_bf16(siluf_(a1[rt][0]), siluf_(a1[rt][1])); aw.w = cvt_pk_bf16(siluf_(a1[rt][2]), siluf_(a1[rt][3]));
            if (!ok) aw = (u32x4){0u, 0u, 0u, 0u};
            acc[rt] = __builtin_amdgcn_mfma_f32_16x16x32_bf16(bfrag, __builtin_bit_cast(bf16x8, aw), acc[rt], 0, 0, 0); }
    }
    f32x4* red = (f32x4*)lds;
#pragma unroll
    for (int rt = 0; rt < 9; ++rt) red[(wave * 9 + rt) * 64 + lane] = acc[rt];
    __syncthreads();
    if (kq == 0) {
        const f32x4 bv = *(const f32x4*)(bias + c0 + 4 * fq);
#pragma unroll
        for (int rt = 0; rt < 9; ++rt) { const int row = 16 * rt + fr;
            const f32x4 sum = red[(wave * 9 + rt) * 64 + lane] + red[((wave + 1) * 9 + rt) * 64 + lane] + red[((wave + 2) * 9 + rt) * 64 + lane] + red[((wave + 3) * 9 + rt) * 64 + lane];
            if (row <= 128) *(f32x4*)(ADAo + (size_t)row * NADA + c0 + 4 * fq) = sum + bv; }
    }
    __syncthreads();
}

#define LAS __attribute__((address_space(3)))
#define XB_TMO      128
#define XB_XCNT(j)  (256  + 64 * (j))
#define XB_XSUB(j)  (1280 + 64 * (j))
#define XB_XGEN(j)  (2304 + 64 * (j))
#define XB_TOP      3328
#define XB_TOPGEN   3392
#define XCD_BAR_WORDS 3456
#define XB_SPIN_CAP (1u << 22)
constexpr size_t WS_BAR = 64 * 1024;
constexpr int MISC_OFF = 143360;
__device__ __forceinline__ unsigned xb_ld(unsigned* p)              { return __hip_atomic_load(p, __ATOMIC_RELAXED, __HIP_MEMORY_SCOPE_AGENT); }
__device__ __forceinline__ unsigned xb_add(unsigned* p, unsigned v) { return __hip_atomic_fetch_add(p, v, __ATOMIC_RELAXED, __HIP_MEMORY_SCOPE_AGENT); }
__device__ __forceinline__ unsigned xb_xcc_id() { return (unsigned)__builtin_amdgcn_s_getreg((3 << 11) | 20) & 0xFu; }
#define XB_SPIN(cond, bar) do { unsigned _sp = 0; while (cond) { __builtin_amdgcn_s_sleep(1); \
    if ((++_sp & 255u) == 0u) { if (xb_ld(&(bar)[XB_TMO])) break; if (_sp > XB_SPIN_CAP) { atomicAdd(&(bar)[XB_TMO], 1u); break; } } } } while (0)
struct XcdBarrier { unsigned* bar; unsigned x; volatile LAS unsigned* st; };
__device__ __forceinline__ XcdBarrier xcd_barrier_post(unsigned* bar, volatile LAS unsigned* st, bool leader) {
    XcdBarrier b; b.bar = bar; b.x = xb_xcc_id(); b.st = st;
    if (leader) (void)xb_add(&bar[XB_XCNT(b.x)], 1u);
    return b;
}
__device__ __forceinline__ void xcd_barrier_complete(unsigned* bar, unsigned x, unsigned& nloc, unsigned& nx) {
    const unsigned G = gridDim.x * gridDim.y * gridDim.z;
    unsigned sum, cnt, mine, sp = 0u;
    for (;;) {
        sum = 0u; cnt = 0u; mine = 0u;
#pragma unroll
        for (unsigned j = 0; j < 16; ++j) { const unsigned c = xb_ld(&bar[XB_XCNT(j)]); sum += c; cnt += (c > 0u) ? 1u : 0u; mine = (j == x) ? c : mine; }
        if (sum == G) break;
        __builtin_amdgcn_s_sleep(1);
        if ((++sp & 255u) == 0u) { if (xb_ld(&bar[XB_TMO])) break; if (sp > XB_SPIN_CAP) { atomicAdd(&bar[XB_TMO], 1u); break; } }
    }
    nloc = mine > 0u ? mine : 1u; nx = cnt > 0u ? cnt : 1u;
}
__device__ __forceinline__ void xcd_barrier_core(const XcdBarrier& b, bool leader) {
    if (leader) {
        unsigned* bar = b.bar;
        __builtin_amdgcn_s_waitcnt(0);
        unsigned nloc = b.st[0], nx = b.st[1];
        if (nloc == 0u) { xcd_barrier_complete(bar, b.x, nloc, nx); b.st[0] = nloc; b.st[1] = nx; }
        const unsigned old = xb_add(&bar[XB_XSUB(b.x)], 1u);
        const unsigned gen = old / nloc;
        if (old + 1u == (gen + 1u) * nloc) {
            __builtin_amdgcn_fence(__ATOMIC_RELEASE, "agent");
            asm volatile("s_waitcnt vmcnt(0)" ::: "memory");
            const unsigned og = xb_add(&bar[XB_TOP], 1u);
            const unsigned tg = og / nx;
            if (og + 1u == (tg + 1u) * nx) xb_add(&bar[XB_TOPGEN], 1u);
            else XB_SPIN(xb_ld(&bar[XB_TOPGEN]) == tg, bar);
            __builtin_amdgcn_fence(__ATOMIC_ACQUIRE, "agent");
            xb_add(&bar[XB_XGEN(b.x)], 1u);
            asm volatile("s_waitcnt vmcnt(0)" ::: "memory");
        } else {
            XB_SPIN(xb_ld(&bar[XB_XGEN(b.x)]) == gen, bar);
            __builtin_amdgcn_fence(__ATOMIC_ACQUIRE, "agent");
            asm volatile("s_waitcnt vmcnt(0)" ::: "memory");
        }
    }
}
struct Args { const float* in[23]; float* out; unsigned char* ws; };
enum { I_XP = 0, I_XS, I_CP, I_CS, I_SCA, I_CK, I_CV, I_SFF, I_WADA, I_BADA, I_GMIX, I_WIN, I_CAW, I_SINK, I_WAO, I_WBO, I_WO, I_GFFN, I_WUP, I_FCW, I_FCB, I_WDN, I_GFIN };

typedef const __attribute__((address_space(4))) Args* KArgsP;
__device__ __forceinline__ void shadow_work(KArgsP ap, unsigned nb, int w7, int bid, int G, int lane, unsigned char* lds) {
    const int sw = bid * 7 + w7, NSW = G * 7;
    float* scr = (float*)(lds + (w7 + 1) * 16384);
    unsigned char* ws = ap->ws;
    if (nb == 1u) {
        for (int it = sw; it < 16 * (NIN / 32); it += NSW) { const int nbk = NIN / 32, kb = it / nbk, n0 = 32 * (it % nbk);
            transpose_item(ap->in[I_WIN], 1024, NIN, (bf16_t*)(ws + WS_WIN), 64 * kb, n0, win_drow(n0), scr, lane); }
    } else if (nb == 2u || nb == 3u) {
        constexpr int I_UPS = 16 * (FF2 / 32), SPLIT_ = 1024;
        if (nb == 2u) for (int r = sw; r < 3 * 512; r += NSW) { const int which = r / 512, q = r % 512, kb = q / 32, n0 = 32 * (q % 32);
            transpose_item(ap->in[which == 0 ? I_WAO : (which == 1 ? I_WBO : I_WO)], 1024, 1024, (bf16_t*)(ws + (which == 0 ? WS_WA : (which == 1 ? WS_WB : WS_WO))), 64 * kb, n0, n0, scr, lane); }
        for (int it = (nb == 2u ? 0 : SPLIT_) + sw; it < (nb == 2u ? SPLIT_ : I_UPS); it += NSW) { const int nbk = FF2 / 32, kb = it / nbk, n0 = 32 * (it % nbk);
            transpose_item(ap->in[I_WUP], 1024, FF2, (bf16_t*)(ws + WS_WUP), 64 * kb, n0, wup_drow(n0), scr, lane); }
    } else if (nb == 4u) {
        for (int it = sw; it < (FF / 64) * 32; it += NSW) { const int kb = it / 32, n0 = 32 * (it % 32); transpose_item(ap->in[I_WDN], FF, 1024, (bf16_t*)(ws + WS_WDN), 64 * kb, n0, n0, scr, lane); }
    } else if (nb == 5u || nb == 6u) {
        const float* ck_ = ap->in[I_CK]; const float* cv_ = ap->in[I_CV]; const bf16_t* kb_ = (const bf16_t*)(ws + WS_KB); const bf16_t* vb_ = (const bf16_t*)(ws + WS_VB); float* out = ap->out;
        const long st = (long)sw * 64 + lane, NST = (long)NSW * 64; const long lo = (nb == 5u) ? 0 : 1048576, hi = lo + 1048576;
#pragma unroll 4
        for (long i = lo + st; i < hi; i += NST) {
            const int which = (int)(i >> 20); const int r2 = (int)(i & 1048575); const int b = r2 >> 13, r = (r2 >> 6) & 127, c = r2 & 63;
            const float* cache = which ? cv_ : ck_; const bf16_t* nbp = which ? vb_ : kb_;
            f32x4 v;
            if (r < 127) v = *(const f32x4*)(cache + ((size_t)(b * 128 + r + 1) * 256 + 4 * c));
            else { const u32x2 w = *(const u32x2*)(nbp + (size_t)(SEQ + b) * 256 + 4 * c); v = (f32x4){bf2f(w.x & 0xffffu), bf2f(w.x >> 16), bf2f(w.y & 0xffffu), bf2f(w.y >> 16)}; }
            *(f32x4*)(out + (which ? O_VS : O_KS) + (size_t)r2 * 4) = v;
        }
        if (nb == 5u) for (long i = st; i < 2L * 128 * 64; i += NST) {
            const int which = (int)(i >> 13); const int r2 = (int)(i & 8191); const int r = r2 >> 6, c = r2 & 63; const bf16_t* nbp = which ? vb_ : kb_;
            const u32x2 w = *(const u32x2*)(nbp + (size_t)(SEQ - 128 + r) * 256 + 4 * c);
            *(f32x4*)(out + (which ? O_VP : O_KP) + (size_t)r2 * 4) = (f32x4){bf2f(w.x & 0xffffu), bf2f(w.x >> 16), bf2f(w.y & 0xffffu), bf2f(w.y >> 16)};
        }
    }
}

__global__ void __launch_bounds__(512, 2) mega(Args a) {
    extern __shared__ __attribute__((aligned(16))) unsigned char lds[];
    PG8_LAS unsigned char* ldsl = (PG8_LAS unsigned char*)lds;
    const int G = gridDim.x, bid = blockIdx.x, NGW = G * 8;
    const int wave0 = __builtin_amdgcn_readfirstlane((int)threadIdx.x >> 6);
    const long NGT = (long)G * 512;
#define PHASE_IDS() int tid = wave0 * 64 + (int)lane_id_now(); asm volatile("" : "+v"(tid)); const int lane = tid & 63, wave = wave0; \
    const int gw = bid * 8 + wave; const long gt = (long)bid * 512 + tid; float* const scr = (float*)(lds + wave * 16384); (void)lane; (void)gw; (void)gt; (void)scr;
    typedef const __attribute__((address_space(4))) Args* KArgs;
    const KArgs ap0 = (KArgs)__builtin_amdgcn_kernarg_segment_ptr();
#define ARGS() ({ KArgs p_ = ap0; asm volatile("" : "+s"(p_)); p_; })
#define IN(i) (ARGS()->in[i])
#define WS(off) (ARGS()->ws + (off))
#define OUT() (ARGS()->out)
#define AADA ((bf16_t*)WS(WS_AADA))
#define ADA ((float*)WS(WS_ADA))
#define WA ((bf16_t*)WS(WS_WA))
#define WB ((bf16_t*)WS(WS_WB))
#define WO ((bf16_t*)WS(WS_WO))
#define WADA ((bf16_t*)WS(WS_WADA))
#define WIN ((bf16_t*)WS(WS_WIN))
#define WUP ((bf16_t*)WS(WS_WUP))
#define WDN ((bf16_t*)WS(WS_WDN))
#define H ((bf16_t*)WS(WS_H))
#define U ((bf16_t*)WS(WS_U))
#define BG ((bf16_t*)WS(WS_BG))
#define Q ((bf16_t*)WS(WS_Q))
#define KB ((bf16_t*)WS(WS_KB))
#define VB ((bf16_t*)WS(WS_VB))
#define GA ((bf16_t*)WS(WS_GA))
#define GB ((bf16_t*)WS(WS_GB))
#define GG ((bf16_t*)WS(WS_G))
#define AIN H
#define Z U
#define H2 BG
    if (gridDim.x == 0x7fffffffu) cg::this_grid().sync();
    if (threadIdx.x < 2) ((volatile LAS unsigned*)(ldsl + MISC_OFF))[threadIdx.x] = 0u;
    __syncthreads();
#define LEADER() (wave0 == 0 && lane_id_now() == 0u)
    const XcdBarrier xbar = xcd_barrier_post((unsigned*)WS(WS_BAR), (volatile LAS unsigned*)(ldsl + MISC_OFF), LEADER());
    unsigned nbar_ = 0u;
#define GRID_SYNC() do { ++nbar_; asm volatile("s_waitcnt vmcnt(0)" ::: "memory"); __syncthreads(); \
        if (wave0 == 0) xcd_barrier_core(xbar, LEADER()); else shadow_work((KArgsP)ap0, nbar_, wave0 - 1, bid, G, (int)lane_id_now(), lds); \
        __syncthreads(); } while (0)

#if TIMESEL >= 0
#define STAMP(k) do { if (bid == 0 && threadIdx.x == 0) ((unsigned long long*)WS(768 * 1024))[k] = __builtin_amdgcn_s_memrealtime(); } while (0)
#else
#define STAMP(k) do {} while (0)
#endif
    STAMP(0);
    {
        PHASE_IDS();
        {   const float* const cs = IN(I_CS); const float* const cp = IN(I_CP); const float* const wad = IN(I_WADA); const float* const bad = IN(I_BADA); float* const ada = ADA;
            for (int pr = bid; pr < NADA / 32; pr += G) ada_block(lds, cs, cp, wad, bad, ada, pr, wave, lane); }
    }
    GRID_SYNC();
    STAMP(1);
    STAMP(2);
    {
        PHASE_IDS();
        norm_phase<0>(IN(I_XP), IN(I_XS), IN(I_GMIX), ADA, 1024, 0, H, nullptr, gw, NGW, lane);
    }
    GRID_SYNC();
    STAMP(3);
    {
        typedef Sched<0, 2048, 2048> SC; SC S; S.to.init(NMT, NIN / 256); S.G = G; S.c = bid; S.A0 = (const char*)H; S.B0 = (const char*)WIN;
        EpiProj E{U, BG, Q, KB, VB, GA, GB};
        pg8::gemm_phase<EpiProj, SC, 1024, 1024, 1024, true, true>(ldsl, wave0, S, E);
    }
    GRID_SYNC();
    STAMP(4);
    {
        PHASE_IDS();
        {   bf16_t* const q_ = Q; const bf16_t* const kb_ = KB; const bf16_t* const vb_ = VB; const float* const sinks = IN(I_SINK);
            AttnKV cur; if (bid < 512) attn_fetch(cur, kb_, vb_, bid >> 2, bid & 3, tid);
            for (int un = bid; un < 512; un += G) {
                AttnKV nxt; const int un2 = un + G; if (un2 < 512) attn_fetch(nxt, kb_, vb_, un2 >> 2, un2 & 3, tid);
                attn_prompt_unit(lds, q_, cur, sinks, un >> 2, un & 3, tid);
                if (un2 < 512) cur = nxt; } }
        {   bf16_t* const q_ = Q; const bf16_t* const kb_ = KB; const bf16_t* const vb_ = VB; const float* const sinks = IN(I_SINK);
            const float* const ck_ = IN(I_CK); const float* const cv_ = IN(I_CV);
            float* wl = (float*)(lds + 123392 + (wave >> 2) * 4096);
            for (int t4 = gw; t4 < 2048; t4 += NGW) if ((t4 & 3) == 0) { const int t = t4 >> 2; attn_sample_task(wl, q_, kb_, vb_, ck_, cv_, sinks, t >> 2, t & 3, lane); } }
        const bool worker = (wave & 3) != 0; const long wt = ((long)bid * 6 + (wave - 1 - (wave > 4 ? 1 : 0))) * 64 + lane, NWT = (long)G * 6 * 64;
        {
        float* const out = OUT();
        const float* caw = IN(I_CAW); const float* sca = IN(I_SCA); const bf16_t* const u_ = U; const bf16_t* const bg_ = BG; bf16_t* const ain_ = AIN;
        if (worker)
        for (long it = wt; it < (long)(SEQ / 8) * 128 + (long)NS * 128; it += NWT) {
            const bool smp = it >= (long)(SEQ / 8) * 128; const long it2 = smp ? it - (long)(SEQ / 8) * 128 : it;
            const int row0 = smp ? SEQ + (int)(it2 >> 7) : (int)(it2 >> 7) * 8, c8 = (int)(it2 & 127) * 8; const int nr = smp ? 1 : 8;
            float w0[8], w1[8], w2[8], u0[8], u1[8];
            *(f32x4*)w0 = *(const f32x4*)(caw + c8); *(f32x4*)(w0 + 4) = *(const f32x4*)(caw + c8 + 4);
            *(f32x4*)w1 = *(const f32x4*)(caw + 1024 + c8); *(f32x4*)(w1 + 4) = *(const f32x4*)(caw + 1024 + c8 + 4);
            *(f32x4*)w2 = *(const f32x4*)(caw + 2048 + c8); *(f32x4*)(w2 + 4) = *(const f32x4*)(caw + 2048 + c8 + 4);
            if (row0 < SEQ) {
                if (row0 >= 2) { unpack8(*(const u32x4*)(u_ + (size_t)(row0 - 2) * 1024 + c8), u0); unpack8(*(const u32x4*)(u_ + (size_t)(row0 - 1) * 1024 + c8), u1); }
                else { for (int i = 0; i < 8; ++i) { u0[i] = 0.f; u1[i] = 0.f; } }
#pragma unroll 4
                for (int r = 0; r < 8; ++r) { const int row = row0 + r; float u2[8], bg[8], o[8];
                    unpack8(*(const u32x4*)(u_ + (size_t)row * 1024 + c8), u2); unpack8(*(const u32x4*)(bg_ + (size_t)row * 1024 + c8), bg);
#pragma unroll
                    for (int i = 0; i < 8; ++i) { o[i] = bg[i] * (w0[i] * u0[i] + w1[i] * u1[i] + w2[i] * u2[i]); u0[i] = u1[i]; u1[i] = u2[i]; }
                    *(u32x4*)(ain_ + (size_t)row * 1024 + c8) = pack8(o);
                    if (row >= SEQ - 2) { float* op = out + O_CAP + (size_t)(row - (SEQ - 2)) * 1024 + c8; *(f32x4*)op = (f32x4){u2[0], u2[1], u2[2], u2[3]}; *(f32x4*)(op + 4) = (f32x4){u2[4], u2[5], u2[6], u2[7]}; } }
            } else {
                for (int r = 0; r < nr; ++r) { const int row = row0 + r, b = row - SEQ; float u2[8], bg[8], o[8];
                    const float* s0 = sca + (size_t)(b * 2) * 1024 + c8; const float* s1 = s0 + 1024;
                    *(f32x4*)u0 = *(const f32x4*)s0; *(f32x4*)(u0 + 4) = *(const f32x4*)(s0 + 4); *(f32x4*)u1 = *(const f32x4*)s1; *(f32x4*)(u1 + 4) = *(const f32x4*)(s1 + 4);
                    unpack8(*(const u32x4*)(u_ + (size_t)row * 1024 + c8), u2); unpack8(*(const u32x4*)(bg_ + (size_t)row * 1024 + c8), bg);
#pragma unroll
                    for (int i = 0; i < 8; ++i) o[i] = bg[i] * (w0[i] * u0[i] + w1[i] * u1[i] + w2[i] * u2[i]);
                    *(u32x4*)(ain_ + (size_t)row * 1024 + c8) = pack8(o);
                    float* op = out + O_CAS + (size_t)(b * 2) * 1024 + c8;
                    *(f32x4*)op = *(f32x4*)u1; *(f32x4*)(op + 4) = *(f32x4*)(u1 + 4); *(f32x4*)(op + 1024) = (f32x4){u2[0], u2[1], u2[2], u2[3]}; *(f32x4*)(op + 1024 + 4) = (f32x4){u2[4], u2[5], u2[6], u2[7]}; }
            }
        }
        }
    }
    GRID_SYNC();
    STAMP(5);
    {
        typedef Sched<1, 2048, 2048> SC; SC S; S.to.init(SEQ / 256, 4); S.G = G; S.c = bid; S.A0 = (const char*)AIN; S.B0 = (const char*)WA; S.A1 = (const char*)Q; S.B1 = (const char*)WB;
        EpiMix E{GA, GB, OUT(), Z};
        pg8::gemm_phase<EpiMix, SC, 1024, 1024, 1024, true, true>(ldsl, wave0, S, E);
        { PHASE_IDS(); MiniArgs P{AIN, WA, Q, WB, GA, GB, Z, nullptr, nullptr, nullptr, 0}; mini_sample_gemm<0, 1024>(lds, P, bid, G, wave, lane); }
    }
    GRID_SYNC();
    STAMP(6);
    {
        typedef Sched<0, 2048, 2048> SC; SC S; S.to.init(SEQ / 256, 4); S.G = G; S.c = bid; S.A0 = (const char*)Z; S.B0 = (const char*)WO;
        EpiRes E{IN(I_XP), IN(I_XS), OUT(), ADA, 2048};
        pg8::gemm_phase<EpiRes, SC, 1024, 1024, 1024, true, true>(ldsl, wave0, S, E);
        { PHASE_IDS(); MiniArgs P{Z, WO, nullptr, nullptr, nullptr, nullptr, nullptr, IN(I_XS), OUT(), ADA, 2048}; mini_sample_gemm<1, 1024>(lds, P, bid, G, wave, lane); }
    }
    GRID_SYNC();
    STAMP(7);
    {
        PHASE_IDS();
        bf16_t* const h2 = H2;
        if (gt < 256) *(u32x4*)((unsigned char*)h2 - 4096 + gt * 16) = (u32x4){0u, 0u, 0u, 0u};
        norm_phase<1>(OUT(), nullptr, IN(I_GFFN), ADA, 4096, 3072, h2, nullptr, gw, NGW, lane);
    }
    GRID_SYNC();
    STAMP(8);
    {
        typedef Sched<2, 2048, 2048> SC; SC S; S.to.init(NPT5 + 1, FF2 / 256); S.G = G; S.c = bid; S.A0 = (const char*)H2; S.B0 = (const char*)WUP;
        float* const out = OUT(); EpiFfn E{GG, IN(I_FCW), IN(I_FCB), IN(I_SFF), out + O_FP, out + O_FS, (PG8_LAS float*)(ldsl + HALO_OFF)};
        pg8::gemm_phase<EpiFfn, SC, 1024, 1024, 1024, true, true>(ldsl, wave0, S, E);
    }
    GRID_SYNC();
    STAMP(9);
    {
        typedef Sched<0, FF * 2, FF * 2> SC; SC S; S.to.init(SEQ / 256, 4); S.G = G; S.c = bid; S.A0 = (const char*)GG; S.B0 = (const char*)WDN;
        { EpiDelta E{Z, ADA, 5120};
        pg8::gemm_phase<EpiDelta, SC, FF, FF, FF, true, true>(ldsl, wave0, S, E); }
        { PHASE_IDS(); MiniArgs P{GG, WDN, nullptr, nullptr, nullptr, nullptr, Z, nullptr, nullptr, ADA, 5120}; mini_sample_gemm<2, FF>(lds, P, bid, G, wave, lane); }
    }
    GRID_SYNC();
    STAMP(10);
    {
        PHASE_IDS();
        float* const out = OUT();
        norm_phase<2>(out, nullptr, IN(I_GFIN), nullptr, 0, 0, nullptr, out, gw, NGW, lane, Z);
    }
#if TIMESEL >= 0
    GRID_SYNC();
    STAMP(11);
    GRID_SYNC();
    STAMP(12);
    GRID_SYNC();
    {   PHASE_IDS(); const volatile unsigned long long* ts = (const volatile unsigned long long*)WS(768 * 1024);
        const float us = (float)(ts[TIMESEL + TIMESPAN] - ts[TIMESEL]) * 0.01f;
        const float sc = 1.006f + us * 1e-5f; float* o = OUT() + O_KS;
        for (long i = gt; i < 128L * 128 * 256; i += NGT) o[i] *= sc; }
#endif
}

extern "C" void kernel_launch(void* const* d_in, const int* in_sizes, int n_in, void* d_out, int out_size, void* d_ws, size_t ws_size, hipStream_t stream) {
    static int grid = 0;
    if (grid == 0) {
        if (n_in != 23 || ws_size < WS_END) { fprintf(stderr, "kernel_launch: unexpected n_in %d / ws %zu\n", n_in, ws_size); grid = -1; return; }
        int dev = 0, cus = 0, per_cu = 0;
        hipGetDevice(&dev); hipDeviceGetAttribute(&cus, hipDeviceAttributeMultiprocessorCount, dev);
        if (hipFuncSetAttribute((const void*)mega, hipFuncAttributeMaxDynamicSharedMemorySize, LDS_BYTES) != hipSuccess) { fprintf(stderr, "kernel_launch: hipFuncSetAttribute failed\n"); }
        hipOccupancyMaxActiveBlocksPerMultiprocessor(&per_cu, (const void*)mega, 512, LDS_BYTES);
        (void)hipGetLastError();
        if (per_cu < 1) per_cu = 1;
        grid = cus * 1;
        if (grid <= 0) grid = 256;
    }
    if (grid < 0) return;
    Args a{};
    for (int i = 0; i < 23; ++i) a.in[i] = (const float*)d_in[i];
    a.out = (float*)d_out; a.ws = (unsigned char*)d_ws;
    (void)hipMemsetAsync((char*)d_ws + WS_BAR, 0, XCD_BAR_WORDS * 4, stream);
    void* args[] = {&a};
    hipError_t e = hipLaunchCooperativeKernel((const void*)mega, dim3(grid), dim3(512), args, LDS_BYTES, stream);
    if (e != hipSuccess) fprintf(stderr, "cooperative launch failed: %s (grid %d)\n", hipGetErrorString(e), grid);
}
```

```cpp
#ifndef SELFCHECK
#define SELFCHECK 0
#endif
#ifndef TIMESEL
#define TIMESEL -1
#define TIMESPAN 1
#endif
#ifndef TIMESPAN
#define TIMESPAN 1
#endif
#include <hip/hip_runtime.h>
#include <hip/hip_cooperative_groups.h>
#include <cstdio>
#include <cstdint>
namespace cg = cooperative_groups;

constexpr int D = 1024, SEQ = 16384, NS = 128, MROWS = SEQ + NS, MPAD = 16640;
constexpr int NIN = 6656, FF = 2816, FF2 = 5632, NADA = 6144;
constexpr int NMT = MPAD / 256;
constexpr int NPT5 = 65;
constexpr float EPS = 1e-6f;

constexpr size_t MiB = 1u << 20;
constexpr size_t RB = (size_t)MPAD * 1024 * 2;
constexpr size_t KBB = (size_t)MPAD * 256 * 2;
constexpr size_t WS_AADA = 1 * MiB;
constexpr size_t WS_ADA = 2 * MiB;
constexpr size_t WS_WA = 8 * MiB, WS_WB = 10 * MiB, WS_WO = 12 * MiB;
constexpr size_t WS_WADA = 14 * MiB;
constexpr size_t WS_WIN = 26 * MiB;
constexpr size_t WS_WUP = 14 * MiB;
constexpr size_t WS_WDN = 25 * MiB;
constexpr size_t WS_H = 39 * MiB;
constexpr size_t WS_U = 72 * MiB;
constexpr size_t WS_BG = 105 * MiB;
constexpr size_t WS_Q = 138 * MiB;
constexpr size_t WS_KB = WS_Q + RB, WS_VB = WS_KB + KBB, WS_GA = WS_VB + KBB, WS_GB = WS_GA + RB;
constexpr size_t WS_G = WS_Q;
constexpr size_t WS_END = WS_GB + RB;
static_assert(WS_END <= 256 * MiB, "ws map");
static_assert(WS_G + (size_t)MPAD * FF * 2 <= WS_END, "G overlay");
static_assert(WS_WDN + (size_t)1024 * FF * 2 <= WS_H && WS_WUP + (size_t)FF2 * 1024 * 2 <= WS_WDN, "weights");
static_assert(WS_U + RB + 4096 <= WS_BG && WS_H + RB <= WS_U && WS_BG + RB <= WS_Q, "row buffers");

constexpr size_t O_YP = 0, O_YS = 16777216, O_CAP = 16908288, O_CAS = 16910336, O_KP = 17172480, O_KS = 17205248,
                 O_VP = 21399552, O_VS = 21432320, O_FP = 25626624, O_FS = 25637888;

constexpr int LDS_BYTES = 147456;
constexpr int HALO_OFF = 131072;

typedef unsigned short bf16_t;
typedef short bf16x8 __attribute__((ext_vector_type(8)));
typedef float f32x4 __attribute__((ext_vector_type(4)));
typedef float f32x16 __attribute__((ext_vector_type(16)));
typedef float f32x2 __attribute__((ext_vector_type(2)));
typedef unsigned u32x4 __attribute__((ext_vector_type(4)));
typedef unsigned u32x2 __attribute__((ext_vector_type(2)));

__device__ __forceinline__ float bf2f(unsigned b) { return __uint_as_float(b << 16); }
__device__ __forceinline__ unsigned cvt_pk_bf16(float lo, float hi) { unsigned r; asm volatile("v_cvt_pk_bf16_f32 %0, %1, %2" : "=v"(r) : "v"(lo), "v"(hi)); return r; }
__device__ __forceinline__ unsigned lane_id_now() { unsigned l; asm volatile("v_mbcnt_lo_u32_b32 %0, -1, 0\n\tv_mbcnt_hi_u32_b32 %0, -1, %0" : "=v"(l)); return l; }
__device__ __forceinline__ float bperm_f(float v, int byte_addr) { return __int_as_float(__builtin_amdgcn_ds_bpermute(byte_addr, __float_as_int(v))); }
__device__ __forceinline__ float sigmoidf_(float x) { return __builtin_amdgcn_rcpf(1.0f + __expf(-x)); }
__device__ __forceinline__ float siluf_(float x) { return x * __builtin_amdgcn_rcpf(1.0f + __expf(-x)); }
__device__ __forceinline__ float wave_sum(float v) {
#pragma unroll
    for (int o = 1; o < 64; o <<= 1) v += __shfl_xor(v, o);
    return v;
}
__device__ __forceinline__ float wave_max(float v) {
#pragma unroll
    for (int o = 1; o < 64; o <<= 1) v = fmaxf(v, __shfl_xor(v, o));
    return v;
}
__device__ __forceinline__ void unpack8(u32x4 w, float* f) {
    f[0] = bf2f(w.x & 0xffffu); f[1] = bf2f(w.x >> 16); f[2] = bf2f(w.y & 0xffffu); f[3] = bf2f(w.y >> 16);
    f[4] = bf2f(w.z & 0xffffu); f[5] = bf2f(w.z >> 16); f[6] = bf2f(w.w & 0xffffu); f[7] = bf2f(w.w >> 16);
}
__device__ __forceinline__ u32x4 pack8(const float* f) {
    u32x4 w; w.x = cvt_pk_bf16(f[0], f[1]); w.y = cvt_pk_bf16(f[2], f[3]); w.z = cvt_pk_bf16(f[4], f[5]); w.w = cvt_pk_bf16(f[6], f[7]); return w;
}

namespace pg8 {
#define PG8_LAS __attribute__((address_space(3)))
constexpr int BM = 256, BK = 64, HALF = 128, HTB = HALF * BK * 2, STAGE_BYTES = 8 * HTB, NXCD = 8, WGM = 8;
__host__ __device__ __forceinline__ int lds_byte(int r, int c) { const int st = (r >> 4) * 2 + (c >> 5), rr = r & 15, cc = c & 31, ob = rr * 64 + cc * 2; return st * 1024 + (ob ^ (((ob >> 9) & 1) << 5)); }
__host__ __device__ __forceinline__ void stage_rc(int b, int& R, int& C) { const int st = b / 1024, sb = b % 1024, swz = sb ^ (((sb >> 9) & 1) << 5); R = (st >> 1) * 16 + swz / 64; C = (st & 1) * 32 + (swz % 64) / 2; }
__host__ __device__ __forceinline__ int perm32(int rho) { const int n = rho >> 4, i = rho & 15; return 8 * (i >> 2) + 4 * n + (i & 3); }

struct Unit { int pm, pn, aux; const char* a; const char* b; };

struct TileOrder {
    int nM, nN, nwg;
    __device__ __forceinline__ void init(int nM_, int nN_) { nM = nM_; nN = nN_; nwg = nM * nN; }
    __device__ __forceinline__ bool tile(long L, int& pm, int& pn) const {
        if (L >= nwg) return false;
        int wgid = (int)L; { const int q = nwg / NXCD, r = nwg % NXCD, xcd = wgid % NXCD, off = wgid / NXCD; wgid = (xcd < r ? xcd * (q + 1) : r * (q + 1) + (xcd - r) * q) + off; }
        const int nig = WGM * nN, gid = wgid / nig, fm = gid * WGM, gsz = (nM - fm) < WGM ? (nM - fm) : WGM;
        pm = fm + ((wgid % nig) % gsz); pn = (wgid % nig) / gsz; return true;
    }
};

template <class Epi, class Sched, int lda, int ldb, int K, bool ALIGN_EPI, bool SP2>
__device__ __forceinline__ void gemm_phase(PG8_LAS unsigned char* lds, const int wave0, const Sched& S, const Epi& E) {
    int tid_ = wave0 * 64 + (int)lane_id_now(); asm volatile("" : "+v"(tid_));
    const int tid = tid_, wid = __builtin_amdgcn_readfirstlane(tid >> 6), lane = tid & 63, wr = wid >> 2, wc = wid & 3, fr = lane & 15, fq = lane >> 4;
    const int nt = K / BK;
    unsigned voffA[2], voffB[2];
#pragma unroll
    for (int i = 0; i < 2; ++i) { int R, C; stage_rc(tid * 16 + i * 8192, R, C); const int Rb = Epi::PERM ? ((R & ~31) + perm32(R & 31)) : R;
        voffA[i] = (unsigned)(R * lda + C) * 2u; voffB[i] = (unsigned)(Rb * ldb + C) * 2u; }
    const size_t kstep = (size_t)(BK * 2);
    const size_t hstepA = (size_t)HALF * lda * 2, hstepB = (size_t)HALF * ldb * 2;
    const unsigned ldsw = (unsigned)wid * 1024u;
    const int aoff = lds_byte(wr * 64 + fr, fq * 8), boff = lds_byte(wc * 32 + fr, fq * 8);
#define PG8_SA(b, h) (((b) * 2 + (h)) * HTB)
#define PG8_SB(b, h) ((4 + (b) * 2 + (h)) * HTB)
#define PG8_STAGE(bufoff, gbase, voff) do { _Pragma("unroll") for (int _i = 0; _i < 2; ++_i) \
        __builtin_amdgcn_global_load_lds((const unsigned*)((const char*)(gbase) + (voff)[_i]), (PG8_LAS unsigned*)(lds + (bufoff) + ldsw + _i * 8192), 16, 0, 0); } while (0)
#define PG8_LDA(dst, b, h) do { _Pragma("unroll") for (int m = 0; m < 4; ++m) _Pragma("unroll") for (int k = 0; k < 2; ++k) dst[m][k] = *(const PG8_LAS bf16x8*)(lds + PG8_SA(b, h) + aoff + m * 2048 + k * 1024); } while (0)
#define PG8_LDB(dst, b, h) do { _Pragma("unroll") for (int n = 0; n < 2; ++n) _Pragma("unroll") for (int k = 0; k < 2; ++k) dst[n][k] = *(const PG8_LAS bf16x8*)(lds + PG8_SB(b, h) + boff + n * 2048 + k * 1024); } while (0)
#define PG8_MMA(ai, bj, At, Bt) do { __builtin_amdgcn_s_setprio(1); _Pragma("unroll") for (int m = 0; m < 4; ++m) _Pragma("unroll") for (int n = 0; n < 2; ++n) _Pragma("unroll") for (int k = 0; k < 2; ++k) \
        acc[ai][bj][m][n] = __builtin_amdgcn_mfma_f32_16x16x32_bf16(Bt[n][k], At[m][k], acc[ai][bj][m][n], 0, 0, 0); __builtin_amdgcn_s_setprio(0); } while (0)
#define PG8_WAIT_V(n) asm volatile("s_waitcnt vmcnt(" #n ")" ::: "memory")
#define PG8_WAIT_L(n) asm volatile("s_waitcnt lgkmcnt(" #n ")" ::: "memory")
#define PG8_BAR __builtin_amdgcn_s_barrier()
#define PG8_SCHED __builtin_amdgcn_sched_barrier(0)
    Unit cur, nxt; int ui = 0;
    if (!S.next(0, cur)) return;
    f32x4 acc[2][2][4][2];
#pragma unroll
    for (int a = 0; a < 2; ++a)
#pragma unroll
        for (int b = 0; b < 2; ++b)
#pragma unroll
            for (int m = 0; m < 4; ++m)
#pragma unroll
                for (int n = 0; n < 2; ++n) acc[a][b][m][n] = (f32x4){0.f, 0.f, 0.f, 0.f};
    bf16x8 At[4][2], B0[2][2], B1[2][2];
    const char* cA = cur.a; const char* cB = cur.b;
    if constexpr (SP2) {
        PG8_STAGE(PG8_SB(0, 0), cB, voffB); PG8_STAGE(PG8_SB(0, 1), cB + hstepB, voffB); PG8_STAGE(PG8_SA(0, 0), cA, voffA); PG8_STAGE(PG8_SA(0, 1), cA + hstepA, voffA);
        if (wr == 1) PG8_BAR;
        PG8_WAIT_V(2); PG8_BAR;
        PG8_STAGE(PG8_SB(1, 0), cB + kstep, voffB); PG8_STAGE(PG8_SA(1, 0), cA + kstep, voffA); PG8_STAGE(PG8_SB(1, 1), cB + hstepB + kstep, voffB);
        PG8_WAIT_V(6); PG8_BAR;
    } else {
        PG8_STAGE(PG8_SB(0, 0), cB, voffB); PG8_STAGE(PG8_SA(0, 0), cA, voffA); PG8_STAGE(PG8_SB(0, 1), cB + hstepB, voffB); PG8_STAGE(PG8_SA(0, 1), cA + hstepA, voffA);
        if (wr == 1) PG8_BAR;
        PG8_WAIT_V(4); PG8_BAR;
        PG8_STAGE(PG8_SB(1, 0), cB + kstep, voffB); PG8_STAGE(PG8_SA(1, 0), cA + kstep, voffA); PG8_STAGE(PG8_SB(1, 1), cB + hstepB + kstep, voffB);
        PG8_WAIT_V(6); PG8_BAR;
    }
    for (;;) {
        const bool has_next = S.next(ui + 1, nxt);
        const char* nA = has_next ? nxt.a : cA; const char* nB = has_next ? nxt.b : cB;
        for (int t = 0; t < nt; t += 2) {
            const bool last = (t == nt - 2);
            const char* a1 = cA + (size_t)(t + 1) * kstep;
            const char* a2 = last ? nA : cA + (size_t)(t + 2) * kstep; const char* b2 = last ? nB : cB + (size_t)(t + 2) * kstep;
            const char* a3 = a2 + kstep; const char* b3 = b2 + kstep;
            if constexpr (SP2) {
            PG8_LDB(B0, 0, 0); PG8_LDB(B1, 0, 1); PG8_SCHED; PG8_LDA(At, 0, 0); PG8_STAGE(PG8_SA(1, 1), a1 + hstepA, voffA);
            PG8_WAIT_V(8); PG8_WAIT_L(0); PG8_BAR; PG8_MMA(0, 0, At, B0); PG8_MMA(0, 1, At, B1); PG8_BAR; PG8_SCHED;
            PG8_LDA(At, 0, 1); PG8_STAGE(PG8_SB(0, 0), b2, voffB); PG8_STAGE(PG8_SB(0, 1), b2 + hstepB, voffB); PG8_STAGE(PG8_SA(0, 0), a2, voffA);
            PG8_WAIT_V(8); PG8_WAIT_L(0); PG8_BAR; PG8_MMA(1, 0, At, B0); PG8_MMA(1, 1, At, B1); PG8_BAR; PG8_SCHED;
            PG8_LDB(B0, 1, 0); PG8_LDB(B1, 1, 1); PG8_SCHED; PG8_LDA(At, 1, 0); PG8_STAGE(PG8_SA(0, 1), a2 + hstepA, voffA);
            PG8_WAIT_V(8); PG8_WAIT_L(0); PG8_BAR; PG8_MMA(0, 0, At, B0); PG8_MMA(0, 1, At, B1); PG8_BAR; PG8_SCHED;
            PG8_LDA(At, 1, 1); PG8_STAGE(PG8_SB(1, 0), b3, voffB); PG8_STAGE(PG8_SB(1, 1), b3 + hstepB, voffB); PG8_STAGE(PG8_SA(1, 0), a3, voffA);
            PG8_WAIT_V(8); PG8_WAIT_L(0); PG8_BAR; PG8_MMA(1, 0, At, B0); PG8_MMA(1, 1, At, B1); PG8_BAR; PG8_SCHED;
            } else {
            PG8_LDB(B0, 0, 0); PG8_SCHED; PG8_LDA(At, 0, 0); PG8_STAGE(PG8_SA(1, 1), a1 + hstepA, voffA);
            PG8_WAIT_L(8); PG8_BAR; PG8_WAIT_L(0); PG8_MMA(0, 0, At, B0); PG8_BAR; PG8_SCHED;
            PG8_LDB(B1, 0, 1); PG8_STAGE(PG8_SB(0, 0), b2, voffB);
            PG8_BAR; PG8_WAIT_L(0); PG8_MMA(0, 1, At, B1); PG8_BAR;
            PG8_LDA(At, 0, 1); PG8_STAGE(PG8_SA(0, 0), a2, voffA);
            PG8_BAR; PG8_WAIT_L(0); PG8_MMA(1, 0, At, B0); PG8_BAR; PG8_SCHED;
            PG8_STAGE(PG8_SB(0, 1), b2 + hstepB, voffB);
            PG8_WAIT_V(6); PG8_BAR; PG8_MMA(1, 1, At, B1); PG8_BAR;
            PG8_LDB(B0, 1, 0); PG8_SCHED; PG8_LDA(At, 1, 0); PG8_STAGE(PG8_SA(0, 1), a2 + hstepA, voffA);
            PG8_WAIT_L(8); PG8_BAR; PG8_WAIT_L(0); PG8_MMA(0, 0, At, B0); PG8_BAR; PG8_SCHED;
            PG8_LDB(B1, 1, 1); PG8_STAGE(PG8_SB(1, 0), b3, voffB);
            PG8_BAR; PG8_WAIT_L(0); PG8_MMA(0, 1, At, B1); PG8_BAR;
            PG8_LDA(At, 1, 1); PG8_STAGE(PG8_SA(1, 0), a3, voffA);
            PG8_BAR; PG8_WAIT_L(0); PG8_MMA(1, 0, At, B0); PG8_BAR; PG8_SCHED;
            PG8_STAGE(PG8_SB(1, 1), b3 + hstepB, voffB);
            PG8_WAIT_V(6); PG8_BAR; PG8_MMA(1, 1, At, B1); PG8_BAR;
            }
        }
        if constexpr (ALIGN_EPI) { if (wr == 0) PG8_BAR; }
        E(acc, cur, wr, wc, fr, fq);
        if (!has_next) break;
#pragma unroll
        for (int a = 0; a < 2; ++a)
#pragma unroll
            for (int b = 0; b < 2; ++b)
#pragma unroll
                for (int m = 0; m < 4; ++m)
#pragma unroll
                    for (int n = 0; n < 2; ++n) acc[a][b][m][n] = (f32x4){0.f, 0.f, 0.f, 0.f};
        cur = nxt; cA = nA; cB = nB; ++ui;
        if constexpr (ALIGN_EPI) { if (wr == 1) PG8_BAR; }
    }
    PG8_WAIT_V(0);
    if constexpr (!ALIGN_EPI) { if (wr == 0) PG8_BAR; }
    PG8_BAR;
#undef PG8_SA
#undef PG8_SB
#undef PG8_STAGE
#undef PG8_LDA
#undef PG8_LDB
#undef PG8_MMA
#undef PG8_WAIT_V
#undef PG8_WAIT_L
#undef PG8_BAR
#undef PG8_SCHED
}
}
using pg8::Unit;

template <int MODE, int LDA_B, int LDB_B> struct Sched {
    pg8::TileOrder to; int G, c;
    const char* A0; const char* B0; const char* A1; const char* B1;
    __device__ __forceinline__ bool next(int i, Unit& u) const {
        if (MODE == 1) {
            const long L = (long)(i >> 1) * G + c; if (!to.tile(L, u.pm, u.pn)) return false;
            u.aux = i & 1;
            u.a = (u.aux ? A1 : A0) + (size_t)u.pm * 256 * LDA_B; u.b = (u.aux ? B1 : B0) + (size_t)u.pn * 256 * LDB_B; return true;
        } else {
            const long L = (long)i * G + c;
            if (MODE == 2 && G >= 64) {
                const int nS = FF2 / 256;
                if (L >= (long)to.nwg + nS) return false;
                if (L >= G - nS && L < G) { u.pm = NPT5; u.pn = (int)(L - (G - nS)); }
                else if (!to.tile(L < G - nS ? L : L - nS, u.pm, u.pn)) return false;
            } else if (!to.tile(L, u.pm, u.pn)) return false;
            u.aux = 0;
            if (MODE == 2) { const long r0 = (u.pm < NPT5) ? (254L * u.pm - 2) : (long)SEQ; u.a = A0 + r0 * (long)LDA_B; }
            else u.a = A0 + (size_t)u.pm * 256 * LDA_B;
            u.b = B0 + (size_t)u.pn * 256 * LDB_B; return true;
        }
    }
};

#define EPI_ARGS const f32x4 (&acc)[2][2][4][2], const Unit& u, int wr, int wc, int fr, int fq
struct EpiAda {
    static constexpr bool PERM = true;
    float* ADA; const float* bias;
    __device__ __forceinline__ void operator()(EPI_ARGS) const {
#pragma unroll
        for (int ai = 0; ai < 2; ++ai)
#pragma unroll
            for (int m = 0; m < 4; ++m) { const int row = 128 * ai + 64 * wr + 16 * m + fr;
#pragma unroll
                for (int bj = 0; bj < 2; ++bj) { const int col = 256 * u.pn + 128 * bj + 32 * wc + 8 * fq;
#pragma unroll
                    for (int n = 0; n < 2; ++n) { const f32x4 b = *(const f32x4*)(bias + col + 4 * n); *(f32x4*)(ADA + (size_t)row * NADA + col + 4 * n) = acc[ai][bj][m][n] + b; } } }
    }
};
struct EpiProj {
    static constexpr bool PERM = true;
    bf16_t *U, *BG, *Q, *KB, *VB, *GA, *GB;
    __device__ __forceinline__ void operator()(EPI_ARGS) const {
        const int row0 = u.pm * 256 + wr * 64 + fr;
        if (u.pn < 8) {
#pragma unroll
            for (int ai = 0; ai < 2; ++ai)
#pragma unroll
                for (int m = 0; m < 4; ++m) { const int row = row0 + 128 * ai + 16 * m;
                    const f32x4 v0 = acc[ai][0][m][0] * acc[ai][1][m][0], v1 = acc[ai][0][m][1] * acc[ai][1][m][1];
                    u32x4 w; w.x = cvt_pk_bf16(v0[0], v0[1]); w.y = cvt_pk_bf16(v0[2], v0[3]); w.z = cvt_pk_bf16(v1[0], v1[1]); w.w = cvt_pk_bf16(v1[2], v1[3]);
                    *(u32x4*)(U + (size_t)row * 1024 + 128 * u.pn + 32 * wc + 8 * fq) = w; }
        } else {
            bf16_t* dst; int ld, cb; const int pn = u.pn;
            if (pn < 12) { dst = BG; ld = 1024; cb = 256 * (pn - 8); }
            else if (pn < 16) { dst = Q; ld = 1024; cb = 256 * (pn - 12); }
            else if (pn == 16) { dst = KB; ld = 256; cb = 0; }
            else if (pn == 17) { dst = VB; ld = 256; cb = 0; }
            else if (pn < 22) { dst = GA; ld = 1024; cb = 256 * (pn - 18); }
            else { dst = GB; ld = 1024; cb = 256 * (pn - 22); }
#pragma unroll
            for (int ai = 0; ai < 2; ++ai)
#pragma unroll
                for (int m = 0; m < 4; ++m) { const int row = row0 + 128 * ai + 16 * m;
#pragma unroll
                    for (int bj = 0; bj < 2; ++bj) { const f32x4 v0 = acc[ai][bj][m][0], v1 = acc[ai][bj][m][1];
                        u32x4 w; w.x = cvt_pk_bf16(v0[0], v0[1]); w.y = cvt_pk_bf16(v0[2], v0[3]); w.z = cvt_pk_bf16(v1[0], v1[1]); w.w = cvt_pk_bf16(v1[2], v1[3]);
                        *(u32x4*)(dst + (size_t)row * ld + cb + 128 * bj + 32 * wc + 8 * fq) = w; } }
        }
    }
};
struct EpiMix {
    static constexpr bool PERM = true;
    const bf16_t *GA, *GB; float* T; bf16_t* Z;
    __device__ __forceinline__ void operator()(EPI_ARGS) const {
        const int row0 = u.pm * 256 + wr * 64 + fr;
        const bf16_t* gate = u.aux ? GB : GA;
#pragma unroll
        for (int ai = 0; ai < 2; ++ai)
#pragma unroll
            for (int m = 0; m < 4; ++m) { const int row = row0 + 128 * ai + 16 * m;
                if (row < MROWS) {
#pragma unroll
                for (int bj = 0; bj < 2; ++bj) { const int col = 256 * u.pn + 128 * bj + 32 * wc + 8 * fq;
                    float gv[8]; unpack8(*(const u32x4*)(gate + (size_t)row * 1024 + col), gv);
                    float o[8];
#pragma unroll
                    for (int i = 0; i < 8; ++i) o[i] = sigmoidf_(gv[i]) * acc[ai][bj][m][i >> 2][i & 3];
                    bf16_t* zp = Z + (size_t)row * 1024 + col;
                    if (u.aux == 0) *(u32x4*)zp = pack8(o);
                    else { float t[8]; unpack8(*(const u32x4*)zp, t);
#pragma unroll
                        for (int i = 0; i < 8; ++i) o[i] += t[i];
                        *(u32x4*)zp = pack8(o); } } } }
    }
};
struct EpiRes {
    static constexpr bool PERM = true;
    const float* xp; const float* xs; float* out; const float* ADA; int goff;
    __device__ __forceinline__ void operator()(EPI_ARGS) const {
        const int row0 = u.pm * 256 + wr * 64 + fr;
#pragma unroll
        for (int ai = 0; ai < 2; ++ai)
#pragma unroll
            for (int m = 0; m < 4; ++m) { const int row = row0 + 128 * ai + 16 * m;
                if (row < MROWS) {
                const float* base = (row < SEQ) ? xp + (size_t)row * 1024 : xs + (size_t)(row - SEQ) * 1024;
                const float* gt = ADA + (size_t)((row < SEQ) ? 128 : row - SEQ) * NADA + goff;
#pragma unroll
                for (int bj = 0; bj < 2; ++bj) { const int col = 256 * u.pn + 128 * bj + 32 * wc + 8 * fq;
#pragma unroll
                    for (int n = 0; n < 2; ++n) { const f32x4 b = *(const f32x4*)(base + col + 4 * n), g = *(const f32x4*)(gt + col + 4 * n);
                        *(f32x4*)(out + (size_t)row * 1024 + col + 4 * n) = b + g * acc[ai][bj][m][n]; } } } }
    }
};
struct EpiDelta {
    static constexpr bool PERM = true;
    bf16_t* Dd; const float* ADA; int goff;
    __device__ __forceinline__ void operator()(EPI_ARGS) const {
        const int row0 = u.pm * 256 + wr * 64 + fr;
#pragma unroll
        for (int ai = 0; ai < 2; ++ai)
#pragma unroll
            for (int m = 0; m < 4; ++m) { const int row = row0 + 128 * ai + 16 * m;
                if (row < MROWS) {
                const float* gt = ADA + (size_t)((row < SEQ) ? 128 : row - SEQ) * NADA + goff;
#pragma unroll
                for (int bj = 0; bj < 2; ++bj) { const int col = 256 * u.pn + 128 * bj + 32 * wc + 8 * fq;
                    const f32x4 g0 = *(const f32x4*)(gt + col), g1 = *(const f32x4*)(gt + col + 4); const f32x4 a0 = g0 * acc[ai][bj][m][0], a1 = g1 * acc[ai][bj][m][1];
                    u32x4 w; w.x = cvt_pk_bf16(a0[0], a0[1]); w.y = cvt_pk_bf16(a0[2], a0[3]); w.z = cvt_pk_bf16(a1[0], a1[1]); w.w = cvt_pk_bf16(a1[2], a1[3]);
                    *(u32x4*)(Dd + (size_t)row * 1024 + col) = w; } } }
    }
};
struct EpiRes4 {
    static constexpr bool PERM = true;
    const float* xp; float* out; const float* ADA; const float* gf; bf16_t* A2; float* SS;
    __device__ __forceinline__ void operator()(EPI_ARGS) const {
        const int row0 = u.pm * 256 + wr * 64 + fr; const float* ad = ADA + (size_t)128 * NADA;
#pragma unroll
        for (int ai = 0; ai < 2; ++ai)
#pragma unroll
            for (int m = 0; m < 4; ++m) { const int row = row0 + 128 * ai + 16 * m; float ss = 0.f;
#pragma unroll
                for (int bj = 0; bj < 2; ++bj) { const int col = 256 * u.pn + 128 * bj + 32 * wc + 8 * fq; float a2[8];
#pragma unroll
                    for (int n = 0; n < 2; ++n) { const f32x4 b = *(const f32x4*)(xp + (size_t)row * 1024 + col + 4 * n), g = *(const f32x4*)(ad + 2048 + col + 4 * n);
                        const f32x4 x1 = b + g * acc[ai][bj][m][n]; *(f32x4*)(out + (size_t)row * 1024 + col + 4 * n) = x1;
                        ss += (x1[0] * x1[0] + x1[1] * x1[1]) + (x1[2] * x1[2] + x1[3] * x1[3]);
                        const f32x4 gm = *(const f32x4*)(gf + col + 4 * n) * (*(const f32x4*)(ad + 4096 + col + 4 * n) + 1.0f); const f32x4 av = x1 * gm;
                        a2[4 * n] = av[0]; a2[4 * n + 1] = av[1]; a2[4 * n + 2] = av[2]; a2[4 * n + 3] = av[3]; }
                    *(u32x4*)(A2 + (size_t)row * 1024 + col) = pack8(a2); }
                ss += __shfl_xor(ss, 16); ss += __shfl_xor(ss, 32);
                if (fq == 0) SS[(size_t)row * 16 + u.pn * 4 + wc] = ss; }
    }
};
__device__ __forceinline__ float ss_sum16(const float* SS, unsigned row) {
    const f32x4* p = (const f32x4*)((const char*)SS + (size_t)row * 64u); const f32x4 a = p[0], b = p[1], c = p[2], d = p[3]; const f32x4 s = (a + b) + (c + d); return (s[0] + s[1]) + (s[2] + s[3]); }
struct EpiFfn {
    static constexpr bool PERM = true;
    bf16_t* G; const float* cw; const float* cb; const float* st; float* ofp; float* ofs; PG8_LAS float* halo; const float* SS; const float* C0;
    template <int CTRL> static __device__ __forceinline__ float dppf(float oldv, float src) {
        return __int_as_float(__builtin_amdgcn_update_dpp(__float_as_int(oldv), __float_as_int(src), CTRL, 0xf, 0xf, false)); }
    __device__ __forceinline__ void operator()(const f32x4 (&acc)[2][2][4][2], const Unit& u, int wr, int wc, int fr_, int fq_) const {
        const int l_ = (int)lane_id_now();
        const int fr = l_ & 15, fq = l_ >> 4; (void)fr_; (void)fq_;
        const int wid = wr * 4 + wc;
        const int f0 = 128 * u.pn + 32 * wc + 8 * fq;
        if (u.pm < NPT5) {
            PG8_LAS float* par = halo + 2048;
            {
                const int t = wid * 64 + l_;
                if (t < 256) { const int gc = (t < 128) ? 128 * u.pn + t : FF + 128 * u.pn + (t - 128);
                    const float w0_ = cw[gc], w1_ = cw[FF2 + gc], w2_ = cw[2 * FF2 + gc], b_ = cb[gc], c0_ = C0[gc];
                    par[t] = w0_; par[256 + t] = w1_; par[512 + t] = w2_; par[768 + t] = b_ + c0_ * (w0_ + w1_ + w2_); par[1024 + t] = c0_; }
                else { const int tr_ = t - 256, gr_ = 254 * u.pm - 2 + tr_; const unsigned go_ = (unsigned)((gr_ < 0 || gr_ >= SEQ) ? 0 : gr_);
                    const float ssv = ss_sum16(SS, go_); par[1280 + tr_] = (gr_ >= 0) ? rsqrtf(ssv * (1.0f / 1024.0f) + EPS) : 0.f; }
            }
            unsigned pb_ = (unsigned)(uintptr_t)(par + 32 * wc + 8 * fq); asm volatile("" : "+v"(pb_)); const PG8_LAS float* parl = (const PG8_LAS float*)(uintptr_t)pb_;
            unsigned rb_ = (unsigned)(uintptr_t)(par + 1280 + 64 * wr + fr); asm volatile("" : "+v"(rb_)); const PG8_LAS float* rsl = (const PG8_LAS float*)(uintptr_t)rb_;
            if (fr >= 14) {
#pragma unroll
                for (int ai = 0; ai < 2; ++ai)
#pragma unroll
                    for (int bj = 0; bj < 2; ++bj)
#pragma unroll
                        for (int n = 0; n < 2; ++n) { const int gr_ = 254 * u.pm - 2 + 128 * ai + 64 * wr + 48 + fr; const float r_ = rsqrtf(ss_sum16(SS, (unsigned)(gr_ >= SEQ ? 0 : gr_)) * (1.0f / 1024.0f) + EPS);
                            *(PG8_LAS f32x4*)(halo + ((wid * 2 + ai) * 2 + (fr - 14)) * 64 + bj * 32 + fq * 8 + n * 4) = acc[ai][bj][3][n] * r_; }
            }
            const bool first = (u.pm == 0) && (wr == 0);
            asm volatile("s_waitcnt vmcnt(0) lgkmcnt(0)" ::: "memory"); __builtin_amdgcn_s_barrier(); asm volatile("" ::: "memory");
#pragma unroll
            for (int ai = 0; ai < 2; ++ai) {
                const int swr = (ai == 0) ? 0 : (wr == 0 ? 1 : 0), sai = (ai == 1 && wr == 1) ? 1 : 0;
                unsigned hb_ = (unsigned)(uintptr_t)(halo + (((swr * 4 + wc) * 2 + sai) * 2) * 64 + fq * 8); asm volatile("" : "+v"(hb_)); const PG8_LAS float* hp = (const PG8_LAS float*)(uintptr_t)hb_;
#pragma unroll
                for (int n = 0; n < 2; ++n) {
                    const int cg0 = 4 * n, cv0 = 128 + cg0;
                    f32x4 cvv[4];
                    {
                        const f32x4 w0 = *(const PG8_LAS f32x4*)(parl + cv0), w1 = *(const PG8_LAS f32x4*)(parl + 256 + cv0), w2 = *(const PG8_LAS f32x4*)(parl + 512 + cv0), bb = *(const PG8_LAS f32x4*)(parl + 768 + cv0);
                        const f32x4 h2 = *(const PG8_LAS f32x4*)(hp + 32 + n * 4), h1 = *(const PG8_LAS f32x4*)(hp + 64 + 32 + n * 4);
                        f32x4 p1 = h1, p2 = (fr == 1) ? h1 : h2;
                        const f32x4 bbe = bb;
#pragma unroll
                        for (int m = 0; m < 4; ++m) {
                            const float r_ = rsl[128 * ai + 16 * m];
                            const f32x4 x = acc[ai][1][m][n] * r_; f32x4 q1, q2, n1, n2;
#pragma unroll
                            for (int i = 0; i < 4; ++i) { q1[i] = dppf<0x111>(p1[i], x[i]); q2[i] = dppf<0x112>(p2[i], x[i]); n1[i] = dppf<0x121>(x[i], x[i]); n2[i] = dppf<0x122>(x[i], x[i]); }
                            p1 = n1; p2 = n2;
                            cvv[m] = w0 * q2 + w1 * q1 + w2 * x + bbe;
                            if (ai == 0 && m == 0 && first) { const f32x4 c0v = *(const PG8_LAS f32x4*)(parl + 1024 + cv0); if (fr == 2) cvv[m] -= c0v * (w0 + w1); else if (fr == 3) cvv[m] -= c0v * w0; }
                            __builtin_amdgcn_sched_barrier(0);
                        }
                    }
                    {
                        const f32x4 w0 = *(const PG8_LAS f32x4*)(parl + cg0), w1 = *(const PG8_LAS f32x4*)(parl + 256 + cg0), w2 = *(const PG8_LAS f32x4*)(parl + 512 + cg0), bb = *(const PG8_LAS f32x4*)(parl + 768 + cg0);
                        const f32x4 h2 = *(const PG8_LAS f32x4*)(hp + n * 4), h1 = *(const PG8_LAS f32x4*)(hp + 64 + n * 4);
                        f32x4 p1 = h1, p2 = (fr == 1) ? h1 : h2;
                        const f32x4 bbe = bb;
#pragma unroll
                        for (int m = 0; m < 4; ++m) {
                            const float r_ = rsl[128 * ai + 16 * m];
                            const f32x4 x = acc[ai][0][m][n] * r_; f32x4 q1, q2, n1, n2;
#pragma unroll
                            for (int i = 0; i < 4; ++i) { q1[i] = dppf<0x111>(p1[i], x[i]); q2[i] = dppf<0x112>(p2[i], x[i]); n1[i] = dppf<0x121>(x[i], x[i]); n2[i] = dppf<0x122>(x[i], x[i]); }
                            p1 = n1; p2 = n2;
                            f32x4 cgv = w0 * q2 + w1 * q1 + w2 * x + bbe;
                            if (ai == 0 && m == 0 && first) { const f32x4 c0v = *(const PG8_LAS f32x4*)(parl + 1024 + cg0); if (fr == 2) cgv -= c0v * (w0 + w1); else if (fr == 3) cgv -= c0v * w0; }
                            u32x2 pk; pk.x = cvt_pk_bf16(siluf_(cgv[0]) * cvv[m][0], siluf_(cgv[1]) * cvv[m][1]); pk.y = cvt_pk_bf16(siluf_(cgv[2]) * cvv[m][2], siluf_(cgv[3]) * cvv[m][3]);
                            {
                                const int tr = 128 * ai + 64 * wr + 16 * m + fr; const int grow = 254 * u.pm - 2 + tr;
                                if (tr >= 2 && grow < SEQ) {
                                    *(u32x2*)(G + (size_t)grow * FF + f0 + 4 * n) = pk;
                                    if (n == 1 && grow >= SEQ - 2) { float* o = ofp + (size_t)(grow - (SEQ - 2)) * FF2 + f0;
                                        *(f32x4*)o = acc[ai][0][m][0] * r_ + *(const PG8_LAS f32x4*)(parl + 1024); *(f32x4*)(o + 4) = acc[ai][0][m][1] * r_ + *(const PG8_LAS f32x4*)(parl + 1024 + 4);
                                        *(f32x4*)(o + FF) = acc[ai][1][m][0] * r_ + *(const PG8_LAS f32x4*)(parl + 1024 + 128); *(f32x4*)(o + FF + 4) = acc[ai][1][m][1] * r_ + *(const PG8_LAS f32x4*)(parl + 1024 + 128 + 4); }
                                }
                            }
                            asm volatile("" ::: "memory"); __builtin_amdgcn_sched_barrier(0);
                        }
                    }
                }
                asm volatile("" ::: "memory"); __builtin_amdgcn_sched_barrier(0);
            }
        } else {
#pragma unroll
            for (int n = 0; n < 2; ++n) {
                const int fg = f0 + 4 * n, fv = FF + fg;
#pragma unroll
                for (int m = 0; m < 4; ++m) {
                    const int b = 64 * wr + 16 * m + fr;
                    const float* s0 = st + (size_t)(b * 2) * FF2; const float* s1 = s0 + FF2;
                    float* o0 = ofs + (size_t)(b * 2) * FF2; float* o1 = o0 + FF2;
                    f32x4 cvv;
                    { const f32x4 x = acc[0][1][m][n];
                      const f32x4 w0 = *(const f32x4*)(cw + fv), w1 = *(const f32x4*)(cw + FF2 + fv), w2 = *(const f32x4*)(cw + 2 * FF2 + fv), bb = *(const f32x4*)(cb + fv);
                      const f32x4 t0 = *(const f32x4*)(s0 + fv), t1 = *(const f32x4*)(s1 + fv);
                      cvv = w0 * t0 + w1 * t1 + w2 * x + bb; *(f32x4*)(o0 + fv) = t1; *(f32x4*)(o1 + fv) = x; }
                    asm volatile("" ::: "memory"); __builtin_amdgcn_sched_barrier(0);
                    { const f32x4 x = acc[0][0][m][n];
                      const f32x4 w0 = *(const f32x4*)(cw + fg), w1 = *(const f32x4*)(cw + FF2 + fg), w2 = *(const f32x4*)(cw + 2 * FF2 + fg), bb = *(const f32x4*)(cb + fg);
                      const f32x4 t0 = *(const f32x4*)(s0 + fg), t1 = *(const f32x4*)(s1 + fg);
                      const f32x4 cgv = w0 * t0 + w1 * t1 + w2 * x + bb; *(f32x4*)(o0 + fg) = t1; *(f32x4*)(o1 + fg) = x;
                      u32x2 w; w.x = cvt_pk_bf16(siluf_(cgv[0]) * cvv[0], siluf_(cgv[1]) * cvv[1]); w.y = cvt_pk_bf16(siluf_(cgv[2]) * cvv[2], siluf_(cgv[3]) * cvv[3]);
                      *(u32x2*)(G + (size_t)(SEQ + b) * FF + fg) = w; }
                    asm volatile("" ::: "memory"); __builtin_amdgcn_sched_barrier(0);
                }
            }
        }
    }
};

__device__ __forceinline__ void transpose_item(const float* W, int K, int N, bf16_t* WT, int k0, int n0, int drow0, float* scr, int lane) {
    float tv[32];
#pragma unroll
    for (int i = 0; i < 32; ++i) tv[i] = W[(size_t)(k0 + 2 * i + (lane >> 5)) * N + n0 + (lane & 31)];
#pragma unroll
    for (int i = 0; i < 32; ++i) scr[(2 * i + (lane >> 5)) * 33 + (lane & 31)] = tv[i];
    asm volatile("s_waitcnt lgkmcnt(0)" ::: "memory");
    const int c = lane & 7;
#pragma unroll
    for (int j = 0; j < 4; ++j) { const int n = (lane >> 3) + 8 * j; const float* s = scr + (8 * c) * 33 + n;
        u32x4 o; o.x = cvt_pk_bf16(s[0 * 33], s[1 * 33]); o.y = cvt_pk_bf16(s[2 * 33], s[3 * 33]); o.z = cvt_pk_bf16(s[4 * 33], s[5 * 33]); o.w = cvt_pk_bf16(s[6 * 33], s[7 * 33]);
        *(u32x4*)(WT + (size_t)(drow0 + n) * K + k0 + 8 * c) = o; }
    asm volatile("s_waitcnt lgkmcnt(0)" ::: "memory");
}
__device__ __forceinline__ int win_drow(int n) {
    if (n < 1024) return 256 * (n >> 7) + (n & 127);
    if (n < 2048) return 2048 + (n - 1024);
    if (n < 3072) { const int f = n - 2048; return 256 * (f >> 7) + 128 + (f & 127); }
    return n;
}
__device__ __forceinline__ int wup_drow(int n) { const int f = (n < FF) ? n : n - FF; return 256 * (f >> 7) + ((n < FF) ? 0 : 128) + (f & 127); }

__device__ __forceinline__ void modnorm_row(const float* xrow, const float* g, const float* sc, const float* sh, bf16_t* orow, int lane) {
    f32x4 v[4]; float s = 0.f;
#pragma unroll
    for (int j = 0; j < 4; ++j) { v[j] = ((const f32x4*)xrow)[lane + 64 * j]; s += (v[j][0] * v[j][0] + v[j][1] * v[j][1]) + (v[j][2] * v[j][2] + v[j][3] * v[j][3]); }
    const float rstd = rsqrtf(wave_sum(s) * (1.0f / 1024.0f) + EPS);
#pragma unroll
    for (int j = 0; j < 4; ++j) { const int col = 4 * (lane + 64 * j);
        const f32x4 gg = *(const f32x4*)(g + col), ss = *(const f32x4*)(sc + col), hh = *(const f32x4*)(sh + col);
        const f32x4 o = v[j] * rstd * gg * (ss + 1.0f) + hh;
        u32x2 w; w.x = cvt_pk_bf16(o[0], o[1]); w.y = cvt_pk_bf16(o[2], o[3]); *(u32x2*)(orow + col) = w; }
}


template <int MODE>
__device__ __forceinline__ void norm_phase(const float* xp, const float* xs, const float* gvec, const float* ada, int scoff, int shoff, bf16_t* ob, float* of, int gw, int NGW, int lane, const bf16_t* dadd = nullptr) {
    f32x4 gmP[4], shP[4];
#pragma unroll
    for (int j = 0; j < 4; ++j) { const int col = 4 * (lane + 64 * j); const f32x4 g = *(const f32x4*)(gvec + col);
        if (MODE == 2) { gmP[j] = g; shP[j] = (f32x4){0.f, 0.f, 0.f, 0.f}; }
        else { const float* ad = ada + (size_t)128 * NADA; gmP[j] = g * (*(const f32x4*)(ad + scoff + col) + 1.0f); shP[j] = *(const f32x4*)(ad + shoff + col); } }
#pragma unroll 1
    for (int base = gw; base < MROWS; base += 4 * NGW) {
        f32x4 v[4][4];
#pragma unroll
        for (int r = 0; r < 4; ++r) { const int row = base + r * NGW;
            if (row < MROWS) { const float* xr = (MODE == 0) ? ((row < SEQ) ? xp + (size_t)row * 1024 : xs + (size_t)(row - SEQ) * 1024) : xp + (size_t)row * 1024;
#pragma unroll
                for (int j = 0; j < 4; ++j) v[r][j] = ((const f32x4*)xr)[lane + 64 * j];
                if (MODE == 2) {
#pragma unroll
                    for (int j = 0; j < 4; ++j) { const u32x2 w = *(const u32x2*)(dadd + (size_t)row * 1024 + 4 * (lane + 64 * j));
                        v[r][j] += (f32x4){bf2f(w.x & 0xffffu), bf2f(w.x >> 16), bf2f(w.y & 0xffffu), bf2f(w.y >> 16)}; } } } }
#pragma unroll
        for (int r = 0; r < 4; ++r) { const int row = base + r * NGW;
            if (row < MROWS) {
                float s = 0.f;
#pragma unroll
                for (int j = 0; j < 4; ++j) s += (v[r][j][0] * v[r][j][0] + v[r][j][1] * v[r][j][1]) + (v[r][j][2] * v[r][j][2] + v[r][j][3] * v[r][j][3]);
                const float rstd = rsqrtf(wave_sum(s) * (1.0f / 1024.0f) + EPS);
#pragma unroll
                for (int j = 0; j < 4; ++j) { const int col = 4 * (lane + 64 * j);
                    f32x4 gm = gmP[j], sh = shP[j];
                    if (MODE != 2 && row >= SEQ) { const float* ad = ada + (size_t)(row - SEQ) * NADA; gm = *(const f32x4*)(gvec + col) * (*(const f32x4*)(ad + scoff + col) + 1.0f); sh = *(const f32x4*)(ad + shoff + col); }
                    const f32x4 o = v[r][j] * rstd * gm + sh;
                    if (MODE == 2) *(f32x4*)(of + (size_t)row * 1024 + col) = o;
                    else { u32x2 w; w.x = cvt_pk_bf16(o[0], o[1]); w.y = cvt_pk_bf16(o[2], o[3]); *(u32x2*)(ob + (size_t)row * 1024 + col) = w; } }
            } }
    }
}
__device__ __forceinline__ void attn_prompt_unit(unsigned char* lds, bf16_t* Q, const bf16_t* KB, const bf16_t* VB, const float* sinks, int j, int g, int tid) {
    bf16_t* Ks = (bf16_t*)lds;
    bf16_t* Vt = (bf16_t*)(lds + 36864);
    bf16x8 qpre[2][4];
    {   const int wave_ = tid >> 6, ql_ = tid & 31, hi_ = (tid >> 5) & 1;
#pragma unroll
        for (int tt = 0; tt < 2; ++tt) { const int t = wave_ * 2 + tt, hq = t >> 2, qg = t & 3; const bf16_t* qp = Q + (size_t)(128 * j + 32 * qg + ql_) * 1024 + (4 * g + hq) * 64;
#pragma unroll
            for (int d0 = 0; d0 < 4; ++d0) qpre[tt][d0] = *(const bf16x8*)(qp + 16 * d0 + 8 * hi_); } }
    for (int c = tid; c < 2048; c += 512) {
        const int s = c >> 3, ch = c & 7; const int tok = 128 * (j - 1) + s;
        u32x4 kv = (u32x4){0u, 0u, 0u, 0u}, vv = (u32x4){0u, 0u, 0u, 0u};
        if (tok >= 0) { kv = *(const u32x4*)(KB + (size_t)tok * 256 + 64 * g + 8 * ch); vv = *(const u32x4*)(VB + (size_t)tok * 256 + 64 * g + 8 * ch); }
        *(u32x4*)(Ks + s * 72 + 8 * ch) = kv;
        bf16_t* vd = Vt + (8 * ch) * 264 + s;
        vd[0 * 264] = (bf16_t)(vv.x & 0xffffu); vd[1 * 264] = (bf16_t)(vv.x >> 16); vd[2 * 264] = (bf16_t)(vv.y & 0xffffu); vd[3 * 264] = (bf16_t)(vv.y >> 16);
        vd[4 * 264] = (bf16_t)(vv.z & 0xffffu); vd[5 * 264] = (bf16_t)(vv.z >> 16); vd[6 * 264] = (bf16_t)(vv.w & 0xffffu); vd[7 * 264] = (bf16_t)(vv.w >> 16);
    }
    __syncthreads();
    const int wave = tid >> 6, lane = tid & 63, ql = lane & 31, hi = lane >> 5;
#pragma unroll
    for (int tt = 0; tt < 2; ++tt) {
        const int t = wave * 2 + tt, hq = t >> 2, qg = t & 3, head = 4 * g + hq;
        bf16_t* qp = Q + (size_t)(128 * j + 32 * qg + ql) * 1024 + head * 64;
        bf16x8 qf[4];
#pragma unroll
        for (int d0 = 0; d0 < 4; ++d0) qf[d0] = qpre[tt][d0];
        f32x16 p[5];
#pragma unroll
        for (int kt = 0; kt < 5; ++kt) {
#pragma unroll
            for (int r = 0; r < 16; ++r) p[kt][r] = 0.f;
#pragma unroll
            for (int d0 = 0; d0 < 4; ++d0) { const bf16x8 kf = *(const bf16x8*)(Ks + (32 * qg + 32 * kt + ql) * 72 + 16 * d0 + 8 * hi);
                p[kt] = __builtin_amdgcn_mfma_f32_32x32x16_bf16(kf, qf[d0], p[kt], 0, 0, 0); }
        }
        const float sink = sinks[head];
        float mx = -INFINITY;
#pragma unroll
        for (int kt = 0; kt < 5; ++kt)
#pragma unroll
            for (int r = 0; r < 16; ++r) { const int kk = (r & 3) + 8 * (r >> 2) + 4 * hi; bool valid = true;
                if (kt == 0) valid = kk >= ql; if (kt == 4) valid = kk <= ql; if (j == 0) valid = valid && (32 * qg + 32 * kt + kk >= 128);
                const float v = valid ? p[kt][r] * 0.125f : -INFINITY; p[kt][r] = v; mx = fmaxf(mx, v); }
        mx = fmaxf(mx, __shfl_xor(mx, 32)); mx = fmaxf(mx, sink);
        float l = 0.f;
#pragma unroll
        for (int kt = 0; kt < 5; ++kt)
#pragma unroll
            for (int r = 0; r < 16; ++r) { const float e = __expf(p[kt][r] - mx); p[kt][r] = e; l += e; }
        l += __shfl_xor(l, 32);
        const float inv = 1.0f / (l + __expf(sink - mx));
        f32x16 o0, o1;
#pragma unroll
        for (int r = 0; r < 16; ++r) { o0[r] = 0.f; o1[r] = 0.f; }
#pragma unroll
        for (int kt = 0; kt < 5; ++kt)
#pragma unroll
            for (int hf = 0; hf < 2; ++hf) {
                u32x4 pw; pw.x = cvt_pk_bf16(p[kt][8 * hf + 0], p[kt][8 * hf + 1]); pw.y = cvt_pk_bf16(p[kt][8 * hf + 2], p[kt][8 * hf + 3]);
                pw.z = cvt_pk_bf16(p[kt][8 * hf + 4], p[kt][8 * hf + 5]); pw.w = cvt_pk_bf16(p[kt][8 * hf + 6], p[kt][8 * hf + 7]);
                const bf16x8 pf = __builtin_bit_cast(bf16x8, pw);
                const int sk = 32 * qg + 32 * kt + 16 * hf + 4 * hi;
                { const bf16_t* vp = Vt + ql * 264 + sk; const u32x2 a = *(const u32x2*)vp, b = *(const u32x2*)(vp + 8);
                  const bf16x8 vf = __builtin_bit_cast(bf16x8, ((u32x4){a.x, a.y, b.x, b.y})); o0 = __builtin_amdgcn_mfma_f32_32x32x16_bf16(vf, pf, o0, 0, 0, 0); }
                { const bf16_t* vp = Vt + (32 + ql) * 264 + sk; const u32x2 a = *(const u32x2*)vp, b = *(const u32x2*)(vp + 8);
                  const bf16x8 vf = __builtin_bit_cast(bf16x8, ((u32x4){a.x, a.y, b.x, b.y})); o1 = __builtin_amdgcn_mfma_f32_32x32x16_bf16(vf, pf, o1, 0, 0, 0); }
            }
#pragma unroll
        for (int c4 = 0; c4 < 4; ++c4) {
            u32x2 w0, w1;
            w0.x = cvt_pk_bf16(o0[4 * c4 + 0] * inv, o0[4 * c4 + 1] * inv); w0.y = cvt_pk_bf16(o0[4 * c4 + 2] * inv, o0[4 * c4 + 3] * inv);
            w1.x = cvt_pk_bf16(o1[4 * c4 + 0] * inv, o1[4 * c4 + 1] * inv); w1.y = cvt_pk_bf16(o1[4 * c4 + 2] * inv, o1[4 * c4 + 3] * inv);
            *(u32x2*)(qp + 8 * c4 + 4 * hi) = w0; *(u32x2*)(qp + 32 + 8 * c4 + 4 * hi) = w1;
        }
    }
    __syncthreads();
}
__device__ __forceinline__ void attn_sample_task(float* wl, bf16_t* Q, const bf16_t* KB, const bf16_t* VB, const float* ck, const float* cv, const float* sinks, int b, int g, int lane) {
    float* qs = wl; float* pp = wl + 256;
    bf16_t* qrow = Q + (size_t)(SEQ + b) * 1024 + 4 * g * 64;
#pragma unroll
    for (int h = 0; h < 4; ++h) qs[h * 64 + lane] = bf2f(qrow[h * 64 + lane]) * 0.125f;
    const float knew = bf2f(KB[(size_t)(SEQ + b) * 256 + 64 * g + lane]), vnew = bf2f(VB[(size_t)(SEQ + b) * 256 + 64 * g + lane]);
    asm volatile("s_waitcnt lgkmcnt(0)" ::: "memory");
    float sc[2][4];
#pragma unroll
    for (int kk = 0; kk < 2; ++kk) { const int s = lane + 64 * kk; const f32x4* kp = (const f32x4*)(ck + ((size_t)(b * 128 + s) * 4 + g) * 64);
        float a0 = 0.f, a1 = 0.f, a2 = 0.f, a3 = 0.f;
#pragma unroll 4
        for (int c = 0; c < 16; ++c) { const f32x4 kv = kp[c];
            const f32x4 q0 = *(const f32x4*)(qs + 4 * c), q1 = *(const f32x4*)(qs + 64 + 4 * c), q2 = *(const f32x4*)(qs + 128 + 4 * c), q3 = *(const f32x4*)(qs + 192 + 4 * c);
            a0 += kv[0] * q0[0] + kv[1] * q0[1] + kv[2] * q0[2] + kv[3] * q0[3]; a1 += kv[0] * q1[0] + kv[1] * q1[1] + kv[2] * q1[2] + kv[3] * q1[3];
            a2 += kv[0] * q2[0] + kv[1] * q2[1] + kv[2] * q2[2] + kv[3] * q2[3]; a3 += kv[0] * q3[0] + kv[1] * q3[1] + kv[2] * q3[2] + kv[3] * q3[3]; }
        sc[kk][0] = a0; sc[kk][1] = a1; sc[kk][2] = a2; sc[kk][3] = a3; }
#pragma unroll
    for (int h = 0; h < 4; ++h) {
        const float sn = wave_sum(qs[h * 64 + lane] * knew), sink = sinks[4 * g + h];
        float m = wave_max(fmaxf(sc[0][h], sc[1][h])); m = fmaxf(fmaxf(m, sn), sink);
        const float e0 = __expf(sc[0][h] - m), e1 = __expf(sc[1][h] - m), en = __expf(sn - m);
        const float inv = 1.0f / (wave_sum(e0 + e1) + en + __expf(sink - m));
        pp[lane * 4 + h] = e0 * inv; pp[(64 + lane) * 4 + h] = e1 * inv; if (lane == 0) pp[512 + h] = en * inv;
    }
    asm volatile("s_waitcnt lgkmcnt(0)" ::: "memory");
    float o0 = 0.f, o1 = 0.f, o2 = 0.f, o3 = 0.f;
    const float* vp = cv + ((size_t)(b * 128) * 4 + g) * 64 + lane;
#pragma unroll 8
    for (int s = 0; s < 128; ++s) { const float v = vp[(size_t)s * 256]; const f32x4 pv = *(const f32x4*)(pp + 4 * s); o0 += pv[0] * v; o1 += pv[1] * v; o2 += pv[2] * v; o3 += pv[3] * v; }
    { const f32x4 pv = *(const f32x4*)(pp + 512); o0 += pv[0] * vnew; o1 += pv[1] * vnew; o2 += pv[2] * vnew; o3 += pv[3] * vnew; }
    qrow[lane] = (bf16_t)(cvt_pk_bf16(o0, 0.f) & 0xffffu); qrow[64 + lane] = (bf16_t)(cvt_pk_bf16(o1, 0.f) & 0xffffu);
    qrow[128 + lane] = (bf16_t)(cvt_pk_bf16(o2, 0.f) & 0xffffu); qrow[192 + lane] = (bf16_t)(cvt_pk_bf16(o3, 0.f) & 0xffffu);
    asm volatile("s_waitcnt lgkmcnt(0)" ::: "memory");
}


#if SELFCHECK
constexpr size_t WS_CHK = 512 * 1024;
__device__ __forceinline__ unsigned hsh(unsigned x) { x ^= x >> 16; x *= 0x7feb352du; x ^= x >> 15; x *= 0x846ca68bu; x ^= x >> 16; return x; }
__device__ __forceinline__ int samp_row(int s) {
    if ((s & 3) == 0) { switch ((s >> 2) & 7) { case 0: return 0; case 1: return 1; case 2: return 255; case 3: return 256; case 4: return SEQ - 1; case 5: return SEQ; case 6: return SEQ + 100; default: return 8191; } }
    if ((s & 3) == 1) return SEQ + (int)(hsh(s) % NS);
    return (int)(hsh(s * 3 + 1) % SEQ);
}
__device__ __forceinline__ bool chk_bad(float got, float ref) { return !(fabsf(got - ref) <= 0.05f * fabsf(ref) + 0.04f); }
__device__ __forceinline__ float wdot_bf(const bf16_t* a, const float* W, int ldw, int col, int K, int lane) {
    float s = 0.f; for (int k = lane; k < K; k += 64) s += bf2f(a[k]) * W[(size_t)k * ldw + col]; return wave_sum(s); }
#define CHK_FAIL(bit) do { if (lane == 0) atomicOr(mask, 1u << (bit)); } while (0)
#endif

template <int KLEN>
__device__ __forceinline__ f32x4 mini_kloop(const bf16_t* Arow, const bf16_t* Brow, f32x4 acc) {
    constexpr int NS_ = KLEN / 32;
    static_assert(KLEN % 32 == 0, "K quarter");
#pragma unroll 1
    for (int s0 = 0; s0 < NS_; s0 += 8) {
        bf16x8 a[8], b[8];
#pragma unroll
        for (int i = 0; i < 8; ++i) if (s0 + i < NS_) { a[i] = *(const bf16x8*)(Arow + (s0 + i) * 32); b[i] = *(const bf16x8*)(Brow + (s0 + i) * 32); }
#pragma unroll
        for (int i = 0; i < 8; ++i) if (s0 + i < NS_) acc = __builtin_amdgcn_mfma_f32_16x16x32_bf16(b[i], a[i], acc, 0, 0, 0);
    }
    return acc;
}
struct MiniArgs { const bf16_t* A0; const bf16_t* B0; const bf16_t* A1; const bf16_t* B1; const bf16_t* GA; const bf16_t* GB; bf16_t* Z; const float* base; float* out; const float* ADA; int goff; };
template <int MODE, int K>
__device__ __forceinline__ void mini_sample_gemm(unsigned char* lds, const MiniArgs& P, int bid, int G, int wave, int lane) {
    const int fr = lane & 15, fq = lane >> 4, tl = wave >> 2, kq = wave & 3;
    f32x4* red = (f32x4*)lds;
    for (int T0 = 2 * bid; T0 < 512; T0 += 2 * G) {
        const int T = T0 + tl, rt = T & 7, ct = T >> 3;
        const int row = SEQ + 16 * rt + fr, colb = 16 * ct + fr;
        const size_t ko = (size_t)kq * (K / 4) + 8 * fq;
        f32x4 acc0 = (f32x4){0.f, 0.f, 0.f, 0.f}, acc1 = acc0;
        acc0 = mini_kloop<K / 4>(P.A0 + (size_t)row * K + ko, P.B0 + (size_t)colb * K + ko, acc0);
        if (MODE == 0) acc1 = mini_kloop<K / 4>(P.A1 + (size_t)row * K + ko, P.B1 + (size_t)colb * K + ko, acc1);
        red[wave * 64 + lane] = acc0; if (MODE == 0) red[512 + wave * 64 + lane] = acc1;
        __syncthreads();
        if (kq == 0) {
            f32x4 s0 = red[wave * 64 + lane] + red[(wave + 1) * 64 + lane] + red[(wave + 2) * 64 + lane] + red[(wave + 3) * 64 + lane];
            const int col = 16 * ct + 4 * fq;
            if (MODE == 0) {
                const f32x4 s1 = red[512 + wave * 64 + lane] + red[512 + (wave + 1) * 64 + lane] + red[512 + (wave + 2) * 64 + lane] + red[512 + (wave + 3) * 64 + lane];
                const u32x2 ga = *(const u32x2*)(P.GA + (size_t)row * 1024 + col), gb = *(const u32x2*)(P.GB + (size_t)row * 1024 + col);
                const float z0 = sigmoidf_(bf2f(ga.x & 0xffffu)) * s0[0] + sigmoidf_(bf2f(gb.x & 0xffffu)) * s1[0], z1 = sigmoidf_(bf2f(ga.x >> 16)) * s0[1] + sigmoidf_(bf2f(gb.x >> 16)) * s1[1];
                const float z2 = sigmoidf_(bf2f(ga.y & 0xffffu)) * s0[2] + sigmoidf_(bf2f(gb.y & 0xffffu)) * s1[2], z3 = sigmoidf_(bf2f(ga.y >> 16)) * s0[3] + sigmoidf_(bf2f(gb.y >> 16)) * s1[3];
                u32x2 w; w.x = cvt_pk_bf16(z0, z1); w.y = cvt_pk_bf16(z2, z3); *(u32x2*)(P.Z + (size_t)row * 1024 + col) = w;
            } else if (MODE == 2) {
                const int b = row - SEQ; const f32x4 g = *(const f32x4*)(P.ADA + (size_t)b * NADA + P.goff + col); const f32x4 d = g * s0;
                u32x2 w; w.x = cvt_pk_bf16(d[0], d[1]); w.y = cvt_pk_bf16(d[2], d[3]); *(u32x2*)(P.Z + (size_t)row * 1024 + col) = w;
            } else {
                const int b = row - SEQ;
                const f32x4 bs = *(const f32x4*)(P.base + (size_t)b * 1024 + col), g = *(const f32x4*)(P.ADA + (size_t)b * NADA + P.goff + col);
                *(f32x4*)(P.out + (size_t)row * 1024 + col) = bs + g * s0;
            }
        }
        __syncthreads();
    }
}

__device__ __forceinline__ void ada_block(unsigned char* lds, const float* cs, const float* cp, const float* W, const float* bias, float* ADAo, int pair, int wave, int lane) {
    const int fr = lane & 15, fq = lane >> 4, tl = wave >> 2, kq = wave & 3, c0 = 16 * (2 * pair + tl);
    f32x4 acc[9];
#pragma unroll
    for (int rt = 0; rt < 9; ++rt) acc[rt] = (f32x4){0.f, 0.f, 0.f, 0.f};
#pragma unroll 1
    for (int ks = 0; ks < 8; ++ks) {
        const int k0 = 256 * kq + 32 * ks + 8 * fq;
        float wv[8];
#pragma unroll
        for (int j = 0; j < 8; ++j) wv[j] = W[(size_t)(k0 + j) * NADA + c0 + fr];
        f32x4 a0[9], a1[9];
#pragma unroll
        for (int rt = 0; rt < 9; ++rt) { const int row = 16 * rt + fr; const float* cr = (row < 128) ? cs + (size_t)row * 1024 : cp;
            a0[rt] = *(const f32x4*)(cr + k0); a1[rt] = *(const f32x4*)(cr + k0 + 4); }
        u32x4 bw; bw.x = cvt_pk_bf16(wv[0], wv[1]); bw.y = cvt_pk_bf16(wv[2], wv[3]); bw.z = cvt_pk_bf16(wv[4], wv[5]); bw.w = cvt_pk_bf16(wv[6], wv[7]);
        const bf16x8 bfrag = __builtin_bit_cast(bf16x8, bw);
#pragma unroll
        for (int rt = 0; rt < 9; ++rt) { const bool ok = (16 * rt + fr) <= 128;
            u32x4 aw; aw.x = cvt_pk_bf16(siluf_(a0[rt][0]), siluf_(a0[rt][1])); aw.y = cvt_pk_bf16(siluf_(a0[rt][2]), siluf_(a0[rt][3]));
            aw.z = cvt_pk_bf16(siluf_(a1[rt][0]), siluf_(a1[rt][1])); aw.w = cvt_pk_bf16(siluf_(a1[rt][2]), siluf_(a1[rt][3]));
            if (!ok) aw = (u32x4){0u, 0u, 0u, 0u};
            acc[rt] = __builtin_amdgcn_mfma_f32_16x16x32_bf16(bfrag, __builtin_bit_cast(bf16x8, aw), acc[rt], 0, 0, 0); }
    }
    f32x4* red = (f32x4*)lds;
#pragma unroll
    for (int rt = 0; rt < 9; ++rt) red[(wave * 9 + rt) * 64 + lane] = acc[rt];
    __syncthreads();
    if (kq == 0) {
        const f32x4 bv = *(const f32x4*)(bias + c0 + 4 * fq);
#pragma unroll
        for (int rt = 0; rt < 9; ++rt) { const int row = 16 * rt + fr;
            const f32x4 sum = red[(wave * 9 + rt) * 64 + lane] + red[((wave + 1) * 9 + rt) * 64 + lane] + red[((wave + 2) * 9 + rt) * 64 + lane] + red[((wave + 3) * 9 + rt) * 64 + lane];
            if (row <= 128) *(f32x4*)(ADAo + (size_t)row * NADA + c0 + 4 * fq) = sum + bv; }
    }
    __syncthreads();
}

#define LAS __attribute__((address_space(3)))
#define XB_TMO      128
#define XB_XCNT(j)  (256  + 64 * (j))
#define XB_XSUB(j)  (1280 + 64 * (j))
#define XB_XGEN(j)  (2304 + 64 * (j))
#define XB_TOP      3328
#define XB_TOPGEN   3392
#define XCD_BAR_WORDS 3456
#define XB_SPIN_CAP (1u << 22)
constexpr size_t WS_BAR = 64 * 1024;
constexpr int MISC_OFF = 146432;
constexpr size_t WS_SS = 768 * 1024;
constexpr size_t WS_C0 = WS_BAR + 16384;
constexpr size_t BAR_ZERO_BYTES = (WS_C0 - WS_BAR) + 22528;
__device__ __forceinline__ unsigned xb_ld(unsigned* p)              { return __hip_atomic_load(p, __ATOMIC_RELAXED, __HIP_MEMORY_SCOPE_AGENT); }
__device__ __forceinline__ unsigned xb_add(unsigned* p, unsigned v) { return __hip_atomic_fetch_add(p, v, __ATOMIC_RELAXED, __HIP_MEMORY_SCOPE_AGENT); }
__device__ __forceinline__ unsigned xb_xcc_id() { return (unsigned)__builtin_amdgcn_s_getreg((3 << 11) | 20) & 0xFu; }
#define XB_SPIN(cond, bar) do { unsigned _sp = 0; while (cond) { __builtin_amdgcn_s_sleep(1); \
    if ((++_sp & 255u) == 0u) { if (xb_ld(&(bar)[XB_TMO])) break; if (_sp > XB_SPIN_CAP) { atomicAdd(&(bar)[XB_TMO], 1u); break; } } } } while (0)
struct XcdBarrier { unsigned* bar; unsigned x; volatile LAS unsigned* st; };
__device__ __forceinline__ XcdBarrier xcd_barrier_post(unsigned* bar, volatile LAS unsigned* st, bool leader) {
    XcdBarrier b; b.bar = bar; b.x = xb_xcc_id(); b.st = st;
    if (leader) (void)xb_add(&bar[XB_XCNT(b.x)], 1u);
    return b;
}
__device__ __forceinline__ void xcd_barrier_complete(unsigned* bar, unsigned x, unsigned& nloc, unsigned& nx) {
    const unsigned G = gridDim.x * gridDim.y * gridDim.z;
    unsigned sum, cnt, mine, sp = 0u;
    for (;;) {
        sum = 0u; cnt = 0u; mine = 0u;
#pragma unroll
        for (unsigned j = 0; j < 16; ++j) { const unsigned c = xb_ld(&bar[XB_XCNT(j)]); sum += c; cnt += (c > 0u) ? 1u : 0u; mine = (j == x) ? c : mine; }
        if (sum == G) break;
        __builtin_amdgcn_s_sleep(1);
        if ((++sp & 255u) == 0u) { if (xb_ld(&bar[XB_TMO])) break; if (sp > XB_SPIN_CAP) { atomicAdd(&bar[XB_TMO], 1u); break; } }
    }
    nloc = mine > 0u ? mine : 1u; nx = cnt > 0u ? cnt : 1u;
}
__device__ __forceinline__ void xcd_barrier_core(const XcdBarrier& b, bool leader) {
    if (leader) {
        unsigned* bar = b.bar;
        __builtin_amdgcn_s_waitcnt(0);
        unsigned nloc = b.st[0], nx = b.st[1];
        if (nloc == 0u) { xcd_barrier_complete(bar, b.x, nloc, nx); b.st[0] = nloc; b.st[1] = nx; }
        const unsigned old = xb_add(&bar[XB_XSUB(b.x)], 1u);
        const unsigned gen = old / nloc;
        if (old + 1u == (gen + 1u) * nloc) {
            __builtin_amdgcn_fence(__ATOMIC_RELEASE, "agent");
            asm volatile("s_waitcnt vmcnt(0)" ::: "memory");
            const unsigned og = xb_add(&bar[XB_TOP], 1u);
            const unsigned tg = og / nx;
            if (og + 1u == (tg + 1u) * nx) xb_add(&bar[XB_TOPGEN], 1u);
            else XB_SPIN(xb_ld(&bar[XB_TOPGEN]) == tg, bar);
            __builtin_amdgcn_fence(__ATOMIC_ACQUIRE, "agent");
            xb_add(&bar[XB_XGEN(b.x)], 1u);
            asm volatile("s_waitcnt vmcnt(0)" ::: "memory");
        } else {
            XB_SPIN(xb_ld(&bar[XB_XGEN(b.x)]) == gen, bar);
            __builtin_amdgcn_fence(__ATOMIC_ACQUIRE, "agent");
            asm volatile("s_waitcnt vmcnt(0)" ::: "memory");
        }
    }
}
struct Args { const float* in[23]; float* out; unsigned char* ws; };
enum { I_XP = 0, I_XS, I_CP, I_CS, I_SCA, I_CK, I_CV, I_SFF, I_WADA, I_BADA, I_GMIX, I_WIN, I_CAW, I_SINK, I_WAO, I_WBO, I_WO, I_GFFN, I_WUP, I_FCW, I_FCB, I_WDN, I_GFIN };

typedef const __attribute__((address_space(4))) Args* KArgsP;
__device__ __forceinline__ void shadow_work(KArgsP ap, unsigned nb, int w7, int bid, int G, int lane, unsigned char* lds) {
    const int sw = bid * 7 + w7, NSW = G * 7;
    float* scr = (float*)(lds + (w7 + 1) * 16384);
    unsigned char* ws = ap->ws;
    if (nb == 1u) {
        for (int it = sw; it < 16 * (NIN / 32); it += NSW) { const int nbk = NIN / 32, kb = it / nbk, n0 = 32 * (it % nbk);
            transpose_item(ap->in[I_WIN], 1024, NIN, (bf16_t*)(ws + WS_WIN), 64 * kb, n0, win_drow(n0), scr, lane); }
    } else if (nb == 2u || nb == 3u) {
        constexpr int I_UPS = 16 * (FF2 / 32), SPLIT_ = 1024;
        if (nb == 2u) for (int r = sw; r < 3 * 512; r += NSW) { const int which = r / 512, q = r % 512, kb = q / 32, n0 = 32 * (q % 32);
            transpose_item(ap->in[which == 0 ? I_WAO : (which == 1 ? I_WBO : I_WO)], 1024, 1024, (bf16_t*)(ws + (which == 0 ? WS_WA : (which == 1 ? WS_WB : WS_WO))), 64 * kb, n0, n0, scr, lane); }
        for (int it = (nb == 2u ? 0 : SPLIT_) + sw; it < (nb == 2u ? SPLIT_ : I_UPS); it += NSW) { const int nbk = FF2 / 32, kb = it / nbk, n0 = 32 * (it % nbk);
            transpose_item(ap->in[I_WUP], 1024, FF2, (bf16_t*)(ws + WS_WUP), 64 * kb, n0, wup_drow(n0), scr, lane); }
        if (nb == 2u)
            for (int t = sw; t < 88 * 16; t += NSW) { const int cgp = t % 88, ks = t / 88, col = 64 * cgp + lane;
                const float* Wp = ap->in[I_WUP] + (size_t)(64 * ks) * FF2 + col; const float* sh = (const float*)(ws + WS_ADA) + (size_t)128 * NADA + 3072 + 64 * ks;
                float a = 0.f;
#pragma unroll 16
                for (int k = 0; k < 64; ++k) a += sh[k] * Wp[(size_t)k * FF2];
                (void)__hip_atomic_fetch_add((float*)(ws + WS_C0) + col, a, __ATOMIC_RELAXED, __HIP_MEMORY_SCOPE_AGENT); }
    } else if (nb == 4u) {
        for (int it = sw; it < (FF / 64) * 32; it += NSW) { const int kb = it / 32, n0 = 32 * (it % 32); transpose_item(ap->in[I_WDN], FF, 1024, (bf16_t*)(ws + WS_WDN), 64 * kb, n0, n0, scr, lane); }
    }
    if (nb == 4u || nb == 5u) {
        const float* ck_ = ap->in[I_CK]; const float* cv_ = ap->in[I_CV]; const bf16_t* kb_ = (const bf16_t*)(ws + WS_KB); const bf16_t* vb_ = (const bf16_t*)(ws + WS_VB); float* out = ap->out;
        const long st = (long)sw * 64 + lane, NST = (long)NSW * 64; const long lo = (nb == 4u) ? 0 : 1048576, hi = lo + 1048576;
#pragma unroll 4
        for (long i = lo + st; i < hi; i += NST) {
            const int which = (int)(i >> 20); const int r2 = (int)(i & 1048575); const int b = r2 >> 13, r = (r2 >> 6) & 127, c = r2 & 63;
            const float* cache = which ? cv_ : ck_; const bf16_t* nbp = which ? vb_ : kb_;
            f32x4 v;
            if (r < 127) v = *(const f32x4*)(cache + ((size_t)(b * 128 + r + 1) * 256 + 4 * c));
            else { const u32x2 w = *(const u32x2*)(nbp + (size_t)(SEQ + b) * 256 + 4 * c); v = (f32x4){bf2f(w.x & 0xffffu), bf2f(w.x >> 16), bf2f(w.y & 0xffffu), bf2f(w.y >> 16)}; }
            *(f32x4*)(out + (which ? O_VS : O_KS) + (size_t)r2 * 4) = v;
        }
        if (nb == 4u) for (long i = st; i < 2L * 128 * 64; i += NST) {
            const int which = (int)(i >> 13); const int r2 = (int)(i & 8191); const int r = r2 >> 6, c = r2 & 63; const bf16_t* nbp = which ? vb_ : kb_;
            const u32x2 w = *(const u32x2*)(nbp + (size_t)(SEQ - 128 + r) * 256 + 4 * c);
            *(f32x4*)(out + (which ? O_VP : O_KP) + (size_t)r2 * 4) = (f32x4){bf2f(w.x & 0xffffu), bf2f(w.x >> 16), bf2f(w.y & 0xffffu), bf2f(w.y >> 16)};
        }
    }
}

__global__ void __launch_bounds__(512, 2) mega(Args a) {
    extern __shared__ __attribute__((aligned(16))) unsigned char lds[];
    PG8_LAS unsigned char* ldsl = (PG8_LAS unsigned char*)lds;
    const int G = gridDim.x, bid = blockIdx.x, NGW = G * 8;
    const int wave0 = __builtin_amdgcn_readfirstlane((int)threadIdx.x >> 6);
    const long NGT = (long)G * 512;
#define PHASE_IDS() int tid = wave0 * 64 + (int)lane_id_now(); asm volatile("" : "+v"(tid)); const int lane = tid & 63, wave = wave0; \
    const int gw = bid * 8 + wave; const long gt = (long)bid * 512 + tid; float* const scr = (float*)(lds + wave * 16384); (void)lane; (void)gw; (void)gt; (void)scr;
    typedef const __attribute__((address_space(4))) Args* KArgs;
    const KArgs ap0 = (KArgs)__builtin_amdgcn_kernarg_segment_ptr();
#define ARGS() ({ KArgs p_ = ap0; asm volatile("" : "+s"(p_)); p_; })
#define IN(i) (ARGS()->in[i])
#define WS(off) (ARGS()->ws + (off))
#define OUT() (ARGS()->out)
#define AADA ((bf16_t*)WS(WS_AADA))
#define ADA ((float*)WS(WS_ADA))
#define WA ((bf16_t*)WS(WS_WA))
#define WB ((bf16_t*)WS(WS_WB))
#define WO ((bf16_t*)WS(WS_WO))
#define WADA ((bf16_t*)WS(WS_WADA))
#define WIN ((bf16_t*)WS(WS_WIN))
#define WUP ((bf16_t*)WS(WS_WUP))
#define WDN ((bf16_t*)WS(WS_WDN))
#define H ((bf16_t*)WS(WS_H))
#define U ((bf16_t*)WS(WS_U))
#define BG ((bf16_t*)WS(WS_BG))
#define Q ((bf16_t*)WS(WS_Q))
#define KB ((bf16_t*)WS(WS_KB))
#define VB ((bf16_t*)WS(WS_VB))
#define GA ((bf16_t*)WS(WS_GA))
#define GB ((bf16_t*)WS(WS_GB))
#define GG ((bf16_t*)WS(WS_G))
#define AIN H
#define Z U
#define H2 BG
    if (gridDim.x == 0x7fffffffu) cg::this_grid().sync();
    if (threadIdx.x < 2) ((volatile LAS unsigned*)(ldsl + MISC_OFF))[threadIdx.x] = 0u;
    __syncthreads();
#define LEADER() (wave0 == 0 && lane_id_now() == 0u)
    const XcdBarrier xbar = xcd_barrier_post((unsigned*)WS(WS_BAR), (volatile LAS unsigned*)(ldsl + MISC_OFF), LEADER());
    unsigned nbar_ = 0u;
#define GRID_SYNC() do { ++nbar_; asm volatile("s_waitcnt vmcnt(0)" ::: "memory"); __syncthreads(); \
        if (wave0 == 0) xcd_barrier_core(xbar, LEADER()); else shadow_work((KArgsP)ap0, nbar_, wave0 - 1, bid, G, (int)lane_id_now(), lds); \
        __syncthreads(); } while (0)

#if TIMESEL >= 0
#define STAMP(k) do { if (bid == 0 && threadIdx.x == 0) ((unsigned long long*)WS(768 * 1024))[k] = __builtin_amdgcn_s_memrealtime(); } while (0)
#else
#define STAMP(k) do {} while (0)
#endif
    STAMP(0);
    {
        PHASE_IDS();
        {   const float* const cs = IN(I_CS); const float* const cp = IN(I_CP); const float* const wad = IN(I_WADA); const float* const bad = IN(I_BADA); float* const ada = ADA;
            for (int pr = bid; pr < NADA / 32; pr += G) ada_block(lds, cs, cp, wad, bad, ada, pr, wave, lane); }
    }
    GRID_SYNC();
    STAMP(1);
    STAMP(2);
    {
        PHASE_IDS();
        norm_phase<0>(IN(I_XP), IN(I_XS), IN(I_GMIX), ADA, 1024, 0, H, nullptr, gw, NGW, lane);
    }
    GRID_SYNC();
    STAMP(3);
    {
        typedef Sched<0, 2048, 2048> SC; SC S; S.to.init(NMT, NIN / 256); S.G = G; S.c = bid; S.A0 = (const char*)H; S.B0 = (const char*)WIN;
        EpiProj E{U, BG, Q, KB, VB, GA, GB};
        pg8::gemm_phase<EpiProj, SC, 1024, 1024, 1024, true, true>(ldsl, wave0, S, E);
    }
    GRID_SYNC();
    STAMP(4);
    {
        PHASE_IDS();
        {   bf16_t* const q_ = Q; const bf16_t* const kb_ = KB; const bf16_t* const vb_ = VB; const float* const sinks = IN(I_SINK);
            for (int un = bid; un < 512; un += G) attn_prompt_unit(lds, q_, kb_, vb_, sinks, un >> 2, un & 3, tid); }
        {   bf16_t* const q_ = Q; const bf16_t* const kb_ = KB; const bf16_t* const vb_ = VB; const float* const sinks = IN(I_SINK);
            const float* const ck_ = IN(I_CK); const float* const cv_ = IN(I_CV);
            float* wl = (float*)(lds + 123392 + (wave >> 2) * 4096);
            for (int t4 = gw; t4 < 2048; t4 += NGW) if ((t4 & 3) == 0) { const int t = t4 >> 2; attn_sample_task(wl, q_, kb_, vb_, ck_, cv_, sinks, t >> 2, t & 3, lane); } }
        const bool worker = (wave & 3) != 0; const long wt = ((long)bid * 6 + (wave - 1 - (wave > 4 ? 1 : 0))) * 64 + lane, NWT = (long)G * 6 * 64;
        {
        float* const out = OUT();
        const float* caw = IN(I_CAW); const float* sca = IN(I_SCA); const bf16_t* const u_ = U; const bf16_t* const bg_ = BG; bf16_t* const ain_ = AIN;
        if (worker)
        for (long it = wt; it < (long)(SEQ / 8) * 128 + (long)NS * 128; it += NWT) {
            const bool smp = it >= (long)(SEQ / 8) * 128; const long it2 = smp ? it - (long)(SEQ / 8) * 128 : it;
            const int row0 = smp ? SEQ + (int)(it2 >> 7) : (int)(it2 >> 7) * 8, c8 = (int)(it2 & 127) * 8; const int nr = smp ? 1 : 8;
            float w0[8], w1[8], w2[8], u0[8], u1[8];
            *(f32x4*)w0 = *(const f32x4*)(caw + c8); *(f32x4*)(w0 + 4) = *(const f32x4*)(caw + c8 + 4);
            *(f32x4*)w1 = *(const f32x4*)(caw + 1024 + c8); *(f32x4*)(w1 + 4) = *(const f32x4*)(caw + 1024 + c8 + 4);
            *(f32x4*)w2 = *(const f32x4*)(caw + 2048 + c8); *(f32x4*)(w2 + 4) = *(const f32x4*)(caw + 2048 + c8 + 4);
            if (row0 < SEQ) {
                if (row0 >= 2) { unpack8(*(const u32x4*)(u_ + (size_t)(row0 - 2) * 1024 + c8), u0); unpack8(*(const u32x4*)(u_ + (size_t)(row0 - 1) * 1024 + c8), u1); }
                else { for (int i = 0; i < 8; ++i) { u0[i] = 0.f; u1[i] = 0.f; } }
#pragma unroll 4
                for (int r = 0; r < 8; ++r) { const int row = row0 + r; float u2[8], bg[8], o[8];
                    unpack8(*(const u32x4*)(u_ + (size_t)row * 1024 + c8), u2); unpack8(*(const u32x4*)(bg_ + (size_t)row * 1024 + c8), bg);
#pragma unroll
                    for (int i = 0; i < 8; ++i) { o[i] = bg[i] * (w0[i] * u0[i] + w1[i] * u1[i] + w2[i] * u2[i]); u0[i] = u1[i]; u1[i] = u2[i]; }
                    *(u32x4*)(ain_ + (size_t)row * 1024 + c8) = pack8(o);
                    if (row >= SEQ - 2) { float* op = out + O_CAP + (size_t)(row - (SEQ - 2)) * 1024 + c8; *(f32x4*)op = (f32x4){u2[0], u2[1], u2[2], u2[3]}; *(f32x4*)(op + 4) = (f32x4){u2[4], u2[5], u2[6], u2[7]}; } }
            } else {
                for (int r = 0; r < nr; ++r) { const int row = row0 + r, b = row - SEQ; float u2[8], bg[8], o[8];
                    const float* s0 = sca + (size_t)(b * 2) * 1024 + c8; const float* s1 = s0 + 1024;
                    *(f32x4*)u0 = *(const f32x4*)s0; *(f32x4*)(u0 + 4) = *(const f32x4*)(s0 + 4); *(f32x4*)u1 = *(const f32x4*)s1; *(f32x4*)(u1 + 4) = *(const f32x4*)(s1 + 4);
                    unpack8(*(const u32x4*)(u_ + (size_t)row * 1024 + c8), u2); unpack8(*(const u32x4*)(bg_ + (size_t)row * 1024 + c8), bg);
#pragma unroll
                    for (int i = 0; i < 8; ++i) o[i] = bg[i] * (w0[i] * u0[i] + w1[i] * u1[i] + w2[i] * u2[i]);
                    *(u32x4*)(ain_ + (size_t)row * 1024 + c8) = pack8(o);
                    float* op = out + O_CAS + (size_t)(b * 2) * 1024 + c8;
                    *(f32x4*)op = *(f32x4*)u1; *(f32x4*)(op + 4) = *(f32x4*)(u1 + 4); *(f32x4*)(op + 1024) = (f32x4){u2[0], u2[1], u2[2], u2[3]}; *(f32x4*)(op + 1024 + 4) = (f32x4){u2[4], u2[5], u2[6], u2[7]}; }
            }
        }
        }
    }
    GRID_SYNC();
    STAMP(5);
    {
        typedef Sched<1, 2048, 2048> SC; SC S; S.to.init(SEQ / 256, 4); S.G = G; S.c = bid; S.A0 = (const char*)AIN; S.B0 = (const char*)WA; S.A1 = (const char*)Q; S.B1 = (const char*)WB;
        EpiMix E{GA, GB, OUT(), Z};
        pg8::gemm_phase<EpiMix, SC, 1024, 1024, 1024, true, true>(ldsl, wave0, S, E);
        { PHASE_IDS(); MiniArgs P{AIN, WA, Q, WB, GA, GB, Z, nullptr, nullptr, nullptr, 0}; mini_sample_gemm<0, 1024>(lds, P, bid, G, wave, lane); }
    }
    GRID_SYNC();
    STAMP(6);
    {
        typedef Sched<0, 2048, 2048> SC; SC S; S.to.init(SEQ / 256, 4); S.G = G; S.c = bid; S.A0 = (const char*)Z; S.B0 = (const char*)WO;
        EpiRes4 E{IN(I_XP), OUT(), ADA, IN(I_GFFN), H2, (float*)WS(WS_SS)};
        pg8::gemm_phase<EpiRes4, SC, 1024, 1024, 1024, true, true>(ldsl, wave0, S, E);
        { PHASE_IDS(); if (gt < 256) *(u32x4*)((unsigned char*)H2 - 4096 + gt * 16) = (u32x4){0u, 0u, 0u, 0u}; }
        { PHASE_IDS(); MiniArgs P{Z, WO, nullptr, nullptr, nullptr, nullptr, nullptr, IN(I_XS), OUT(), ADA, 2048}; mini_sample_gemm<1, 1024>(lds, P, bid, G, wave, lane); }
    }
    GRID_SYNC();
    STAMP(8);
    {
        typedef Sched<2, 2048, 2048> SC; SC S; S.to.init(G >= 64 ? NPT5 : NPT5 + 1, FF2 / 256); S.G = G; S.c = bid; S.A0 = (const char*)H2; S.B0 = (const char*)WUP;
        {
            PHASE_IDS(); bool has = false; Unit u; for (int i = 0; S.next(i, u); ++i) has = has || (u.pm == NPT5);
            if (has) norm_phase<1>(OUT(), nullptr, IN(I_GFFN), ADA, 4096, 3072, H2, nullptr, SEQ + wave, 8, lane);
            asm volatile("s_waitcnt vmcnt(0)" ::: "memory"); __syncthreads(); }
        float* const out = OUT(); EpiFfn E{GG, IN(I_FCW), IN(I_FCB), IN(I_SFF), out + O_FP, out + O_FS, (PG8_LAS float*)(ldsl + HALO_OFF), (const float*)WS(WS_SS), (const float*)WS(WS_C0)};
        pg8::gemm_phase<EpiFfn, SC, 1024, 1024, 1024, true, true>(ldsl, wave0, S, E);
    }
    GRID_SYNC();
    STAMP(9);
    {
        typedef Sched<0, FF * 2, FF * 2> SC; SC S; S.to.init(SEQ / 256, 4); S.G = G; S.c = bid; S.A0 = (const char*)GG; S.B0 = (const char*)WDN;
        { EpiDelta E{Z, ADA, 5120};
        pg8::gemm_phase<EpiDelta, SC, FF, FF, FF, true, true>(ldsl, wave0, S, E); }
        { PHASE_IDS(); MiniArgs P{GG, WDN, nullptr, nullptr, nullptr, nullptr, Z, nullptr, nullptr, ADA, 5120}; mini_sample_gemm<2, FF>(lds, P, bid, G, wave, lane); }
    }
    GRID_SYNC();
    STAMP(10);
    {
        PHASE_IDS();
        float* const out = OUT();
        norm_phase<2>(out, nullptr, IN(I_GFIN), nullptr, 0, 0, nullptr, out, gw, NGW, lane, Z);
    }
#if TIMESEL >= 0
    GRID_SYNC();
    STAMP(11);
    GRID_SYNC();
    STAMP(12);
    GRID_SYNC();
    {   PHASE_IDS(); const volatile unsigned long long* ts = (const volatile unsigned long long*)WS(768 * 1024);
        const float us = (float)(ts[TIMESEL + TIMESPAN] - ts[TIMESEL]) * 0.01f;
        const float sc = 1.006f + us * 1e-5f; float* o = OUT() + O_KS;
        for (long i = gt; i < 128L * 128 * 256; i += NGT) o[i] *= sc; }
#endif
}

extern "C" void kernel_launch(void* const* d_in, const int* in_sizes, int n_in, void* d_out, int out_size, void* d_ws, size_t ws_size, hipStream_t stream) {
    static int grid = 0;
    if (grid == 0) {
        if (n_in != 23 || ws_size < WS_END) { fprintf(stderr, "kernel_launch: unexpected n_in %d / ws %zu\n", n_in, ws_size); grid = -1; return; }
        int dev = 0, cus = 0, per_cu = 0;
        hipGetDevice(&dev); hipDeviceGetAttribute(&cus, hipDeviceAttributeMultiprocessorCount, dev);
        if (hipFuncSetAttribute((const void*)mega, hipFuncAttributeMaxDynamicSharedMemorySize, LDS_BYTES) != hipSuccess) { fprintf(stderr, "kernel_launch: hipFuncSetAttribute failed\n"); }
        hipOccupancyMaxActiveBlocksPerMultiprocessor(&per_cu, (const void*)mega, 512, LDS_BYTES);
        (void)hipGetLastError();
        if (per_cu < 1) per_cu = 1;
        grid = cus * 1;
        if (grid <= 0) grid = 256;
    }
    if (grid < 0) return;
    Args a{};
    for (int i = 0; i < 23; ++i) a.in[i] = (const float*)d_in[i];
    a.out = (float*)d_out; a.ws = (unsigned char*)d_ws;
    (void)hipMemsetAsync((char*)d_ws + WS_BAR, 0, BAR_ZERO_BYTES, stream);
    void* args[] = {&a};
    hipError_t e = hipLaunchCooperativeKernel((const void*)mega, dim3(grid), dim3(512), args, LDS_BYTES, stream);
    if (e != hipSuccess) fprintf(stderr, "cooperative launch failed: %s (grid %d)\n", hipGetErrorString(e), grid);
}
```

```cpp
#ifndef SELFCHECK
#define SELFCHECK 0
#endif
#ifndef TIMESEL
#define TIMESEL -1
#define TIMESPAN 1
#endif
#ifndef TIMESPAN
#define TIMESPAN 1
#endif
#include <hip/hip_runtime.h>
#include <hip/hip_cooperative_groups.h>
#include <cstdio>
#include <cstdint>
namespace cg = cooperative_groups;

constexpr int D = 1024, SEQ = 16384, NS = 128, MROWS = SEQ + NS, MPAD = 16640;
constexpr int NIN = 6656, FF = 2816, FF2 = 5632, NADA = 6144;
constexpr int NMT = MPAD / 256;
constexpr int NPT5 = 65;
constexpr float EPS = 1e-6f;

constexpr size_t MiB = 1u << 20;
constexpr size_t RB = (size_t)MPAD * 1024 * 2;
constexpr size_t KBB = (size_t)MPAD * 256 * 2;
constexpr size_t WS_AADA = 1 * MiB;
constexpr size_t WS_ADA = 2 * MiB;
constexpr size_t WS_WA = 8 * MiB, WS_WB = 10 * MiB, WS_WO = 12 * MiB;
constexpr size_t WS_WADA = 14 * MiB;
constexpr size_t WS_WIN = 26 * MiB;
constexpr size_t WS_WUP = 14 * MiB;
constexpr size_t WS_WDN = 25 * MiB;
constexpr size_t WS_H = 39 * MiB;
constexpr size_t WS_U = 72 * MiB;
constexpr size_t WS_BG = 105 * MiB;
constexpr size_t WS_Q = 138 * MiB;
constexpr size_t WS_KB = WS_Q + RB, WS_VB = WS_KB + KBB, WS_GA = WS_VB + KBB, WS_GB = WS_GA + RB;
constexpr size_t WS_G = WS_Q;
constexpr size_t WS_END = WS_GB + RB;
static_assert(WS_END <= 256 * MiB, "ws map");
static_assert(WS_G + (size_t)MPAD * FF * 2 <= WS_END, "G overlay");
static_assert(WS_WDN + (size_t)1024 * FF * 2 <= WS_H && WS_WUP + (size_t)FF2 * 1024 * 2 <= WS_WDN, "weights");
static_assert(WS_U + RB + 4096 <= WS_BG && WS_H + RB <= WS_U && WS_BG + RB <= WS_Q, "row buffers");

constexpr size_t O_YP = 0, O_YS = 16777216, O_CAP = 16908288, O_CAS = 16910336, O_KP = 17172480, O_KS = 17205248,
                 O_VP = 21399552, O_VS = 21432320, O_FP = 25626624, O_FS = 25637888;

constexpr int LDS_BYTES = 147456;
constexpr int HALO_OFF = 131072;

typedef unsigned short bf16_t;
typedef short bf16x8 __attribute__((ext_vector_type(8)));
typedef float f32x4 __attribute__((ext_vector_type(4)));
typedef float f32x16 __attribute__((ext_vector_type(16)));
typedef float f32x2 __attribute__((ext_vector_type(2)));
typedef unsigned u32x4 __attribute__((ext_vector_type(4)));
typedef unsigned u32x2 __attribute__((ext_vector_type(2)));

__device__ __forceinline__ float bf2f(unsigned b) { return __uint_as_float(b << 16); }
__device__ __forceinline__ unsigned cvt_pk_bf16(float lo, float hi) { unsigned r; asm volatile("v_cvt_pk_bf16_f32 %0, %1, %2" : "=v"(r) : "v"(lo), "v"(hi)); return r; }
__device__ __forceinline__ unsigned lane_id_now() { unsigned l; asm volatile("v_mbcnt_lo_u32_b32 %0, -1, 0\n\tv_mbcnt_hi_u32_b32 %0, -1, %0" : "=v"(l)); return l; }
__device__ __forceinline__ float bperm_f(float v, int byte_addr) { return __int_as_float(__builtin_amdgcn_ds_bpermute(byte_addr, __float_as_int(v))); }
__device__ __forceinline__ float sigmoidf_(float x) { return __builtin_amdgcn_rcpf(1.0f + __expf(-x)); }
__device__ __forceinline__ float siluf_(float x) { return x * __builtin_amdgcn_rcpf(1.0f + __expf(-x)); }
__device__ __forceinline__ float wave_sum(float v) {
#pragma unroll
    for (int o = 1; o < 64; o <<= 1) v += __shfl_xor(v, o);
    return v;
}
__device__ __forceinline__ float wave_max(float v) {
#pragma unroll
    for (int o = 1; o < 64; o <<= 1) v = fmaxf(v, __shfl_xor(v, o));
    return v;
}
__device__ __forceinline__ void unpack8(u32x4 w, float* f) {
    f[0] = bf2f(w.x & 0xffffu); f[1] = bf2f(w.x >> 16); f[2] = bf2f(w.y & 0xffffu); f[3] = bf2f(w.y >> 16);
    f[4] = bf2f(w.z & 0xffffu); f[5] = bf2f(w.z >> 16); f[6] = bf2f(w.w & 0xffffu); f[7] = bf2f(w.w >> 16);
}
__device__ __forceinline__ u32x4 pack8(const float* f) {
    u32x4 w; w.x = cvt_pk_bf16(f[0], f[1]); w.y = cvt_pk_bf16(f[2], f[3]); w.z = cvt_pk_bf16(f[4], f[5]); w.w = cvt_pk_bf16(f[6], f[7]); return w;
}

namespace pg8 {
#define PG8_LAS __attribute__((address_space(3)))
constexpr int BM = 256, BK = 64, HALF = 128, HTB = HALF * BK * 2, STAGE_BYTES = 8 * HTB, NXCD = 8, WGM = 8;
__host__ __device__ __forceinline__ int lds_byte(int r, int c) { const int st = (r >> 4) * 2 + (c >> 5), rr = r & 15, cc = c & 31, ob = rr * 64 + cc * 2; return st * 1024 + (ob ^ (((ob >> 9) & 1) << 5)); }
__host__ __device__ __forceinline__ void stage_rc(int b, int& R, int& C) { const int st = b / 1024, sb = b % 1024, swz = sb ^ (((sb >> 9) & 1) << 5); R = (st >> 1) * 16 + swz / 64; C = (st & 1) * 32 + (swz % 64) / 2; }
__host__ __device__ __forceinline__ int perm32(int rho) { const int n = rho >> 4, i = rho & 15; return 8 * (i >> 2) + 4 * n + (i & 3); }

struct Unit { int pm, pn, aux; const char* a; const char* b; };

struct TileOrder {
    int nM, nN, nwg;
    __device__ __forceinline__ void init(int nM_, int nN_) { nM = nM_; nN = nN_; nwg = nM * nN; }
    __device__ __forceinline__ bool tile(long L, int& pm, int& pn) const {
        if (L >= nwg) return false;
        int wgid = (int)L; { const int q = nwg / NXCD, r = nwg % NXCD, xcd = wgid % NXCD, off = wgid / NXCD; wgid = (xcd < r ? xcd * (q + 1) : r * (q + 1) + (xcd - r) * q) + off; }
        const int nig = WGM * nN, gid = wgid / nig, fm = gid * WGM, gsz = (nM - fm) < WGM ? (nM - fm) : WGM;
        pm = fm + ((wgid % nig) % gsz); pn = (wgid % nig) / gsz; return true;
    }
};

template <class Epi, class Sched, int lda, int ldb, int K, bool ALIGN_EPI, bool SP2>
__device__ __forceinline__ void gemm_phase(PG8_LAS unsigned char* lds, const int wave0, const Sched& S, const Epi& E) {
    int tid_ = wave0 * 64 + (int)lane_id_now(); asm volatile("" : "+v"(tid_));
    const int tid = tid_, wid = __builtin_amdgcn_readfirstlane(tid >> 6), lane = tid & 63, wr = wid >> 2, wc = wid & 3, fr = lane & 15, fq = lane >> 4;
    const int nt = K / BK;
    unsigned voffA[2], voffB[2];
#pragma unroll
    for (int i = 0; i < 2; ++i) { int R, C; stage_rc(tid * 16 + i * 8192, R, C); const int Rb = Epi::PERM ? ((R & ~31) + perm32(R & 31)) : R;
        voffA[i] = (unsigned)(R * lda + C) * 2u; voffB[i] = (unsigned)(Rb * ldb + C) * 2u; }
    const size_t kstep = (size_t)(BK * 2);
    const size_t hstepA = (size_t)HALF * lda * 2, hstepB = (size_t)HALF * ldb * 2;
    const unsigned ldsw = (unsigned)wid * 1024u;
    const int aoff = lds_byte(wr * 64 + fr, fq * 8), boff = lds_byte(wc * 32 + fr, fq * 8);
#define PG8_SA(b, h) (((b) * 2 + (h)) * HTB)
#define PG8_SB(b, h) ((4 + (b) * 2 + (h)) * HTB)
#define PG8_STAGE(bufoff, gbase, voff) do { _Pragma("unroll") for (int _i = 0; _i < 2; ++_i) \
        __builtin_amdgcn_global_load_lds((const unsigned*)((const char*)(gbase) + (voff)[_i]), (PG8_LAS unsigned*)(lds + (bufoff) + ldsw + _i * 8192), 16, 0, 0); } while (0)
#define PG8_LDA(dst, b, h) do { _Pragma("unroll") for (int m = 0; m < 4; ++m) _Pragma("unroll") for (int k = 0; k < 2; ++k) dst[m][k] = *(const PG8_LAS bf16x8*)(lds + PG8_SA(b, h) + aoff + m * 2048 + k * 1024); } while (0)
#define PG8_LDB(dst, b, h) do { _Pragma("unroll") for (int n = 0; n < 2; ++n) _Pragma("unroll") for (int k = 0; k < 2; ++k) dst[n][k] = *(const PG8_LAS bf16x8*)(lds + PG8_SB(b, h) + boff + n * 2048 + k * 1024); } while (0)
#define PG8_MMA(ai, bj, At, Bt) do { __builtin_amdgcn_s_setprio(1); _Pragma("unroll") for (int m = 0; m < 4; ++m) _Pragma("unroll") for (int n = 0; n < 2; ++n) _Pragma("unroll") for (int k = 0; k < 2; ++k) \
        acc[ai][bj][m][n] = __builtin_amdgcn_mfma_f32_16x16x32_bf16(Bt[n][k], At[m][k], acc[ai][bj][m][n], 0, 0, 0); __builtin_amdgcn_s_setprio(0); } while (0)
#define PG8_WAIT_V(n) asm volatile("s_waitcnt vmcnt(" #n ")" ::: "memory")
#define PG8_WAIT_L(n) asm volatile("s_waitcnt lgkmcnt(" #n ")" ::: "memory")
#define PG8_BAR __builtin_amdgcn_s_barrier()
#define PG8_SCHED __builtin_amdgcn_sched_barrier(0)
    Unit cur, nxt; int ui = 0;
    if (!S.next(0, cur)) return;
    f32x4 acc[2][2][4][2];
#pragma unroll
    for (int a = 0; a < 2; ++a)
#pragma unroll
        for (int b = 0; b < 2; ++b)
#pragma unroll
            for (int m = 0; m < 4; ++m)
#pragma unroll
                for (int n = 0; n < 2; ++n) acc[a][b][m][n] = (f32x4){0.f, 0.f, 0.f, 0.f};
    bf16x8 At[4][2], B0[2][2], B1[2][2];
    const char* cA = cur.a; const char* cB = cur.b;
    if constexpr (SP2) {
        PG8_STAGE(PG8_SB(0, 0), cB, voffB); PG8_STAGE(PG8_SB(0, 1), cB + hstepB, voffB); PG8_STAGE(PG8_SA(0, 0), cA, voffA); PG8_STAGE(PG8_SA(0, 1), cA + hstepA, voffA);
        if (wr == 1) PG8_BAR;
        PG8_WAIT_V(2); PG8_BAR;
        PG8_STAGE(PG8_SB(1, 0), cB + kstep, voffB); PG8_STAGE(PG8_SA(1, 0), cA + kstep, voffA); PG8_STAGE(PG8_SB(1, 1), cB + hstepB + kstep, voffB);
        PG8_WAIT_V(6); PG8_BAR;
    } else {
        PG8_STAGE(PG8_SB(0, 0), cB, voffB); PG8_STAGE(PG8_SA(0, 0), cA, voffA); PG8_STAGE(PG8_SB(0, 1), cB + hstepB, voffB); PG8_STAGE(PG8_SA(0, 1), cA + hstepA, voffA);
        if (wr == 1) PG8_BAR;
        PG8_WAIT_V(4); PG8_BAR;
        PG8_STAGE(PG8_SB(1, 0), cB + kstep, voffB); PG8_STAGE(PG8_SA(1, 0), cA + kstep, voffA); PG8_STAGE(PG8_SB(1, 1), cB + hstepB + kstep, voffB);
        PG8_WAIT_V(6); PG8_BAR;
    }
    for (;;) {
        const bool has_next = S.next(ui + 1, nxt);
        const char* nA = has_next ? nxt.a : cA; const char* nB = has_next ? nxt.b : cB;
        for (int t = 0; t < nt; t += 2) {
            const bool last = (t == nt - 2);
            const char* a1 = cA + (size_t)(t + 1) * kstep;
            const char* a2 = last ? nA : cA + (size_t)(t + 2) * kstep; const char* b2 = last ? nB : cB + (size_t)(t + 2) * kstep;
            const char* a3 = a2 + kstep; const char* b3 = b2 + kstep;
            if constexpr (SP2) {
            PG8_LDB(B0, 0, 0); PG8_LDB(B1, 0, 1); PG8_SCHED; PG8_LDA(At, 0, 0); PG8_STAGE(PG8_SA(1, 1), a1 + hstepA, voffA);
            PG8_WAIT_V(8); PG8_WAIT_L(0); PG8_BAR; PG8_MMA(0, 0, At, B0); PG8_MMA(0, 1, At, B1); PG8_BAR; PG8_SCHED;
            PG8_LDA(At, 0, 1); PG8_STAGE(PG8_SB(0, 0), b2, voffB); PG8_STAGE(PG8_SB(0, 1), b2 + hstepB, voffB); PG8_STAGE(PG8_SA(0, 0), a2, voffA);
            PG8_WAIT_V(8); PG8_WAIT_L(0); PG8_BAR; PG8_MMA(1, 0, At, B0); PG8_MMA(1, 1, At, B1); PG8_BAR; PG8_SCHED;
            PG8_LDB(B0, 1, 0); PG8_LDB(B1, 1, 1); PG8_SCHED; PG8_LDA(At, 1, 0); PG8_STAGE(PG8_SA(0, 1), a2 + hstepA, voffA);
            PG8_WAIT_V(8); PG8_WAIT_L(0); PG8_BAR; PG8_MMA(0, 0, At, B0); PG8_MMA(0, 1, At, B1); PG8_BAR; PG8_SCHED;
            PG8_LDA(At, 1, 1); PG8_STAGE(PG8_SB(1, 0), b3, voffB); PG8_STAGE(PG8_SB(1, 1), b3 + hstepB, voffB); PG8_STAGE(PG8_SA(1, 0), a3, voffA);
            PG8_WAIT_V(8); PG8_WAIT_L(0); PG8_BAR; PG8_MMA(1, 0, At, B0); PG8_MMA(1, 1, At, B1); PG8_BAR; PG8_SCHED;
            } else {
            PG8_LDB(B0, 0, 0); PG8_SCHED; PG8_LDA(At, 0, 0); PG8_STAGE(PG8_SA(1, 1), a1 + hstepA, voffA);
            PG8_WAIT_L(8); PG8_BAR; PG8_WAIT_L(0); PG8_MMA(0, 0, At, B0); PG8_BAR; PG8_SCHED;
            PG8_LDB(B1, 0, 1); PG8_STAGE(PG8_SB(0, 0), b2, voffB);
            PG8_BAR; PG8_WAIT_L(0); PG8_MMA(0, 1, At, B1); PG8_BAR;
            PG8_LDA(At, 0, 1); PG8_STAGE(PG8_SA(0, 0), a2, voffA);
            PG8_BAR; PG8_WAIT_L(0); PG8_MMA(1, 0, At, B0); PG8_BAR; PG8_SCHED;
            PG8_STAGE(PG8_SB(0, 1), b2 + hstepB, voffB);
            PG8_WAIT_V(6); PG8_BAR; PG8_MMA(1, 1, At, B1); PG8_BAR;
            PG8_LDB(B0, 1, 0); PG8_SCHED; PG8_LDA(At, 1, 0); PG8_STAGE(PG8_SA(0, 1), a2 + hstepA, voffA);
            PG8_WAIT_L(8); PG8_BAR; PG8_WAIT_L(0); PG8_MMA(0, 0, At, B0); PG8_BAR; PG8_SCHED;
            PG8_LDB(B1, 1, 1); PG8_STAGE(PG8_SB(1, 0), b3, voffB);
            PG8_BAR; PG8_WAIT_L(0); PG8_MMA(0, 1, At, B1); PG8_BAR;
            PG8_LDA(At, 1, 1); PG8_STAGE(PG8_SA(1, 0), a3, voffA);
            PG8_BAR; PG8_WAIT_L(0); PG8_MMA(1, 0, At, B0); PG8_BAR; PG8_SCHED;
            PG8_STAGE(PG8_SB(1, 1), b3 + hstepB, voffB);
            PG8_WAIT_V(6); PG8_BAR; PG8_MMA(1, 1, At, B1); PG8_BAR;
            }
        }
        if constexpr (ALIGN_EPI) { if (wr == 0) PG8_BAR; }
        E(acc, cur, wr, wc, fr, fq);
        if (!has_next) break;
#pragma unroll
        for (int a = 0; a < 2; ++a)
#pragma unroll
            for (int b = 0; b < 2; ++b)
#pragma unroll
                for (int m = 0; m < 4; ++m)
#pragma unroll
                    for (int n = 0; n < 2; ++n) acc[a][b][m][n] = (f32x4){0.f, 0.f, 0.f, 0.f};
        cur = nxt; cA = nA; cB = nB; ++ui;
        if constexpr (ALIGN_EPI) { if (wr == 1) PG8_BAR; }
    }
    PG8_WAIT_V(0);
    if constexpr (!ALIGN_EPI) { if (wr == 0) PG8_BAR; }
    PG8_BAR;
#undef PG8_SA
#undef PG8_SB
#undef PG8_STAGE
#undef PG8_LDA
#undef PG8_LDB
#undef PG8_MMA
#undef PG8_WAIT_V
#undef PG8_WAIT_L
#undef PG8_BAR
#undef PG8_SCHED
}
}
using pg8::Unit;

template <int MODE, int LDA_B, int LDB_B> struct Sched {
    pg8::TileOrder to; int G, c;
    const char* A0; const char* B0; const char* A1; const char* B1;
    __device__ __forceinline__ bool next(int i, Unit& u) const {
        if (MODE == 1) {
            const long L = (long)(i >> 1) * G + c; if (!to.tile(L, u.pm, u.pn)) return false;
            u.aux = i & 1;
            u.a = (u.aux ? A1 : A0) + (size_t)u.pm * 256 * LDA_B; u.b = (u.aux ? B1 : B0) + (size_t)u.pn * 256 * LDB_B; return true;
        } else {
            const long L = (long)i * G + c;
            if (MODE == 2 && G >= 64) {
                const int nS = FF2 / 256;
                if (L >= (long)to.nwg + nS) return false;
                if (L >= G - nS && L < G) { u.pm = NPT5; u.pn = (int)(L - (G - nS)); }
                else if (!to.tile(L < G - nS ? L : L - nS, u.pm, u.pn)) return false;
            } else if (!to.tile(L, u.pm, u.pn)) return false;
            u.aux = 0;
            if (MODE == 2) { const long r0 = (u.pm < NPT5) ? (254L * u.pm - 2) : (long)SEQ; u.a = A0 + r0 * (long)LDA_B; }
            else u.a = A0 + (size_t)u.pm * 256 * LDA_B;
            u.b = B0 + (size_t)u.pn * 256 * LDB_B; return true;
        }
    }
};

#define EPI_ARGS const f32x4 (&acc)[2][2][4][2], const Unit& u, int wr, int wc, int fr, int fq
struct EpiAda {
    static constexpr bool PERM = true;
    float* ADA; const float* bias;
    __device__ __forceinline__ void operator()(EPI_ARGS) const {
#pragma unroll
        for (int ai = 0; ai < 2; ++ai)
#pragma unroll
            for (int m = 0; m < 4; ++m) { const int row = 128 * ai + 64 * wr + 16 * m + fr;
#pragma unroll
                for (int bj = 0; bj < 2; ++bj) { const int col = 256 * u.pn + 128 * bj + 32 * wc + 8 * fq;
#pragma unroll
                    for (int n = 0; n < 2; ++n) { const f32x4 b = *(const f32x4*)(bias + col + 4 * n); *(f32x4*)(ADA + (size_t)row * NADA + col + 4 * n) = acc[ai][bj][m][n] + b; } } }
    }
};
struct EpiProj {
    static constexpr bool PERM = true;
    bf16_t *U, *BG, *Q, *KB, *VB, *GA, *GB;
    __device__ __forceinline__ void operator()(EPI_ARGS) const {
        const int row0 = u.pm * 256 + wr * 64 + fr;
        if (u.pn < 8) {
#pragma unroll
            for (int ai = 0; ai < 2; ++ai)
#pragma unroll
                for (int m = 0; m < 4; ++m) { const int row = row0 + 128 * ai + 16 * m;
                    const f32x4 v0 = acc[ai][0][m][0] * acc[ai][1][m][0], v1 = acc[ai][0][m][1] * acc[ai][1][m][1];
                    u32x4 w; w.x = cvt_pk_bf16(v0[0], v0[1]); w.y = cvt_pk_bf16(v0[2], v0[3]); w.z = cvt_pk_bf16(v1[0], v1[1]); w.w = cvt_pk_bf16(v1[2], v1[3]);
                    *(u32x4*)(U + (size_t)row * 1024 + 128 * u.pn + 32 * wc + 8 * fq) = w; }
        } else {
            bf16_t* dst; int ld, cb; const int pn = u.pn;
            if (pn < 12) { dst = BG; ld = 1024; cb = 256 * (pn - 8); }
            else if (pn < 16) { dst = Q; ld = 1024; cb = 256 * (pn - 12); }
            else if (pn == 16) { dst = KB; ld = 256; cb = 0; }
            else if (pn == 17) { dst = VB; ld = 256; cb = 0; }
            else if (pn < 22) { dst = GA; ld = 1024; cb = 256 * (pn - 18); }
            else { dst = GB; ld = 1024; cb = 256 * (pn - 22); }
#pragma unroll
            for (int ai = 0; ai < 2; ++ai)
#pragma unroll
                for (int m = 0; m < 4; ++m) { const int row = row0 + 128 * ai + 16 * m;
#pragma unroll
                    for (int bj = 0; bj < 2; ++bj) { const f32x4 v0 = acc[ai][bj][m][0], v1 = acc[ai][bj][m][1];
                        u32x4 w; w.x = cvt_pk_bf16(v0[0], v0[1]); w.y = cvt_pk_bf16(v0[2], v0[3]); w.z = cvt_pk_bf16(v1[0], v1[1]); w.w = cvt_pk_bf16(v1[2], v1[3]);
                        *(u32x4*)(dst + (size_t)row * ld + cb + 128 * bj + 32 * wc + 8 * fq) = w; } }
        }
    }
};
struct EpiMix {
    static constexpr bool PERM = true;
    const bf16_t *GA, *GB; float* T; bf16_t* Z;
    __device__ __forceinline__ void operator()(EPI_ARGS) const {
        const int row0 = u.pm * 256 + wr * 64 + fr;
        const bf16_t* gate = u.aux ? GB : GA;
#pragma unroll
        for (int ai = 0; ai < 2; ++ai)
#pragma unroll
            for (int m = 0; m < 4; ++m) { const int row = row0 + 128 * ai + 16 * m;
                if (row < MROWS) {
#pragma unroll
                for (int bj = 0; bj < 2; ++bj) { const int col = 256 * u.pn + 128 * bj + 32 * wc + 8 * fq;
                    float gv[8]; unpack8(*(const u32x4*)(gate + (size_t)row * 1024 + col), gv);
                    float o[8];
#pragma unroll
                    for (int i = 0; i < 8; ++i) o[i] = sigmoidf_(gv[i]) * acc[ai][bj][m][i >> 2][i & 3];
                    bf16_t* zp = Z + (size_t)row * 1024 + col;
                    if (u.aux == 0) *(u32x4*)zp = pack8(o);
                    else { float t[8]; unpack8(*(const u32x4*)zp, t);
#pragma unroll
                        for (int i = 0; i < 8; ++i) o[i] += t[i];
                        *(u32x4*)zp = pack8(o); } } } }
    }
};
struct EpiRes {
    static constexpr bool PERM = true;
    const float* xp; const float* xs; float* out; const float* ADA; int goff;
    __device__ __forceinline__ void operator()(EPI_ARGS) const {
        const int row0 = u.pm * 256 + wr * 64 + fr;
#pragma unroll
        for (int ai = 0; ai < 2; ++ai)
#pragma unroll
            for (int m = 0; m < 4; ++m) { const int row = row0 + 128 * ai + 16 * m;
                if (row < MROWS) {
                const float* base = (row < SEQ) ? xp + (size_t)row * 1024 : xs + (size_t)(row - SEQ) * 1024;
                const float* gt = ADA + (size_t)((row < SEQ) ? 128 : row - SEQ) * NADA + goff;
#pragma unroll
                for (int bj = 0; bj < 2; ++bj) { const int col = 256 * u.pn + 128 * bj + 32 * wc + 8 * fq;
#pragma unroll
                    for (int n = 0; n < 2; ++n) { const f32x4 b = *(const f32x4*)(base + col + 4 * n), g = *(const f32x4*)(gt + col + 4 * n);
                        *(f32x4*)(out + (size_t)row * 1024 + col + 4 * n) = b + g * acc[ai][bj][m][n]; } } } }
    }
};
struct EpiDelta {
    static constexpr bool PERM = true;
    bf16_t* Dd; const float* ADA; int goff;
    __device__ __forceinline__ void operator()(EPI_ARGS) const {
        const int row0 = u.pm * 256 + wr * 64 + fr;
#pragma unroll
        for (int ai = 0; ai < 2; ++ai)
#pragma unroll
            for (int m = 0; m < 4; ++m) { const int row = row0 + 128 * ai + 16 * m;
                if (row < MROWS) {
                const float* gt = ADA + (size_t)((row < SEQ) ? 128 : row - SEQ) * NADA + goff;
#pragma unroll
                for (int bj = 0; bj < 2; ++bj) { const int col = 256 * u.pn + 128 * bj + 32 * wc + 8 * fq;
                    const f32x4 g0 = *(const f32x4*)(gt + col), g1 = *(const f32x4*)(gt + col + 4); const f32x4 a0 = g0 * acc[ai][bj][m][0], a1 = g1 * acc[ai][bj][m][1];
                    u32x4 w; w.x = cvt_pk_bf16(a0[0], a0[1]); w.y = cvt_pk_bf16(a0[2], a0[3]); w.z = cvt_pk_bf16(a1[0], a1[1]); w.w = cvt_pk_bf16(a1[2], a1[3]);
                    *(u32x4*)(Dd + (size_t)row * 1024 + col) = w; } } }
    }
};
struct EpiRes4 {
    static constexpr bool PERM = true;
    const float* xp; float* out; const float* ADA; const float* gf; bf16_t* A2; float* SS;
    __device__ __forceinline__ void operator()(EPI_ARGS) const {
        const int row0 = u.pm * 256 + wr * 64 + fr; const float* ad = ADA + (size_t)128 * NADA;
#pragma unroll
        for (int ai = 0; ai < 2; ++ai)
#pragma unroll
            for (int m = 0; m < 4; ++m) { const int row = row0 + 128 * ai + 16 * m; float ss = 0.f;
#pragma unroll
                for (int bj = 0; bj < 2; ++bj) { const int col = 256 * u.pn + 128 * bj + 32 * wc + 8 * fq; float a2[8];
#pragma unroll
                    for (int n = 0; n < 2; ++n) { const f32x4 b = *(const f32x4*)(xp + (size_t)row * 1024 + col + 4 * n), g = *(const f32x4*)(ad + 2048 + col + 4 * n);
                        const f32x4 x1 = b + g * acc[ai][bj][m][n]; *(f32x4*)(out + (size_t)row * 1024 + col + 4 * n) = x1;
                        ss += (x1[0] * x1[0] + x1[1] * x1[1]) + (x1[2] * x1[2] + x1[3] * x1[3]);
                        const f32x4 gm = *(const f32x4*)(gf + col + 4 * n) * (*(const f32x4*)(ad + 4096 + col + 4 * n) + 1.0f); const f32x4 av = x1 * gm;
                        a2[4 * n] = av[0]; a2[4 * n + 1] = av[1]; a2[4 * n + 2] = av[2]; a2[4 * n + 3] = av[3]; }
                    *(u32x4*)(A2 + (size_t)row * 1024 + col) = pack8(a2); }
                ss += __shfl_xor(ss, 16); ss += __shfl_xor(ss, 32);
                if (fq == 0) SS[(size_t)row * 16 + u.pn * 4 + wc] = ss; }
    }
};
__device__ __forceinline__ float ss_sum16(const float* SS, unsigned row) {
    const f32x4* p = (const f32x4*)((const char*)SS + (size_t)row * 64u); const f32x4 a = p[0], b = p[1], c = p[2], d = p[3]; const f32x4 s = (a + b) + (c + d); return (s[0] + s[1]) + (s[2] + s[3]); }
struct EpiFfn {
    static constexpr bool PERM = true;
    bf16_t* G; const float* cw; const float* cb; const float* st; float* ofp; float* ofs; PG8_LAS float* halo; const float* SS; const float* C0;
    template <int CTRL> static __device__ __forceinline__ float dppf(float oldv, float src) {
        return __int_as_float(__builtin_amdgcn_update_dpp(__float_as_int(oldv), __float_as_int(src), CTRL, 0xf, 0xf, false)); }
    __device__ __forceinline__ void operator()(const f32x4 (&acc)[2][2][4][2], const Unit& u, int wr, int wc, int fr_, int fq_) const {
        const int l_ = (int)lane_id_now();
        const int fr = l_ & 15, fq = l_ >> 4; (void)fr_; (void)fq_;
        const int wid = wr * 4 + wc;
        const int f0 = 128 * u.pn + 32 * wc + 8 * fq;
        if (u.pm < NPT5) {
            PG8_LAS float* par = halo + 2048;
            {
                const int t = wid * 64 + l_;
                if (t < 256) { const int gc = (t < 128) ? 128 * u.pn + t : FF + 128 * u.pn + (t - 128);
                    const float w0_ = cw[gc], w1_ = cw[FF2 + gc], w2_ = cw[2 * FF2 + gc], b_ = cb[gc], c0_ = C0[gc];
                    par[t] = w0_; par[256 + t] = w1_; par[512 + t] = w2_; par[768 + t] = b_ + c0_ * (w0_ + w1_ + w2_); par[1024 + t] = c0_; }
                else { const int tr_ = t - 256, gr_ = 254 * u.pm - 2 + tr_; const unsigned go_ = (unsigned)((gr_ < 0 || gr_ >= SEQ) ? 0 : gr_);
                    const float ssv = ss_sum16(SS, go_); par[1280 + tr_] = (gr_ >= 0) ? rsqrtf(ssv * (1.0f / 1024.0f) + EPS) : 0.f; }
            }
            unsigned pb_ = (unsigned)(uintptr_t)(par + 32 * wc + 8 * fq); asm volatile("" : "+v"(pb_)); const PG8_LAS float* parl = (const PG8_LAS float*)(uintptr_t)pb_;
            unsigned rb_ = (unsigned)(uintptr_t)(par + 1280 + 64 * wr + fr); asm volatile("" : "+v"(rb_)); const PG8_LAS float* rsl = (const PG8_LAS float*)(uintptr_t)rb_;
            if (fr >= 14) {
#pragma unroll
                for (int ai = 0; ai < 2; ++ai)
#pragma unroll
                    for (int bj = 0; bj < 2; ++bj)
#pragma unroll
                        for (int n = 0; n < 2; ++n) { const int gr_ = 254 * u.pm - 2 + 128 * ai + 64 * wr + 48 + fr; const float r_ = rsqrtf(ss_sum16(SS, (unsigned)(gr_ >= SEQ ? 0 : gr_)) * (1.0f / 1024.0f) + EPS);
                            *(PG8_LAS f32x4*)(halo + ((wid * 2 + ai) * 2 + (fr - 14)) * 64 + bj * 32 + fq * 8 + n * 4) = acc[ai][bj][3][n] * r_; }
            }
            const bool first = (u.pm == 0) && (wr == 0);
            asm volatile("s_waitcnt vmcnt(0) lgkmcnt(0)" ::: "memory"); __builtin_amdgcn_s_barrier(); asm volatile("" ::: "memory");
#pragma unroll
            for (int ai = 0; ai < 2; ++ai) {
                const int swr = (ai == 0) ? 0 : (wr == 0 ? 1 : 0), sai = (ai == 1 && wr == 1) ? 1 : 0;
                unsigned hb_ = (unsigned)(uintptr_t)(halo + (((swr * 4 + wc) * 2 + sai) * 2) * 64 + fq * 8); asm volatile("" : "+v"(hb_)); const PG8_LAS float* hp = (const PG8_LAS float*)(uintptr_t)hb_;
#pragma unroll
                for (int n = 0; n < 2; ++n) {
                    const int cg0 = 4 * n, cv0 = 128 + cg0;
                    f32x4 cvv[4];
                    {
                        const f32x4 w0 = *(const PG8_LAS f32x4*)(parl + cv0), w1 = *(const PG8_LAS f32x4*)(parl + 256 + cv0), w2 = *(const PG8_LAS f32x4*)(parl + 512 + cv0), bb = *(const PG8_LAS f32x4*)(parl + 768 + cv0);
                        const f32x4 h2 = *(const PG8_LAS f32x4*)(hp + 32 + n * 4), h1 = *(const PG8_LAS f32x4*)(hp + 64 + 32 + n * 4);
                        f32x4 p1 = h1, p2 = (fr == 1) ? h1 : h2;
                        const f32x4 bbe = bb;
#pragma unroll
                        for (int m = 0; m < 4; ++m) {
                            const float r_ = rsl[128 * ai + 16 * m];
                            const f32x4 x = acc[ai][1][m][n] * r_; f32x4 q1, q2, n1, n2;
#pragma unroll
                            for (int i = 0; i < 4; ++i) { q1[i] = dppf<0x111>(p1[i], x[i]); q2[i] = dppf<0x112>(p2[i], x[i]); n1[i] = dppf<0x121>(x[i], x[i]); n2[i] = dppf<0x122>(x[i], x[i]); }
                            p1 = n1; p2 = n2;
                            cvv[m] = w0 * q2 + w1 * q1 + w2 * x + bbe;
                            if (ai == 0 && m == 0 && first) { const f32x4 c0v = *(const PG8_LAS f32x4*)(parl + 1024 + cv0); if (fr == 2) cvv[m] -= c0v * (w0 + w1); else if (fr == 3) cvv[m] -= c0v * w0; }
                            __builtin_amdgcn_sched_barrier(0);
                        }
                    }
                    {
                        const f32x4 w0 = *(const PG8_LAS f32x4*)(parl + cg0), w1 = *(const PG8_LAS f32x4*)(parl + 256 + cg0), w2 = *(const PG8_LAS f32x4*)(parl + 512 + cg0), bb = *(const PG8_LAS f32x4*)(parl + 768 + cg0);
                        const f32x4 h2 = *(const PG8_LAS f32x4*)(hp + n * 4), h1 = *(const PG8_LAS f32x4*)(hp + 64 + n * 4);
                        f32x4 p1 = h1, p2 = (fr == 1) ? h1 : h2;
                        const f32x4 bbe = bb;
#pragma unroll
                        for (int m = 0; m < 4; ++m) {
                            const float r_ = rsl[128 * ai + 16 * m];
                            const f32x4 x = acc[ai][0][m][n] * r_; f32x4 q1, q2, n1, n2;
#pragma unroll
                            for (int i = 0; i < 4; ++i) { q1[i] = dppf<0x111>(p1[i], x[i]); q2[i] = dppf<0x112>(p2[i], x[i]); n1[i] = dppf<0x121>(x[i], x[i]); n2[i] = dppf<0x122>(x[i], x[i]); }
                            p1 = n1; p2 = n2;
                            f32x4 cgv = w0 * q2 + w1 * q1 + w2 * x + bbe;
                            if (ai == 0 && m == 0 && first) { const f32x4 c0v = *(const PG8_LAS f32x4*)(parl + 1024 + cg0); if (fr == 2) cgv -= c0v * (w0 + w1); else if (fr == 3) cgv -= c0v * w0; }
                            u32x2 pk; pk.x = cvt_pk_bf16(siluf_(cgv[0]) * cvv[m][0], siluf_(cgv[1]) * cvv[m][1]); pk.y = cvt_pk_bf16(siluf_(cgv[2]) * cvv[m][2], siluf_(cgv[3]) * cvv[m][3]);
                            {
                                const int tr = 128 * ai + 64 * wr + 16 * m + fr; const int grow = 254 * u.pm - 2 + tr;
                                if (tr >= 2 && grow < SEQ) {
                                    *(u32x2*)(G + (size_t)grow * FF + f0 + 4 * n) = pk;
                                    if (n == 1 && grow >= SEQ - 2) { float* o = ofp + (size_t)(grow - (SEQ - 2)) * FF2 + f0;
                                        *(f32x4*)o = acc[ai][0][m][0] * r_ + *(const PG8_LAS f32x4*)(parl + 1024); *(f32x4*)(o + 4) = acc[ai][0][m][1] * r_ + *(const PG8_LAS f32x4*)(parl + 1024 + 4);
                                        *(f32x4*)(o + FF) = acc[ai][1][m][0] * r_ + *(const PG8_LAS f32x4*)(parl + 1024 + 128); *(f32x4*)(o + FF + 4) = acc[ai][1][m][1] * r_ + *(const PG8_LAS f32x4*)(parl + 1024 + 128 + 4); }
                                }
                            }
                            asm volatile("" ::: "memory"); __builtin_amdgcn_sched_barrier(0);
                        }
                    }
                }
                asm volatile("" ::: "memory"); __builtin_amdgcn_sched_barrier(0);
            }
        } else {
#pragma unroll
            for (int n = 0; n < 2; ++n) {
                const int fg = f0 + 4 * n, fv = FF + fg;
#pragma unroll
                for (int m = 0; m < 4; ++m) {
                    const int b = 64 * wr + 16 * m + fr;
                    const float* s0 = st + (size_t)(b * 2) * FF2; const float* s1 = s0 + FF2;
                    float* o0 = ofs + (size_t)(b * 2) * FF2; float* o1 = o0 + FF2;
                    f32x4 cvv;
                    { const f32x4 x = acc[0][1][m][n];
                      const f32x4 w0 = *(const f32x4*)(cw + fv), w1 = *(const f32x4*)(cw + FF2 + fv), w2 = *(const f32x4*)(cw + 2 * FF2 + fv), bb = *(const f32x4*)(cb + fv);
                      const f32x4 t0 = *(const f32x4*)(s0 + fv), t1 = *(const f32x4*)(s1 + fv);
                      cvv = w0 * t0 + w1 * t1 + w2 * x + bb; *(f32x4*)(o0 + fv) = t1; *(f32x4*)(o1 + fv) = x; }
                    asm volatile("" ::: "memory"); __builtin_amdgcn_sched_barrier(0);
                    { const f32x4 x = acc[0][0][m][n];
                      const f32x4 w0 = *(const f32x4*)(cw + fg), w1 = *(const f32x4*)(cw + FF2 + fg), w2 = *(const f32x4*)(cw + 2 * FF2 + fg), bb = *(const f32x4*)(cb + fg);
                      const f32x4 t0 = *(const f32x4*)(s0 + fg), t1 = *(const f32x4*)(s1 + fg);
                      const f32x4 cgv = w0 * t0 + w1 * t1 + w2 * x + bb; *(f32x4*)(o0 + fg) = t1; *(f32x4*)(o1 + fg) = x;
                      u32x2 w; w.x = cvt_pk_bf16(siluf_(cgv[0]) * cvv[0], siluf_(cgv[1]) * cvv[1]); w.y = cvt_pk_bf16(siluf_(cgv[2]) * cvv[2], siluf_(cgv[3]) * cvv[3]);
                      *(u32x2*)(G + (size_t)(SEQ + b) * FF + fg) = w; }
                    asm volatile("" ::: "memory"); __builtin_amdgcn_sched_barrier(0);
                }
            }
        }
    }
};

__device__ __forceinline__ void transpose_item(const float* W, int K, int N, bf16_t* WT, int k0, int n0, int drow0, float* scr, int lane) {
    float tv[32];
#pragma unroll
    for (int i = 0; i < 32; ++i) tv[i] = W[(size_t)(k0 + 2 * i + (lane >> 5)) * N + n0 + (lane & 31)];
#pragma unroll
    for (int i = 0; i < 32; ++i) scr[(2 * i + (lane >> 5)) * 33 + (lane & 31)] = tv[i];
    asm volatile("s_waitcnt lgkmcnt(0)" ::: "memory");
    const int c = lane & 7;
#pragma unroll
    for (int j = 0; j < 4; ++j) { const int n = (lane >> 3) + 8 * j; const float* s = scr + (8 * c) * 33 + n;
        u32x4 o; o.x = cvt_pk_bf16(s[0 * 33], s[1 * 33]); o.y = cvt_pk_bf16(s[2 * 33], s[3 * 33]); o.z = cvt_pk_bf16(s[4 * 33], s[5 * 33]); o.w = cvt_pk_bf16(s[6 * 33], s[7 * 33]);
        *(u32x4*)(WT + (size_t)(drow0 + n) * K + k0 + 8 * c) = o; }
    asm volatile("s_waitcnt lgkmcnt(0)" ::: "memory");
}
__device__ __forceinline__ int win_drow(int n) {
    if (n < 1024) return 256 * (n >> 7) + (n & 127);
    if (n < 2048) return 2048 + (n - 1024);
    if (n < 3072) { const int f = n - 2048; return 256 * (f >> 7) + 128 + (f & 127); }
    return n;
}
__device__ __forceinline__ int wup_drow(int n) { const int f = (n < FF) ? n : n - FF; return 256 * (f >> 7) + ((n < FF) ? 0 : 128) + (f & 127); }

__device__ __forceinline__ void modnorm_row(const float* xrow, const float* g, const float* sc, const float* sh, bf16_t* orow, int lane) {
    f32x4 v[4]; float s = 0.f;
#pragma unroll
    for (int j = 0; j < 4; ++j) { v[j] = ((const f32x4*)xrow)[lane + 64 * j]; s += (v[j][0] * v[j][0] + v[j][1] * v[j][1]) + (v[j][2] * v[j][2] + v[j][3] * v[j][3]); }
    const float rstd = rsqrtf(wave_sum(s) * (1.0f / 1024.0f) + EPS);
#pragma unroll
    for (int j = 0; j < 4; ++j) { const int col = 4 * (lane + 64 * j);
        const f32x4 gg = *(const f32x4*)(g + col), ss = *(const f32x4*)(sc + col), hh = *(const f32x4*)(sh + col);
        const f32x4 o = v[j] * rstd * gg * (ss + 1.0f) + hh;
        u32x2 w; w.x = cvt_pk_bf16(o[0], o[1]); w.y = cvt_pk_bf16(o[2], o[3]); *(u32x2*)(orow + col) = w; }
}


template <int MODE>
__device__ __forceinline__ void norm_phase(const float* xp, const float* xs, const float* gvec, const float* ada, int scoff, int shoff, bf16_t* ob, float* of, int gw, int NGW, int lane, const bf16_t* dadd = nullptr) {
    f32x4 gmP[4], shP[4];
#pragma unroll
    for (int j = 0; j < 4; ++j) { const int col = 4 * (lane + 64 * j); const f32x4 g = *(const f32x4*)(gvec + col);
        if (MODE == 2) { gmP[j] = g; shP[j] = (f32x4){0.f, 0.f, 0.f, 0.f}; }
        else { const float* ad = ada + (size_t)128 * NADA; gmP[j] = g * (*(const f32x4*)(ad + scoff + col) + 1.0f); shP[j] = *(const f32x4*)(ad + shoff + col); } }
#pragma unroll 1
    for (int base = gw; base < MROWS; base += 4 * NGW) {
        f32x4 v[4][4];
#pragma unroll
        for (int r = 0; r < 4; ++r) { const int row = base + r * NGW;
            if (row < MROWS) { const float* xr = (MODE == 0) ? ((row < SEQ) ? xp + (size_t)row * 1024 : xs + (size_t)(row - SEQ) * 1024) : xp + (size_t)row * 1024;
#pragma unroll
                for (int j = 0; j < 4; ++j) v[r][j] = ((const f32x4*)xr)[lane + 64 * j];
                if (MODE == 2) {
#pragma unroll
                    for (int j = 0; j < 4; ++j) { const u32x2 w = *(const u32x2*)(dadd + (size_t)row * 1024 + 4 * (lane + 64 * j));
                        v[r][j] += (f32x4){bf2f(w.x & 0xffffu), bf2f(w.x >> 16), bf2f(w.y & 0xffffu), bf2f(w.y >> 16)}; } } } }
#pragma unroll
        for (int r = 0; r < 4; ++r) { const int row = base + r * NGW;
            if (row < MROWS) {
                float s = 0.f;
#pragma unroll
                for (int j = 0; j < 4; ++j) s += (v[r][j][0] * v[r][j][0] + v[r][j][1] * v[r][j][1]) + (v[r][j][2] * v[r][j][2] + v[r][j][3] * v[r][j][3]);
                const float rstd = rsqrtf(wave_sum(s) * (1.0f / 1024.0f) + EPS);
#pragma unroll
                for (int j = 0; j < 4; ++j) { const int col = 4 * (lane + 64 * j);
                    f32x4 gm = gmP[j], sh = shP[j];
                    if (MODE != 2 && row >= SEQ) { const float* ad = ada + (size_t)(row - SEQ) * NADA; gm = *(const f32x4*)(gvec + col) * (*(const f32x4*)(ad + scoff + col) + 1.0f); sh = *(const f32x4*)(ad + shoff + col); }
                    const f32x4 o = v[r][j] * rstd * gm + sh;
                    if (MODE == 2) *(f32x4*)(of + (size_t)row * 1024 + col) = o;
                    else { u32x2 w; w.x = cvt_pk_bf16(o[0], o[1]); w.y = cvt_pk_bf16(o[2], o[3]); *(u32x2*)(ob + (size_t)row * 1024 + col) = w; } }
            } }
    }
}
__device__ __forceinline__ void attn_prompt_unit(unsigned char* lds, bf16_t* Q, const bf16_t* KB, const bf16_t* VB, const float* sinks, int j, int g, int tid) {
    bf16_t* Ks = (bf16_t*)lds;
    bf16_t* Vt = (bf16_t*)(lds + 36864);
    bf16x8 qpre[2][4];
    {   const int wave_ = tid >> 6, ql_ = tid & 31, hi_ = (tid >> 5) & 1;
#pragma unroll
        for (int tt = 0; tt < 2; ++tt) { const int t = wave_ * 2 + tt, hq = t >> 2, qg = t & 3; const bf16_t* qp = Q + (size_t)(128 * j + 32 * qg + ql_) * 1024 + (4 * g + hq) * 64;
#pragma unroll
            for (int d0 = 0; d0 < 4; ++d0) qpre[tt][d0] = *(const bf16x8*)(qp + 16 * d0 + 8 * hi_); } }
    for (int c = tid; c < 2048; c += 512) {
        const int s = c >> 3, ch = c & 7; const int tok = 128 * (j - 1) + s;
        u32x4 kv = (u32x4){0u, 0u, 0u, 0u}, vv = (u32x4){0u, 0u, 0u, 0u};
        if (tok >= 0) { kv = *(const u32x4*)(KB + (size_t)tok * 256 + 64 * g + 8 * ch); vv = *(const u32x4*)(VB + (size_t)tok * 256 + 64 * g + 8 * ch); }
        *(u32x4*)(Ks + s * 72 + 8 * ch) = kv;
        bf16_t* vd = Vt + (8 * ch) * 264 + s;
        vd[0 * 264] = (bf16_t)(vv.x & 0xffffu); vd[1 * 264] = (bf16_t)(vv.x >> 16); vd[2 * 264] = (bf16_t)(vv.y & 0xffffu); vd[3 * 264] = (bf16_t)(vv.y >> 16);
        vd[4 * 264] = (bf16_t)(vv.z & 0xffffu); vd[5 * 264] = (bf16_t)(vv.z >> 16); vd[6 * 264] = (bf16_t)(vv.w & 0xffffu); vd[7 * 264] = (bf16_t)(vv.w >> 16);
    }
    __syncthreads();
    const int wave = tid >> 6, lane = tid & 63, ql = lane & 31, hi = lane >> 5;
#pragma unroll
    for (int tt = 0; tt < 2; ++tt) {
        const int t = wave * 2 + tt, hq = t >> 2, qg = t & 3, head = 4 * g + hq;
        bf16_t* qp = Q + (size_t)(128 * j + 32 * qg + ql) * 1024 + head * 64;
        bf16x8 qf[4];
#pragma unroll
        for (int d0 = 0; d0 < 4; ++d0) qf[d0] = qpre[tt][d0];
        f32x16 p[5];
#pragma unroll
        for (int kt = 0; kt < 5; ++kt) {
#pragma unroll
            for (int r = 0; r < 16; ++r) p[kt][r] = 0.f;
#pragma unroll
            for (int d0 = 0; d0 < 4; ++d0) { const bf16x8 kf = *(const bf16x8*)(Ks + (32 * qg + 32 * kt + ql) * 72 + 16 * d0 + 8 * hi);
                p[kt] = __builtin_amdgcn_mfma_f32_32x32x16_bf16(kf, qf[d0], p[kt], 0, 0, 0); }
        }
        const float sink = sinks[head];
        float mx = -INFINITY;
#pragma unroll
        for (int kt = 0; kt < 5; ++kt)
#pragma unroll
            for (int r = 0; r < 16; ++r) { const int kk = (r & 3) + 8 * (r >> 2) + 4 * hi; bool valid = true;
                if (kt == 0) valid = kk >= ql; if (kt == 4) valid = kk <= ql; if (j == 0) valid = valid && (32 * qg + 32 * kt + kk >= 128);
                const float v = valid ? p[kt][r] * 0.125f : -INFINITY; p[kt][r] = v; mx = fmaxf(mx, v); }
        mx = fmaxf(mx, __shfl_xor(mx, 32)); mx = fmaxf(mx, sink);
        float l = 0.f;
#pragma unroll
        for (int kt = 0; kt < 5; ++kt)
#pragma unroll
            for (int r = 0; r < 16; ++r) { const float e = __expf(p[kt][r] - mx); p[kt][r] = e; l += e; }
        l += __shfl_xor(l, 32);
        const float inv = 1.0f / (l + __expf(sink - mx));
        f32x16 o0, o1;
#pragma unroll
        for (int r = 0; r < 16; ++r) { o0[r] = 0.f; o1[r] = 0.f; }
#pragma unroll
        for (int kt = 0; kt < 5; ++kt)
#pragma unroll
            for (int hf = 0; hf < 2; ++hf) {
                u32x4 pw; pw.x = cvt_pk_bf16(p[kt][8 * hf + 0], p[kt][8 * hf + 1]); pw.y = cvt_pk_bf16(p[kt][8 * hf + 2], p[kt][8 * hf + 3]);
                pw.z = cvt_pk_bf16(p[kt][8 * hf + 4], p[kt][8 * hf + 5]); pw.w = cvt_pk_bf16(p[kt][8 * hf + 6], p[kt][8 * hf + 7]);
                const bf16x8 pf = __builtin_bit_cast(bf16x8, pw);
                const int sk = 32 * qg + 32 * kt + 16 * hf + 4 * hi;
                { const bf16_t* vp = Vt + ql * 264 + sk; const u32x2 a = *(const u32x2*)vp, b = *(const u32x2*)(vp + 8);
                  const bf16x8 vf = __builtin_bit_cast(bf16x8, ((u32x4){a.x, a.y, b.x, b.y})); o0 = __builtin_amdgcn_mfma_f32_32x32x16_bf16(vf, pf, o0, 0, 0, 0); }
                { const bf16_t* vp = Vt + (32 + ql) * 264 + sk; const u32x2 a = *(const u32x2*)vp, b = *(const u32x2*)(vp + 8);
                  const bf16x8 vf = __builtin_bit_cast(bf16x8, ((u32x4){a.x, a.y, b.x, b.y})); o1 = __builtin_amdgcn_mfma_f32_32x32x16_bf16(vf, pf, o1, 0, 0, 0); }
            }
#pragma unroll
        for (int c4 = 0; c4 < 4; ++c4) {
            u32x2 w0, w1;
            w0.x = cvt_pk_bf16(o0[4 * c4 + 0] * inv, o0[4 * c4 + 1] * inv); w0.y = cvt_pk_bf16(o0[4 * c4 + 2] * inv, o0[4 * c4 + 3] * inv);
            w1.x = cvt_pk_bf16(o1[4 * c4 + 0] * inv, o1[4 * c4 + 1] * inv); w1.y = cvt_pk_bf16(o1[4 * c4 + 2] * inv, o1[4 * c4 + 3] * inv);
            *(u32x2*)(qp + 8 * c4 + 4 * hi) = w0; *(u32x2*)(qp + 32 + 8 * c4 + 4 * hi) = w1;
        }
    }
    __syncthreads();
}
__device__ __forceinline__ void attn_sample_task(float* wl, bf16_t* Q, const bf16_t* KB, const bf16_t* VB, const float* ck, const float* cv, const float* sinks, int b, int g, int lane) {
    float* qs = wl; float* pp = wl + 256;
    bf16_t* qrow = Q + (size_t)(SEQ + b) * 1024 + 4 * g * 64;
#pragma unroll
    for (int h = 0; h < 4; ++h) qs[h * 64 + lane] = bf2f(qrow[h * 64 + lane]) * 0.125f;
    const float knew = bf2f(KB[(size_t)(SEQ + b) * 256 + 64 * g + lane]), vnew = bf2f(VB[(size_t)(SEQ + b) * 256 + 64 * g + lane]);
    asm volatile("s_waitcnt lgkmcnt(0)" ::: "memory");
    float sc[2][4];
#pragma unroll
    for (int kk = 0; kk < 2; ++kk) { const int s = lane + 64 * kk; const f32x4* kp = (const f32x4*)(ck + ((size_t)(b * 128 + s) * 4 + g) * 64);
        float a0 = 0.f, a1 = 0.f, a2 = 0.f, a3 = 0.f;
#pragma unroll 4
        for (int c = 0; c < 16; ++c) { const f32x4 kv = kp[c];
            const f32x4 q0 = *(const f32x4*)(qs + 4 * c), q1 = *(const f32x4*)(qs + 64 + 4 * c), q2 = *(const f32x4*)(qs + 128 + 4 * c), q3 = *(const f32x4*)(qs + 192 + 4 * c);
            a0 += kv[0] * q0[0] + kv[1] * q0[1] + kv[2] * q0[2] + kv[3] * q0[3]; a1 += kv[0] * q1[0] + kv[1] * q1[1] + kv[2] * q1[2] + kv[3] * q1[3];
            a2 += kv[0] * q2[0] + kv[1] * q2[1] + kv[2] * q2[2] + kv[3] * q2[3]; a3 += kv[0] * q3[0] + kv[1] * q3[1] + kv[2] * q3[2] + kv[3] * q3[3]; }
        sc[kk][0] = a0; sc[kk][1] = a1; sc[kk][2] = a2; sc[kk][3] = a3; }
#pragma unroll
    for (int h = 0; h < 4; ++h) {
        const float sn = wave_sum(qs[h * 64 + lane] * knew), sink = sinks[4 * g + h];
        float m = wave_max(fmaxf(sc[0][h], sc[1][h])); m = fmaxf(fmaxf(m, sn), sink);
        const float e0 = __expf(sc[0][h] - m), e1 = __expf(sc[1][h] - m), en = __expf(sn - m);
        const float inv = 1.0f / (wave_sum(e0 + e1) + en + __expf(sink - m));
        pp[lane * 4 + h] = e0 * inv; pp[(64 + lane) * 4 + h] = e1 * inv; if (lane == 0) pp[512 + h] = en * inv;
    }
    asm volatile("s_waitcnt lgkmcnt(0)" ::: "memory");
    float o0 = 0.f, o1 = 0.f, o2 = 0.f, o3 = 0.f;
    const float* vp = cv + ((size_t)(b * 128) * 4 + g) * 64 + lane;
#pragma unroll 8
    for (int s = 0; s < 128; ++s) { const float v = vp[(size_t)s * 256]; const f32x4 pv = *(const f32x4*)(pp + 4 * s); o0 += pv[0] * v; o1 += pv[1] * v; o2 += pv[2] * v; o3 += pv[3] * v; }
    { const f32x4 pv = *(const f32x4*)(pp + 512); o0 += pv[0] * vnew; o1 += pv[1] * vnew; o2 += pv[2] * vnew; o3 += pv[3] * vnew; }
    qrow[lane] = (bf16_t)(cvt_pk_bf16(o0, 0.f) & 0xffffu); qrow[64 + lane] = (bf16_t)(cvt_pk_bf16(o1, 0.f) & 0xffffu);
    qrow[128 + lane] = (bf16_t)(cvt_pk_bf16(o2, 0.f) & 0xffffu); qrow[192 + lane] = (bf16_t)(cvt_pk_bf16(o3, 0.f) & 0xffffu);
    asm volatile("s_waitcnt lgkmcnt(0)" ::: "memory");
}


#if SELFCHECK
constexpr size_t WS_CHK = 512 * 1024;
__device__ __forceinline__ unsigned hsh(unsigned x) { x ^= x >> 16; x *= 0x7feb352du; x ^= x >> 15; x *= 0x846ca68bu; x ^= x >> 16; return x; }
__device__ __forceinline__ int samp_row(int s) {
    if ((s & 3) == 0) { switch ((s >> 2) & 7) { case 0: return 0; case 1: return 1; case 2: return 255; case 3: return 256; case 4: return SEQ - 1; case 5: return SEQ; case 6: return SEQ + 100; default: return 8191; } }
    if ((s & 3) == 1) return SEQ + (int)(hsh(s) % NS);
    return (int)(hsh(s * 3 + 1) % SEQ);
}
__device__ __forceinline__ bool chk_bad(float got, float ref) { return !(fabsf(got - ref) <= 0.05f * fabsf(ref) + 0.04f); }
__device__ __forceinline__ float wdot_bf(const bf16_t* a, const float* W, int ldw, int col, int K, int lane) {
    float s = 0.f; for (int k = lane; k < K; k += 64) s += bf2f(a[k]) * W[(size_t)k * ldw + col]; return wave_sum(s); }
#define CHK_FAIL(bit) do { if (lane == 0) atomicOr(mask, 1u << (bit)); } while (0)
#endif

template <int KLEN>
__device__ __forceinline__ f32x4 mini_kloop(const bf16_t* Arow, const bf16_t* Brow, f32x4 acc) {
    constexpr int NS_ = KLEN / 32;
    static_assert(KLEN % 32 == 0, "K quarter");
#pragma unroll 1
    for (int s0 = 0; s0 < NS_; s0 += 8) {
        bf16x8 a[8], b[8];
#pragma unroll
        for (int i = 0; i < 8; ++i) if (s0 + i < NS_) { a[i] = *(const bf16x8*)(Arow + (s0 + i) * 32); b[i] = *(const bf16x8*)(Brow + (s0 + i) * 32); }
#pragma unroll
        for (int i = 0; i < 8; ++i) if (s0 + i < NS_) acc = __builtin_amdgcn_mfma_f32_16x16x32_bf16(b[i], a[i], acc, 0, 0, 0);
    }
    return acc;
}
struct MiniArgs { const bf16_t* A0; const bf16_t* B0; const bf16_t* A1; const bf16_t* B1; const bf16_t* GA; const bf16_t* GB; bf16_t* Z; const float* base; float* out; const float* ADA; int goff; };
template <int MODE, int K>
__device__ __forceinline__ void mini_sample_gemm(unsigned char* lds, const MiniArgs& P, int bid, int G, int wave, int lane) {
    const int fr = lane & 15, fq = lane >> 4, tl = wave >> 2, kq = wave & 3;
    f32x4* red = (f32x4*)lds;
    for (int T0 = 2 * bid; T0 < 512; T0 += 2 * G) {
        const int T = T0 + tl, rt = T & 7, ct = T >> 3;
        const int row = SEQ + 16 * rt + fr, colb = 16 * ct + fr;
        const size_t ko = (size_t)kq * (K / 4) + 8 * fq;
        f32x4 acc0 = (f32x4){0.f, 0.f, 0.f, 0.f}, acc1 = acc0;
        acc0 = mini_kloop<K / 4>(P.A0 + (size_t)row * K + ko, P.B0 + (size_t)colb * K + ko, acc0);
        if (MODE == 0) acc1 = mini_kloop<K / 4>(P.A1 + (size_t)row * K + ko, P.B1 + (size_t)colb * K + ko, acc1);
        red[wave * 64 + lane] = acc0; if (MODE == 0) red[512 + wave * 64 + lane] = acc1;
        __syncthreads();
        if (kq == 0) {
            f32x4 s0 = red[wave * 64 + lane] + red[(wave + 1) * 64 + lane] + red[(wave + 2) * 64 + lane] + red[(wave + 3) * 64 + lane];
            const int col = 16 * ct + 4 * fq;
            if (MODE == 0) {
                const f32x4 s1 = red[512 + wave * 64 + lane] + red[512 + (wave + 1) * 64 + lane] + red[512 + (wave + 2) * 64 + lane] + red[512 + (wave + 3) * 64 + lane];
                const u32x2 ga = *(const u32x2*)(P.GA + (size_t)row * 1024 + col), gb = *(const u32x2*)(P.GB + (size_t)row * 1024 + col);
                const float z0 = sigmoidf_(bf2f(ga.x & 0xffffu)) * s0[0] + sigmoidf_(bf2f(gb.x & 0xffffu)) * s1[0], z1 = sigmoidf_(bf2f(ga.x >> 16)) * s0[1] + sigmoidf_(bf2f(gb.x >> 16)) * s1[1];
                const float z2 = sigmoidf_(bf2f(ga.y & 0xffffu)) * s0[2] + sigmoidf_(bf2f(gb.y & 0xffffu)) * s1[2], z3 = sigmoidf_(bf2f(ga.y >> 16)) * s0[3] + sigmoidf_(bf2f(gb.y >> 16)) * s1[3];
                u32x2 w; w.x = cvt_pk_bf16(z0, z1); w.y = cvt_pk_bf16(z2, z3); *(u32x2*)(P.Z + (size_t)row * 1024 + col) = w;
            } else if (MODE == 2) {
                const int b = row - SEQ; const f32x4 g = *(const f32x4*)(P.ADA + (size_t)b * NADA + P.goff + col); const f32x4 d = g * s0;
                u32x2 w; w.x = cvt_pk_bf16(d[0], d[1]); w.y = cvt_pk_bf16(d[2], d[3]); *(u32x2*)(P.Z + (size_t)row * 1024 + col) = w;
            } else {
                const int b = row - SEQ;
                const f32x4 bs = *(const f32x4*)(P.base + (size_t)b * 1024 + col), g = *(const f32x4*)(P.ADA + (size_t)b * NADA + P.goff + col);
                *(f32x4*)(P.out + (size_t)row * 1024 + col) = bs + g * s0;
            }
        }
        __syncthreads();
    }
}

__device__ __forceinline__ void ada_block(unsigned char* lds, const float* cs, const float* cp, const float* W, const float* bias, float* ADAo, int pair, int wave, int lane) {
    const int fr = lane & 15, fq = lane >> 4, tl = wave >> 2, kq = wave & 3, c0 = 16 * (2 * pair + tl);
    f32x4 acc[9];
#pragma unroll
    for (int rt = 0; rt < 9; ++rt) acc[rt] = (f32x4){0.f, 0.f, 0.f, 0.f};
#pragma unroll 1
    for (int ks = 0; ks < 8; ++ks) {
        const int k0 = 256 * kq + 32 * ks + 8 * fq;
        float wv[8];
#pragma unroll
        for (int j = 0; j < 8; ++j) wv[j] = W[(size_t)(k0 + j) * NADA + c0 + fr];
        f32x4 a0[9], a1[9];
#pragma unroll
        for (int rt = 0; rt < 9; ++rt) { const int row = 16 * rt + fr; const float* cr = (row < 128) ? cs + (size_t)row * 1024 : cp;
            a0[rt] = *(const f32x4*)(cr + k0); a1[rt] = *(const f32x4*)(cr + k0 + 4); }
        u32x4 bw; bw.x = cvt_pk_bf16(wv[0], wv[1]); bw.y = cvt_pk_bf16(wv[2], wv[3]); bw.z = cvt_pk_bf16(wv[4], wv[5]); bw.w = cvt_pk_bf16(wv[6], wv[7]);
        const bf16x8 bfrag = __builtin_bit_cast(bf16x8, bw);
#pragma unroll
        for (int rt = 0; rt < 9; ++rt) { const bool ok = (16 * rt + fr) <= 128;
            u32x4 aw; aw.x = cvt_pk_bf16(siluf_(a0[rt][0]), siluf_(a0[rt][1])); aw.y = cvt_pk_bf16(siluf_(a0[rt][2]), siluf_(a0[rt][3]));
            aw.z = cvt_pk_bf16(siluf_(a1[rt][0]), siluf_(a1[rt][1])); aw.w = cvt_pk_bf16(siluf_(a1[rt][2]), siluf_(a1[rt][3]));
            if (!ok) aw = (u32x4){0u, 0u, 0u, 0u};
            acc[rt] = __builtin_amdgcn_mfma_f32_16x16x32_bf16(bfrag, __builtin_bit_cast(bf16x8, aw), acc[rt], 0, 0, 0); }
    }
    f32x4* red = (f32x4*)lds;
#pragma unroll
    for (int rt = 0; rt < 9; ++rt) red[(wave * 9 + rt) * 64 + lane] = acc[rt];
    __syncthreads();
    if (kq == 0) {
        const f32x4 bv = *(const f32x4*)(bias + c0 + 4 * fq);
#pragma unroll
        for (int rt = 0; rt < 9; ++rt) { const int row = 16 * rt + fr;
            const f32x4 sum = red[(wave * 9 + rt) * 64 + lane] + red[((wave + 1) * 9 + rt) * 64 + lane] + red[((wave + 2) * 9 + rt) * 64 + lane] + red[((wave + 3) * 9 + rt) * 64 + lane];
            if (row <= 128) *(f32x4*)(ADAo + (size_t)row * NADA + c0 + 4 * fq) = sum + bv; }
    }
    __syncthreads();
}

#define LAS __attribute__((address_space(3)))
#define XB_TMO      128
#define XB_XCNT(j)  (256  + 64 * (j))
#define XB_XSUB(j)  (1280 + 64 * (j))
#define XB_XGEN(j)  (2304 + 64 * (j))
#define XB_TOP      3328
#define XB_TOPGEN   3392
#define XCD_BAR_WORDS 3456
#define XB_SPIN_CAP (1u << 22)
constexpr size_t WS_BAR = 64 * 1024;
constexpr int MISC_OFF = 146432;
constexpr size_t WS_SS = 768 * 1024;
constexpr size_t WS_C0 = WS_BAR + 16384;
constexpr size_t BAR_ZERO_BYTES = (WS_C0 - WS_BAR) + 22528;
__device__ __forceinline__ unsigned xb_ld(unsigned* p)              { return __hip_atomic_load(p, __ATOMIC_RELAXED, __HIP_MEMORY_SCOPE_AGENT); }
__device__ __forceinline__ unsigned xb_add(unsigned* p, unsigned v) { return __hip_atomic_fetch_add(p, v, __ATOMIC_RELAXED, __HIP_MEMORY_SCOPE_AGENT); }
__device__ __forceinline__ unsigned xb_xcc_id() { return (unsigned)__builtin_amdgcn_s_getreg((3 << 11) | 20) & 0xFu; }
#define XB_SPIN(cond, bar) do { unsigned _sp = 0; while (cond) { __builtin_amdgcn_s_sleep(1); \
    if ((++_sp & 255u) == 0u) { if (xb_ld(&(bar)[XB_TMO])) break; if (_sp > XB_SPIN_CAP) { atomicAdd(&(bar)[XB_TMO], 1u); break; } } } } while (0)
struct XcdBarrier { unsigned* bar; unsigned x; volatile LAS unsigned* st; };
__device__ __forceinline__ XcdBarrier xcd_barrier_post(unsigned* bar, volatile LAS unsigned* st, bool leader) {
    XcdBarrier b; b.bar = bar; b.x = xb_xcc_id(); b.st = st;
    if (leader) (void)xb_add(&bar[XB_XCNT(b.x)], 1u);
    return b;
}
__device__ __forceinline__ void xcd_barrier_complete(unsigned* bar, unsigned x, unsigned& nloc, unsigned& nx) {
    const unsigned G = gridDim.x * gridDim.y * gridDim.z;
    unsigned sum, cnt, mine, sp = 0u;
    for (;;) {
        sum = 0u; cnt = 0u; mine = 0u;
#pragma unroll
        for (unsigned j = 0; j < 16; ++j) { const unsigned c = xb_ld(&bar[XB_XCNT(j)]); sum += c; cnt += (c > 0u) ? 1u : 0u; mine = (j == x) ? c : mine; }
        if (sum == G) break;
        __builtin_amdgcn_s_sleep(1);
        if ((++sp & 255u) == 0u) { if (xb_ld(&bar[XB_TMO])) break; if (sp > XB_SPIN_CAP) { atomicAdd(&bar[XB_TMO], 1u); break; } }
    }
    nloc = mine > 0u ? mine : 1u; nx = cnt > 0u ? cnt : 1u;
}
__device__ __forceinline__ void xcd_barrier_core(const XcdBarrier& b, bool leader) {
    if (leader) {
        unsigned* bar = b.bar;
        __builtin_amdgcn_s_waitcnt(0);
        unsigned nloc = b.st[0], nx = b.st[1];
        if (nloc == 0u) { xcd_barrier_complete(bar, b.x, nloc, nx); b.st[0] = nloc; b.st[1] = nx; }
        const unsigned old = xb_add(&bar[XB_XSUB(b.x)], 1u);
        const unsigned gen = old / nloc;
        if (old + 1u == (gen + 1u) * nloc) {
            __builtin_amdgcn_fence(__ATOMIC_RELEASE, "agent");
            asm volatile("s_waitcnt vmcnt(0)" ::: "memory");
            const unsigned og = xb_add(&bar[XB_TOP], 1u);
            const unsigned tg = og / nx;
            if (og + 1u == (tg + 1u) * nx) xb_add(&bar[XB_TOPGEN], 1u);
            else XB_SPIN(xb_ld(&bar[XB_TOPGEN]) == tg, bar);
            __builtin_amdgcn_fence(__ATOMIC_ACQUIRE, "agent");
            xb_add(&bar[XB_XGEN(b.x)], 1u);
            asm volatile("s_waitcnt vmcnt(0)" ::: "memory");
        } else {
            XB_SPIN(xb_ld(&bar[XB_XGEN(b.x)]) == gen, bar);
            __builtin_amdgcn_fence(__ATOMIC_ACQUIRE, "agent");
            asm volatile("s_waitcnt vmcnt(0)" ::: "memory");
        }
    }
}
struct Args { const float* in[23]; float* out; unsigned char* ws; };
enum { I_XP = 0, I_XS, I_CP, I_CS, I_SCA, I_CK, I_CV, I_SFF, I_WADA, I_BADA, I_GMIX, I_WIN, I_CAW, I_SINK, I_WAO, I_WBO, I_WO, I_GFFN, I_WUP, I_FCW, I_FCB, I_WDN, I_GFIN };

typedef const __attribute__((address_space(4))) Args* KArgsP;
__device__ __forceinline__ void shadow_work(KArgsP ap, unsigned nb, int w7, int bid, int G, int lane, unsigned char* lds) {
    const int sw = bid * 7 + w7, NSW = G * 7;
    float* scr = (float*)(lds + (w7 + 1) * 16384);
    unsigned char* ws = ap->ws;
    if (nb == 1u) {
        for (int it = sw; it < 16 * (NIN / 32); it += NSW) { const int nbk = NIN / 32, kb = it / nbk, n0 = 32 * (it % nbk);
            transpose_item(ap->in[I_WIN], 1024, NIN, (bf16_t*)(ws + WS_WIN), 64 * kb, n0, win_drow(n0), scr, lane); }
    } else if (nb == 2u || nb == 3u) {
        constexpr int I_UPS = 16 * (FF2 / 32), SPLIT_ = 1024;
        if (nb == 2u) for (int r = sw; r < 3 * 512; r += NSW) { const int which = r / 512, q = r % 512, kb = q / 32, n0 = 32 * (q % 32);
            transpose_item(ap->in[which == 0 ? I_WAO : (which == 1 ? I_WBO : I_WO)], 1024, 1024, (bf16_t*)(ws + (which == 0 ? WS_WA : (which == 1 ? WS_WB : WS_WO))), 64 * kb, n0, n0, scr, lane); }
        for (int it = (nb == 2u ? 0 : SPLIT_) + sw; it < (nb == 2u ? SPLIT_ : I_UPS); it += NSW) { const int nbk = FF2 / 32, kb = it / nbk, n0 = 32 * (it % nbk);
            transpose_item(ap->in[I_WUP], 1024, FF2, (bf16_t*)(ws + WS_WUP), 64 * kb, n0, wup_drow(n0), scr, lane); }
        if (nb == 2u)
            for (int t = sw; t < 88 * 16; t += NSW) { const int cgp = t % 88, ks = t / 88, col = 64 * cgp + lane;
                const float* Wp = ap->in[I_WUP] + (size_t)(64 * ks) * FF2 + col; const float* sh = (const float*)(ws + WS_ADA) + (size_t)128 * NADA + 3072 + 64 * ks;
                float a = 0.f;
#pragma unroll 16
                for (int k = 0; k < 64; ++k) a += sh[k] * Wp[(size_t)k * FF2];
                (void)__hip_atomic_fetch_add((float*)(ws + WS_C0) + col, a, __ATOMIC_RELAXED, __HIP_MEMORY_SCOPE_AGENT); }
    } else if (nb == 4u) {
        for (int it = sw; it < (FF / 64) * 32; it += NSW) { const int kb = it / 32, n0 = 32 * (it % 32); transpose_item(ap->in[I_WDN], FF, 1024, (bf16_t*)(ws + WS_WDN), 64 * kb, n0, n0, scr, lane); }
    }
    if (nb == 4u || nb == 5u) {
        const float* ck_ = ap->in[I_CK]; const float* cv_ = ap->in[I_CV]; const bf16_t* kb_ = (const bf16_t*)(ws + WS_KB); const bf16_t* vb_ = (const bf16_t*)(ws + WS_VB); float* out = ap->out;
        const long st = (long)sw * 64 + lane, NST = (long)NSW * 64; const long lo = (nb == 4u) ? 0 : 1048576, hi = lo + 1048576;
#pragma unroll 4
        for (long i = lo + st; i < hi; i += NST) {
            const int which = (int)(i >> 20); const int r2 = (int)(i & 1048575); const int b = r2 >> 13, r = (r2 >> 6) & 127, c = r2 & 63;
            const float* cache = which ? cv_ : ck_; const bf16_t* nbp = which ? vb_ : kb_;
            f32x4 v;
            if (r < 127) v = *(const f32x4*)(cache + ((size_t)(b * 128 + r + 1) * 256 + 4 * c));
            else { const u32x2 w = *(const u32x2*)(nbp + (size_t)(SEQ + b) * 256 + 4 * c); v = (f32x4){bf2f(w.x & 0xffffu), bf2f(w.x >> 16), bf2f(w.y & 0xffffu), bf2f(w.y >> 16)}; }
            *(f32x4*)(out + (which ? O_VS : O_KS) + (size_t)r2 * 4) = v;
        }
        if (nb == 4u) for (long i = st; i < 2L * 128 * 64; i += NST) {
            const int which = (int)(i >> 13); const int r2 = (int)(i & 8191); const int r = r2 >> 6, c = r2 & 63; const bf16_t* nbp = which ? vb_ : kb_;
            const u32x2 w = *(const u32x2*)(nbp + (size_t)(SEQ - 128 + r) * 256 + 4 * c);
            *(f32x4*)(out + (which ? O_VP : O_KP) + (size_t)r2 * 4) = (f32x4){bf2f(w.x & 0xffffu), bf2f(w.x >> 16), bf2f(w.y & 0xffffu), bf2f(w.y >> 16)};
        }
    }
}

__global__ void __launch_bounds__(512, 2) mega(Args a) {
    extern __shared__ __attribute__((aligned(16))) unsigned char lds[];
    PG8_LAS unsigned char* ldsl = (PG8_LAS unsigned char*)lds;
    const int G = gridDim.x, bid = blockIdx.x, NGW = G * 8;
    const int wave0 = __builtin_amdgcn_readfirstlane((int)threadIdx.x >> 6);
    const long NGT = (long)G * 512;
#define PHASE_IDS() int tid = wave0 * 64 + (int)lane_id_now(); asm volatile("" : "+v"(tid)); const int lane = tid & 63, wave = wave0; \
    const int gw = bid * 8 + wave; const long gt = (long)bid * 512 + tid; float* const scr = (float*)(lds + wave * 16384); (void)lane; (void)gw; (void)gt; (void)scr;
    typedef const __attribute__((address_space(4))) Args* KArgs;
    const KArgs ap0 = (KArgs)__builtin_amdgcn_kernarg_segment_ptr();
#define ARGS() ({ KArgs p_ = ap0; asm volatile("" : "+s"(p_)); p_; })
#define IN(i) (ARGS()->in[i])
#define WS(off) (ARGS()->ws + (off))
#define OUT() (ARGS()->out)
#define AADA ((bf16_t*)WS(WS_AADA))
#define ADA ((float*)WS(WS_ADA))
#define WA ((bf16_t*)WS(WS_WA))
#define WB ((bf16_t*)WS(WS_WB))
#define WO ((bf16_t*)WS(WS_WO))
#define WADA ((bf16_t*)WS(WS_WADA))
#define WIN ((bf16_t*)WS(WS_WIN))
#define WUP ((bf16_t*)WS(WS_WUP))
#define WDN ((bf16_t*)WS(WS_WDN))
#define H ((bf16_t*)WS(WS_H))
#define U ((bf16_t*)WS(WS_U))
#define BG ((bf16_t*)WS(WS_BG))
#define Q ((bf16_t*)WS(WS_Q))
#define KB ((bf16_t*)WS(WS_KB))
#define VB ((bf16_t*)WS(WS_VB))
#define GA ((bf16_t*)WS(WS_GA))
#define GB ((bf16_t*)WS(WS_GB))
#define GG ((bf16_t*)WS(WS_G))
#define AIN H
#define Z U
#define H2 BG
    if (gridDim.x == 0x7fffffffu) cg::this_grid().sync();
    if (threadIdx.x < 2) ((volatile LAS unsigned*)(ldsl + MISC_OFF))[threadIdx.x] = 0u;
    __syncthreads();
#define LEADER() (wave0 == 0 && lane_id_now() == 0u)
    const XcdBarrier xbar = xcd_barrier_post((unsigned*)WS(WS_BAR), (volatile LAS unsigned*)(ldsl + MISC_OFF), LEADER());
    unsigned nbar_ = 0u;
#define GRID_SYNC() do { ++nbar_; asm volatile("s_waitcnt vmcnt(0)" ::: "memory"); __syncthreads(); \
        if (wave0 == 0) xcd_barrier_core(xbar, LEADER()); else shadow_work((KArgsP)ap0, nbar_, wave0 - 1, bid, G, (int)lane_id_now(), lds); \
        __syncthreads(); } while (0)

#if TIMESEL >= 0
#define STAMP(k) do { if (bid == 0 && threadIdx.x == 0) ((unsigned long long*)WS(768 * 1024))[k] = __builtin_amdgcn_s_memrealtime(); } while (0)
#else
#define STAMP(k) do {} while (0)
#endif
    STAMP(0);
    {
        PHASE_IDS();
        {   const float* const cs = IN(I_CS); const float* const cp = IN(I_CP); const float* const wad = IN(I_WADA); const float* const bad = IN(I_BADA); float* const ada = ADA;
            for (int pr = bid; pr < NADA / 32; pr += G) ada_block(lds, cs, cp, wad, bad, ada, pr, wave, lane); }
        if (bid >= NADA / 32) {
            const f32x4* xp4 = (const f32x4*)IN(I_XP); const long nidle = (long)(G - NADA / 32) * 512, me = (long)(bid - NADA / 32) * 512 + tid; f32x4 sink = (f32x4){0.f, 0.f, 0.f, 0.f};
#pragma unroll 8
            for (long i = me; i < (long)SEQ * 256; i += nidle) sink += xp4[i];
            asm volatile("" :: "v"(sink)); }
    }
    GRID_SYNC();
    STAMP(1);
    STAMP(2);
    {
        PHASE_IDS();
        norm_phase<0>(IN(I_XP), IN(I_XS), IN(I_GMIX), ADA, 1024, 0, H, nullptr, gw, NGW, lane);
    }
    GRID_SYNC();
    STAMP(3);
    {
        typedef Sched<0, 2048, 2048> SC; SC S; S.to.init(NMT, NIN / 256); S.G = G; S.c = bid; S.A0 = (const char*)H; S.B0 = (const char*)WIN;
        EpiProj E{U, BG, Q, KB, VB, GA, GB};
        pg8::gemm_phase<EpiProj, SC, 1024, 1024, 1024, true, true>(ldsl, wave0, S, E);
    }
    GRID_SYNC();
    STAMP(4);
    {
        PHASE_IDS();
        {   bf16_t* const q_ = Q; const bf16_t* const kb_ = KB; const bf16_t* const vb_ = VB; const float* const sinks = IN(I_SINK);
            for (int un = bid; un < 512; un += G) attn_prompt_unit(lds, q_, kb_, vb_, sinks, un >> 2, un & 3, tid); }
        {   bf16_t* const q_ = Q; const bf16_t* const kb_ = KB; const bf16_t* const vb_ = VB; const float* const sinks = IN(I_SINK);
            const float* const ck_ = IN(I_CK); const float* const cv_ = IN(I_CV);
            float* wl = (float*)(lds + 123392 + (wave >> 2) * 4096);
            for (int t4 = gw; t4 < 2048; t4 += NGW) if ((t4 & 3) == 0) { const int t = t4 >> 2; attn_sample_task(wl, q_, kb_, vb_, ck_, cv_, sinks, t >> 2, t & 3, lane); } }
        const bool worker = (wave & 3) != 0; const long wt = ((long)bid * 6 + (wave - 1 - (wave > 4 ? 1 : 0))) * 64 + lane, NWT = (long)G * 6 * 64;
        {
        float* const out = OUT();
        const float* caw = IN(I_CAW); const float* sca = IN(I_SCA); const bf16_t* const u_ = U; const bf16_t* const bg_ = BG; bf16_t* const ain_ = AIN;
        if (worker)
        for (long it = wt; it < (long)(SEQ / 8) * 128 + (long)NS * 128; it += NWT) {
            const bool smp = it >= (long)(SEQ / 8) * 128; const long it2 = smp ? it - (long)(SEQ / 8) * 128 : it;
            const int row0 = smp ? SEQ + (int)(it2 >> 7) : (int)(it2 >> 7) * 8, c8 = (int)(it2 & 127) * 8; const int nr = smp ? 1 : 8;
            float w0[8], w1[8], w2[8], u0[8], u1[8];
            *(f32x4*)w0 = *(const f32x4*)(caw + c8); *(f32x4*)(w0 + 4) = *(const f32x4*)(caw + c8 + 4);
            *(f32x4*)w1 = *(const f32x4*)(caw + 1024 + c8); *(f32x4*)(w1 + 4) = *(const f32x4*)(caw + 1024 + c8 + 4);
            *(f32x4*)w2 = *(const f32x4*)(caw + 2048 + c8); *(f32x4*)(w2 + 4) = *(const f32x4*)(caw + 2048 + c8 + 4);
            if (row0 < SEQ) {
                if (row0 >= 2) { unpack8(*(const u32x4*)(u_ + (size_t)(row0 - 2) * 1024 + c8), u0); unpack8(*(const u32x4*)(u_ + (size_t)(row0 - 1) * 1024 + c8), u1); }
                else { for (int i = 0; i < 8; ++i) { u0[i] = 0.f; u1[i] = 0.f; } }
#pragma unroll 4
                for (int r = 0; r < 8; ++r) { const int row = row0 + r; float u2[8], bg[8], o[8];
                    unpack8(*(const u32x4*)(u_ + (size_t)row * 1024 + c8), u2); unpack8(*(const u32x4*)(bg_ + (size_t)row * 1024 + c8), bg);
#pragma unroll
                    for (int i = 0; i < 8; ++i) { o[i] = bg[i] * (w0[i] * u0[i] + w1[i] * u1[i] + w2[i] * u2[i]); u0[i] = u1[i]; u1[i] = u2[i]; }
                    *(u32x4*)(ain_ + (size_t)row * 1024 + c8) = pack8(o);
                    if (row >= SEQ - 2) { float* op = out + O_CAP + (size_t)(row - (SEQ - 2)) * 1024 + c8; *(f32x4*)op = (f32x4){u2[0], u2[1], u2[2], u2[3]}; *(f32x4*)(op + 4) = (f32x4){u2[4], u2[5], u2[6], u2[7]}; } }
            } else {
                for (int r = 0; r < nr; ++r) { const int row = row0 + r, b = row - SEQ; float u2[8], bg[8], o[8];
                    const float* s0 = sca + (size_t)(b * 2) * 1024 + c8; const float* s1 = s0 + 1024;
                    *(f32x4*)u0 = *(const f32x4*)s0; *(f32x4*)(u0 + 4) = *(const f32x4*)(s0 + 4); *(f32x4*)u1 = *(const f32x4*)s1; *(f32x4*)(u1 + 4) = *(const f32x4*)(s1 + 4);
                    unpack8(*(const u32x4*)(u_ + (size_t)row * 1024 + c8), u2); unpack8(*(const u32x4*)(bg_ + (size_t)row * 1024 + c8), bg);
#pragma unroll
                    for (int i = 0; i < 8; ++i) o[i] = bg[i] * (w0[i] * u0[i] + w1[i] * u1[i] + w2[i] * u2[i]);
                    *(u32x4*)(ain_ + (size_t)row * 1024 + c8) = pack8(o);
                    float* op = out + O_CAS + (size_t)(b * 2) * 1024 + c8;
                    *(f32x4*)op = *(f32x4*)u1; *(f32x4*)(op + 4) = *(f32x4*)(u1 + 4); *(f32x4*)(op + 1024) = (f32x4){u2[0], u2[1], u2[2], u2[3]}; *(f32x4*)(op + 1024 + 4) = (f32x4){u2[4], u2[5], u2[6], u2[7]}; }
            }
        }
        }
    }
    GRID_SYNC();
    STAMP(5);
    {
        typedef Sched<1, 2048, 2048> SC; SC S; S.to.init(SEQ / 256, 4); S.G = G; S.c = bid; S.A0 = (const char*)AIN; S.B0 = (const char*)WA; S.A1 = (const char*)Q; S.B1 = (const char*)WB;
        EpiMix E{GA, GB, OUT(), Z};
        pg8::gemm_phase<EpiMix, SC, 1024, 1024, 1024, true, true>(ldsl, wave0, S, E);
        { PHASE_IDS(); MiniArgs P{AIN, WA, Q, WB, GA, GB, Z, nullptr, nullptr, nullptr, 0}; mini_sample_gemm<0, 1024>(lds, P, bid, G, wave, lane); }
    }
    GRID_SYNC();
    STAMP(6);
    {
        typedef Sched<0, 2048, 2048> SC; SC S; S.to.init(SEQ / 256, 4); S.G = G; S.c = bid; S.A0 = (const char*)Z; S.B0 = (const char*)WO;
        EpiRes4 E{IN(I_XP), OUT(), ADA, IN(I_GFFN), H2, (float*)WS(WS_SS)};
        pg8::gemm_phase<EpiRes4, SC, 1024, 1024, 1024, true, true>(ldsl, wave0, S, E);
        { PHASE_IDS(); if (gt < 256) *(u32x4*)((unsigned char*)H2 - 4096 + gt * 16) = (u32x4){0u, 0u, 0u, 0u}; }
        { PHASE_IDS(); MiniArgs P{Z, WO, nullptr, nullptr, nullptr, nullptr, nullptr, IN(I_XS), OUT(), ADA, 2048}; mini_sample_gemm<1, 1024>(lds, P, bid, G, wave, lane); }
    }
    GRID_SYNC();
    STAMP(8);
    {
        typedef Sched<2, 2048, 2048> SC; SC S; S.to.init(G >= 64 ? NPT5 : NPT5 + 1, FF2 / 256); S.G = G; S.c = bid; S.A0 = (const char*)H2; S.B0 = (const char*)WUP;
        {
            PHASE_IDS(); bool has = false; Unit u; for (int i = 0; S.next(i, u); ++i) has = has || (u.pm == NPT5);
            if (has) norm_phase<1>(OUT(), nullptr, IN(I_GFFN), ADA, 4096, 3072, H2, nullptr, SEQ + wave, 8, lane);
            asm volatile("s_waitcnt vmcnt(0)" ::: "memory"); __syncthreads(); }
        float* const out = OUT(); EpiFfn E{GG, IN(I_FCW), IN(I_FCB), IN(I_SFF), out + O_FP, out + O_FS, (PG8_LAS float*)(ldsl + HALO_OFF), (const float*)WS(WS_SS), (const float*)WS(WS_C0)};
        pg8::gemm_phase<EpiFfn, SC, 1024, 1024, 1024, true, true>(ldsl, wave0, S, E);
    }
    GRID_SYNC();
    STAMP(9);
    {
        typedef Sched<0, FF * 2, FF * 2> SC; SC S; S.to.init(SEQ / 256, 4); S.G = G; S.c = bid; S.A0 = (const char*)GG; S.B0 = (const char*)WDN;
        { EpiDelta E{Z, ADA, 5120};
        pg8::gemm_phase<EpiDelta, SC, FF, FF, FF, true, true>(ldsl, wave0, S, E); }
        { PHASE_IDS(); MiniArgs P{GG, WDN, nullptr, nullptr, nullptr, nullptr, Z, nullptr, nullptr, ADA, 5120}; mini_sample_gemm<2, FF>(lds, P, bid, G, wave, lane); }
    }
    GRID_SYNC();
    STAMP(10);
    {
        PHASE_IDS();
        float* const out = OUT();
        norm_phase<2>(out, nullptr, IN(I_GFIN), nullptr, 0, 0, nullptr, out, gw, NGW, lane, Z);
    }
#if TIMESEL >= 0
    GRID_SYNC();
    STAMP(11);
    GRID_SYNC();
    STAMP(12);
    GRID_SYNC();
    {   PHASE_IDS(); const volatile unsigned long long* ts = (const volatile unsigned long long*)WS(768 * 1024);
        const float us = (float)(ts[TIMESEL + TIMESPAN] - ts[TIMESEL]) * 0.01f;
        const float sc = 1.006f + us * 1e-5f; float* o = OUT() + O_KS;
        for (long i = gt; i < 128L * 128 * 256; i += NGT) o[i] *= sc; }
#endif
}

extern "C" void kernel_launch(void* const* d_in, const int* in_sizes, int n_in, void* d_out, int out_size, void* d_ws, size_t ws_size, hipStream_t stream) {
    static int grid = 0;
    if (grid == 0) {
        if (n_in != 23 || ws_size < WS_END) { fprintf(stderr, "kernel_launch: unexpected n_in %d / ws %zu\n", n_in, ws_size); grid = -1; return; }
        int dev = 0, cus = 0, per_cu = 0;
        hipGetDevice(&dev); hipDeviceGetAttribute(&cus, hipDeviceAttributeMultiprocessorCount, dev);
        if (hipFuncSetAttribute((const void*)mega, hipFuncAttributeMaxDynamicSharedMemorySize, LDS_BYTES) != hipSuccess) { fprintf(stderr, "kernel_launch: hipFuncSetAttribute failed\n"); }
        hipOccupancyMaxActiveBlocksPerMultiprocessor(&per_cu, (const void*)mega, 512, LDS_BYTES);
        (void)hipGetLastError();
        if (per_cu < 1) per_cu = 1;
        grid = cus * 1;
        if (grid <= 0) grid = 256;
    }
    if (grid < 0) return;
    Args a{};
    for (int i = 0; i < 23; ++i) a.in[i] = (const float*)d_in[i];
    a.out = (float*)d_out; a.ws = (unsigned char*)d_ws;
    (void)hipMemsetAsync((char*)d_ws + WS_BAR, 0, BAR_ZERO_BYTES, stream);
    void* args[] = {&a};
    hipError_t e = hipLaunchCooperativeKernel((const void*)mega, dim3(grid), dim3(512), args, LDS_BYTES, stream);
    if (e != hipSuccess) fprintf(stderr, "cooperative launch failed: %s (grid %d)\n", hipGetErrorString(e), grid);
}
```

```cpp
#ifndef SELFCHECK
#define SELFCHECK 0
#endif
#ifndef TIMESEL
#define TIMESEL -1
#define TIMESPAN 1
#endif
#ifndef TIMESPAN
#define TIMESPAN 1
#endif
#include <hip/hip_runtime.h>
#include <hip/hip_cooperative_groups.h>
#include <cstdio>
#include <cstdint>
namespace cg = cooperative_groups;

constexpr int D = 1024, SEQ = 16384, NS = 128, MROWS = SEQ + NS, MPAD = 16640;
constexpr int NIN = 6656, FF = 2816, FF2 = 5632, NADA = 6144;
constexpr int NMT = MPAD / 256;
constexpr int NPT5 = 65;
constexpr float EPS = 1e-6f;

constexpr size_t MiB = 1u << 20;
constexpr size_t RB = (size_t)MPAD * 1024 * 2;
constexpr size_t KBB = (size_t)MPAD * 256 * 2;
constexpr size_t WS_AADA = 1 * MiB;
constexpr size_t WS_ADA = 2 * MiB;
constexpr size_t WS_WA = 8 * MiB, WS_WB = 10 * MiB, WS_WO = 12 * MiB;
constexpr size_t WS_WADA = 14 * MiB;
constexpr size_t WS_WIN = 26 * MiB;
constexpr size_t WS_WUP = 14 * MiB;
constexpr size_t WS_WDN = 25 * MiB;
constexpr size_t WS_H = 39 * MiB;
constexpr size_t WS_U = 72 * MiB;
constexpr size_t WS_BG = 105 * MiB;
constexpr size_t WS_Q = 138 * MiB;
constexpr size_t WS_KB = WS_Q + RB, WS_VB = WS_KB + KBB, WS_GA = WS_VB + KBB, WS_GB = WS_GA + RB;
constexpr size_t WS_G = WS_Q;
constexpr size_t WS_END = WS_GB + RB;
static_assert(WS_END <= 256 * MiB, "ws map");
static_assert(WS_G + (size_t)MPAD * FF * 2 <= WS_END, "G overlay");
static_assert(WS_WDN + (size_t)1024 * FF * 2 <= WS_H && WS_WUP + (size_t)FF2 * 1024 * 2 <= WS_WDN, "weights");
static_assert(WS_U + RB + 4096 <= WS_BG && WS_H + RB <= WS_U && WS_BG + RB <= WS_Q, "row buffers");

constexpr size_t O_YP = 0, O_YS = 16777216, O_CAP = 16908288, O_CAS = 16910336, O_KP = 17172480, O_KS = 17205248,
                 O_VP = 21399552, O_VS = 21432320, O_FP = 25626624, O_FS = 25637888;

constexpr int LDS_BYTES = 147456;
constexpr int HALO_OFF = 131072;

typedef unsigned short bf16_t;
typedef short bf16x8 __attribute__((ext_vector_type(8)));
typedef float f32x4 __attribute__((ext_vector_type(4)));
typedef float f32x16 __attribute__((ext_vector_type(16)));
typedef float f32x2 __attribute__((ext_vector_type(2)));
typedef unsigned u32x4 __attribute__((ext_vector_type(4)));
typedef unsigned u32x2 __attribute__((ext_vector_type(2)));

__device__ __forceinline__ float bf2f(unsigned b) { return __uint_as_float(b << 16); }
__device__ __forceinline__ unsigned cvt_pk_bf16(float lo, float hi) { unsigned r; asm volatile("v_cvt_pk_bf16_f32 %0, %1, %2" : "=v"(r) : "v"(lo), "v"(hi)); return r; }
__device__ __forceinline__ unsigned lane_id_now() { unsigned l; asm volatile("v_mbcnt_lo_u32_b32 %0, -1, 0\n\tv_mbcnt_hi_u32_b32 %0, -1, %0" : "=v"(l)); return l; }
__device__ __forceinline__ float bperm_f(float v, int byte_addr) { return __int_as_float(__builtin_amdgcn_ds_bpermute(byte_addr, __float_as_int(v))); }
__device__ __forceinline__ float sigmoidf_(float x) { return __builtin_amdgcn_rcpf(1.0f + __expf(-x)); }
__device__ __forceinline__ float siluf_(float x) { return x * __builtin_amdgcn_rcpf(1.0f + __expf(-x)); }
__device__ __forceinline__ float wave_sum(float v) {
#pragma unroll
    for (int o = 1; o < 64; o <<= 1) v += __shfl_xor(v, o);
    return v;
}
__device__ __forceinline__ float wave_max(float v) {
#pragma unroll
    for (int o = 1; o < 64; o <<= 1) v = fmaxf(v, __shfl_xor(v, o));
    return v;
}
__device__ __forceinline__ void unpack8(u32x4 w, float* f) {
    f[0] = bf2f(w.x & 0xffffu); f[1] = bf2f(w.x >> 16); f[2] = bf2f(w.y & 0xffffu); f[3] = bf2f(w.y >> 16);
    f[4] = bf2f(w.z & 0xffffu); f[5] = bf2f(w.z >> 16); f[6] = bf2f(w.w & 0xffffu); f[7] = bf2f(w.w >> 16);
}
__device__ __forceinline__ u32x4 pack8(const float* f) {
    u32x4 w; w.x = cvt_pk_bf16(f[0], f[1]); w.y = cvt_pk_bf16(f[2], f[3]); w.z = cvt_pk_bf16(f[4], f[5]); w.w = cvt_pk_bf16(f[6], f[7]); return w;
}

namespace pg8 {
#define PG8_LAS __attribute__((address_space(3)))
constexpr int BM = 256, BK = 64, HALF = 128, HTB = HALF * BK * 2, STAGE_BYTES = 8 * HTB, NXCD = 8, WGM = 8;
__host__ __device__ __forceinline__ int lds_byte(int r, int c) { const int st = (r >> 4) * 2 + (c >> 5), rr = r & 15, cc = c & 31, ob = rr * 64 + cc * 2; return st * 1024 + (ob ^ (((ob >> 9) & 1) << 5)); }
__host__ __device__ __forceinline__ void stage_rc(int b, int& R, int& C) { const int st = b / 1024, sb = b % 1024, swz = sb ^ (((sb >> 9) & 1) << 5); R = (st >> 1) * 16 + swz / 64; C = (st & 1) * 32 + (swz % 64) / 2; }
__host__ __device__ __forceinline__ int perm32(int rho) { const int n = rho >> 4, i = rho & 15; return 8 * (i >> 2) + 4 * n + (i & 3); }

struct Unit { int pm, pn, aux; const char* a; const char* b; };

struct TileOrder {
    int nM, nN, nwg;
    __device__ __forceinline__ void init(int nM_, int nN_) { nM = nM_; nN = nN_; nwg = nM * nN; }
    __device__ __forceinline__ bool tile(long L, int& pm, int& pn) const {
        if (L >= nwg) return false;
        int wgid = (int)L; { const int q = nwg / NXCD, r = nwg % NXCD, xcd = wgid % NXCD, off = wgid / NXCD; wgid = (xcd < r ? xcd * (q + 1) : r * (q + 1) + (xcd - r) * q) + off; }
        const int nig = WGM * nN, gid = wgid / nig, fm = gid * WGM, gsz = (nM - fm) < WGM ? (nM - fm) : WGM;
        pm = fm + ((wgid % nig) % gsz); pn = (wgid % nig) / gsz; return true;
    }
};

template <class Epi, class Sched, int lda, int ldb, int K, bool ALIGN_EPI, bool SP2>
__device__ __forceinline__ void gemm_phase(PG8_LAS unsigned char* lds, const int wave0, const Sched& S, const Epi& E) {
    int tid_ = wave0 * 64 + (int)lane_id_now(); asm volatile("" : "+v"(tid_));
    const int tid = tid_, wid = __builtin_amdgcn_readfirstlane(tid >> 6), lane = tid & 63, wr = wid >> 2, wc = wid & 3, fr = lane & 15, fq = lane >> 4;
    const int nt = K / BK;
    unsigned voffA[2], voffB[2];
#pragma unroll
    for (int i = 0; i < 2; ++i) { int R, C; stage_rc(tid * 16 + i * 8192, R, C); const int Rb = Epi::PERM ? ((R & ~31) + perm32(R & 31)) : R;
        voffA[i] = (unsigned)(R * lda + C) * 2u; voffB[i] = (unsigned)(Rb * ldb + C) * 2u; }
    const size_t kstep = (size_t)(BK * 2);
    const size_t hstepA = (size_t)HALF * lda * 2, hstepB = (size_t)HALF * ldb * 2;
    const unsigned ldsw = (unsigned)wid * 1024u;
    const int aoff = lds_byte(wr * 64 + fr, fq * 8), boff = lds_byte(wc * 32 + fr, fq * 8);
#define PG8_SA(b, h) (((b) * 2 + (h)) * HTB)
#define PG8_SB(b, h) ((4 + (b) * 2 + (h)) * HTB)
#define PG8_STAGE(bufoff, gbase, voff) do { _Pragma("unroll") for (int _i = 0; _i < 2; ++_i) \
        __builtin_amdgcn_global_load_lds((const unsigned*)((const char*)(gbase) + (voff)[_i]), (PG8_LAS unsigned*)(lds + (bufoff) + ldsw + _i * 8192), 16, 0, 0); } while (0)
#define PG8_LDA(dst, b, h) do { _Pragma("unroll") for (int m = 0; m < 4; ++m) _Pragma("unroll") for (int k = 0; k < 2; ++k) dst[m][k] = *(const PG8_LAS bf16x8*)(lds + PG8_SA(b, h) + aoff + m * 2048 + k * 1024); } while (0)
#define PG8_LDB(dst, b, h) do { _Pragma("unroll") for (int n = 0; n < 2; ++n) _Pragma("unroll") for (int k = 0; k < 2; ++k) dst[n][k] = *(const PG8_LAS bf16x8*)(lds + PG8_SB(b, h) + boff + n * 2048 + k * 1024); } while (0)
#define PG8_MMA(ai, bj, At, Bt) do { __builtin_amdgcn_s_setprio(1); _Pragma("unroll") for (int m = 0; m < 4; ++m) _Pragma("unroll") for (int n = 0; n < 2; ++n) _Pragma("unroll") for (int k = 0; k < 2; ++k) \
        acc[ai][bj][m][n] = __builtin_amdgcn_mfma_f32_16x16x32_bf16(Bt[n][k], At[m][k], acc[ai][bj][m][n], 0, 0, 0); __builtin_amdgcn_s_setprio(0); } while (0)
#define PG8_WAIT_V(n) asm volatile("s_waitcnt vmcnt(" #n ")" ::: "memory")
#define PG8_WAIT_L(n) asm volatile("s_waitcnt lgkmcnt(" #n ")" ::: "memory")
#define PG8_BAR __builtin_amdgcn_s_barrier()
#define PG8_SCHED __builtin_amdgcn_sched_barrier(0)
    Unit cur, nxt; int ui = 0;
    if (!S.next(0, cur)) return;
    f32x4 acc[2][2][4][2];
#pragma unroll
    for (int a = 0; a < 2; ++a)
#pragma unroll
        for (int b = 0; b < 2; ++b)
#pragma unroll
            for (int m = 0; m < 4; ++m)
#pragma unroll
                for (int n = 0; n < 2; ++n) acc[a][b][m][n] = (f32x4){0.f, 0.f, 0.f, 0.f};
    bf16x8 At[4][2], B0[2][2], B1[2][2];
    const char* cA = cur.a; const char* cB = cur.b;
    if constexpr (SP2) {
        PG8_STAGE(PG8_SB(0, 0), cB, voffB); PG8_STAGE(PG8_SB(0, 1), cB + hstepB, voffB); PG8_STAGE(PG8_SA(0, 0), cA, voffA); PG8_STAGE(PG8_SA(0, 1), cA + hstepA, voffA);
        if (wr == 1) PG8_BAR;
        PG8_WAIT_V(2); PG8_BAR;
        PG8_STAGE(PG8_SB(1, 0), cB + kstep, voffB); PG8_STAGE(PG8_SA(1, 0), cA + kstep, voffA); PG8_STAGE(PG8_SB(1, 1), cB + hstepB + kstep, voffB);
        PG8_WAIT_V(6); PG8_BAR;
    } else {
        PG8_STAGE(PG8_SB(0, 0), cB, voffB); PG8_STAGE(PG8_SA(0, 0), cA, voffA); PG8_STAGE(PG8_SB(0, 1), cB + hstepB, voffB); PG8_STAGE(PG8_SA(0, 1), cA + hstepA, voffA);
        if (wr == 1) PG8_BAR;
        PG8_WAIT_V(4); PG8_BAR;
        PG8_STAGE(PG8_SB(1, 0), cB + kstep, voffB); PG8_STAGE(PG8_SA(1, 0), cA + kstep, voffA); PG8_STAGE(PG8_SB(1, 1), cB + hstepB + kstep, voffB);
        PG8_WAIT_V(6); PG8_BAR;
    }
    for (;;) {
        const bool has_next = S.next(ui + 1, nxt);
        const char* nA = has_next ? nxt.a : cA; const char* nB = has_next ? nxt.b : cB;
        for (int t = 0; t < nt; t += 2) {
            const bool last = (t == nt - 2);
            const char* a1 = cA + (size_t)(t + 1) * kstep;
            const char* a2 = last ? nA : cA + (size_t)(t + 2) * kstep; const char* b2 = last ? nB : cB + (size_t)(t + 2) * kstep;
            const char* a3 = a2 + kstep; const char* b3 = b2 + kstep;
            if constexpr (SP2) {
            PG8_LDB(B0, 0, 0); PG8_LDB(B1, 0, 1); PG8_SCHED; PG8_LDA(At, 0, 0); PG8_STAGE(PG8_SA(1, 1), a1 + hstepA, voffA);
            PG8_WAIT_V(8); PG8_WAIT_L(0); PG8_BAR; PG8_MMA(0, 0, At, B0); PG8_MMA(0, 1, At, B1); PG8_BAR; PG8_SCHED;
            PG8_LDA(At, 0, 1); PG8_STAGE(PG8_SB(0, 0), b2, voffB); PG8_STAGE(PG8_SB(0, 1), b2 + hstepB, voffB); PG8_STAGE(PG8_SA(0, 0), a2, voffA);
            PG8_WAIT_V(8); PG8_WAIT_L(0); PG8_BAR; PG8_MMA(1, 0, At, B0); PG8_MMA(1, 1, At, B1); PG8_BAR; PG8_SCHED;
            PG8_LDB(B0, 1, 0); PG8_LDB(B1, 1, 1); PG8_SCHED; PG8_LDA(At, 1, 0); PG8_STAGE(PG8_SA(0, 1), a2 + hstepA, voffA);
            PG8_WAIT_V(8); PG8_WAIT_L(0); PG8_BAR; PG8_MMA(0, 0, At, B0); PG8_MMA(0, 1, At, B1); PG8_BAR; PG8_SCHED;
            PG8_LDA(At, 1, 1); PG8_STAGE(PG8_SB(1, 0), b3, voffB); PG8_STAGE(PG8_SB(1, 1), b3 + hstepB, voffB); PG8_STAGE(PG8_SA(1, 0), a3, voffA);
            PG8_WAIT_V(8); PG8_WAIT_L(0); PG8_BAR; PG8_MMA(1, 0, At, B0); PG8_MMA(1, 1, At, B1); PG8_BAR; PG8_SCHED;
            } else {
            PG8_LDB(B0, 0, 0); PG8_SCHED; PG8_LDA(At, 0, 0); PG8_STAGE(PG8_SA(1, 1), a1 + hstepA, voffA);
            PG8_WAIT_L(8); PG8_BAR; PG8_WAIT_L(0); PG8_MMA(0, 0, At, B0); PG8_BAR; PG8_SCHED;
            PG8_LDB(B1, 0, 1); PG8_STAGE(PG8_SB(0, 0), b2, voffB);
            PG8_BAR; PG8_WAIT_L(0); PG8_MMA(0, 1, At, B1); PG8_BAR;
            PG8_LDA(At, 0, 1); PG8_STAGE(PG8_SA(0, 0), a2, voffA);
            PG8_BAR; PG8_WAIT_L(0); PG8_MMA(1, 0, At, B0); PG8_BAR; PG8_SCHED;
            PG8_STAGE(PG8_SB(0, 1), b2 + hstepB, voffB);
            PG8_WAIT_V(6); PG8_BAR; PG8_MMA(1, 1, At, B1); PG8_BAR;
            PG8_LDB(B0, 1, 0); PG8_SCHED; PG8_LDA(At, 1, 0); PG8_STAGE(PG8_SA(0, 1), a2 + hstepA, voffA);
            PG8_WAIT_L(8); PG8_BAR; PG8_WAIT_L(0); PG8_MMA(0, 0, At, B0); PG8_BAR; PG8_SCHED;
            PG8_LDB(B1, 1, 1); PG8_STAGE(PG8_SB(1, 0), b3, voffB);
            PG8_BAR; PG8_WAIT_L(0); PG8_MMA(0, 1, At, B1); PG8_BAR;
            PG8_LDA(At, 1, 1); PG8_STAGE(PG8_SA(1, 0), a3, voffA);
            PG8_BAR; PG8_WAIT_L(0); PG8_MMA(1, 0, At, B0); PG8_BAR; PG8_SCHED;
            PG8_STAGE(PG8_SB(1, 1), b3 + hstepB, voffB);
            PG8_WAIT_V(6); PG8_BAR; PG8_MMA(1, 1, At, B1); PG8_BAR;
            }
        }
        if constexpr (ALIGN_EPI) { if (wr == 0) PG8_BAR; }
        E(acc, cur, wr, wc, fr, fq);
        if (!has_next) break;
#pragma unroll
        for (int a = 0; a < 2; ++a)
#pragma unroll
            for (int b = 0; b < 2; ++b)
#pragma unroll
                for (int m = 0; m < 4; ++m)
#pragma unroll
                    for (int n = 0; n < 2; ++n) acc[a][b][m][n] = (f32x4){0.f, 0.f, 0.f, 0.f};
        cur = nxt; cA = nA; cB = nB; ++ui;
        if constexpr (ALIGN_EPI) { if (wr == 1) PG8_BAR; }
    }
    PG8_WAIT_V(0);
    if constexpr (!ALIGN_EPI) { if (wr == 0) PG8_BAR; }
    PG8_BAR;
#undef PG8_SA
#undef PG8_SB
#undef PG8_STAGE
#undef PG8_LDA
#undef PG8_LDB
#undef PG8_MMA
#undef PG8_WAIT_V
#undef PG8_WAIT_L
#undef PG8_BAR
#undef PG8_SCHED
}
}
using pg8::Unit;

template <int MODE, int LDA_B, int LDB_B> struct Sched {
    pg8::TileOrder to; int G, c;
    const char* A0; const char* B0; const char* A1; const char* B1;
    __device__ __forceinline__ bool next(int i, Unit& u) const {
        if (MODE == 1) {
            const long L = (long)(i >> 1) * G + c; if (!to.tile(L, u.pm, u.pn)) return false;
            u.aux = i & 1;
            u.a = (u.aux ? A1 : A0) + (size_t)u.pm * 256 * LDA_B; u.b = (u.aux ? B1 : B0) + (size_t)u.pn * 256 * LDB_B; return true;
        } else {
            const long L = (long)i * G + c;
            if (MODE == 2 && G >= 64) {
                const int nS = FF2 / 256;
                if (L >= (long)to.nwg + nS) return false;
                if (L >= G - nS && L < G) { u.pm = NPT5; u.pn = (int)(L - (G - nS)); }
                else if (!to.tile(L < G - nS ? L : L - nS, u.pm, u.pn)) return false;
            } else if (!to.tile(L, u.pm, u.pn)) return false;
            u.aux = 0;
            if (MODE == 2) { const long r0 = (u.pm < NPT5) ? (254L * u.pm - 2) : (long)SEQ; u.a = A0 + r0 * (long)LDA_B; }
            else u.a = A0 + (size_t)u.pm * 256 * LDA_B;
            u.b = B0 + (size_t)u.pn * 256 * LDB_B; return true;
        }
    }
};

#define EPI_ARGS const f32x4 (&acc)[2][2][4][2], const Unit& u, int wr, int wc, int fr, int fq
struct EpiAda {
    static constexpr bool PERM = true;
    float* ADA; const float* bias;
    __device__ __forceinline__ void operator()(EPI_ARGS) const {
#pragma unroll
        for (int ai = 0; ai < 2; ++ai)
#pragma unroll
            for (int m = 0; m < 4; ++m) { const int row = 128 * ai + 64 * wr + 16 * m + fr;
#pragma unroll
                for (int bj = 0; bj < 2; ++bj) { const int col = 256 * u.pn + 128 * bj + 32 * wc + 8 * fq;
#pragma unroll
                    for (int n = 0; n < 2; ++n) { const f32x4 b = *(const f32x4*)(bias + col + 4 * n); *(f32x4*)(ADA + (size_t)row * NADA + col + 4 * n) = acc[ai][bj][m][n] + b; } } }
    }
};
struct EpiProj {
    static constexpr bool PERM = true;
    bf16_t *U, *BG, *Q, *KB, *VB, *GA, *GB;
    __device__ __forceinline__ void operator()(EPI_ARGS) const {
        const int row0 = u.pm * 256 + wr * 64 + fr;
        if (u.pn < 8) {
#pragma unroll
            for (int ai = 0; ai < 2; ++ai)
#pragma unroll
                for (int m = 0; m < 4; ++m) { const int row = row0 + 128 * ai + 16 * m;
                    const f32x4 v0 = acc[ai][0][m][0] * acc[ai][1][m][0], v1 = acc[ai][0][m][1] * acc[ai][1][m][1];
                    u32x4 w; w.x = cvt_pk_bf16(v0[0], v0[1]); w.y = cvt_pk_bf16(v0[2], v0[3]); w.z = cvt_pk_bf16(v1[0], v1[1]); w.w = cvt_pk_bf16(v1[2], v1[3]);
                    *(u32x4*)(U + (size_t)row * 1024 + 128 * u.pn + 32 * wc + 8 * fq) = w; }
        } else {
            bf16_t* dst; int ld, cb; const int pn = u.pn;
            if (pn < 12) { dst = BG; ld = 1024; cb = 256 * (pn - 8); }
            else if (pn < 16) { dst = Q; ld = 1024; cb = 256 * (pn - 12); }
            else if (pn == 16) { dst = KB; ld = 256; cb = 0; }
            else if (pn == 17) { dst = VB; ld = 256; cb = 0; }
            else if (pn < 22) { dst = GA; ld = 1024; cb = 256 * (pn - 18); }
            else { dst = GB; ld = 1024; cb = 256 * (pn - 22); }
#pragma unroll
            for (int ai = 0; ai < 2; ++ai)
#pragma unroll
                for (int m = 0; m < 4; ++m) { const int row = row0 + 128 * ai + 16 * m;
#pragma unroll
                    for (int bj = 0; bj < 2; ++bj) { const f32x4 v0 = acc[ai][bj][m][0], v1 = acc[ai][bj][m][1];
                        u32x4 w; w.x = cvt_pk_bf16(v0[0], v0[1]); w.y = cvt_pk_bf16(v0[2], v0[3]); w.z = cvt_pk_bf16(v1[0], v1[1]); w.w = cvt_pk_bf16(v1[2], v1[3]);
                        *(u32x4*)(dst + (size_t)row * ld + cb + 128 * bj + 32 * wc + 8 * fq) = w; } }
        }
    }
};
struct EpiMix {
    static constexpr bool PERM = true;
    const bf16_t *GA, *GB; float* T; bf16_t* Z;
    __device__ __forceinline__ void operator()(EPI_ARGS) const {
        const int row0 = u.pm * 256 + wr * 64 + fr;
        const bf16_t* gate = u.aux ? GB : GA;
#pragma unroll
        for (int ai = 0; ai < 2; ++ai)
#pragma unroll
            for (int m = 0; m < 4; ++m) { const int row = row0 + 128 * ai + 16 * m;
                if (row < MROWS) {
#pragma unroll
                for (int bj = 0; bj < 2; ++bj) { const int col = 256 * u.pn + 128 * bj + 32 * wc + 8 * fq;
                    float gv[8]; unpack8(*(const u32x4*)(gate + (size_t)row * 1024 + col), gv);
                    float o[8];
#pragma unroll
                    for (int i = 0; i < 8; ++i) o[i] = sigmoidf_(gv[i]) * acc[ai][bj][m][i >> 2][i & 3];
                    bf16_t* zp = Z + (size_t)row * 1024 + col;
                    if (u.aux == 0) *(u32x4*)zp = pack8(o);
                    else { float t[8]; unpack8(*(const u32x4*)zp, t);
#pragma unroll
                        for (int i = 0; i < 8; ++i) o[i] += t[i];
                        *(u32x4*)zp = pack8(o); } } } }
    }
};
struct EpiRes {
    static constexpr bool PERM = true;
    const float* xp; const float* xs; float* out; const float* ADA; int goff;
    __device__ __forceinline__ void operator()(EPI_ARGS) const {
        const int row0 = u.pm * 256 + wr * 64 + fr;
#pragma unroll
        for (int ai = 0; ai < 2; ++ai)
#pragma unroll
            for (int m = 0; m < 4; ++m) { const int row = row0 + 128 * ai + 16 * m;
                if (row < MROWS) {
                const float* base = (row < SEQ) ? xp + (size_t)row * 1024 : xs + (size_t)(row - SEQ) * 1024;
                const float* gt = ADA + (size_t)((row < SEQ) ? 128 : row - SEQ) * NADA + goff;
#pragma unroll
                for (int bj = 0; bj < 2; ++bj) { const int col = 256 * u.pn + 128 * bj + 32 * wc + 8 * fq;
#pragma unroll
                    for (int n = 0; n < 2; ++n) { const f32x4 b = *(const f32x4*)(base + col + 4 * n), g = *(const f32x4*)(gt + col + 4 * n);
                        *(f32x4*)(out + (size_t)row * 1024 + col + 4 * n) = b + g * acc[ai][bj][m][n]; } } } }
    }
};
struct EpiDelta {
    static constexpr bool PERM = true;
    bf16_t* Dd; const float* ADA; int goff;
    __device__ __forceinline__ void operator()(EPI_ARGS) const {
        const int row0 = u.pm * 256 + wr * 64 + fr;
#pragma unroll
        for (int ai = 0; ai < 2; ++ai)
#pragma unroll
            for (int m = 0; m < 4; ++m) { const int row = row0 + 128 * ai + 16 * m;
                if (row < MROWS) {
                const float* gt = ADA + (size_t)((row < SEQ) ? 128 : row - SEQ) * NADA + goff;
#pragma unroll
                for (int bj = 0; bj < 2; ++bj) { const int col = 256 * u.pn + 128 * bj + 32 * wc + 8 * fq;
                    const f32x4 g0 = *(const f32x4*)(gt + col), g1 = *(const f32x4*)(gt + col + 4); const f32x4 a0 = g0 * acc[ai][bj][m][0], a1 = g1 * acc[ai][bj][m][1];
                    u32x4 w; w.x = cvt_pk_bf16(a0[0], a0[1]); w.y = cvt_pk_bf16(a0[2], a0[3]); w.z = cvt_pk_bf16(a1[0], a1[1]); w.w = cvt_pk_bf16(a1[2], a1[3]);
                    *(u32x4*)(Dd + (size_t)row * 1024 + col) = w; } } }
    }
};
struct EpiRes4 {
    static constexpr bool PERM = true;
    const float* xp; float* out; const float* ADA; const float* gf; bf16_t* A2; float* SS;
    __device__ __forceinline__ void operator()(EPI_ARGS) const {
        const int row0 = u.pm * 256 + wr * 64 + fr; const float* ad = ADA + (size_t)128 * NADA;
#pragma unroll
        for (int ai = 0; ai < 2; ++ai)
#pragma unroll
            for (int m = 0; m < 4; ++m) { const int row = row0 + 128 * ai + 16 * m; float ss = 0.f;
#pragma unroll
                for (int bj = 0; bj < 2; ++bj) { const int col = 256 * u.pn + 128 * bj + 32 * wc + 8 * fq; float a2[8];
#pragma unroll
                    for (int n = 0; n < 2; ++n) { const f32x4 b = *(const f32x4*)(xp + (size_t)row * 1024 + col + 4 * n), g = *(const f32x4*)(ad + 2048 + col + 4 * n);
                        const f32x4 x1 = b + g * acc[ai][bj][m][n]; *(f32x4*)(out + (size_t)row * 1024 + col + 4 * n) = x1;
                        ss += (x1[0] * x1[0] + x1[1] * x1[1]) + (x1[2] * x1[2] + x1[3] * x1[3]);
                        const f32x4 gm = *(const f32x4*)(gf + col + 4 * n) * (*(const f32x4*)(ad + 4096 + col + 4 * n) + 1.0f); const f32x4 av = x1 * gm;
                        a2[4 * n] = av[0]; a2[4 * n + 1] = av[1]; a2[4 * n + 2] = av[2]; a2[4 * n + 3] = av[3]; }
                    *(u32x4*)(A2 + (size_t)row * 1024 + col) = pack8(a2); }
                ss += __shfl_xor(ss, 16); ss += __shfl_xor(ss, 32);
                if (fq == 0) SS[(size_t)row * 16 + u.pn * 4 + wc] = ss; }
    }
};
__device__ __forceinline__ float ss_sum16(const float* SS, unsigned row) {
    const f32x4* p = (const f32x4*)((const char*)SS + (size_t)row * 64u); const f32x4 a = p[0], b = p[1], c = p[2], d = p[3]; const f32x4 s = (a + b) + (c + d); return (s[0] + s[1]) + (s[2] + s[3]); }
struct EpiFfn {
    static constexpr bool PERM = true;
    bf16_t* G; const float* cw; const float* cb; const float* st; float* ofp; float* ofs; PG8_LAS float* halo; const float* SS; const float* C0;
    template <int CTRL> static __device__ __forceinline__ float dppf(float oldv, float src) {
        return __int_as_float(__builtin_amdgcn_update_dpp(__float_as_int(oldv), __float_as_int(src), CTRL, 0xf, 0xf, false)); }
    __device__ __forceinline__ void operator()(const f32x4 (&acc)[2][2][4][2], const Unit& u, int wr, int wc, int fr_, int fq_) const {
        const int l_ = (int)lane_id_now();
        const int fr = l_ & 15, fq = l_ >> 4; (void)fr_; (void)fq_;
        const int wid = wr * 4 + wc;
        const int f0 = 128 * u.pn + 32 * wc + 8 * fq;
        if (u.pm < NPT5) {
            PG8_LAS float* par = halo + 2048;
            {
                const int t = wid * 64 + l_;
                if (t < 256) { const int gc = (t < 128) ? 128 * u.pn + t : FF + 128 * u.pn + (t - 128);
                    const float w0_ = cw[gc], w1_ = cw[FF2 + gc], w2_ = cw[2 * FF2 + gc], b_ = cb[gc], c0_ = C0[gc];
                    par[t] = w0_; par[256 + t] = w1_; par[512 + t] = w2_; par[768 + t] = b_ + c0_ * (w0_ + w1_ + w2_); par[1024 + t] = c0_; }
                else { const int tr_ = t - 256, gr_ = 254 * u.pm - 2 + tr_; const unsigned go_ = (unsigned)((gr_ < 0 || gr_ >= SEQ) ? 0 : gr_);
                    const float ssv = ss_sum16(SS, go_); par[1280 + tr_] = (gr_ >= 0) ? rsqrtf(ssv * (1.0f / 1024.0f) + EPS) : 0.f; }
            }
            unsigned pb_ = (unsigned)(uintptr_t)(par + 32 * wc + 8 * fq); asm volatile("" : "+v"(pb_)); const PG8_LAS float* parl = (const PG8_LAS float*)(uintptr_t)pb_;
            unsigned rb_ = (unsigned)(uintptr_t)(par + 1280 + 64 * wr + fr); asm volatile("" : "+v"(rb_)); const PG8_LAS float* rsl = (const PG8_LAS float*)(uintptr_t)rb_;
            if (fr >= 14) {
#pragma unroll
                for (int ai = 0; ai < 2; ++ai)
#pragma unroll
                    for (int bj = 0; bj < 2; ++bj)
#pragma unroll
                        for (int n = 0; n < 2; ++n) { const int gr_ = 254 * u.pm - 2 + 128 * ai + 64 * wr + 48 + fr; const float r_ = rsqrtf(ss_sum16(SS, (unsigned)(gr_ >= SEQ ? 0 : gr_)) * (1.0f / 1024.0f) + EPS);
                            *(PG8_LAS f32x4*)(halo + ((wid * 2 + ai) * 2 + (fr - 14)) * 64 + bj * 32 + fq * 8 + n * 4) = acc[ai][bj][3][n] * r_; }
            }
            const bool first = (u.pm == 0) && (wr == 0);
            asm volatile("s_waitcnt vmcnt(0) lgkmcnt(0)" ::: "memory"); __builtin_amdgcn_s_barrier(); asm volatile("" ::: "memory");
#pragma unroll
            for (int ai = 0; ai < 2; ++ai) {
                const int swr = (ai == 0) ? 0 : (wr == 0 ? 1 : 0), sai = (ai == 1 && wr == 1) ? 1 : 0;
                unsigned hb_ = (unsigned)(uintptr_t)(halo + (((swr * 4 + wc) * 2 + sai) * 2) * 64 + fq * 8); asm volatile("" : "+v"(hb_)); const PG8_LAS float* hp = (const PG8_LAS float*)(uintptr_t)hb_;
#pragma unroll
                for (int n = 0; n < 2; ++n) {
                    const int cg0 = 4 * n, cv0 = 128 + cg0;
                    f32x4 cvv[4];
                    {
                        const f32x4 w0 = *(const PG8_LAS f32x4*)(parl + cv0), w1 = *(const PG8_LAS f32x4*)(parl + 256 + cv0), w2 = *(const PG8_LAS f32x4*)(parl + 512 + cv0), bb = *(const PG8_LAS f32x4*)(parl + 768 + cv0);
                        const f32x4 h2 = *(const PG8_LAS f32x4*)(hp + 32 + n * 4), h1 = *(const PG8_LAS f32x4*)(hp + 64 + 32 + n * 4);
                        f32x4 p1 = h1, p2 = (fr == 1) ? h1 : h2;
                        const f32x4 bbe = bb;
#pragma unroll
                        for (int m = 0; m < 4; ++m) {
                            const float r_ = rsl[128 * ai + 16 * m];
                            const f32x4 x = acc[ai][1][m][n] * r_; f32x4 q1, q2, n1, n2;
#pragma unroll
                            for (int i = 0; i < 4; ++i) { q1[i] = dppf<0x111>(p1[i], x[i]); q2[i] = dppf<0x112>(p2[i], x[i]); n1[i] = dppf<0x121>(x[i], x[i]); n2[i] = dppf<0x122>(x[i], x[i]); }
                            p1 = n1; p2 = n2;
                            cvv[m] = w0 * q2 + w1 * q1 + w2 * x + bbe;
                            if (ai == 0 && m == 0 && first) { const f32x4 c0v = *(const PG8_LAS f32x4*)(parl + 1024 + cv0); if (fr == 2) cvv[m] -= c0v * (w0 + w1); else if (fr == 3) cvv[m] -= c0v * w0; }
                            __builtin_amdgcn_sched_barrier(0);
                        }
                    }
                    {
                        const f32x4 w0 = *(const PG8_LAS f32x4*)(parl + cg0), w1 = *(const PG8_LAS f32x4*)(parl + 256 + cg0), w2 = *(const PG8_LAS f32x4*)(parl + 512 + cg0), bb = *(const PG8_LAS f32x4*)(parl + 768 + cg0);
                        const f32x4 h2 = *(const PG8_LAS f32x4*)(hp + n * 4), h1 = *(const PG8_LAS f32x4*)(hp + 64 + n * 4);
                        f32x4 p1 = h1, p2 = (fr == 1) ? h1 : h2;
                        const f32x4 bbe = bb;
#pragma unroll
                        for (int m = 0; m < 4; ++m) {
                            const float r_ = rsl[128 * ai + 16 * m];
                            const f32x4 x = acc[ai][0][m][n] * r_; f32x4 q1, q2, n1, n2;
#pragma unroll
                            for (int i = 0; i < 4; ++i) { q1[i] = dppf<0x111>(p1[i], x[i]); q2[i] = dppf<0x112>(p2[i], x[i]); n1[i] = dppf<0x121>(x[i], x[i]); n2[i] = dppf<0x122>(x[i], x[i]); }
                            p1 = n1; p2 = n2;
                            f32x4 cgv = w0 * q2 + w1 * q1 + w2 * x + bbe;
                            if (ai == 0 && m == 0 && first) { const f32x4 c0v = *(const PG8_LAS f32x4*)(parl + 1024 + cg0); if (fr == 2) cgv -= c0v * (w0 + w1); else if (fr == 3) cgv -= c0v * w0; }
                            u32x2 pk; pk.x = cvt_pk_bf16(siluf_(cgv[0]) * cvv[m][0], siluf_(cgv[1]) * cvv[m][1]); pk.y = cvt_pk_bf16(siluf_(cgv[2]) * cvv[m][2], siluf_(cgv[3]) * cvv[m][3]);
                            {
                                const int tr = 128 * ai + 64 * wr + 16 * m + fr; const int grow = 254 * u.pm - 2 + tr;
                                if (tr >= 2 && grow < SEQ) {
                                    *(u32x2*)(G + (size_t)grow * FF + f0 + 4 * n) = pk;
                                    if (n == 1 && grow >= SEQ - 2) { float* o = ofp + (size_t)(grow - (SEQ - 2)) * FF2 + f0;
                                        *(f32x4*)o = acc[ai][0][m][0] * r_ + *(const PG8_LAS f32x4*)(parl + 1024); *(f32x4*)(o + 4) = acc[ai][0][m][1] * r_ + *(const PG8_LAS f32x4*)(parl + 1024 + 4);
                                        *(f32x4*)(o + FF) = acc[ai][1][m][0] * r_ + *(const PG8_LAS f32x4*)(parl + 1024 + 128); *(f32x4*)(o + FF + 4) = acc[ai][1][m][1] * r_ + *(const PG8_LAS f32x4*)(parl + 1024 + 128 + 4); }
                                }
                            }
                            asm volatile("" ::: "memory"); __builtin_amdgcn_sched_barrier(0);
                        }
                    }
                }
                asm volatile("" ::: "memory"); __builtin_amdgcn_sched_barrier(0);
            }
        } else {
#pragma unroll
            for (int n = 0; n < 2; ++n) {
                const int fg = f0 + 4 * n, fv = FF + fg;
#pragma unroll
                for (int m = 0; m < 4; ++m) {
                    const int b = 64 * wr + 16 * m + fr;
                    const float* s0 = st + (size_t)(b * 2) * FF2; const float* s1 = s0 + FF2;
                    float* o0 = ofs + (size_t)(b * 2) * FF2; float* o1 = o0 + FF2;
                    f32x4 cvv;
                    { const f32x4 x = acc[0][1][m][n];
                      const f32x4 w0 = *(const f32x4*)(cw + fv), w1 = *(const f32x4*)(cw + FF2 + fv), w2 = *(const f32x4*)(cw + 2 * FF2 + fv), bb = *(const f32x4*)(cb + fv);
                      const f32x4 t0 = *(const f32x4*)(s0 + fv), t1 = *(const f32x4*)(s1 + fv);
                      cvv = w0 * t0 + w1 * t1 + w2 * x + bb; *(f32x4*)(o0 + fv) = t1; *(f32x4*)(o1 + fv) = x; }
                    asm volatile("" ::: "memory"); __builtin_amdgcn_sched_barrier(0);
                    { const f32x4 x = acc[0][0][m][n];
                      const f32x4 w0 = *(const f32x4*)(cw + fg), w1 = *(const f32x4*)(cw + FF2 + fg), w2 = *(const f32x4*)(cw + 2 * FF2 + fg), bb = *(const f32x4*)(cb + fg);
                      const f32x4 t0 = *(const f32x4*)(s0 + fg), t1 = *(const f32x4*)(s1 + fg);
                      const f32x4 cgv = w0 * t0 + w1 * t1 + w2 * x + bb; *(f32x4*)(o0 + fg) = t1; *(f32x4*)(o1 + fg) = x;
                      u32x2 w; w.x = cvt_pk_bf16(siluf_(cgv[0]) * cvv[0], siluf_(cgv[1]) * cvv[1]); w.y = cvt_pk_bf16(siluf_(cgv[2]) * cvv[2], siluf_(cgv[3]) * cvv[3]);
                      *(u32x2*)(G + (size_t)(SEQ + b) * FF + fg) = w; }
                    asm volatile("" ::: "memory"); __builtin_amdgcn_sched_barrier(0);
                }
            }
        }
    }
};

__device__ __forceinline__ void transpose_item(const float* W, int K, int N, bf16_t* WT, int k0, int n0, int drow0, float* scr, int lane) {
    float tv[32];
#pragma unroll
    for (int i = 0; i < 32; ++i) tv[i] = __builtin_nontemporal_load(W + (size_t)(k0 + 2 * i + (lane >> 5)) * N + n0 + (lane & 31));
#pragma unroll
    for (int i = 0; i < 32; ++i) scr[(2 * i + (lane >> 5)) * 33 + (lane & 31)] = tv[i];
    asm volatile("s_waitcnt lgkmcnt(0)" ::: "memory");
    const int c = lane & 7;
#pragma unroll
    for (int j = 0; j < 4; ++j) { const int n = (lane >> 3) + 8 * j; const float* s = scr + (8 * c) * 33 + n;
        u32x4 o; o.x = cvt_pk_bf16(s[0 * 33], s[1 * 33]); o.y = cvt_pk_bf16(s[2 * 33], s[3 * 33]); o.z = cvt_pk_bf16(s[4 * 33], s[5 * 33]); o.w = cvt_pk_bf16(s[6 * 33], s[7 * 33]);
        *(u32x4*)(WT + (size_t)(drow0 + n) * K + k0 + 8 * c) = o; }
    asm volatile("s_waitcnt lgkmcnt(0)" ::: "memory");
}
__device__ __forceinline__ int win_drow(int n) {
    if (n < 1024) return 256 * (n >> 7) + (n & 127);
    if (n < 2048) return 2048 + (n - 1024);
    if (n < 3072) { const int f = n - 2048; return 256 * (f >> 7) + 128 + (f & 127); }
    return n;
}
__device__ __forceinline__ int wup_drow(int n) { const int f = (n < FF) ? n : n - FF; return 256 * (f >> 7) + ((n < FF) ? 0 : 128) + (f & 127); }

__device__ __forceinline__ void modnorm_row(const float* xrow, const float* g, const float* sc, const float* sh, bf16_t* orow, int lane) {
    f32x4 v[4]; float s = 0.f;
#pragma unroll
    for (int j = 0; j < 4; ++j) { v[j] = ((const f32x4*)xrow)[lane + 64 * j]; s += (v[j][0] * v[j][0] + v[j][1] * v[j][1]) + (v[j][2] * v[j][2] + v[j][3] * v[j][3]); }
    const float rstd = rsqrtf(wave_sum(s) * (1.0f / 1024.0f) + EPS);
#pragma unroll
    for (int j = 0; j < 4; ++j) { const int col = 4 * (lane + 64 * j);
        const f32x4 gg = *(const f32x4*)(g + col), ss = *(const f32x4*)(sc + col), hh = *(const f32x4*)(sh + col);
        const f32x4 o = v[j] * rstd * gg * (ss + 1.0f) + hh;
        u32x2 w; w.x = cvt_pk_bf16(o[0], o[1]); w.y = cvt_pk_bf16(o[2], o[3]); *(u32x2*)(orow + col) = w; }
}


template <int MODE>
__device__ __forceinline__ void norm_phase(const float* xp, const float* xs, const float* gvec, const float* ada, int scoff, int shoff, bf16_t* ob, float* of, int gw, int NGW, int lane, const bf16_t* dadd = nullptr) {
    f32x4 gmP[4], shP[4];
#pragma unroll
    for (int j = 0; j < 4; ++j) { const int col = 4 * (lane + 64 * j); const f32x4 g = *(const f32x4*)(gvec + col);
        if (MODE == 2) { gmP[j] = g; shP[j] = (f32x4){0.f, 0.f, 0.f, 0.f}; }
        else { const float* ad = ada + (size_t)128 * NADA; gmP[j] = g * (*(const f32x4*)(ad + scoff + col) + 1.0f); shP[j] = *(const f32x4*)(ad + shoff + col); } }
#pragma unroll 1
    for (int base = gw; base < MROWS; base += 4 * NGW) {
        f32x4 v[4][4];
#pragma unroll
        for (int r = 0; r < 4; ++r) { const int row = base + r * NGW;
            if (row < MROWS) { const float* xr = (MODE == 0) ? ((row < SEQ) ? xp + (size_t)row * 1024 : xs + (size_t)(row - SEQ) * 1024) : xp + (size_t)row * 1024;
#pragma unroll
                for (int j = 0; j < 4; ++j) v[r][j] = ((const f32x4*)xr)[lane + 64 * j];
                if (MODE == 2) {
#pragma unroll
                    for (int j = 0; j < 4; ++j) { const u32x2 w = *(const u32x2*)(dadd + (size_t)row * 1024 + 4 * (lane + 64 * j));
                        v[r][j] += (f32x4){bf2f(w.x & 0xffffu), bf2f(w.x >> 16), bf2f(w.y & 0xffffu), bf2f(w.y >> 16)}; } } } }
#pragma unroll
        for (int r = 0; r < 4; ++r) { const int row = base + r * NGW;
            if (row < MROWS) {
                float s = 0.f;
#pragma unroll
                for (int j = 0; j < 4; ++j) s += (v[r][j][0] * v[r][j][0] + v[r][j][1] * v[r][j][1]) + (v[r][j][2] * v[r][j][2] + v[r][j][3] * v[r][j][3]);
                const float rstd = rsqrtf(wave_sum(s) * (1.0f / 1024.0f) + EPS);
#pragma unroll
                for (int j = 0; j < 4; ++j) { const int col = 4 * (lane + 64 * j);
                    f32x4 gm = gmP[j], sh = shP[j];
                    if (MODE != 2 && row >= SEQ) { const float* ad = ada + (size_t)(row - SEQ) * NADA; gm = *(const f32x4*)(gvec + col) * (*(const f32x4*)(ad + scoff + col) + 1.0f); sh = *(const f32x4*)(ad + shoff + col); }
                    const f32x4 o = v[r][j] * rstd * gm + sh;
                    if (MODE == 2) __builtin_nontemporal_store(o, (f32x4*)(of + (size_t)row * 1024 + col));
                    else { u32x2 w; w.x = cvt_pk_bf16(o[0], o[1]); w.y = cvt_pk_bf16(o[2], o[3]); *(u32x2*)(ob + (size_t)row * 1024 + col) = w; } }
            } }
    }
}
__device__ __forceinline__ void attn_prompt_unit(unsigned char* lds, bf16_t* Q, const bf16_t* KB, const bf16_t* VB, const float* sinks, int j, int g, int tid) {
    bf16_t* Ks = (bf16_t*)lds;
    bf16_t* Vt = (bf16_t*)(lds + 36864);
    bf16x8 qpre[2][4];
    {   const int wave_ = tid >> 6, ql_ = tid & 31, hi_ = (tid >> 5) & 1;
#pragma unroll
        for (int tt = 0; tt < 2; ++tt) { const int t = wave_ * 2 + tt, hq = t >> 2, qg = t & 3; const bf16_t* qp = Q + (size_t)(128 * j + 32 * qg + ql_) * 1024 + (4 * g + hq) * 64;
#pragma unroll
            for (int d0 = 0; d0 < 4; ++d0) qpre[tt][d0] = *(const bf16x8*)(qp + 16 * d0 + 8 * hi_); } }
    for (int c = tid; c < 2048; c += 512) {
        const int s = c >> 3, ch = c & 7; const int tok = 128 * (j - 1) + s;
        u32x4 kv = (u32x4){0u, 0u, 0u, 0u}, vv = (u32x4){0u, 0u, 0u, 0u};
        if (tok >= 0) { kv = *(const u32x4*)(KB + (size_t)tok * 256 + 64 * g + 8 * ch); vv = *(const u32x4*)(VB + (size_t)tok * 256 + 64 * g + 8 * ch); }
        *(u32x4*)(Ks + s * 72 + 8 * ch) = kv;
        bf16_t* vd = Vt + (8 * ch) * 264 + s;
        vd[0 * 264] = (bf16_t)(vv.x & 0xffffu); vd[1 * 264] = (bf16_t)(vv.x >> 16); vd[2 * 264] = (bf16_t)(vv.y & 0xffffu); vd[3 * 264] = (bf16_t)(vv.y >> 16);
        vd[4 * 264] = (bf16_t)(vv.z & 0xffffu); vd[5 * 264] = (bf16_t)(vv.z >> 16); vd[6 * 264] = (bf16_t)(vv.w & 0xffffu); vd[7 * 264] = (bf16_t)(vv.w >> 16);
    }
    __syncthreads();
    const int wave = tid >> 6, lane = tid & 63, ql = lane & 31, hi = lane >> 5;
#pragma unroll
    for (int tt = 0; tt < 2; ++tt) {
        const int t = wave * 2 + tt, hq = t >> 2, qg = t & 3, head = 4 * g + hq;
        bf16_t* qp = Q + (size_t)(128 * j + 32 * qg + ql) * 1024 + head * 64;
        bf16x8 qf[4];
#pragma unroll
        for (int d0 = 0; d0 < 4; ++d0) qf[d0] = qpre[tt][d0];
        f32x16 p[5];
#pragma unroll
        for (int kt = 0; kt < 5; ++kt) {
#pragma unroll
            for (int r = 0; r < 16; ++r) p[kt][r] = 0.f;
#pragma unroll
            for (int d0 = 0; d0 < 4; ++d0) { const bf16x8 kf = *(const bf16x8*)(Ks + (32 * qg + 32 * kt + ql) * 72 + 16 * d0 + 8 * hi);
                p[kt] = __builtin_amdgcn_mfma_f32_32x32x16_bf16(kf, qf[d0], p[kt], 0, 0, 0); }
        }
        const float sink = sinks[head];
        float mx = -INFINITY;
#pragma unroll
        for (int kt = 0; kt < 5; ++kt)
#pragma unroll
            for (int r = 0; r < 16; ++r) { const int kk = (r & 3) + 8 * (r >> 2) + 4 * hi; bool valid = true;
                if (kt == 0) valid = kk >= ql; if (kt == 4) valid = kk <= ql; if (j == 0) valid = valid && (32 * qg + 32 * kt + kk >= 128);
                const float v = valid ? p[kt][r] * 0.125f : -INFINITY; p[kt][r] = v; mx = fmaxf(mx, v); }
        mx = fmaxf(mx, __shfl_xor(mx, 32)); mx = fmaxf(mx, sink);
        float l = 0.f;
#pragma unroll
        for (int kt = 0; kt < 5; ++kt)
#pragma unroll
            for (int r = 0; r < 16; ++r) { const float e = __expf(p[kt][r] - mx); p[kt][r] = e; l += e; }
        l += __shfl_xor(l, 32);
        const float inv = 1.0f / (l + __expf(sink - mx));
        f32x16 o0, o1;
#pragma unroll
        for (int r = 0; r < 16; ++r) { o0[r] = 0.f; o1[r] = 0.f; }
#pragma unroll
        for (int kt = 0; kt < 5; ++kt)
#pragma unroll
            for (int hf = 0; hf < 2; ++hf) {
                u32x4 pw; pw.x = cvt_pk_bf16(p[kt][8 * hf + 0], p[kt][8 * hf + 1]); pw.y = cvt_pk_bf16(p[kt][8 * hf + 2], p[kt][8 * hf + 3]);
                pw.z = cvt_pk_bf16(p[kt][8 * hf + 4], p[kt][8 * hf + 5]); pw.w = cvt_pk_bf16(p[kt][8 * hf + 6], p[kt][8 * hf + 7]);
                const bf16x8 pf = __builtin_bit_cast(bf16x8, pw);
                const int sk = 32 * qg + 32 * kt + 16 * hf + 4 * hi;
                { const bf16_t* vp = Vt + ql * 264 + sk; const u32x2 a = *(const u32x2*)vp, b = *(const u32x2*)(vp + 8);
                  const bf16x8 vf = __builtin_bit_cast(bf16x8, ((u32x4){a.x, a.y, b.x, b.y})); o0 = __builtin_amdgcn_mfma_f32_32x32x16_bf16(vf, pf, o0, 0, 0, 0); }
                { const bf16_t* vp = Vt + (32 + ql) * 264 + sk; const u32x2 a = *(const u32x2*)vp, b = *(const u32x2*)(vp + 8);
                  const bf16x8 vf = __builtin_bit_cast(bf16x8, ((u32x4){a.x, a.y, b.x, b.y})); o1 = __builtin_amdgcn_mfma_f32_32x32x16_bf16(vf, pf, o1, 0, 0, 0); }
            }
#pragma unroll
        for (int c4 = 0; c4 < 4; ++c4) {
            u32x2 w0, w1;
            w0.x = cvt_pk_bf16(o0[4 * c4 + 0] * inv, o0[4 * c4 + 1] * inv); w0.y = cvt_pk_bf16(o0[4 * c4 + 2] * inv, o0[4 * c4 + 3] * inv);
            w1.x = cvt_pk_bf16(o1[4 * c4 + 0] * inv, o1[4 * c4 + 1] * inv); w1.y = cvt_pk_bf16(o1[4 * c4 + 2] * inv, o1[4 * c4 + 3] * inv);
            *(u32x2*)(qp + 8 * c4 + 4 * hi) = w0; *(u32x2*)(qp + 32 + 8 * c4 + 4 * hi) = w1;
        }
    }
    __syncthreads();
}
__device__ __forceinline__ void attn_sample_task(float* wl, bf16_t* Q, const bf16_t* KB, const bf16_t* VB, const float* ck, const float* cv, const float* sinks, int b, int g, int lane) {
    float* qs = wl; float* pp = wl + 256;
    bf16_t* qrow = Q + (size_t)(SEQ + b) * 1024 + 4 * g * 64;
#pragma unroll
    for (int h = 0; h < 4; ++h) qs[h * 64 + lane] = bf2f(qrow[h * 64 + lane]) * 0.125f;
    const float knew = bf2f(KB[(size_t)(SEQ + b) * 256 + 64 * g + lane]), vnew = bf2f(VB[(size_t)(SEQ + b) * 256 + 64 * g + lane]);
    asm volatile("s_waitcnt lgkmcnt(0)" ::: "memory");
    float sc[2][4];
#pragma unroll
    for (int kk = 0; kk < 2; ++kk) { const int s = lane + 64 * kk; const f32x4* kp = (const f32x4*)(ck + ((size_t)(b * 128 + s) * 4 + g) * 64);
        float a0 = 0.f, a1 = 0.f, a2 = 0.f, a3 = 0.f;
#pragma unroll 4
        for (int c = 0; c < 16; ++c) { const f32x4 kv = kp[c];
            const f32x4 q0 = *(const f32x4*)(qs + 4 * c), q1 = *(const f32x4*)(qs + 64 + 4 * c), q2 = *(const f32x4*)(qs + 128 + 4 * c), q3 = *(const f32x4*)(qs + 192 + 4 * c);
            a0 += kv[0] * q0[0] + kv[1] * q0[1] + kv[2] * q0[2] + kv[3] * q0[3]; a1 += kv[0] * q1[0] + kv[1] * q1[1] + kv[2] * q1[2] + kv[3] * q1[3];
            a2 += kv[0] * q2[0] + kv[1] * q2[1] + kv[2] * q2[2] + kv[3] * q2[3]; a3 += kv[0] * q3[0] + kv[1] * q3[1] + kv[2] * q3[2] + kv[3] * q3[3]; }
        sc[kk][0] = a0; sc[kk][1] = a1; sc[kk][2] = a2; sc[kk][3] = a3; }
#pragma unroll
    for (int h = 0; h < 4; ++h) {
        const float sn = wave_sum(qs[h * 64 + lane] * knew), sink = sinks[4 * g + h];
        float m = wave_max(fmaxf(sc[0][h], sc[1][h])); m = fmaxf(fmaxf(m, sn), sink);
        const float e0 = __expf(sc[0][h] - m), e1 = __expf(sc[1][h] - m), en = __expf(sn - m);
        const float inv = 1.0f / (wave_sum(e0 + e1) + en + __expf(sink - m));
        pp[lane * 4 + h] = e0 * inv; pp[(64 + lane) * 4 + h] = e1 * inv; if (lane == 0) pp[512 + h] = en * inv;
    }
    asm volatile("s_waitcnt lgkmcnt(0)" ::: "memory");
    float o0 = 0.f, o1 = 0.f, o2 = 0.f, o3 = 0.f;
    const float* vp = cv + ((size_t)(b * 128) * 4 + g) * 64 + lane;
#pragma unroll 8
    for (int s = 0; s < 128; ++s) { const float v = vp[(size_t)s * 256]; const f32x4 pv = *(const f32x4*)(pp + 4 * s); o0 += pv[0] * v; o1 += pv[1] * v; o2 += pv[2] * v; o3 += pv[3] * v; }
    { const f32x4 pv = *(const f32x4*)(pp + 512); o0 += pv[0] * vnew; o1 += pv[1] * vnew; o2 += pv[2] * vnew; o3 += pv[3] * vnew; }
    qrow[lane] = (bf16_t)(cvt_pk_bf16(o0, 0.f) & 0xffffu); qrow[64 + lane] = (bf16_t)(cvt_pk_bf16(o1, 0.f) & 0xffffu);
    qrow[128 + lane] = (bf16_t)(cvt_pk_bf16(o2, 0.f) & 0xffffu); qrow[192 + lane] = (bf16_t)(cvt_pk_bf16(o3, 0.f) & 0xffffu);
    asm volatile("s_waitcnt lgkmcnt(0)" ::: "memory");
}


#if SELFCHECK
constexpr size_t WS_CHK = 512 * 1024;
__device__ __forceinline__ unsigned hsh(unsigned x) { x ^= x >> 16; x *= 0x7feb352du; x ^= x >> 15; x *= 0x846ca68bu; x ^= x >> 16; return x; }
__device__ __forceinline__ int samp_row(int s) {
    if ((s & 3) == 0) { switch ((s >> 2) & 7) { case 0: return 0; case 1: return 1; case 2: return 255; case 3: return 256; case 4: return SEQ - 1; case 5: return SEQ; case 6: return SEQ + 100; default: return 8191; } }
    if ((s & 3) == 1) return SEQ + (int)(hsh(s) % NS);
    return (int)(hsh(s * 3 + 1) % SEQ);
}
__device__ __forceinline__ bool chk_bad(float got, float ref) { return !(fabsf(got - ref) <= 0.05f * fabsf(ref) + 0.04f); }
__device__ __forceinline__ float wdot_bf(const bf16_t* a, const float* W, int ldw, int col, int K, int lane) {
    float s = 0.f; for (int k = lane; k < K; k += 64) s += bf2f(a[k]) * W[(size_t)k * ldw + col]; return wave_sum(s); }
#define CHK_FAIL(bit) do { if (lane == 0) atomicOr(mask, 1u << (bit)); } while (0)
#endif

template <int KLEN>
__device__ __forceinline__ f32x4 mini_kloop(const bf16_t* Arow, const bf16_t* Brow, f32x4 acc) {
    constexpr int NS_ = KLEN / 32;
    static_assert(KLEN % 32 == 0, "K quarter");
#pragma unroll 1
    for (int s0 = 0; s0 < NS_; s0 += 8) {
        bf16x8 a[8], b[8];
#pragma unroll
        for (int i = 0; i < 8; ++i) if (s0 + i < NS_) { a[i] = *(const bf16x8*)(Arow + (s0 + i) * 32); b[i] = *(const bf16x8*)(Brow + (s0 + i) * 32); }
#pragma unroll
        for (int i = 0; i < 8; ++i) if (s0 + i < NS_) acc = __builtin_amdgcn_mfma_f32_16x16x32_bf16(b[i], a[i], acc, 0, 0, 0);
    }
    return acc;
}
struct MiniArgs { const bf16_t* A0; const bf16_t* B0; const bf16_t* A1; const bf16_t* B1; const bf16_t* GA; const bf16_t* GB; bf16_t* Z; const float* base; float* out; const float* ADA; int goff; };
template <int MODE, int K>
__device__ __forceinline__ void mini_sample_gemm(unsigned char* lds, const MiniArgs& P, int bid, int G, int wave, int lane) {
    const int fr = lane & 15, fq = lane >> 4, tl = wave >> 2, kq = wave & 3;
    f32x4* red = (f32x4*)lds;
    for (int T0 = 2 * bid; T0 < 512; T0 += 2 * G) {
        const int T = T0 + tl, rt = T & 7, ct = T >> 3;
        const int row = SEQ + 16 * rt + fr, colb = 16 * ct + fr;
        const size_t ko = (size_t)kq * (K / 4) + 8 * fq;
        f32x4 acc0 = (f32x4){0.f, 0.f, 0.f, 0.f}, acc1 = acc0;
        acc0 = mini_kloop<K / 4>(P.A0 + (size_t)row * K + ko, P.B0 + (size_t)colb * K + ko, acc0);
        if (MODE == 0) acc1 = mini_kloop<K / 4>(P.A1 + (size_t)row * K + ko, P.B1 + (size_t)colb * K + ko, acc1);
        red[wave * 64 + lane] = acc0; if (MODE == 0) red[512 + wave * 64 + lane] = acc1;
        __syncthreads();
        if (kq == 0) {
            f32x4 s0 = red[wave * 64 + lane] + red[(wave + 1) * 64 + lane] + red[(wave + 2) * 64 + lane] + red[(wave + 3) * 64 + lane];
            const int col = 16 * ct + 4 * fq;
            if (MODE == 0) {
                const f32x4 s1 = red[512 + wave * 64 + lane] + red[512 + (wave + 1) * 64 + lane] + red[512 + (wave + 2) * 64 + lane] + red[512 + (wave + 3) * 64 + lane];
                const u32x2 ga = *(const u32x2*)(P.GA + (size_t)row * 1024 + col), gb = *(const u32x2*)(P.GB + (size_t)row * 1024 + col);
                const float z0 = sigmoidf_(bf2f(ga.x & 0xffffu)) * s0[0] + sigmoidf_(bf2f(gb.x & 0xffffu)) * s1[0], z1 = sigmoidf_(bf2f(ga.x >> 16)) * s0[1] + sigmoidf_(bf2f(gb.x >> 16)) * s1[1];
                const float z2 = sigmoidf_(bf2f(ga.y & 0xffffu)) * s0[2] + sigmoidf_(bf2f(gb.y & 0xffffu)) * s1[2], z3 = sigmoidf_(bf2f(ga.y >> 16)) * s0[3] + sigmoidf_(bf2f(gb.y >> 16)) * s1[3];
                u32x2 w; w.x = cvt_pk_bf16(z0, z1); w.y = cvt_pk_bf16(z2, z3); *(u32x2*)(P.Z + (size_t)row * 1024 + col) = w;
            } else if (MODE == 2) {
                const int b = row - SEQ; const f32x4 g = *(const f32x4*)(P.ADA + (size_t)b * NADA + P.goff + col); const f32x4 d = g * s0;
                u32x2 w; w.x = cvt_pk_bf16(d[0], d[1]); w.y = cvt_pk_bf16(d[2], d[3]); *(u32x2*)(P.Z + (size_t)row * 1024 + col) = w;
            } else {
                const int b = row - SEQ;
                const f32x4 bs = *(const f32x4*)(P.base + (size_t)b * 1024 + col), g = *(const f32x4*)(P.ADA + (size_t)b * NADA + P.goff + col);
                *(f32x4*)(P.out + (size_t)row * 1024 + col) = bs + g * s0;
            }
        }
        __syncthreads();
    }
}

__device__ __forceinline__ void ada_block(unsigned char* lds, const float* cs, const float* cp, const float* W, const float* bias, float* ADAo, int pair, int wave, int lane) {
    const int fr = lane & 15, fq = lane >> 4, tl = wave >> 2, kq = wave & 3, c0 = 16 * (2 * pair + tl);
    f32x4 acc[9];
#pragma unroll
    for (int rt = 0; rt < 9; ++rt) acc[rt] = (f32x4){0.f, 0.f, 0.f, 0.f};
#pragma unroll 1
    for (int ks = 0; ks < 8; ++ks) {
        const int k0 = 256 * kq + 32 * ks + 8 * fq;
        float wv[8];
#pragma unroll
        for (int j = 0; j < 8; ++j) wv[j] = __builtin_nontemporal_load(W + (size_t)(k0 + j) * NADA + c0 + fr);
        f32x4 a0[9], a1[9];
#pragma unroll
        for (int rt = 0; rt < 9; ++rt) { const int row = 16 * rt + fr; const float* cr = (row < 128) ? cs + (size_t)row * 1024 : cp;
            a0[rt] = *(const f32x4*)(cr + k0); a1[rt] = *(const f32x4*)(cr + k0 + 4); }
        u32x4 bw; bw.x = cvt_pk_bf16(wv[0], wv[1]); bw.y = cvt_pk_bf16(wv[2], wv[3]); bw.z = cvt_pk_bf16(wv[4], wv[5]); bw.w = cvt_pk_bf16(wv[6], wv[7]);
        const bf16x8 bfrag = __builtin_bit_cast(bf16x8, bw);
#pragma unroll
        for (int rt = 0; rt < 9; ++rt) { const bool ok = (16 * rt + fr) <= 128;
            u32x4 aw; aw.x = cvt_pk_bf16(siluf_(a0[rt][0]), siluf_(a0[rt][1])); aw.y = cvt_pk_bf16(siluf_(a0[rt][2]), siluf_(a0[rt][3]));
            aw.z = cvt_pk_bf16(siluf_(a1[rt][0]), siluf_(a1[rt][1])); aw.w = cvt_pk_bf16(siluf_(a1[rt][2]), siluf_(a1[rt][3]));
            if (!ok) aw = (u32x4){0u, 0u, 0u, 0u};
            acc[rt] = __builtin_amdgcn_mfma_f32_16x16x32_bf16(bfrag, __builtin_bit_cast(bf16x8, aw), acc[rt], 0, 0, 0); }
    }
    f32x4* red = (f32x4*)lds;
#pragma unroll
    for (int rt = 0; rt < 9; ++rt) red[(wave * 9 + rt) * 64 + lane] = acc[rt];
    __syncthreads();
    if (kq == 0) {
        const f32x4 bv = *(const f32x4*)(bias + c0 + 4 * fq);
#pragma unroll
        for (int rt = 0; rt < 9; ++rt) { const int row = 16 * rt + fr;
            const f32x4 sum = red[(wave * 9 + rt) * 64 + lane] + red[((wave + 1) * 9 + rt) * 64 + lane] + red[((wave + 2) * 9 + rt) * 64 + lane] + red[((wave + 3) * 9 + rt) * 64 + lane];
            if (row <= 128) *(f32x4*)(ADAo + (size_t)row * NADA + c0 + 4 * fq) = sum + bv; }
    }
    __syncthreads();
}

#define LAS __attribute__((address_space(3)))
#define XB_TMO      128
#define XB_XCNT(j)  (256  + 64 * (j))
#define XB_XSUB(j)  (1280 + 64 * (j))
#define XB_XGEN(j)  (2304 + 64 * (j))
#define XB_TOP      3328
#define XB_TOPGEN   3392
#define XCD_BAR_WORDS 3456
#define XB_SPIN_CAP (1u << 22)
constexpr size_t WS_BAR = 64 * 1024;
constexpr int MISC_OFF = 146432;
constexpr size_t WS_SS = 768 * 1024;
constexpr size_t WS_C0 = WS_BAR + 16384;
constexpr size_t BAR_ZERO_BYTES = (WS_C0 - WS_BAR) + 22528;
__device__ __forceinline__ unsigned xb_ld(unsigned* p)              { return __hip_atomic_load(p, __ATOMIC_RELAXED, __HIP_MEMORY_SCOPE_AGENT); }
__device__ __forceinline__ unsigned xb_add(unsigned* p, unsigned v) { return __hip_atomic_fetch_add(p, v, __ATOMIC_RELAXED, __HIP_MEMORY_SCOPE_AGENT); }
__device__ __forceinline__ unsigned xb_xcc_id() { return (unsigned)__builtin_amdgcn_s_getreg((3 << 11) | 20) & 0xFu; }
#define XB_SPIN(cond, bar) do { unsigned _sp = 0; while (cond) { __builtin_amdgcn_s_sleep(1); \
    if ((++_sp & 255u) == 0u) { if (xb_ld(&(bar)[XB_TMO])) break; if (_sp > XB_SPIN_CAP) { atomicAdd(&(bar)[XB_TMO], 1u); break; } } } } while (0)
struct XcdBarrier { unsigned* bar; unsigned x; volatile LAS unsigned* st; };
__device__ __forceinline__ XcdBarrier xcd_barrier_post(unsigned* bar, volatile LAS unsigned* st, bool leader) {
    XcdBarrier b; b.bar = bar; b.x = xb_xcc_id(); b.st = st;
    if (leader) (void)xb_add(&bar[XB_XCNT(b.x)], 1u);
    return b;
}
__device__ __forceinline__ void xcd_barrier_complete(unsigned* bar, unsigned x, unsigned& nloc, unsigned& nx) {
    const unsigned G = gridDim.x * gridDim.y * gridDim.z;
    unsigned sum, cnt, mine, sp = 0u;
    for (;;) {
        sum = 0u; cnt = 0u; mine = 0u;
#pragma unroll
        for (unsigned j = 0; j < 16; ++j) { const unsigned c = xb_ld(&bar[XB_XCNT(j)]); sum += c; cnt += (c > 0u) ? 1u : 0u; mine = (j == x) ? c : mine; }
        if (sum == G) break;
        __builtin_amdgcn_s_sleep(1);
        if ((++sp & 255u) == 0u) { if (xb_ld(&bar[XB_TMO])) break; if (sp > XB_SPIN_CAP) { atomicAdd(&bar[XB_TMO], 1u); break; } }
    }
    nloc = mine > 0u ? mine : 1u; nx = cnt > 0u ? cnt : 1u;
}
__device__ __forceinline__ void xcd_barrier_core(const XcdBarrier& b, bool leader) {
    if (leader) {
        unsigned* bar = b.bar;
        __builtin_amdgcn_s_waitcnt(0);
        unsigned nloc = b.st[0], nx = b.st[1];
        if (nloc == 0u) { xcd_barrier_complete(bar, b.x, nloc, nx); b.st[0] = nloc; b.st[1] = nx; }
        const unsigned old = xb_add(&bar[XB_XSUB(b.x)], 1u);
        const unsigned gen = old / nloc;
        if (old + 1u == (gen + 1u) * nloc) {
            __builtin_amdgcn_fence(__ATOMIC_RELEASE, "agent");
            asm volatile("s_waitcnt vmcnt(0)" ::: "memory");
            const unsigned og = xb_add(&bar[XB_TOP], 1u);
            const unsigned tg = og / nx;
            if (og + 1u == (tg + 1u) * nx) xb_add(&bar[XB_TOPGEN], 1u);
            else XB_SPIN(xb_ld(&bar[XB_TOPGEN]) == tg, bar);
            __builtin_amdgcn_fence(__ATOMIC_ACQUIRE, "agent");
            xb_add(&bar[XB_XGEN(b.x)], 1u);
            asm volatile("s_waitcnt vmcnt(0)" ::: "memory");
        } else {
            XB_SPIN(xb_ld(&bar[XB_XGEN(b.x)]) == gen, bar);
            __builtin_amdgcn_fence(__ATOMIC_ACQUIRE, "agent");
            asm volatile("s_waitcnt vmcnt(0)" ::: "memory");
        }
    }
}
struct Args { const float* in[23]; float* out; unsigned char* ws; };
enum { I_XP = 0, I_XS, I_CP, I_CS, I_SCA, I_CK, I_CV, I_SFF, I_WADA, I_BADA, I_GMIX, I_WIN, I_CAW, I_SINK, I_WAO, I_WBO, I_WO, I_GFFN, I_WUP, I_FCW, I_FCB, I_WDN, I_GFIN };

typedef const __attribute__((address_space(4))) Args* KArgsP;
__device__ __forceinline__ void shadow_work(KArgsP ap, unsigned nb, int w7, int bid, int G, int lane, unsigned char* lds) {
    const int sw = bid * 7 + w7, NSW = G * 7;
    float* scr = (float*)(lds + (w7 + 1) * 16384);
    unsigned char* ws = ap->ws;
    if (nb == 1u) {
        for (int it = sw; it < 16 * (NIN / 32); it += NSW) { const int nbk = NIN / 32, kb = it / nbk, n0 = 32 * (it % nbk);
            transpose_item(ap->in[I_WIN], 1024, NIN, (bf16_t*)(ws + WS_WIN), 64 * kb, n0, win_drow(n0), scr, lane); }
    } else if (nb == 2u || nb == 3u) {
        constexpr int I_UPS = 16 * (FF2 / 32), SPLIT_ = 1024;
        if (nb == 2u) for (int r = sw; r < 3 * 512; r += NSW) { const int which = r / 512, q = r % 512, kb = q / 32, n0 = 32 * (q % 32);
            transpose_item(ap->in[which == 0 ? I_WAO : (which == 1 ? I_WBO : I_WO)], 1024, 1024, (bf16_t*)(ws + (which == 0 ? WS_WA : (which == 1 ? WS_WB : WS_WO))), 64 * kb, n0, n0, scr, lane); }
        for (int it = (nb == 2u ? 0 : SPLIT_) + sw; it < (nb == 2u ? SPLIT_ : I_UPS); it += NSW) { const int nbk = FF2 / 32, kb = it / nbk, n0 = 32 * (it % nbk);
            transpose_item(ap->in[I_WUP], 1024, FF2, (bf16_t*)(ws + WS_WUP), 64 * kb, n0, wup_drow(n0), scr, lane); }
        if (nb == 2u)
            for (int t = sw; t < 88 * 16; t += NSW) { const int cgp = t % 88, ks = t / 88, col = 64 * cgp + lane;
                const float* Wp = ap->in[I_WUP] + (size_t)(64 * ks) * FF2 + col; const float* sh = (const float*)(ws + WS_ADA) + (size_t)128 * NADA + 3072 + 64 * ks;
                float a = 0.f;
#pragma unroll 16
                for (int k = 0; k < 64; ++k) a += sh[k] * __builtin_nontemporal_load(Wp + (size_t)k * FF2);
                (void)__hip_atomic_fetch_add((float*)(ws + WS_C0) + col, a, __ATOMIC_RELAXED, __HIP_MEMORY_SCOPE_AGENT); }
    } else if (nb == 4u) {
        for (int it = sw; it < (FF / 64) * 32; it += NSW) { const int kb = it / 32, n0 = 32 * (it % 32); transpose_item(ap->in[I_WDN], FF, 1024, (bf16_t*)(ws + WS_WDN), 64 * kb, n0, n0, scr, lane); }
    }
    if (nb == 4u || nb == 5u) {
        const float* ck_ = ap->in[I_CK]; const float* cv_ = ap->in[I_CV]; const bf16_t* kb_ = (const bf16_t*)(ws + WS_KB); const bf16_t* vb_ = (const bf16_t*)(ws + WS_VB); float* out = ap->out;
        const long st = (long)sw * 64 + lane, NST = (long)NSW * 64; const long lo = (nb == 4u) ? 0 : 1048576, hi = lo + 1048576;
#pragma unroll 4
        for (long i = lo + st; i < hi; i += NST) {
            const int which = (int)(i >> 20); const int r2 = (int)(i & 1048575); const int b = r2 >> 13, r = (r2 >> 6) & 127, c = r2 & 63;
            const float* cache = which ? cv_ : ck_; const bf16_t* nbp = which ? vb_ : kb_;
            f32x4 v;
            if (r < 127) v = __builtin_nontemporal_load((const f32x4*)(cache + ((size_t)(b * 128 + r + 1) * 256 + 4 * c)));
            else { const u32x2 w = *(const u32x2*)(nbp + (size_t)(SEQ + b) * 256 + 4 * c); v = (f32x4){bf2f(w.x & 0xffffu), bf2f(w.x >> 16), bf2f(w.y & 0xffffu), bf2f(w.y >> 16)}; }
            __builtin_nontemporal_store(v, (f32x4*)(out + (which ? O_VS : O_KS) + (size_t)r2 * 4));
        }
        if (nb == 4u) for (long i = st; i < 2L * 128 * 64; i += NST) {
            const int which = (int)(i >> 13); const int r2 = (int)(i & 8191); const int r = r2 >> 6, c = r2 & 63; const bf16_t* nbp = which ? vb_ : kb_;
            const u32x2 w = *(const u32x2*)(nbp + (size_t)(SEQ - 128 + r) * 256 + 4 * c);
            *(f32x4*)(out + (which ? O_VP : O_KP) + (size_t)r2 * 4) = (f32x4){bf2f(w.x & 0xffffu), bf2f(w.x >> 16), bf2f(w.y & 0xffffu), bf2f(w.y >> 16)};
        }
    }
}

__global__ void __launch_bounds__(512, 2) mega(Args a) {
    extern __shared__ __attribute__((aligned(16))) unsigned char lds[];
    PG8_LAS unsigned char* ldsl = (PG8_LAS unsigned char*)lds;
    const int G = gridDim.x, bid = blockIdx.x, NGW = G * 8;
    const int wave0 = __builtin_amdgcn_readfirstlane((int)threadIdx.x >> 6);
    const long NGT = (long)G * 512;
#define PHASE_IDS() int tid = wave0 * 64 + (int)lane_id_now(); asm volatile("" : "+v"(tid)); const int lane = tid & 63, wave = wave0; \
    const int gw = bid * 8 + wave; const long gt = (long)bid * 512 + tid; float* const scr = (float*)(lds + wave * 16384); (void)lane; (void)gw; (void)gt; (void)scr;
    typedef const __attribute__((address_space(4))) Args* KArgs;
    const KArgs ap0 = (KArgs)__builtin_amdgcn_kernarg_segment_ptr();
#define ARGS() ({ KArgs p_ = ap0; asm volatile("" : "+s"(p_)); p_; })
#define IN(i) (ARGS()->in[i])
#define WS(off) (ARGS()->ws + (off))
#define OUT() (ARGS()->out)
#define AADA ((bf16_t*)WS(WS_AADA))
#define ADA ((float*)WS(WS_ADA))
#define WA ((bf16_t*)WS(WS_WA))
#define WB ((bf16_t*)WS(WS_WB))
#define WO ((bf16_t*)WS(WS_WO))
#define WADA ((bf16_t*)WS(WS_WADA))
#define WIN ((bf16_t*)WS(WS_WIN))
#define WUP ((bf16_t*)WS(WS_WUP))
#define WDN ((bf16_t*)WS(WS_WDN))
#define H ((bf16_t*)WS(WS_H))
#define U ((bf16_t*)WS(WS_U))
#define BG ((bf16_t*)WS(WS_BG))
#define Q ((bf16_t*)WS(WS_Q))
#define KB ((bf16_t*)WS(WS_KB))
#define VB ((bf16_t*)WS(WS_VB))
#define GA ((bf16_t*)WS(WS_GA))
#define GB ((bf16_t*)WS(WS_GB))
#define GG ((bf16_t*)WS(WS_G))
#define AIN H
#define Z U
#define H2 BG
    if (gridDim.x == 0x7fffffffu) cg::this_grid().sync();
    if (threadIdx.x < 2) ((volatile LAS unsigned*)(ldsl + MISC_OFF))[threadIdx.x] = 0u;
    __syncthreads();
#define LEADER() (wave0 == 0 && lane_id_now() == 0u)
    const XcdBarrier xbar = xcd_barrier_post((unsigned*)WS(WS_BAR), (volatile LAS unsigned*)(ldsl + MISC_OFF), LEADER());
    unsigned nbar_ = 0u;
#define GRID_SYNC() do { ++nbar_; asm volatile("s_waitcnt vmcnt(0)" ::: "memory"); __syncthreads(); \
        if (wave0 == 0) xcd_barrier_core(xbar, LEADER()); else shadow_work((KArgsP)ap0, nbar_, wave0 - 1, bid, G, (int)lane_id_now(), lds); \
        __syncthreads(); } while (0)

#if TIMESEL >= 0
#define STAMP(k) do { if (bid == 0 && threadIdx.x == 0) ((unsigned long long*)WS(768 * 1024))[k] = __builtin_amdgcn_s_memrealtime(); } while (0)
#else
#define STAMP(k) do {} while (0)
#endif
    STAMP(0);
    {
        PHASE_IDS();
        {   const float* const cs = IN(I_CS); const float* const cp = IN(I_CP); const float* const wad = IN(I_WADA); const float* const bad = IN(I_BADA); float* const ada = ADA;
            for (int pr = bid; pr < NADA / 32; pr += G) ada_block(lds, cs, cp, wad, bad, ada, pr, wave, lane); }
        if (bid >= NADA / 32) {
            const f32x4* xp4 = (const f32x4*)IN(I_XP); const long nidle = (long)(G - NADA / 32) * 512, me = (long)(bid - NADA / 32) * 512 + tid; f32x4 sink = (f32x4){0.f, 0.f, 0.f, 0.f};
#pragma unroll 8
            for (long i = me; i < (long)SEQ * 256; i += nidle) sink += xp4[i];
            asm volatile("" :: "v"(sink)); }
    }
    GRID_SYNC();
    STAMP(1);
    STAMP(2);
    {
        PHASE_IDS();
        norm_phase<0>(IN(I_XP), IN(I_XS), IN(I_GMIX), ADA, 1024, 0, H, nullptr, gw, NGW, lane);
    }
    GRID_SYNC();
    STAMP(3);
    {
        typedef Sched<0, 2048, 2048> SC; SC S; S.to.init(NMT, NIN / 256); S.G = G; S.c = bid; S.A0 = (const char*)H; S.B0 = (const char*)WIN;
        EpiProj E{U, BG, Q, KB, VB, GA, GB};
        pg8::gemm_phase<EpiProj, SC, 1024, 1024, 1024, true, true>(ldsl, wave0, S, E);
    }
    GRID_SYNC();
    STAMP(4);
    {
        PHASE_IDS();
        {   bf16_t* const q_ = Q; const bf16_t* const kb_ = KB; const bf16_t* const vb_ = VB; const float* const sinks = IN(I_SINK);
            for (int un = bid; un < 512; un += G) attn_prompt_unit(lds, q_, kb_, vb_, sinks, un >> 2, un & 3, tid); }
        {   bf16_t* const q_ = Q; const bf16_t* const kb_ = KB; const bf16_t* const vb_ = VB; const float* const sinks = IN(I_SINK);
            const float* const ck_ = IN(I_CK); const float* const cv_ = IN(I_CV);
            float* wl = (float*)(lds + 123392 + (wave >> 2) * 4096);
            for (int t4 = gw; t4 < 2048; t4 += NGW) if ((t4 & 3) == 0) { const int t = t4 >> 2; attn_sample_task(wl, q_, kb_, vb_, ck_, cv_, sinks, t >> 2, t & 3, lane); } }
        const bool worker = (wave & 3) != 0; const long wt = ((long)bid * 6 + (wave - 1 - (wave > 4 ? 1 : 0))) * 64 + lane, NWT = (long)G * 6 * 64;
        {
        float* const out = OUT();
        const float* caw = IN(I_CAW); const float* sca = IN(I_SCA); const bf16_t* const u_ = U; const bf16_t* const bg_ = BG; bf16_t* const ain_ = AIN;
        if (worker)
        for (long it = wt; it < (long)(SEQ / 8) * 128 + (long)NS * 128; it += NWT) {
            const bool smp = it >= (long)(SEQ / 8) * 128; const long it2 = smp ? it - (long)(SEQ / 8) * 128 : it;
            const int row0 = smp ? SEQ + (int)(it2 >> 7) : (int)(it2 >> 7) * 8, c8 = (int)(it2 & 127) * 8; const int nr = smp ? 1 : 8;
            float w0[8], w1[8], w2[8], u0[8], u1[8];
            *(f32x4*)w0 = *(const f32x4*)(caw + c8); *(f32x4*)(w0 + 4) = *(const f32x4*)(caw + c8 + 4);
            *(f32x4*)w1 = *(const f32x4*)(caw + 1024 + c8); *(f32x4*)(w1 + 4) = *(const f32x4*)(caw + 1024 + c8 + 4);
            *(f32x4*)w2 = *(const f32x4*)(caw + 2048 + c8); *(f32x4*)(w2 + 4) = *(const f32x4*)(caw + 2048 + c8 + 4);
            if (row0 < SEQ) {
                if (row0 >= 2) { unpack8(*(const u32x4*)(u_ + (size_t)(row0 - 2) * 1024 + c8), u0); unpack8(*(const u32x4*)(u_ + (size_t)(row0 - 1) * 1024 + c8), u1); }
                else { for (int i = 0; i < 8; ++i) { u0[i] = 0.f; u1[i] = 0.f; } }
#pragma unroll 4
                for (int r = 0; r < 8; ++r) { const int row = row0 + r; float u2[8], bg[8], o[8];
                    unpack8(*(const u32x4*)(u_ + (size_t)row * 1024 + c8), u2); unpack8(*(const u32x4*)(bg_ + (size_t)row * 1024 + c8), bg);
#pragma unroll
                    for (int i = 0; i < 8; ++i) { o[i] = bg[i] * (w0[i] * u0[i] + w1[i] * u1[i] + w2[i] * u2[i]); u0[i] = u1[i]; u1[i] = u2[i]; }
                    *(u32x4*)(ain_ + (size_t)row * 1024 + c8) = pack8(o);
                    if (row >= SEQ - 2) { float* op = out + O_CAP + (size_t)(row - (SEQ - 2)) * 1024 + c8; *(f32x4*)op = (f32x4){u2[0], u2[1], u2[2], u2[3]}; *(f32x4*)(op + 4) = (f32x4){u2[4], u2[5], u2[6], u2[7]}; } }
            } else {
                for (int r = 0; r < nr; ++r) { const int row = row0 + r, b = row - SEQ; float u2[8], bg[8], o[8];
                    const float* s0 = sca + (size_t)(b * 2) * 1024 + c8; const float* s1 = s0 + 1024;
                    *(f32x4*)u0 = *(const f32x4*)s0; *(f32x4*)(u0 + 4) = *(const f32x4*)(s0 + 4); *(f32x4*)u1 = *(const f32x4*)s1; *(f32x4*)(u1 + 4) = *(const f32x4*)(s1 + 4);
                    unpack8(*(const u32x4*)(u_ + (size_t)row * 1024 + c8), u2); unpack8(*(const u32x4*)(bg_ + (size_t)row * 1024 + c8), bg);
#pragma unroll
                    for (int i = 0; i < 8; ++i) o[i] = bg[i] * (w0[i] * u0[i] + w1[i] * u1[i] + w2[i] * u2[i]);
                    *(u32x4*)(ain_ + (size_t)row * 1024 + c8) = pack8(o);
                    float* op = out + O_CAS + (size_t)(b * 2) * 1024 + c8;
                    *(f32x4*)op = *(f32x4*)u1; *(f32x4*)(op + 4) = *(f32x4*)(u1 + 4); *(f32x4*)(op + 1024) = (f32x4){u2[0], u2[1], u2[2], u2[3]}; *(f32x4*)(op + 1024 + 4) = (f32x4){u2[4], u2[5], u2[6], u2[7]}; }
            }
        }
        }
    }
    GRID_SYNC();
    STAMP(5);
    {
        typedef Sched<1, 2048, 2048> SC; SC S; S.to.init(SEQ / 256, 4); S.G = G; S.c = bid; S.A0 = (const char*)AIN; S.B0 = (const char*)WA; S.A1 = (const char*)Q; S.B1 = (const char*)WB;
        EpiMix E{GA, GB, OUT(), Z};
        pg8::gemm_phase<EpiMix, SC, 1024, 1024, 1024, true, true>(ldsl, wave0, S, E);
        { PHASE_IDS(); MiniArgs P{AIN, WA, Q, WB, GA, GB, Z, nullptr, nullptr, nullptr, 0}; mini_sample_gemm<0, 1024>(lds, P, bid, G, wave, lane); }
    }
    GRID_SYNC();
    STAMP(6);
    {
        typedef Sched<0, 2048, 2048> SC; SC S; S.to.init(SEQ / 256, 4); S.G = G; S.c = bid; S.A0 = (const char*)Z; S.B0 = (const char*)WO;
        EpiRes4 E{IN(I_XP), OUT(), ADA, IN(I_GFFN), H2, (float*)WS(WS_SS)};
        pg8::gemm_phase<EpiRes4, SC, 1024, 1024, 1024, true, true>(ldsl, wave0, S, E);
        { PHASE_IDS(); if (gt < 256) *(u32x4*)((unsigned char*)H2 - 4096 + gt * 16) = (u32x4){0u, 0u, 0u, 0u}; }
        { PHASE_IDS(); MiniArgs P{Z, WO, nullptr, nullptr, nullptr, nullptr, nullptr, IN(I_XS), OUT(), ADA, 2048}; mini_sample_gemm<1, 1024>(lds, P, bid, G, wave, lane); }
    }
    GRID_SYNC();
    STAMP(8);
    {
        typedef Sched<2, 2048, 2048> SC; SC S; S.to.init(G >= 64 ? NPT5 : NPT5 + 1, FF2 / 256); S.G = G; S.c = bid; S.A0 = (const char*)H2; S.B0 = (const char*)WUP;
        {
            PHASE_IDS(); bool has = false; Unit u; for (int i = 0; S.next(i, u); ++i) has = has || (u.pm == NPT5);
            if (has) norm_phase<1>(OUT(), nullptr, IN(I_GFFN), ADA, 4096, 3072, H2, nullptr, SEQ + wave, 8, lane);
            asm volatile("s_waitcnt vmcnt(0)" ::: "memory"); __syncthreads(); }
        float* const out = OUT(); EpiFfn E{GG, IN(I_FCW), IN(I_FCB), IN(I_SFF), out + O_FP, out + O_FS, (PG8_LAS float*)(ldsl + HALO_OFF), (const float*)WS(WS_SS), (const float*)WS(WS_C0)};
        pg8::gemm_phase<EpiFfn, SC, 1024, 1024, 1024, true, true>(ldsl, wave0, S, E);
    }
    GRID_SYNC();
    STAMP(9);
    {
        typedef Sched<0, FF * 2, FF * 2> SC; SC S; S.to.init(SEQ / 256, 4); S.G = G; S.c = bid; S.A0 = (const char*)GG; S.B0 = (const char*)WDN;
        { EpiDelta E{Z, ADA, 5120};
        pg8::gemm_phase<EpiDelta, SC, FF, FF, FF, true, true>(ldsl, wave0, S, E); }
        { PHASE_IDS(); MiniArgs P{GG, WDN, nullptr, nullptr, nullptr, nullptr, Z, nullptr, nullptr, ADA, 5120}; mini_sample_gemm<2, FF>(lds, P, bid, G, wave, lane); }
    }
    GRID_SYNC();
    STAMP(10);
    {
        PHASE_IDS();
        float* const out = OUT();
        norm_phase<2>(out, nullptr, IN(I_GFIN), nullptr, 0, 0, nullptr, out, gw, NGW, lane, Z);
    }
#if TIMESEL >= 0
    GRID_SYNC();
    STAMP(11);
    GRID_SYNC();
    STAMP(12);
    GRID_SYNC();
    {   PHASE_IDS(); const volatile unsigned long long* ts = (const volatile unsigned long long*)WS(768 * 1024);
        const float us = (float)(ts[TIMESEL + TIMESPAN] - ts[TIMESEL]) * 0.01f;
        const float sc = 1.006f + us * 1e-5f; float* o = OUT() + O_KS;
        for (long i = gt; i < 128L * 128 * 256; i += NGT) o[i] *= sc; }
#endif
}

extern "C" void kernel_launch(void* const* d_in, const int* in_sizes, int n_in, void* d_out, int out_size, void* d_ws, size_t ws_size, hipStream_t stream) {
    static int grid = 0;
    if (grid == 0) {
        if (n_in != 23 || ws_size < WS_END) { fprintf(stderr, "kernel_launch: unexpected n_in %d / ws %zu\n", n_in, ws_size); grid = -1; return; }
        int dev = 0, cus = 0, per_cu = 0;
        hipGetDevice(&dev); hipDeviceGetAttribute(&cus, hipDeviceAttributeMultiprocessorCount, dev);
        if (hipFuncSetAttribute((const void*)mega, hipFuncAttributeMaxDynamicSharedMemorySize, LDS_BYTES) != hipSuccess) { fprintf(stderr, "kernel_launch: hipFuncSetAttribute failed\n"); }
        hipOccupancyMaxActiveBlocksPerMultiprocessor(&per_cu, (const void*)mega, 512, LDS_BYTES);
        (void)hipGetLastError();
        if (per_cu < 1) per_cu = 1;
        grid = cus * 1;
        if (grid <= 0) grid = 256;
    }
    if (grid < 0) return;
    Args a{};
    for (int i = 0; i < 23; ++i) a.in[i] = (const float*)d_in[i];
    a.out = (float*)d_out; a.ws = (unsigned char*)d_ws;
    (void)hipMemsetAsync((char*)d_ws + WS_BAR, 0, BAR_ZERO_BYTES, stream);
    void* args[] = {&a};
    hipError_t e = hipLaunchCooperativeKernel((const void*)mega, dim3(grid), dim3(512), args, LDS_BYTES, stream);
    if (e != hipSuccess) fprintf(stderr, "cooperative launch failed: %s (grid %d)\n", hipGetErrorString(e), grid);
}
```

```cpp
#ifndef SELFCHECK
#define SELFCHECK 0
#endif
#ifndef TIMESEL
#define TIMESEL -1
#define TIMESPAN 1
#endif
#ifndef TIMESPAN
#define TIMESPAN 1
#endif
#include <hip/hip_runtime.h>
#include <hip/hip_cooperative_groups.h>
#include <cstdio>
#include <cstdint>
namespace cg = cooperative_groups;

constexpr int D = 1024, SEQ = 16384, NS = 128, MROWS = SEQ + NS, MPAD = 16640;
constexpr int NIN = 6656, FF = 2816, FF2 = 5632, NADA = 6144;
constexpr int NMT = MPAD / 256;
constexpr int NPT5 = 65;
constexpr float EPS = 1e-6f;

constexpr size_t MiB = 1u << 20;
constexpr size_t RB = (size_t)MPAD * 1024 * 2;
constexpr size_t KBB = (size_t)MPAD * 256 * 2;
constexpr size_t WS_AADA = 1 * MiB;
constexpr size_t WS_ADA = 2 * MiB;
constexpr size_t WS_WA = 8 * MiB, WS_WB = 10 * MiB, WS_WO = 12 * MiB;
constexpr size_t WS_WADA = 14 * MiB;
constexpr size_t WS_WIN = 26 * MiB;
constexpr size_t WS_WUP = 14 * MiB;
constexpr size_t WS_WDN = 25 * MiB;
constexpr size_t WS_H = 39 * MiB;
constexpr size_t WS_U = 72 * MiB;
constexpr size_t WS_BG = 105 * MiB;
constexpr size_t WS_Q = 138 * MiB;
constexpr size_t WS_KB = WS_Q + RB, WS_VB = WS_KB + KBB, WS_GA = WS_VB + KBB, WS_GB = WS_GA + RB;
constexpr size_t WS_G = WS_Q;
constexpr size_t WS_END = WS_GB + RB;
static_assert(WS_END <= 256 * MiB, "ws map");
static_assert(WS_G + (size_t)MPAD * FF * 2 <= WS_END, "G overlay");
static_assert(WS_WDN + (size_t)1024 * FF * 2 <= WS_H && WS_WUP + (size_t)FF2 * 1024 * 2 <= WS_WDN, "weights");
static_assert(WS_U + RB + 4096 <= WS_BG && WS_H + RB <= WS_U && WS_BG + RB <= WS_Q, "row buffers");

constexpr size_t O_YP = 0, O_YS = 16777216, O_CAP = 16908288, O_CAS = 16910336, O_KP = 17172480, O_KS = 17205248,
                 O_VP = 21399552, O_VS = 21432320, O_FP = 25626624, O_FS = 25637888;

constexpr int LDS_BYTES = 147456;
constexpr int HALO_OFF = 131072;

typedef unsigned short bf16_t;
typedef short bf16x8 __attribute__((ext_vector_type(8)));
typedef float f32x4 __attribute__((ext_vector_type(4)));
typedef float f32x16 __attribute__((ext_vector_type(16)));
typedef float f32x2 __attribute__((ext_vector_type(2)));
typedef unsigned u32x4 __attribute__((ext_vector_type(4)));
typedef unsigned u32x2 __attribute__((ext_vector_type(2)));

__device__ __forceinline__ float bf2f(unsigned b) { return __uint_as_float(b << 16); }
__device__ __forceinline__ unsigned cvt_pk_bf16(float lo, float hi) { unsigned r; asm volatile("v_cvt_pk_bf16_f32 %0, %1, %2" : "=v"(r) : "v"(lo), "v"(hi)); return r; }
__device__ __forceinline__ unsigned lane_id_now() { unsigned l; asm volatile("v_mbcnt_lo_u32_b32 %0, -1, 0\n\tv_mbcnt_hi_u32_b32 %0, -1, %0" : "=v"(l)); return l; }
__device__ __forceinline__ float bperm_f(float v, int byte_addr) { return __int_as_float(__builtin_amdgcn_ds_bpermute(byte_addr, __float_as_int(v))); }
__device__ __forceinline__ float sigmoidf_(float x) { return __builtin_amdgcn_rcpf(1.0f + __expf(-x)); }
__device__ __forceinline__ float siluf_(float x) { return x * __builtin_amdgcn_rcpf(1.0f + __expf(-x)); }
__device__ __forceinline__ float wave_sum(float v) {
#pragma unroll
    for (int o = 1; o < 64; o <<= 1) v += __shfl_xor(v, o);
    return v;
}
__device__ __forceinline__ float wave_max(float v) {
#pragma unroll
    for (int o = 1; o < 64; o <<= 1) v = fmaxf(v, __shfl_xor(v, o));
    return v;
}
__device__ __forceinline__ void unpack8(u32x4 w, float* f) {
    f[0] = bf2f(w.x & 0xffffu); f[1] = bf2f(w.x >> 16); f[2] = bf2f(w.y & 0xffffu); f[3] = bf2f(w.y >> 16);
    f[4] = bf2f(w.z & 0xffffu); f[5] = bf2f(w.z >> 16); f[6] = bf2f(w.w & 0xffffu); f[7] = bf2f(w.w >> 16);
}
__device__ __forceinline__ u32x4 pack8(const float* f) {
    u32x4 w; w.x = cvt_pk_bf16(f[0], f[1]); w.y = cvt_pk_bf16(f[2], f[3]); w.z = cvt_pk_bf16(f[4], f[5]); w.w = cvt_pk_bf16(f[6], f[7]); return w;
}

namespace pg8 {
#define PG8_LAS __attribute__((address_space(3)))
constexpr int BM = 256, BK = 64, HALF = 128, HTB = HALF * BK * 2, STAGE_BYTES = 8 * HTB, NXCD = 8, WGM = 8;
__host__ __device__ __forceinline__ int lds_byte(int r, int c) { const int st = (r >> 4) * 2 + (c >> 5), rr = r & 15, cc = c & 31, ob = rr * 64 + cc * 2; return st * 1024 + (ob ^ (((ob >> 9) & 1) << 5)); }
__host__ __device__ __forceinline__ void stage_rc(int b, int& R, int& C) { const int st = b / 1024, sb = b % 1024, swz = sb ^ (((sb >> 9) & 1) << 5); R = (st >> 1) * 16 + swz / 64; C = (st & 1) * 32 + (swz % 64) / 2; }
__host__ __device__ __forceinline__ int perm32(int rho) { const int n = rho >> 4, i = rho & 15; return 8 * (i >> 2) + 4 * n + (i & 3); }

struct Unit { int pm, pn, aux; const char* a; const char* b; };

struct TileOrder {
    int nM, nN, nwg;
    __device__ __forceinline__ void init(int nM_, int nN_) { nM = nM_; nN = nN_; nwg = nM * nN; }
    __device__ __forceinline__ bool tile(long L, int& pm, int& pn) const {
        if (L >= nwg) return false;
        int wgid = (int)L; { const int q = nwg / NXCD, r = nwg % NXCD, xcd = wgid % NXCD, off = wgid / NXCD; wgid = (xcd < r ? xcd * (q + 1) : r * (q + 1) + (xcd - r) * q) + off; }
        const int nig = WGM * nN, gid = wgid / nig, fm = gid * WGM, gsz = (nM - fm) < WGM ? (nM - fm) : WGM;
        pm = fm + ((wgid % nig) % gsz); pn = (wgid % nig) / gsz; return true;
    }
};

template <class Epi, class Sched, int lda, int ldb, int K, bool ALIGN_EPI, bool SP2>
__device__ __forceinline__ void gemm_phase(PG8_LAS unsigned char* lds, const int wave0, const Sched& S, const Epi& E) {
    int tid_ = wave0 * 64 + (int)lane_id_now(); asm volatile("" : "+v"(tid_));
    const int tid = tid_, wid = __builtin_amdgcn_readfirstlane(tid >> 6), lane = tid & 63, wr = wid >> 2, wc = wid & 3, fr = lane & 15, fq = lane >> 4;
    const int nt = K / BK;
    unsigned voffA[2], voffB[2];
#pragma unroll
    for (int i = 0; i < 2; ++i) { int R, C; stage_rc(tid * 16 + i * 8192, R, C); const int Rb = Epi::PERM ? ((R & ~31) + perm32(R & 31)) : R;
        voffA[i] = (unsigned)(R * lda + C) * 2u; voffB[i] = (unsigned)(Rb * ldb + C) * 2u; }
    const size_t kstep = (size_t)(BK * 2);
    const size_t hstepA = (size_t)HALF * lda * 2, hstepB = (size_t)HALF * ldb * 2;
    const unsigned ldsw = (unsigned)wid * 1024u;
    const int aoff = lds_byte(wr * 64 + fr, fq * 8), boff = lds_byte(wc * 32 + fr, fq * 8);
#define PG8_SA(b, h) (((b) * 2 + (h)) * HTB)
#define PG8_SB(b, h) ((4 + (b) * 2 + (h)) * HTB)
#define PG8_STAGE(bufoff, gbase, voff) do { _Pragma("unroll") for (int _i = 0; _i < 2; ++_i) \
        __builtin_amdgcn_global_load_lds((const unsigned*)((const char*)(gbase) + (voff)[_i]), (PG8_LAS unsigned*)(lds + (bufoff) + ldsw + _i * 8192), 16, 0, 0); } while (0)
#define PG8_LDA(dst, b, h) do { _Pragma("unroll") for (int m = 0; m < 4; ++m) _Pragma("unroll") for (int k = 0; k < 2; ++k) dst[m][k] = *(const PG8_LAS bf16x8*)(lds + PG8_SA(b, h) + aoff + m * 2048 + k * 1024); } while (0)
#define PG8_LDB(dst, b, h) do { _Pragma("unroll") for (int n = 0; n < 2; ++n) _Pragma("unroll") for (int k = 0; k < 2; ++k) dst[n][k] = *(const PG8_LAS bf16x8*)(lds + PG8_SB(b, h) + boff + n * 2048 + k * 1024); } while (0)
#define PG8_MMA(ai, bj, At, Bt) do { __builtin_amdgcn_s_setprio(1); _Pragma("unroll") for (int m = 0; m < 4; ++m) _Pragma("unroll") for (int n = 0; n < 2; ++n) _Pragma("unroll") for (int k = 0; k < 2; ++k) \
        acc[ai][bj][m][n] = __builtin_amdgcn_mfma_f32_16x16x32_bf16(Bt[n][k], At[m][k], acc[ai][bj][m][n], 0, 0, 0); __builtin_amdgcn_s_setprio(0); } while (0)
#define PG8_WAIT_V(n) asm volatile("s_waitcnt vmcnt(" #n ")" ::: "memory")
#define PG8_WAIT_L(n) asm volatile("s_waitcnt lgkmcnt(" #n ")" ::: "memory")
#define PG8_BAR __builtin_amdgcn_s_barrier()
#define PG8_SCHED __builtin_amdgcn_sched_barrier(0)
    Unit cur, nxt; int ui = 0;
    if (!S.next(0, cur)) return;
    f32x4 acc[2][2][4][2];
#pragma unroll
    for (int a = 0; a < 2; ++a)
#pragma unroll
        for (int b = 0; b < 2; ++b)
#pragma unroll
            for (int m = 0; m < 4; ++m)
#pragma unroll
                for (int n = 0; n < 2; ++n) acc[a][b][m][n] = (f32x4){0.f, 0.f, 0.f, 0.f};
    bf16x8 At[4][2], B0[2][2], B1[2][2];
    const char* cA = cur.a; const char* cB = cur.b;
    if constexpr (SP2) {
        PG8_STAGE(PG8_SB(0, 0), cB, voffB); PG8_STAGE(PG8_SB(0, 1), cB + hstepB, voffB); PG8_STAGE(PG8_SA(0, 0), cA, voffA); PG8_STAGE(PG8_SA(0, 1), cA + hstepA, voffA);
        if (wr == 1) PG8_BAR;
        PG8_WAIT_V(2); PG8_BAR;
        PG8_STAGE(PG8_SB(1, 0), cB + kstep, voffB); PG8_STAGE(PG8_SA(1, 0), cA + kstep, voffA); PG8_STAGE(PG8_SB(1, 1), cB + hstepB + kstep, voffB);
        PG8_WAIT_V(6); PG8_BAR;
    } else {
        PG8_STAGE(PG8_SB(0, 0), cB, voffB); PG8_STAGE(PG8_SA(0, 0), cA, voffA); PG8_STAGE(PG8_SB(0, 1), cB + hstepB, voffB); PG8_STAGE(PG8_SA(0, 1), cA + hstepA, voffA);
        if (wr == 1) PG8_BAR;
        PG8_WAIT_V(4); PG8_BAR;
        PG8_STAGE(PG8_SB(1, 0), cB + kstep, voffB); PG8_STAGE(PG8_SA(1, 0), cA + kstep, voffA); PG8_STAGE(PG8_SB(1, 1), cB + hstepB + kstep, voffB);
        PG8_WAIT_V(6); PG8_BAR;
    }
    for (;;) {
        const bool has_next = S.next(ui + 1, nxt);
        const char* nA = has_next ? nxt.a : cA; const char* nB = has_next ? nxt.b : cB;
        for (int t = 0; t < nt; t += 2) {
            const bool last = (t == nt - 2);
            const char* a1 = cA + (size_t)(t + 1) * kstep;
            const char* a2 = last ? nA : cA + (size_t)(t + 2) * kstep; const char* b2 = last ? nB : cB + (size_t)(t + 2) * kstep;
            const char* a3 = a2 + kstep; const char* b3 = b2 + kstep;
            if constexpr (SP2) {
            PG8_LDB(B0, 0, 0); PG8_LDB(B1, 0, 1); PG8_SCHED; PG8_LDA(At, 0, 0); PG8_STAGE(PG8_SA(1, 1), a1 + hstepA, voffA);
            PG8_WAIT_V(8); PG8_WAIT_L(0); PG8_BAR; PG8_MMA(0, 0, At, B0); PG8_MMA(0, 1, At, B1); PG8_BAR; PG8_SCHED;
            PG8_LDA(At, 0, 1); PG8_STAGE(PG8_SB(0, 0), b2, voffB); PG8_STAGE(PG8_SB(0, 1), b2 + hstepB, voffB); PG8_STAGE(PG8_SA(0, 0), a2, voffA);
            PG8_WAIT_V(8); PG8_WAIT_L(0); PG8_BAR; PG8_MMA(1, 0, At, B0); PG8_MMA(1, 1, At, B1); PG8_BAR; PG8_SCHED;
            PG8_LDB(B0, 1, 0); PG8_LDB(B1, 1, 1); PG8_SCHED; PG8_LDA(At, 1, 0); PG8_STAGE(PG8_SA(0, 1), a2 + hstepA, voffA);
            PG8_WAIT_V(8); PG8_WAIT_L(0); PG8_BAR; PG8_MMA(0, 0, At, B0); PG8_MMA(0, 1, At, B1); PG8_BAR; PG8_SCHED;
            PG8_LDA(At, 1, 1); PG8_STAGE(PG8_SB(1, 0), b3, voffB); PG8_STAGE(PG8_SB(1, 1), b3 + hstepB, voffB); PG8_STAGE(PG8_SA(1, 0), a3, voffA);
            PG8_WAIT_V(8); PG8_WAIT_L(0); PG8_BAR; PG8_MMA(1, 0, At, B0); PG8_MMA(1, 1, At, B1); PG8_BAR; PG8_SCHED;
            } else {
            PG8_LDB(B0, 0, 0); PG8_SCHED; PG8_LDA(At, 0, 0); PG8_STAGE(PG8_SA(1, 1), a1 + hstepA, voffA);
            PG8_WAIT_L(8); PG8_BAR; PG8_WAIT_L(0); PG8_MMA(0, 0, At, B0); PG8_BAR; PG8_SCHED;
            PG8_LDB(B1, 0, 1); PG8_STAGE(PG8_SB(0, 0), b2, voffB);
            PG8_BAR; PG8_WAIT_L(0); PG8_MMA(0, 1, At, B1); PG8_BAR;
            PG8_LDA(At, 0, 1); PG8_STAGE(PG8_SA(0, 0), a2, voffA);
            PG8_BAR; PG8_WAIT_L(0); PG8_MMA(1, 0, At, B0); PG8_BAR; PG8_SCHED;
            PG8_STAGE(PG8_SB(0, 1), b2 + hstepB, voffB);
            PG8_WAIT_V(6); PG8_BAR; PG8_MMA(1, 1, At, B1); PG8_BAR;
            PG8_LDB(B0, 1, 0); PG8_SCHED; PG8_LDA(At, 1, 0); PG8_STAGE(PG8_SA(0, 1), a2 + hstepA, voffA);
            PG8_WAIT_L(8); PG8_BAR; PG8_WAIT_L(0); PG8_MMA(0, 0, At, B0); PG8_BAR; PG8_SCHED;
            PG8_LDB(B1, 1, 1); PG8_STAGE(PG8_SB(1, 0), b3, voffB);
            PG8_BAR; PG8_WAIT_L(0); PG8_MMA(0, 1, At, B1); PG8_BAR;
            PG8_LDA(At, 1, 1); PG8_STAGE(PG8_SA(1, 0), a3, voffA);
            PG8_BAR; PG8_WAIT_L(0); PG8_MMA(1, 0, At, B0); PG8_BAR; PG8_SCHED;
            PG8_STAGE(PG8_SB(1, 1), b3 + hstepB, voffB);
            PG8_WAIT_V(6); PG8_BAR; PG8_MMA(1, 1, At, B1); PG8_BAR;
            }
        }
        if constexpr (ALIGN_EPI) { if (wr == 0) PG8_BAR; }
        E(acc, cur, wr, wc, fr, fq);
        if (!has_next) break;
#pragma unroll
        for (int a = 0; a < 2; ++a)
#pragma unroll
            for (int b = 0; b < 2; ++b)
#pragma unroll
                for (int m = 0; m < 4; ++m)
#pragma unroll
                    for (int n = 0; n < 2; ++n) acc[a][b][m][n] = (f32x4){0.f, 0.f, 0.f, 0.f};
        cur = nxt; cA = nA; cB = nB; ++ui;
        if constexpr (ALIGN_EPI) { if (wr == 1) PG8_BAR; }
    }
    PG8_WAIT_V(0);
    if constexpr (!ALIGN_EPI) { if (wr == 0) PG8_BAR; }
    PG8_BAR;
#undef PG8_SA
#undef PG8_SB
#undef PG8_STAGE
#undef PG8_LDA
#undef PG8_LDB
#undef PG8_MMA
#undef PG8_WAIT_V
#undef PG8_WAIT_L
#undef PG8_BAR
#undef PG8_SCHED
}
}
using pg8::Unit;

template <int MODE, int LDA_B, int LDB_B> struct Sched {
    pg8::TileOrder to; int G, c;
    const char* A0; const char* B0; const char* A1; const char* B1;
    __device__ __forceinline__ bool next(int i, Unit& u) const {
        if (MODE == 1) {
            const long L = (long)(i >> 1) * G + c; if (!to.tile(L, u.pm, u.pn)) return false;
            u.aux = i & 1;
            u.a = (u.aux ? A1 : A0) + (size_t)u.pm * 256 * LDA_B; u.b = (u.aux ? B1 : B0) + (size_t)u.pn * 256 * LDB_B; return true;
        } else {
            const long L = (long)i * G + c;
            if (MODE == 2 && G >= 64) {
                const int nS = FF2 / 256;
                if (L >= (long)to.nwg + nS) return false;
                if (L >= G - nS && L < G) { u.pm = NPT5; u.pn = (int)(L - (G - nS)); }
                else if (!to.tile(L < G - nS ? L : L - nS, u.pm, u.pn)) return false;
            } else if (!to.tile(L, u.pm, u.pn)) return false;
            u.aux = 0;
            if (MODE == 2) { const long r0 = (u.pm < NPT5) ? (254L * u.pm - 2) : (long)SEQ; u.a = A0 + r0 * (long)LDA_B; }
            else u.a = A0 + (size_t)u.pm * 256 * LDA_B;
            u.b = B0 + (size_t)u.pn * 256 * LDB_B; return true;
        }
    }
};

#define EPI_ARGS const f32x4 (&acc)[2][2][4][2], const Unit& u, int wr, int wc, int fr, int fq
struct EpiAda {
    static constexpr bool PERM = true;
    float* ADA; const float* bias;
    __device__ __forceinline__ void operator()(EPI_ARGS) const {
#pragma unroll
        for (int ai = 0; ai < 2; ++ai)
#pragma unroll
            for (int m = 0; m < 4; ++m) { const int row = 128 * ai + 64 * wr + 16 * m + fr;
#pragma unroll
                for (int bj = 0; bj < 2; ++bj) { const int col = 256 * u.pn + 128 * bj + 32 * wc + 8 * fq;
#pragma unroll
                    for (int n = 0; n < 2; ++n) { const f32x4 b = *(const f32x4*)(bias + col + 4 * n); *(f32x4*)(ADA + (size_t)row * NADA + col + 4 * n) = acc[ai][bj][m][n] + b; } } }
    }
};
struct EpiProj {
    static constexpr bool PERM = true;
    bf16_t *U, *BG, *Q, *KB, *VB, *GA, *GB;
    __device__ __forceinline__ void operator()(EPI_ARGS) const {
        const int row0 = u.pm * 256 + wr * 64 + fr;
        if (u.pn < 8) {
#pragma unroll
            for (int ai = 0; ai < 2; ++ai)
#pragma unroll
                for (int m = 0; m < 4; ++m) { const int row = row0 + 128 * ai + 16 * m;
                    const f32x4 v0 = acc[ai][0][m][0] * acc[ai][1][m][0], v1 = acc[ai][0][m][1] * acc[ai][1][m][1];
                    u32x4 w; w.x = cvt_pk_bf16(v0[0], v0[1]); w.y = cvt_pk_bf16(v0[2], v0[3]); w.z = cvt_pk_bf16(v1[0], v1[1]); w.w = cvt_pk_bf16(v1[2], v1[3]);
                    *(u32x4*)(U + (size_t)row * 1024 + 128 * u.pn + 32 * wc + 8 * fq) = w; }
        } else {
            bf16_t* dst; int ld, cb; const int pn = u.pn;
            if (pn < 12) { dst = BG; ld = 1024; cb = 256 * (pn - 8); }
            else if (pn < 16) { dst = Q; ld = 1024; cb = 256 * (pn - 12); }
            else if (pn == 16) { dst = KB; ld = 256; cb = 0; }
            else if (pn == 17) { dst = VB; ld = 256; cb = 0; }
            else if (pn < 22) { dst = GA; ld = 1024; cb = 256 * (pn - 18); }
            else { dst = GB; ld = 1024; cb = 256 * (pn - 22); }
#pragma unroll
            for (int ai = 0; ai < 2; ++ai)
#pragma unroll
                for (int m = 0; m < 4; ++m) { const int row = row0 + 128 * ai + 16 * m;
#pragma unroll
                    for (int bj = 0; bj < 2; ++bj) { const f32x4 v0 = acc[ai][bj][m][0], v1 = acc[ai][bj][m][1];
                        u32x4 w; w.x = cvt_pk_bf16(v0[0], v0[1]); w.y = cvt_pk_bf16(v0[2], v0[3]); w.z = cvt_pk_bf16(v1[0], v1[1]); w.w = cvt_pk_bf16(v1[2], v1[3]);
                        *(u32x4*)(dst + (size_t)row * ld + cb + 128 * bj + 32 * wc + 8 * fq) = w; } }
        }
    }
};
struct EpiMix {
    static constexpr bool PERM = true;
    const bf16_t *GA, *GB; float* T; bf16_t* Z;
    __device__ __forceinline__ void operator()(EPI_ARGS) const {
        const int row0 = u.pm * 256 + wr * 64 + fr;
        const bf16_t* gate = u.aux ? GB : GA;
#pragma unroll
        for (int ai = 0; ai < 2; ++ai)
#pragma unroll
            for (int m = 0; m < 4; ++m) { const int row = row0 + 128 * ai + 16 * m;
                if (row < MROWS) {
#pragma unroll
                for (int bj = 0; bj < 2; ++bj) { const int col = 256 * u.pn + 128 * bj + 32 * wc + 8 * fq;
                    float gv[8]; unpack8(*(const u32x4*)(gate + (size_t)row * 1024 + col), gv);
                    float o[8];
#pragma unroll
                    for (int i = 0; i < 8; ++i) o[i] = sigmoidf_(gv[i]) * acc[ai][bj][m][i >> 2][i & 3];
                    bf16_t* zp = Z + (size_t)row * 1024 + col;
                    if (u.aux == 0) *(u32x4*)zp = pack8(o);
                    else { float t[8]; unpack8(*(const u32x4*)zp, t);
#pragma unroll
                        for (int i = 0; i < 8; ++i) o[i] += t[i];
                        *(u32x4*)zp = pack8(o); } } } }
    }
};
struct EpiRes {
    static constexpr bool PERM = true;
    const float* xp; const float* xs; float* out; const float* ADA; int goff;
    __device__ __forceinline__ void operator()(EPI_ARGS) const {
        const int row0 = u.pm * 256 + wr * 64 + fr;
#pragma unroll
        for (int ai = 0; ai < 2; ++ai)
#pragma unroll
            for (int m = 0; m < 4; ++m) { const int row = row0 + 128 * ai + 16 * m;
                if (row < MROWS) {
                const float* base = (row < SEQ) ? xp + (size_t)row * 1024 : xs + (size_t)(row - SEQ) * 1024;
                const float* gt = ADA + (size_t)((row < SEQ) ? 128 : row - SEQ) * NADA + goff;
#pragma unroll
                for (int bj = 0; bj < 2; ++bj) { const int col = 256 * u.pn + 128 * bj + 32 * wc + 8 * fq;
#pragma unroll
                    for (int n = 0; n < 2; ++n) { const f32x4 b = *(const f32x4*)(base + col + 4 * n), g = *(const f32x4*)(gt + col + 4 * n);
                        *(f32x4*)(out + (size_t)row * 1024 + col + 4 * n) = b + g * acc[ai][bj][m][n]; } } } }
    }
};
struct EpiDelta {
    static constexpr bool PERM = true;
    bf16_t* Dd; const float* ADA; int goff;
    __device__ __forceinline__ void operator()(EPI_ARGS) const {
        const int row0 = u.pm * 256 + wr * 64 + fr;
#pragma unroll
        for (int ai = 0; ai < 2; ++ai)
#pragma unroll
            for (int m = 0; m < 4; ++m) { const int row = row0 + 128 * ai + 16 * m;
                if (row < MROWS) {
                const float* gt = ADA + (size_t)((row < SEQ) ? 128 : row - SEQ) * NADA + goff;
#pragma unroll
                for (int bj = 0; bj < 2; ++bj) { const int col = 256 * u.pn + 128 * bj + 32 * wc + 8 * fq;
                    const f32x4 g0 = *(const f32x4*)(gt + col), g1 = *(const f32x4*)(gt + col + 4); const f32x4 a0 = g0 * acc[ai][bj][m][0], a1 = g1 * acc[ai][bj][m][1];
                    u32x4 w; w.x = cvt_pk_bf16(a0[0], a0[1]); w.y = cvt_pk_bf16(a0[2], a0[3]); w.z = cvt_pk_bf16(a1[0], a1[1]); w.w = cvt_pk_bf16(a1[2], a1[3]);
                    *(u32x4*)(Dd + (size_t)row * 1024 + col) = w; } } }
    }
};
struct EpiRes4 {
    static constexpr bool PERM = true;
    const float* xp; float* out; const float* ADA; const float* gf; bf16_t* A2; float* SS;
    __device__ __forceinline__ void operator()(EPI_ARGS) const {
        const int row0 = u.pm * 256 + wr * 64 + fr; const float* ad = ADA + (size_t)128 * NADA;
#pragma unroll
        for (int ai = 0; ai < 2; ++ai)
#pragma unroll
            for (int m = 0; m < 4; ++m) { const int row = row0 + 128 * ai + 16 * m; float ss = 0.f;
#pragma unroll
                for (int bj = 0; bj < 2; ++bj) { const int col = 256 * u.pn + 128 * bj + 32 * wc + 8 * fq; float a2[8];
#pragma unroll
                    for (int n = 0; n < 2; ++n) { const f32x4 b = *(const f32x4*)(xp + (size_t)row * 1024 + col + 4 * n), g = *(const f32x4*)(ad + 2048 + col + 4 * n);
                        const f32x4 x1 = b + g * acc[ai][bj][m][n]; *(f32x4*)(out + (size_t)row * 1024 + col + 4 * n) = x1;
                        ss += (x1[0] * x1[0] + x1[1] * x1[1]) + (x1[2] * x1[2] + x1[3] * x1[3]);
                        const f32x4 gm = *(const f32x4*)(gf + col + 4 * n) * (*(const f32x4*)(ad + 4096 + col + 4 * n) + 1.0f); const f32x4 av = x1 * gm;
                        a2[4 * n] = av[0]; a2[4 * n + 1] = av[1]; a2[4 * n + 2] = av[2]; a2[4 * n + 3] = av[3]; }
                    *(u32x4*)(A2 + (size_t)row * 1024 + col) = pack8(a2); }
                ss += __shfl_xor(ss, 16); ss += __shfl_xor(ss, 32);
                if (fq == 0) SS[(size_t)row * 16 + u.pn * 4 + wc] = ss; }
    }
};
__device__ __forceinline__ float ss_sum16(const float* SS, unsigned row) {
    const f32x4* p = (const f32x4*)((const char*)SS + (size_t)row * 64u); const f32x4 a = p[0], b = p[1], c = p[2], d = p[3]; const f32x4 s = (a + b) + (c + d); return (s[0] + s[1]) + (s[2] + s[3]); }
struct EpiFfn {
    static constexpr bool PERM = true;
    bf16_t* G; const float* cw; const float* cb; const float* st; float* ofp; float* ofs; PG8_LAS float* halo; const float* SS; const float* C0;
    template <int CTRL> static __device__ __forceinline__ float dppf(float oldv, float src) {
        return __int_as_float(__builtin_amdgcn_update_dpp(__float_as_int(oldv), __float_as_int(src), CTRL, 0xf, 0xf, false)); }
    __device__ __forceinline__ void operator()(const f32x4 (&acc)[2][2][4][2], const Unit& u, int wr, int wc, int fr_, int fq_) const {
        const int l_ = (int)lane_id_now();
        const int fr = l_ & 15, fq = l_ >> 4; (void)fr_; (void)fq_;
        const int wid = wr * 4 + wc;
        const int f0 = 128 * u.pn + 32 * wc + 8 * fq;
        if (u.pm < NPT5) {
            PG8_LAS float* par = halo + 2048;
            {
                const int t = wid * 64 + l_;
                if (t < 256) { const int gc = (t < 128) ? 128 * u.pn + t : FF + 128 * u.pn + (t - 128);
                    const float w0_ = cw[gc], w1_ = cw[FF2 + gc], w2_ = cw[2 * FF2 + gc], b_ = cb[gc], c0_ = C0[gc];
                    par[t] = w0_; par[256 + t] = w1_; par[512 + t] = w2_; par[768 + t] = b_ + c0_ * (w0_ + w1_ + w2_); par[1024 + t] = c0_; }
                else { const int tr_ = t - 256, gr_ = 254 * u.pm - 2 + tr_; const unsigned go_ = (unsigned)((gr_ < 0 || gr_ >= SEQ) ? 0 : gr_);
                    const float ssv = ss_sum16(SS, go_); par[1280 + tr_] = (gr_ >= 0) ? rsqrtf(ssv * (1.0f / 1024.0f) + EPS) : 0.f; }
            }
            unsigned pb_ = (unsigned)(uintptr_t)(par + 32 * wc + 8 * fq); asm volatile("" : "+v"(pb_)); const PG8_LAS float* parl = (const PG8_LAS float*)(uintptr_t)pb_;
            unsigned rb_ = (unsigned)(uintptr_t)(par + 1280 + 64 * wr + fr); asm volatile("" : "+v"(rb_)); const PG8_LAS float* rsl = (const PG8_LAS float*)(uintptr_t)rb_;
            if (fr >= 14) {
#pragma unroll
                for (int ai = 0; ai < 2; ++ai)
#pragma unroll
                    for (int bj = 0; bj < 2; ++bj)
#pragma unroll
                        for (int n = 0; n < 2; ++n) { const int gr_ = 254 * u.pm - 2 + 128 * ai + 64 * wr + 48 + fr; const float r_ = rsqrtf(ss_sum16(SS, (unsigned)(gr_ >= SEQ ? 0 : gr_)) * (1.0f / 1024.0f) + EPS);
                            *(PG8_LAS f32x4*)(halo + ((wid * 2 + ai) * 2 + (fr - 14)) * 64 + bj * 32 + fq * 8 + n * 4) = acc[ai][bj][3][n] * r_; }
            }
            const bool first = (u.pm == 0) && (wr == 0);
            asm volatile("s_waitcnt vmcnt(0) lgkmcnt(0)" ::: "memory"); __builtin_amdgcn_s_barrier(); asm volatile("" ::: "memory");
#pragma unroll
            for (int ai = 0; ai < 2; ++ai) {
                const int swr = (ai == 0) ? 0 : (wr == 0 ? 1 : 0), sai = (ai == 1 && wr == 1) ? 1 : 0;
                unsigned hb_ = (unsigned)(uintptr_t)(halo + (((swr * 4 + wc) * 2 + sai) * 2) * 64 + fq * 8); asm volatile("" : "+v"(hb_)); const PG8_LAS float* hp = (const PG8_LAS float*)(uintptr_t)hb_;
                u32x2 pk0[4];
#pragma unroll
                for (int n = 0; n < 2; ++n) {
                    const int cg0 = 4 * n, cv0 = 128 + cg0;
                    f32x4 cvv[4];
                    {
                        const f32x4 w0 = *(const PG8_LAS f32x4*)(parl + cv0), w1 = *(const PG8_LAS f32x4*)(parl + 256 + cv0), w2 = *(const PG8_LAS f32x4*)(parl + 512 + cv0), bb = *(const PG8_LAS f32x4*)(parl + 768 + cv0);
                        const f32x4 h2 = *(const PG8_LAS f32x4*)(hp + 32 + n * 4), h1 = *(const PG8_LAS f32x4*)(hp + 64 + 32 + n * 4);
                        f32x4 p1 = h1, p2 = (fr == 1) ? h1 : h2;
                        const f32x4 bbe = bb;
#pragma unroll
                        for (int m = 0; m < 4; ++m) {
                            const float r_ = rsl[128 * ai + 16 * m];
                            const f32x4 x = acc[ai][1][m][n] * r_; f32x4 q1, q2, n1, n2;
#pragma unroll
                            for (int i = 0; i < 4; ++i) { q1[i] = dppf<0x111>(p1[i], x[i]); q2[i] = dppf<0x112>(p2[i], x[i]); n1[i] = dppf<0x121>(x[i], x[i]); n2[i] = dppf<0x122>(x[i], x[i]); }
                            p1 = n1; p2 = n2;
                            cvv[m] = w0 * q2 + w1 * q1 + w2 * x + bbe;
                            if (ai == 0 && m == 0 && first) { const f32x4 c0v = *(const PG8_LAS f32x4*)(parl + 1024 + cv0); if (fr == 2) cvv[m] -= c0v * (w0 + w1); else if (fr == 3) cvv[m] -= c0v * w0; }
                            __builtin_amdgcn_sched_barrier(0);
                        }
                    }
                    {
                        const f32x4 w0 = *(const PG8_LAS f32x4*)(parl + cg0), w1 = *(const PG8_LAS f32x4*)(parl + 256 + cg0), w2 = *(const PG8_LAS f32x4*)(parl + 512 + cg0), bb = *(const PG8_LAS f32x4*)(parl + 768 + cg0);
                        const f32x4 h2 = *(const PG8_LAS f32x4*)(hp + n * 4), h1 = *(const PG8_LAS f32x4*)(hp + 64 + n * 4);
                        f32x4 p1 = h1, p2 = (fr == 1) ? h1 : h2;
                        const f32x4 bbe = bb;
#pragma unroll
                        for (int m = 0; m < 4; ++m) {
                            const float r_ = rsl[128 * ai + 16 * m];
                            const f32x4 x = acc[ai][0][m][n] * r_; f32x4 q1, q2, n1, n2;
#pragma unroll
                            for (int i = 0; i < 4; ++i) { q1[i] = dppf<0x111>(p1[i], x[i]); q2[i] = dppf<0x112>(p2[i], x[i]); n1[i] = dppf<0x121>(x[i], x[i]); n2[i] = dppf<0x122>(x[i], x[i]); }
                            p1 = n1; p2 = n2;
                            f32x4 cgv = w0 * q2 + w1 * q1 + w2 * x + bbe;
                            if (ai == 0 && m == 0 && first) { const f32x4 c0v = *(const PG8_LAS f32x4*)(parl + 1024 + cg0); if (fr == 2) cgv -= c0v * (w0 + w1); else if (fr == 3) cgv -= c0v * w0; }
                            u32x2 pk; pk.x = cvt_pk_bf16(siluf_(cgv[0]) * cvv[m][0], siluf_(cgv[1]) * cvv[m][1]); pk.y = cvt_pk_bf16(siluf_(cgv[2]) * cvv[m][2], siluf_(cgv[3]) * cvv[m][3]);
                            if (n == 0) pk0[m] = pk;
                            else {
                                const int tr = 128 * ai + 64 * wr + 16 * m + fr; const int grow = 254 * u.pm - 2 + tr;
                                if (tr >= 2 && grow < SEQ) {
                                    *(u32x4*)(G + (size_t)grow * FF + f0) = (u32x4){pk0[m].x, pk0[m].y, pk.x, pk.y};
                                    if (grow >= SEQ - 2) { float* o = ofp + (size_t)(grow - (SEQ - 2)) * FF2 + f0;
                                        *(f32x4*)o = acc[ai][0][m][0] * r_ + *(const PG8_LAS f32x4*)(parl + 1024); *(f32x4*)(o + 4) = acc[ai][0][m][1] * r_ + *(const PG8_LAS f32x4*)(parl + 1024 + 4);
                                        *(f32x4*)(o + FF) = acc[ai][1][m][0] * r_ + *(const PG8_LAS f32x4*)(parl + 1024 + 128); *(f32x4*)(o + FF + 4) = acc[ai][1][m][1] * r_ + *(const PG8_LAS f32x4*)(parl + 1024 + 128 + 4); }
                                }
                            }
                            asm volatile("" ::: "memory"); __builtin_amdgcn_sched_barrier(0);
                        }
                    }
                }
                asm volatile("" ::: "memory"); __builtin_amdgcn_sched_barrier(0);
            }
        } else {
#pragma unroll
            for (int n = 0; n < 2; ++n) {
                const int fg = f0 + 4 * n, fv = FF + fg;
#pragma unroll
                for (int m = 0; m < 4; ++m) {
                    const int b = 64 * wr + 16 * m + fr;
                    const float* s0 = st + (size_t)(b * 2) * FF2; const float* s1 = s0 + FF2;
                    float* o0 = ofs + (size_t)(b * 2) * FF2; float* o1 = o0 + FF2;
                    f32x4 cvv;
                    { const f32x4 x = acc[0][1][m][n];
                      const f32x4 w0 = *(const f32x4*)(cw + fv), w1 = *(const f32x4*)(cw + FF2 + fv), w2 = *(const f32x4*)(cw + 2 * FF2 + fv), bb = *(const f32x4*)(cb + fv);
                      const f32x4 t0 = *(const f32x4*)(s0 + fv), t1 = *(const f32x4*)(s1 + fv);
                      cvv = w0 * t0 + w1 * t1 + w2 * x + bb; *(f32x4*)(o0 + fv) = t1; *(f32x4*)(o1 + fv) = x; }
                    asm volatile("" ::: "memory"); __builtin_amdgcn_sched_barrier(0);
                    { const f32x4 x = acc[0][0][m][n];
                      const f32x4 w0 = *(const f32x4*)(cw + fg), w1 = *(const f32x4*)(cw + FF2 + fg), w2 = *(const f32x4*)(cw + 2 * FF2 + fg), bb = *(const f32x4*)(cb + fg);
                      const f32x4 t0 = *(const f32x4*)(s0 + fg), t1 = *(const f32x4*)(s1 + fg);
                      const f32x4 cgv = w0 * t0 + w1 * t1 + w2 * x + bb; *(f32x4*)(o0 + fg) = t1; *(f32x4*)(o1 + fg) = x;
                      u32x2 w; w.x = cvt_pk_bf16(siluf_(cgv[0]) * cvv[0], siluf_(cgv[1]) * cvv[1]); w.y = cvt_pk_bf16(siluf_(cgv[2]) * cvv[2], siluf_(cgv[3]) * cvv[3]);
                      *(u32x2*)(G + (size_t)(SEQ + b) * FF + fg) = w; }
                    asm volatile("" ::: "memory"); __builtin_amdgcn_sched_barrier(0);
                }
            }
        }
    }
};

__device__ __forceinline__ void transpose_item(const float* W, int K, int N, bf16_t* WT, int k0, int n0, int drow0, float* scr, int lane) {
    float tv[32];
#pragma unroll
    for (int i = 0; i < 32; ++i) tv[i] = __builtin_nontemporal_load(W + (size_t)(k0 + 2 * i + (lane >> 5)) * N + n0 + (lane & 31));
#pragma unroll
    for (int i = 0; i < 32; ++i) scr[(2 * i + (lane >> 5)) * 33 + (lane & 31)] = tv[i];
    asm volatile("s_waitcnt lgkmcnt(0)" ::: "memory");
    const int c = lane & 7;
#pragma unroll
    for (int j = 0; j < 4; ++j) { const int n = (lane >> 3) + 8 * j; const float* s = scr + (8 * c) * 33 + n;
        u32x4 o; o.x = cvt_pk_bf16(s[0 * 33], s[1 * 33]); o.y = cvt_pk_bf16(s[2 * 33], s[3 * 33]); o.z = cvt_pk_bf16(s[4 * 33], s[5 * 33]); o.w = cvt_pk_bf16(s[6 * 33], s[7 * 33]);
        *(u32x4*)(WT + (size_t)(drow0 + n) * K + k0 + 8 * c) = o; }
    asm volatile("s_waitcnt lgkmcnt(0)" ::: "memory");
}
__device__ __forceinline__ int win_drow(int n) {
    if (n < 1024) return 256 * (n >> 7) + (n & 127);
    if (n < 2048) return 2048 + (n - 1024);
    if (n < 3072) { const int f = n - 2048; return 256 * (f >> 7) + 128 + (f & 127); }
    return n;
}
__device__ __forceinline__ int wup_drow(int n) { const int f = (n < FF) ? n : n - FF; return 256 * (f >> 7) + ((n < FF) ? 0 : 128) + (f & 127); }

__device__ __forceinline__ void modnorm_row(const float* xrow, const float* g, const float* sc, const float* sh, bf16_t* orow, int lane) {
    f32x4 v[4]; float s = 0.f;
#pragma unroll
    for (int j = 0; j < 4; ++j) { v[j] = ((const f32x4*)xrow)[lane + 64 * j]; s += (v[j][0] * v[j][0] + v[j][1] * v[j][1]) + (v[j][2] * v[j][2] + v[j][3] * v[j][3]); }
    const float rstd = rsqrtf(wave_sum(s) * (1.0f / 1024.0f) + EPS);
#pragma unroll
    for (int j = 0; j < 4; ++j) { const int col = 4 * (lane + 64 * j);
        const f32x4 gg = *(const f32x4*)(g + col), ss = *(const f32x4*)(sc + col), hh = *(const f32x4*)(sh + col);
        const f32x4 o = v[j] * rstd * gg * (ss + 1.0f) + hh;
        u32x2 w; w.x = cvt_pk_bf16(o[0], o[1]); w.y = cvt_pk_bf16(o[2], o[3]); *(u32x2*)(orow + col) = w; }
}


template <int MODE>
__device__ __forceinline__ void norm_phase(const float* xp, const float* xs, const float* gvec, const float* ada, int scoff, int shoff, bf16_t* ob, float* of, int gw, int NGW, int lane, const bf16_t* dadd = nullptr) {
    f32x4 gmP[4], shP[4];
#pragma unroll
    for (int j = 0; j < 4; ++j) { const int col = 4 * (lane + 64 * j); const f32x4 g = *(const f32x4*)(gvec + col);
        if (MODE == 2) { gmP[j] = g; shP[j] = (f32x4){0.f, 0.f, 0.f, 0.f}; }
        else { const float* ad = ada + (size_t)128 * NADA; gmP[j] = g * (*(const f32x4*)(ad + scoff + col) + 1.0f); shP[j] = *(const f32x4*)(ad + shoff + col); } }
#pragma unroll 1
    for (int base = gw; base < MROWS; base += 4 * NGW) {
        f32x4 v[4][4];
#pragma unroll
        for (int r = 0; r < 4; ++r) { const int row = base + r * NGW;
            if (row < MROWS) { const float* xr = (MODE == 0) ? ((row < SEQ) ? xp + (size_t)row * 1024 : xs + (size_t)(row - SEQ) * 1024) : xp + (size_t)row * 1024;
#pragma unroll
                for (int j = 0; j < 4; ++j) v[r][j] = ((const f32x4*)xr)[lane + 64 * j];
                if (MODE == 2) {
#pragma unroll
                    for (int j = 0; j < 4; ++j) { const u32x2 w = *(const u32x2*)(dadd + (size_t)row * 1024 + 4 * (lane + 64 * j));
                        v[r][j] += (f32x4){bf2f(w.x & 0xffffu), bf2f(w.x >> 16), bf2f(w.y & 0xffffu), bf2f(w.y >> 16)}; } } } }
#pragma unroll
        for (int r = 0; r < 4; ++r) { const int row = base + r * NGW;
            if (row < MROWS) {
                float s = 0.f;
#pragma unroll
                for (int j = 0; j < 4; ++j) s += (v[r][j][0] * v[r][j][0] + v[r][j][1] * v[r][j][1]) + (v[r][j][2] * v[r][j][2] + v[r][j][3] * v[r][j][3]);
                const float rstd = rsqrtf(wave_sum(s) * (1.0f / 1024.0f) + EPS);
#pragma unroll
                for (int j = 0; j < 4; ++j) { const int col = 4 * (lane + 64 * j);
                    f32x4 gm = gmP[j], sh = shP[j];
                    if (MODE != 2 && row >= SEQ) { const float* ad = ada + (size_t)(row - SEQ) * NADA; gm = *(const f32x4*)(gvec + col) * (*(const f32x4*)(ad + scoff + col) + 1.0f); sh = *(const f32x4*)(ad + shoff + col); }
                    const f32x4 o = v[r][j] * rstd * gm + sh;
                    if (MODE == 2) __builtin_nontemporal_store(o, (f32x4*)(of + (size_t)row * 1024 + col));
                    else { u32x2 w; w.x = cvt_pk_bf16(o[0], o[1]); w.y = cvt_pk_bf16(o[2], o[3]); *(u32x2*)(ob + (size_t)row * 1024 + col) = w; } }
            } }
    }
}
__device__ __forceinline__ void attn_prompt_unit(unsigned char* lds, bf16_t* Q, const bf16_t* KB, const bf16_t* VB, const float* sinks, int j, int g, int tid) {
    bf16_t* Ks = (bf16_t*)lds;
    bf16_t* Vt = (bf16_t*)(lds + 36864);
    bf16x8 qpre[2][4];
    {   const int wave_ = tid >> 6, ql_ = tid & 31, hi_ = (tid >> 5) & 1;
#pragma unroll
        for (int tt = 0; tt < 2; ++tt) { const int t = wave_ * 2 + tt, hq = t >> 2, qg = t & 3; const bf16_t* qp = Q + (size_t)(128 * j + 32 * qg + ql_) * 1024 + (4 * g + hq) * 64;
#pragma unroll
            for (int d0 = 0; d0 < 4; ++d0) qpre[tt][d0] = *(const bf16x8*)(qp + 16 * d0 + 8 * hi_); } }
    for (int c = tid; c < 2048; c += 512) {
        const int s = c >> 3, ch = c & 7; const int tok = 128 * (j - 1) + s;
        u32x4 kv = (u32x4){0u, 0u, 0u, 0u}, vv = (u32x4){0u, 0u, 0u, 0u};
        if (tok >= 0) { kv = *(const u32x4*)(KB + (size_t)tok * 256 + 64 * g + 8 * ch); vv = *(const u32x4*)(VB + (size_t)tok * 256 + 64 * g + 8 * ch); }
        *(u32x4*)(Ks + s * 72 + 8 * ch) = kv;
        bf16_t* vd = Vt + (8 * ch) * 264 + s;
        vd[0 * 264] = (bf16_t)(vv.x & 0xffffu); vd[1 * 264] = (bf16_t)(vv.x >> 16); vd[2 * 264] = (bf16_t)(vv.y & 0xffffu); vd[3 * 264] = (bf16_t)(vv.y >> 16);
        vd[4 * 264] = (bf16_t)(vv.z & 0xffffu); vd[5 * 264] = (bf16_t)(vv.z >> 16); vd[6 * 264] = (bf16_t)(vv.w & 0xffffu); vd[7 * 264] = (bf16_t)(vv.w >> 16);
    }
    __syncthreads();
    const int wave = tid >> 6, lane = tid & 63, ql = lane & 31, hi = lane >> 5;
#pragma unroll
    for (int tt = 0; tt < 2; ++tt) {
        const int t = wave * 2 + tt, hq = t >> 2, qg = t & 3, head = 4 * g + hq;
        bf16_t* qp = Q + (size_t)(128 * j + 32 * qg + ql) * 1024 + head * 64;
        bf16x8 qf[4];
#pragma unroll
        for (int d0 = 0; d0 < 4; ++d0) qf[d0] = qpre[tt][d0];
        f32x16 p[5];
#pragma unroll
        for (int kt = 0; kt < 5; ++kt) {
#pragma unroll
            for (int r = 0; r < 16; ++r) p[kt][r] = 0.f;
#pragma unroll
            for (int d0 = 0; d0 < 4; ++d0) { const bf16x8 kf = *(const bf16x8*)(Ks + (32 * qg + 32 * kt + ql) * 72 + 16 * d0 + 8 * hi);
                p[kt] = __builtin_amdgcn_mfma_f32_32x32x16_bf16(kf, qf[d0], p[kt], 0, 0, 0); }
        }
        const float sink = sinks[head];
        float mx = -INFINITY;
#pragma unroll
        for (int kt = 0; kt < 5; ++kt)
#pragma unroll
            for (int r = 0; r < 16; ++r) { const int kk = (r & 3) + 8 * (r >> 2) + 4 * hi; bool valid = true;
                if (kt == 0) valid = kk >= ql; if (kt == 4) valid = kk <= ql; if (j == 0) valid = valid && (32 * qg + 32 * kt + kk >= 128);
                const float v = valid ? p[kt][r] * 0.125f : -INFINITY; p[kt][r] = v; mx = fmaxf(mx, v); }
        mx = fmaxf(mx, __shfl_xor(mx, 32)); mx = fmaxf(mx, sink);
        float l = 0.f;
#pragma unroll
        for (int kt = 0; kt < 5; ++kt)
#pragma unroll
            for (int r = 0; r < 16; ++r) { const float e = __expf(p[kt][r] - mx); p[kt][r] = e; l += e; }
        l += __shfl_xor(l, 32);
        const float inv = 1.0f / (l + __expf(sink - mx));
        f32x16 o0, o1;
#pragma unroll
        for (int r = 0; r < 16; ++r) { o0[r] = 0.f; o1[r] = 0.f; }
#pragma unroll
        for (int kt = 0; kt < 5; ++kt)
#pragma unroll
            for (int hf = 0; hf < 2; ++hf) {
                u32x4 pw; pw.x = cvt_pk_bf16(p[kt][8 * hf + 0], p[kt][8 * hf + 1]); pw.y = cvt_pk_bf16(p[kt][8 * hf + 2], p[kt][8 * hf + 3]);
                pw.z = cvt_pk_bf16(p[kt][8 * hf + 4], p[kt][8 * hf + 5]); pw.w = cvt_pk_bf16(p[kt][8 * hf + 6], p[kt][8 * hf + 7]);
                const bf16x8 pf = __builtin_bit_cast(bf16x8, pw);
                const int sk = 32 * qg + 32 * kt + 16 * hf + 4 * hi;
                { const bf16_t* vp = Vt + ql * 264 + sk; const u32x2 a = *(const u32x2*)vp, b = *(const u32x2*)(vp + 8);
                  const bf16x8 vf = __builtin_bit_cast(bf16x8, ((u32x4){a.x, a.y, b.x, b.y})); o0 = __builtin_amdgcn_mfma_f32_32x32x16_bf16(vf, pf, o0, 0, 0, 0); }
                { const bf16_t* vp = Vt + (32 + ql) * 264 + sk; const u32x2 a = *(const u32x2*)vp, b = *(const u32x2*)(vp + 8);
                  const bf16x8 vf = __builtin_bit_cast(bf16x8, ((u32x4){a.x, a.y, b.x, b.y})); o1 = __builtin_amdgcn_mfma_f32_32x32x16_bf16(vf, pf, o1, 0, 0, 0); }
            }
#pragma unroll
        for (int c4 = 0; c4 < 4; ++c4) {
            u32x2 w0, w1;
            w0.x = cvt_pk_bf16(o0[4 * c4 + 0] * inv, o0[4 * c4 + 1] * inv); w0.y = cvt_pk_bf16(o0[4 * c4 + 2] * inv, o0[4 * c4 + 3] * inv);
            w1.x = cvt_pk_bf16(o1[4 * c4 + 0] * inv, o1[4 * c4 + 1] * inv); w1.y = cvt_pk_bf16(o1[4 * c4 + 2] * inv, o1[4 * c4 + 3] * inv);
            *(u32x2*)(qp + 8 * c4 + 4 * hi) = w0; *(u32x2*)(qp + 32 + 8 * c4 + 4 * hi) = w1;
        }
    }
    __syncthreads();
}
__device__ __forceinline__ void attn_sample_task(float* wl, bf16_t* Q, const bf16_t* KB, const bf16_t* VB, const float* ck, const float* cv, const float* sinks, int b, int g, int lane) {
    float* qs = wl; float* pp = wl + 256;
    bf16_t* qrow = Q + (size_t)(SEQ + b) * 1024 + 4 * g * 64;
#pragma unroll
    for (int h = 0; h < 4; ++h) qs[h * 64 + lane] = bf2f(qrow[h * 64 + lane]) * 0.125f;
    const float knew = bf2f(KB[(size_t)(SEQ + b) * 256 + 64 * g + lane]), vnew = bf2f(VB[(size_t)(SEQ + b) * 256 + 64 * g + lane]);
    asm volatile("s_waitcnt lgkmcnt(0)" ::: "memory");
    float sc[2][4];
#pragma unroll
    for (int kk = 0; kk < 2; ++kk) { const int s = lane + 64 * kk; const f32x4* kp = (const f32x4*)(ck + ((size_t)(b * 128 + s) * 4 + g) * 64);
        float a0 = 0.f, a1 = 0.f, a2 = 0.f, a3 = 0.f;
#pragma unroll 4
        for (int c = 0; c < 16; ++c) { const f32x4 kv = kp[c];
            const f32x4 q0 = *(const f32x4*)(qs + 4 * c), q1 = *(const f32x4*)(qs + 64 + 4 * c), q2 = *(const f32x4*)(qs + 128 + 4 * c), q3 = *(const f32x4*)(qs + 192 + 4 * c);
            a0 += kv[0] * q0[0] + kv[1] * q0[1] + kv[2] * q0[2] + kv[3] * q0[3]; a1 += kv[0] * q1[0] + kv[1] * q1[1] + kv[2] * q1[2] + kv[3] * q1[3];
            a2 += kv[0] * q2[0] + kv[1] * q2[1] + kv[2] * q2[2] + kv[3] * q2[3]; a3 += kv[0] * q3[0] + kv[1] * q3[1] + kv[2] * q3[2] + kv[3] * q3[3]; }
        sc[kk][0] = a0; sc[kk][1] = a1; sc[kk][2] = a2; sc[kk][3] = a3; }
#pragma unroll
    for (int h = 0; h < 4; ++h) {
        const float sn = wave_sum(qs[h * 64 + lane] * knew), sink = sinks[4 * g + h];
        float m = wave_max(fmaxf(sc[0][h], sc[1][h])); m = fmaxf(fmaxf(m, sn), sink);
        const float e0 = __expf(sc[0][h] - m), e1 = __expf(sc[1][h] - m), en = __expf(sn - m);
        const float inv = 1.0f / (wave_sum(e0 + e1) + en + __expf(sink - m));
        pp[lane * 4 + h] = e0 * inv; pp[(64 + lane) * 4 + h] = e1 * inv; if (lane == 0) pp[512 + h] = en * inv;
    }
    asm volatile("s_waitcnt lgkmcnt(0)" ::: "memory");
    float o0 = 0.f, o1 = 0.f, o2 = 0.f, o3 = 0.f;
    const float* vp = cv + ((size_t)(b * 128) * 4 + g) * 64 + lane;
#pragma unroll 8
    for (int s = 0; s < 128; ++s) { const float v = vp[(size_t)s * 256]; const f32x4 pv = *(const f32x4*)(pp + 4 * s); o0 += pv[0] * v; o1 += pv[1] * v; o2 += pv[2] * v; o3 += pv[3] * v; }
    { const f32x4 pv = *(const f32x4*)(pp + 512); o0 += pv[0] * vnew; o1 += pv[1] * vnew; o2 += pv[2] * vnew; o3 += pv[3] * vnew; }
    qrow[lane] = (bf16_t)(cvt_pk_bf16(o0, 0.f) & 0xffffu); qrow[64 + lane] = (bf16_t)(cvt_pk_bf16(o1, 0.f) & 0xffffu);
    qrow[128 + lane] = (bf16_t)(cvt_pk_bf16(o2, 0.f) & 0xffffu); qrow[192 + lane] = (bf16_t)(cvt_pk_bf16(o3, 0.f) & 0xffffu);
    asm volatile("s_waitcnt lgkmcnt(0)" ::: "memory");
}


#if SELFCHECK
constexpr size_t WS_CHK = 512 * 1024;
__device__ __forceinline__ unsigned hsh(unsigned x) { x ^= x >> 16; x *= 0x7feb352du; x ^= x >> 15; x *= 0x846ca68bu; x ^= x >> 16; return x; }
__device__ __forceinline__ int samp_row(int s) {
    if ((s & 3) == 0) { switch ((s >> 2) & 7) { case 0: return 0; case 1: return 1; case 2: return 255; case 3: return 256; case 4: return SEQ - 1; case 5: return SEQ; case 6: return SEQ + 100; default: return 8191; } }
    if ((s & 3) == 1) return SEQ + (int)(hsh(s) % NS);
    return (int)(hsh(s * 3 + 1) % SEQ);
}
__device__ __forceinline__ bool chk_bad(float got, float ref) { return !(fabsf(got - ref) <= 0.05f * fabsf(ref) + 0.04f); }
__device__ __forceinline__ float wdot_bf(const bf16_t* a, const float* W, int ldw, int col, int K, int lane) {
    float s = 0.f; for (int k = lane; k < K; k += 64) s += bf2f(a[k]) * W[(size_t)k * ldw + col]; return wave_sum(s); }
#define CHK_FAIL(bit) do { if (lane == 0) atomicOr(mask, 1u << (bit)); } while (0)
#endif

template <int KLEN>
__device__ __forceinline__ f32x4 mini_kloop(const bf16_t* Arow, const bf16_t* Brow, f32x4 acc) {
    constexpr int NS_ = KLEN / 32;
    static_assert(KLEN % 32 == 0, "K quarter");
#pragma unroll 1
    for (int s0 = 0; s0 < NS_; s0 += 8) {
        bf16x8 a[8], b[8];
#pragma unroll
        for (int i = 0; i < 8; ++i) if (s0 + i < NS_) { a[i] = *(const bf16x8*)(Arow + (s0 + i) * 32); b[i] = *(const bf16x8*)(Brow + (s0 + i) * 32); }
#pragma unroll
        for (int i = 0; i < 8; ++i) if (s0 + i < NS_) acc = __builtin_amdgcn_mfma_f32_16x16x32_bf16(b[i], a[i], acc, 0, 0, 0);
    }
    return acc;
}
struct MiniArgs { const bf16_t* A0; const bf16_t* B0; const bf16_t* A1; const bf16_t* B1; const bf16_t* GA; const bf16_t* GB; bf16_t* Z; const float* base; float* out; const float* ADA; int goff; };
template <int MODE, int K>
__device__ __forceinline__ void mini_sample_gemm(unsigned char* lds, const MiniArgs& P, int bid, int G, int wave, int lane) {
    const int fr = lane & 15, fq = lane >> 4, tl = wave >> 2, kq = wave & 3;
    f32x4* red = (f32x4*)lds;
    for (int T0 = 2 * bid; T0 < 512; T0 += 2 * G) {
        const int T = T0 + tl, rt = T & 7, ct = T >> 3;
        const int row = SEQ + 16 * rt + fr, colb = 16 * ct + fr;
        const size_t ko = (size_t)kq * (K / 4) + 8 * fq;
        f32x4 acc0 = (f32x4){0.f, 0.f, 0.f, 0.f}, acc1 = acc0;
        acc0 = mini_kloop<K / 4>(P.A0 + (size_t)row * K + ko, P.B0 + (size_t)colb * K + ko, acc0);
        if (MODE == 0) acc1 = mini_kloop<K / 4>(P.A1 + (size_t)row * K + ko, P.B1 + (size_t)colb * K + ko, acc1);
        red[wave * 64 + lane] = acc0; if (MODE == 0) red[512 + wave * 64 + lane] = acc1;
        __syncthreads();
        if (kq == 0) {
            f32x4 s0 = red[wave * 64 + lane] + red[(wave + 1) * 64 + lane] + red[(wave + 2) * 64 + lane] + red[(wave + 3) * 64 + lane];
            const int col = 16 * ct + 4 * fq;
            if (MODE == 0) {
                const f32x4 s1 = red[512 + wave * 64 + lane] + red[512 + (wave + 1) * 64 + lane] + red[512 + (wave + 2) * 64 + lane] + red[512 + (wave + 3) * 64 + lane];
                const u32x2 ga = *(const u32x2*)(P.GA + (size_t)row * 1024 + col), gb = *(const u32x2*)(P.GB + (size_t)row * 1024 + col);
                const float z0 = sigmoidf_(bf2f(ga.x & 0xffffu)) * s0[0] + sigmoidf_(bf2f(gb.x & 0xffffu)) * s1[0], z1 = sigmoidf_(bf2f(ga.x >> 16)) * s0[1] + sigmoidf_(bf2f(gb.x >> 16)) * s1[1];
                const float z2 = sigmoidf_(bf2f(ga.y & 0xffffu)) * s0[2] + sigmoidf_(bf2f(gb.y & 0xffffu)) * s1[2], z3 = sigmoidf_(bf2f(ga.y >> 16)) * s0[3] + sigmoidf_(bf2f(gb.y >> 16)) * s1[3];
                u32x2 w; w.x = cvt_pk_bf16(z0, z1); w.y = cvt_pk_bf16(z2, z3); *(u32x2*)(P.Z + (size_t)row * 1024 + col) = w;
            } else if (MODE == 2) {
                const int b = row - SEQ; const f32x4 g = *(const f32x4*)(P.ADA + (size_t)b * NADA + P.goff + col); const f32x4 d = g * s0;
                u32x2 w; w.x = cvt_pk_bf16(d[0], d[1]); w.y = cvt_pk_bf16(d[2], d[3]); *(u32x2*)(P.Z + (size_t)row * 1024 + col) = w;
            } else {
                const int b = row - SEQ;
                const f32x4 bs = *(const f32x4*)(P.base + (size_t)b * 1024 + col), g = *(const f32x4*)(P.ADA + (size_t)b * NADA + P.goff + col);
                *(f32x4*)(P.out + (size_t)row * 1024 + col) = bs + g * s0;
            }
        }
        __syncthreads();
    }
}

__device__ __forceinline__ void ada_block(unsigned char* lds, const float* cs, const float* cp, const float* W, const float* bias, float* ADAo, int pair, int wave, int lane) {
    const int fr = lane & 15, fq = lane >> 4, tl = wave >> 2, kq = wave & 3, c0 = 16 * (2 * pair + tl);
    f32x4 acc[9];
#pragma unroll
    for (int rt = 0; rt < 9; ++rt) acc[rt] = (f32x4){0.f, 0.f, 0.f, 0.f};
#pragma unroll 1
    for (int ks = 0; ks < 8; ++ks) {
        const int k0 = 256 * kq + 32 * ks + 8 * fq;
        float wv[8];
#pragma unroll
        for (int j = 0; j < 8; ++j) wv[j] = __builtin_nontemporal_load(W + (size_t)(k0 + j) * NADA + c0 + fr);
        f32x4 a0[9], a1[9];
#pragma unroll
        for (int rt = 0; rt < 9; ++rt) { const int row = 16 * rt + fr; const float* cr = (row < 128) ? cs + (size_t)row * 1024 : cp;
            a0[rt] = *(const f32x4*)(cr + k0); a1[rt] = *(const f32x4*)(cr + k0 + 4); }
        u32x4 bw; bw.x = cvt_pk_bf16(wv[0], wv[1]); bw.y = cvt_pk_bf16(wv[2], wv[3]); bw.z = cvt_pk_bf16(wv[4], wv[5]); bw.w = cvt_pk_bf16(wv[6], wv[7]);
        const bf16x8 bfrag = __builtin_bit_cast(bf16x8, bw);
#pragma unroll
        for (int rt = 0; rt < 9; ++rt) { const bool ok = (16 * rt + fr) <= 128;
            u32x4 aw; aw.x = cvt_pk_bf16(siluf_(a0[rt][0]), siluf_(a0[rt][1])); aw.y = cvt_pk_bf16(siluf_(a0[rt][2]), siluf_(a0[rt][3]));
            aw.z = cvt_pk_bf16(siluf_(a1[rt][0]), siluf_(a1[rt][1])); aw.w = cvt_pk_bf16(siluf_(a1[rt][2]), siluf_(a1[rt][3]));
            if (!ok) aw = (u32x4){0u, 0u, 0u, 0u};
            acc[rt] = __builtin_amdgcn_mfma_f32_16x16x32_bf16(bfrag, __builtin_bit_cast(bf16x8, aw), acc[rt], 0, 0, 0); }
    }
    f32x4* red = (f32x4*)lds;
#pragma unroll
    for (int rt = 0; rt < 9; ++rt) red[(wave * 9 + rt) * 64 + lane] = acc[rt];
    __syncthreads();
    if (kq == 0) {
        const f32x4 bv = *(const f32x4*)(bias + c0 + 4 * fq);
#pragma unroll
        for (int rt = 0; rt < 9; ++rt) { const int row = 16 * rt + fr;
            const f32x4 sum = red[(wave * 9 + rt) * 64 + lane] + red[((wave + 1) * 9 + rt) * 64 + lane] + red[((wave + 2) * 9 + rt) * 64 + lane] + red[((wave + 3) * 9 + rt) * 64 + lane];
            if (row <= 128) *(f32x4*)(ADAo + (size_t)row * NADA + c0 + 4 * fq) = sum + bv; }
    }
    __syncthreads();
}

#define LAS __attribute__((address_space(3)))
#define XB_TMO      128
#define XB_XCNT(j)  (256  + 64 * (j))
#define XB_XSUB(j)  (1280 + 64 * (j))
#define XB_XGEN(j)  (2304 + 64 * (j))
#define XB_TOP      3328
#define XB_TOPGEN   3392
#define XCD_BAR_WORDS 3456
#define XB_SPIN_CAP (1u << 22)
constexpr size_t WS_BAR = 64 * 1024;
constexpr int MISC_OFF = 146432;
constexpr size_t WS_SS = 768 * 1024;
constexpr size_t WS_C0 = WS_BAR + 16384;
constexpr size_t BAR_ZERO_BYTES = (WS_C0 - WS_BAR) + 22528;
__device__ __forceinline__ unsigned xb_ld(unsigned* p)              { return __hip_atomic_load(p, __ATOMIC_RELAXED, __HIP_MEMORY_SCOPE_AGENT); }
__device__ __forceinline__ unsigned xb_add(unsigned* p, unsigned v) { return __hip_atomic_fetch_add(p, v, __ATOMIC_RELAXED, __HIP_MEMORY_SCOPE_AGENT); }
__device__ __forceinline__ unsigned xb_xcc_id() { return (unsigned)__builtin_amdgcn_s_getreg((3 << 11) | 20) & 0xFu; }
#define XB_SPIN(cond, bar) do { unsigned _sp = 0; while (cond) { __builtin_amdgcn_s_sleep(1); \
    if ((++_sp & 255u) == 0u) { if (xb_ld(&(bar)[XB_TMO])) break; if (_sp > XB_SPIN_CAP) { atomicAdd(&(bar)[XB_TMO], 1u); break; } } } } while (0)
struct XcdBarrier { unsigned* bar; unsigned x; volatile LAS unsigned* st; };
__device__ __forceinline__ XcdBarrier xcd_barrier_post(unsigned* bar, volatile LAS unsigned* st, bool leader) {
    XcdBarrier b; b.bar = bar; b.x = xb_xcc_id(); b.st = st;
    if (leader) (void)xb_add(&bar[XB_XCNT(b.x)], 1u);
    return b;
}
__device__ __forceinline__ void xcd_barrier_complete(unsigned* bar, unsigned x, unsigned& nloc, unsigned& nx) {
    const unsigned G = gridDim.x * gridDim.y * gridDim.z;
    unsigned sum, cnt, mine, sp = 0u;
    for (;;) {
        sum = 0u; cnt = 0u; mine = 0u;
#pragma unroll
        for (unsigned j = 0; j < 16; ++j) { const unsigned c = xb_ld(&bar[XB_XCNT(j)]); sum += c; cnt += (c > 0u) ? 1u : 0u; mine = (j == x) ? c : mine; }
        if (sum == G) break;
        __builtin_amdgcn_s_sleep(1);
        if ((++sp & 255u) == 0u) { if (xb_ld(&bar[XB_TMO])) break; if (sp > XB_SPIN_CAP) { atomicAdd(&bar[XB_TMO], 1u); break; } }
    }
    nloc = mine > 0u ? mine : 1u; nx = cnt > 0u ? cnt : 1u;
}
__device__ __forceinline__ void xcd_barrier_core(const XcdBarrier& b, bool leader) {
    if (leader) {
        unsigned* bar = b.bar;
        __builtin_amdgcn_s_waitcnt(0);
        unsigned nloc = b.st[0], nx = b.st[1];
        if (nloc == 0u) { xcd_barrier_complete(bar, b.x, nloc, nx); b.st[0] = nloc; b.st[1] = nx; }
        const unsigned old = xb_add(&bar[XB_XSUB(b.x)], 1u);
        const unsigned gen = old / nloc;
        if (old + 1u == (gen + 1u) * nloc) {
            __builtin_amdgcn_fence(__ATOMIC_RELEASE, "agent");
            asm volatile("s_waitcnt vmcnt(0)" ::: "memory");
            const unsigned og = xb_add(&bar[XB_TOP], 1u);
            const unsigned tg = og / nx;
            if (og + 1u == (tg + 1u) * nx) xb_add(&bar[XB_TOPGEN], 1u);
            else XB_SPIN(xb_ld(&bar[XB_TOPGEN]) == tg, bar);
            __builtin_amdgcn_fence(__ATOMIC_ACQUIRE, "agent");
            xb_add(&bar[XB_XGEN(b.x)], 1u);
            asm volatile("s_waitcnt vmcnt(0)" ::: "memory");
        } else {
            XB_SPIN(xb_ld(&bar[XB_XGEN(b.x)]) == gen, bar);
            __builtin_amdgcn_fence(__ATOMIC_ACQUIRE, "agent");
            asm volatile("s_waitcnt vmcnt(0)" ::: "memory");
        }
    }
}
struct Args { const float* in[23]; float* out; unsigned char* ws; };
enum { I_XP = 0, I_XS, I_CP, I_CS, I_SCA, I_CK, I_CV, I_SFF, I_WADA, I_BADA, I_GMIX, I_WIN, I_CAW, I_SINK, I_WAO, I_WBO, I_WO, I_GFFN, I_WUP, I_FCW, I_FCB, I_WDN, I_GFIN };

typedef const __attribute__((address_space(4))) Args* KArgsP;
__device__ __forceinline__ void shadow_work(KArgsP ap, unsigned nb, int w7, int bid, int G, int lane, unsigned char* lds) {
    const int sw = bid * 7 + w7, NSW = G * 7;
    float* scr = (float*)(lds + (w7 + 1) * 16384);
    unsigned char* ws = ap->ws;
    if (nb == 1u) {
        for (int it = sw; it < 16 * (NIN / 32); it += NSW) { const int nbk = NIN / 32, kb = it / nbk, n0 = 32 * (it % nbk);
            transpose_item(ap->in[I_WIN], 1024, NIN, (bf16_t*)(ws + WS_WIN), 64 * kb, n0, win_drow(n0), scr, lane); }
    } else if (nb == 2u || nb == 3u) {
        constexpr int I_UPS = 16 * (FF2 / 32), SPLIT_ = 1024;
        if (nb == 2u) for (int r = sw; r < 3 * 512; r += NSW) { const int which = r / 512, q = r % 512, kb = q / 32, n0 = 32 * (q % 32);
            transpose_item(ap->in[which == 0 ? I_WAO : (which == 1 ? I_WBO : I_WO)], 1024, 1024, (bf16_t*)(ws + (which == 0 ? WS_WA : (which == 1 ? WS_WB : WS_WO))), 64 * kb, n0, n0, scr, lane); }
        for (int it = (nb == 2u ? 0 : SPLIT_) + sw; it < (nb == 2u ? SPLIT_ : I_UPS); it += NSW) { const int nbk = FF2 / 32, kb = it / nbk, n0 = 32 * (it % nbk);
            transpose_item(ap->in[I_WUP], 1024, FF2, (bf16_t*)(ws + WS_WUP), 64 * kb, n0, wup_drow(n0), scr, lane); }
        if (nb == 2u)
            for (int t = sw; t < 88 * 16; t += NSW) { const int cgp = t % 88, ks = t / 88, col = 64 * cgp + lane;
                const float* Wp = ap->in[I_WUP] + (size_t)(64 * ks) * FF2 + col; const float* sh = (const float*)(ws + WS_ADA) + (size_t)128 * NADA + 3072 + 64 * ks;
                float a = 0.f;
#pragma unroll 16
                for (int k = 0; k < 64; ++k) a += sh[k] * __builtin_nontemporal_load(Wp + (size_t)k * FF2);
                (void)__hip_atomic_fetch_add((float*)(ws + WS_C0) + col, a, __ATOMIC_RELAXED, __HIP_MEMORY_SCOPE_AGENT); }
    } else if (nb == 4u) {
        for (int it = sw; it < (FF / 64) * 32; it += NSW) { const int kb = it / 32, n0 = 32 * (it % 32); transpose_item(ap->in[I_WDN], FF, 1024, (bf16_t*)(ws + WS_WDN), 64 * kb, n0, n0, scr, lane); }
    }
    if (nb == 4u || nb == 5u) {
        const float* ck_ = ap->in[I_CK]; const float* cv_ = ap->in[I_CV]; const bf16_t* kb_ = (const bf16_t*)(ws + WS_KB); const bf16_t* vb_ = (const bf16_t*)(ws + WS_VB); float* out = ap->out;
        const long st = (long)sw * 64 + lane, NST = (long)NSW * 64; const long lo = (nb == 4u) ? 0 : 1048576, hi = lo + 1048576;
#pragma unroll 4
        for (long i = lo + st; i < hi; i += NST) {
            const int which = (int)(i >> 20); const int r2 = (int)(i & 1048575); const int b = r2 >> 13, r = (r2 >> 6) & 127, c = r2 & 63;
            const float* cache = which ? cv_ : ck_; const bf16_t* nbp = which ? vb_ : kb_;
            f32x4 v;
            if (r < 127) v = __builtin_nontemporal_load((const f32x4*)(cache + ((size_t)(b * 128 + r + 1) * 256 + 4 * c)));
            else { const u32x2 w = *(const u32x2*)(nbp + (size_t)(SEQ + b) * 256 + 4 * c); v = (f32x4){bf2f(w.x & 0xffffu), bf2f(w.x >> 16), bf2f(w.y & 0xffffu), bf2f(w.y >> 16)}; }
            __builtin_nontemporal_store(v, (f32x4*)(out + (which ? O_VS : O_KS) + (size_t)r2 * 4));
        }
        if (nb == 4u) for (long i = st; i < 2L * 128 * 64; i += NST) {
            const int which = (int)(i >> 13); const int r2 = (int)(i & 8191); const int r = r2 >> 6, c = r2 & 63; const bf16_t* nbp = which ? vb_ : kb_;
            const u32x2 w = *(const u32x2*)(nbp + (size_t)(SEQ - 128 + r) * 256 + 4 * c);
            *(f32x4*)(out + (which ? O_VP : O_KP) + (size_t)r2 * 4) = (f32x4){bf2f(w.x & 0xffffu), bf2f(w.x >> 16), bf2f(w.y & 0xffffu), bf2f(w.y >> 16)};
        }
    }
}

__global__ void __launch_bounds__(512, 2) mega(Args a) {
    extern __shared__ __attribute__((aligned(16))) unsigned char lds[];
    PG8_LAS unsigned char* ldsl = (PG8_LAS unsigned char*)lds;
    const int G = gridDim.x, bid = blockIdx.x, NGW = G * 8;
    const int wave0 = __builtin_amdgcn_readfirstlane((int)threadIdx.x >> 6);
    const long NGT = (long)G * 512;
#define PHASE_IDS() int tid = wave0 * 64 + (int)lane_id_now(); asm volatile("" : "+v"(tid)); const int lane = tid & 63, wave = wave0; \
    const int gw = bid * 8 + wave; const long gt = (long)bid * 512 + tid; float* const scr = (float*)(lds + wave * 16384); (void)lane; (void)gw; (void)gt; (void)scr;
    typedef const __attribute__((address_space(4))) Args* KArgs;
    const KArgs ap0 = (KArgs)__builtin_amdgcn_kernarg_segment_ptr();
#define ARGS() ({ KArgs p_ = ap0; asm volatile("" : "+s"(p_)); p_; })
#define IN(i) (ARGS()->in[i])
#define WS(off) (ARGS()->ws + (off))
#define OUT() (ARGS()->out)
#define AADA ((bf16_t*)WS(WS_AADA))
#define ADA ((float*)WS(WS_ADA))
#define WA ((bf16_t*)WS(WS_WA))
#define WB ((bf16_t*)WS(WS_WB))
#define WO ((bf16_t*)WS(WS_WO))
#define WADA ((bf16_t*)WS(WS_WADA))
#define WIN ((bf16_t*)WS(WS_WIN))
#define WUP ((bf16_t*)WS(WS_WUP))
#define WDN ((bf16_t*)WS(WS_WDN))
#define H ((bf16_t*)WS(WS_H))
#define U ((bf16_t*)WS(WS_U))
#define BG ((bf16_t*)WS(WS_BG))
#define Q ((bf16_t*)WS(WS_Q))
#define KB ((bf16_t*)WS(WS_KB))
#define VB ((bf16_t*)WS(WS_VB))
#define GA ((bf16_t*)WS(WS_GA))
#define GB ((bf16_t*)WS(WS_GB))
#define GG ((bf16_t*)WS(WS_G))
#define AIN H
#define Z U
#define H2 BG
    if (gridDim.x == 0x7fffffffu) cg::this_grid().sync();
    if (threadIdx.x < 2) ((volatile LAS unsigned*)(ldsl + MISC_OFF))[threadIdx.x] = 0u;
    __syncthreads();
#define LEADER() (wave0 == 0 && lane_id_now() == 0u)
    const XcdBarrier xbar = xcd_barrier_post((unsigned*)WS(WS_BAR), (volatile LAS unsigned*)(ldsl + MISC_OFF), LEADER());
    unsigned nbar_ = 0u;
#define GRID_SYNC() do { ++nbar_; asm volatile("s_waitcnt vmcnt(0)" ::: "memory"); __syncthreads(); \
        if (wave0 == 0) xcd_barrier_core(xbar, LEADER()); else shadow_work((KArgsP)ap0, nbar_, wave0 - 1, bid, G, (int)lane_id_now(), lds); \
        __syncthreads(); } while (0)

#if TIMESEL >= 0
#define STAMP(k) do { if (bid == 0 && threadIdx.x == 0) ((unsigned long long*)WS(768 * 1024))[k] = __builtin_amdgcn_s_memrealtime(); } while (0)
#else
#define STAMP(k) do {} while (0)
#endif
    STAMP(0);
    {
        PHASE_IDS();
        {   const float* const cs = IN(I_CS); const float* const cp = IN(I_CP); const float* const wad = IN(I_WADA); const float* const bad = IN(I_BADA); float* const ada = ADA;
            for (int pr = bid; pr < NADA / 32; pr += G) ada_block(lds, cs, cp, wad, bad, ada, pr, wave, lane); }
        if (bid >= NADA / 32) {
            const f32x4* xp4 = (const f32x4*)IN(I_XP); const long nidle = (long)(G - NADA / 32) * 512, me = (long)(bid - NADA / 32) * 512 + tid; f32x4 sink = (f32x4){0.f, 0.f, 0.f, 0.f};
#pragma unroll 8
            for (long i = me; i < (long)SEQ * 256; i += nidle) sink += xp4[i];
            asm volatile("" :: "v"(sink)); }
    }
    GRID_SYNC();
    STAMP(1);
    STAMP(2);
    {
        PHASE_IDS();
        norm_phase<0>(IN(I_XP), IN(I_XS), IN(I_GMIX), ADA, 1024, 0, H, nullptr, gw, NGW, lane);
    }
    GRID_SYNC();
    STAMP(3);
    {
        typedef Sched<0, 2048, 2048> SC; SC S; S.to.init(NMT, NIN / 256); S.G = G; S.c = bid; S.A0 = (const char*)H; S.B0 = (const char*)WIN;
        EpiProj E{U, BG, Q, KB, VB, GA, GB};
        pg8::gemm_phase<EpiProj, SC, 1024, 1024, 1024, true, true>(ldsl, wave0, S, E);
    }
    GRID_SYNC();
    STAMP(4);
    {
        PHASE_IDS();
        {   bf16_t* const q_ = Q; const bf16_t* const kb_ = KB; const bf16_t* const vb_ = VB; const float* const sinks = IN(I_SINK);
            for (int un = bid; un < 512; un += G) attn_prompt_unit(lds, q_, kb_, vb_, sinks, un >> 2, un & 3, tid); }
        {   bf16_t* const q_ = Q; const bf16_t* const kb_ = KB; const bf16_t* const vb_ = VB; const float* const sinks = IN(I_SINK);
            const float* const ck_ = IN(I_CK); const float* const cv_ = IN(I_CV);
            float* wl = (float*)(lds + 123392 + (wave >> 2) * 4096);
            for (int t4 = gw; t4 < 2048; t4 += NGW) if ((t4 & 3) == 0) { const int t = t4 >> 2; attn_sample_task(wl, q_, kb_, vb_, ck_, cv_, sinks, t >> 2, t & 3, lane); } }
        const bool worker = (wave & 3) != 0; const long wt = ((long)bid * 6 + (wave - 1 - (wave > 4 ? 1 : 0))) * 64 + lane, NWT = (long)G * 6 * 64;
        {
        float* const out = OUT();
        const float* caw = IN(I_CAW); const float* sca = IN(I_SCA); const bf16_t* const u_ = U; const bf16_t* const bg_ = BG; bf16_t* const ain_ = AIN;
        if (worker)
        for (long it = wt; it < (long)(SEQ / 8) * 128 + (long)NS * 128; it += NWT) {
            const bool smp = it >= (long)(SEQ / 8) * 128; const long it2 = smp ? it - (long)(SEQ / 8) * 128 : it;
            const int row0 = smp ? SEQ + (int)(it2 >> 7) : (int)(it2 >> 7) * 8, c8 = (int)(it2 & 127) * 8; const int nr = smp ? 1 : 8;
            float w0[8], w1[8], w2[8], u0[8], u1[8];
            *(f32x4*)w0 = *(const f32x4*)(caw + c8); *(f32x4*)(w0 + 4) = *(const f32x4*)(caw + c8 + 4);
            *(f32x4*)w1 = *(const f32x4*)(caw + 1024 + c8); *(f32x4*)(w1 + 4) = *(const f32x4*)(caw + 1024 + c8 + 4);
            *(f32x4*)w2 = *(const f32x4*)(caw + 2048 + c8); *(f32x4*)(w2 + 4) = *(const f32x4*)(caw + 2048 + c8 + 4);
            if (row0 < SEQ) {
                if (row0 >= 2) { unpack8(*(const u32x4*)(u_ + (size_t)(row0 - 2) * 1024 + c8), u0); unpack8(*(const u32x4*)(u_ + (size_t)(row0 - 1) * 1024 + c8), u1); }
                else { for (int i = 0; i < 8; ++i) { u0[i] = 0.f; u1[i] = 0.f; } }
#pragma unroll 4
                for (int r = 0; r < 8; ++r) { const int row = row0 + r; float u2[8], bg[8], o[8];
                    unpack8(*(const u32x4*)(u_ + (size_t)row * 1024 + c8), u2); unpack8(*(const u32x4*)(bg_ + (size_t)row * 1024 + c8), bg);
#pragma unroll
                    for (int i = 0; i < 8; ++i) { o[i] = bg[i] * (w0[i] * u0[i] + w1[i] * u1[i] + w2[i] * u2[i]); u0[i] = u1[i]; u1[i] = u2[i]; }
                    *(u32x4*)(ain_ + (size_t)row * 1024 + c8) = pack8(o);
                    if (row >= SEQ - 2) { float* op = out + O_CAP + (size_t)(row - (SEQ - 2)) * 1024 + c8; *(f32x4*)op = (f32x4){u2[0], u2[1], u2[2], u2[3]}; *(f32x4*)(op + 4) = (f32x4){u2[4], u2[5], u2[6], u2[7]}; } }
            } else {
                for (int r = 0; r < nr; ++r) { const int row = row0 + r, b = row - SEQ; float u2[8], bg[8], o[8];
                    const float* s0 = sca + (size_t)(b * 2) * 1024 + c8; const float* s1 = s0 + 1024;
                    *(f32x4*)u0 = *(const f32x4*)s0; *(f32x4*)(u0 + 4) = *(const f32x4*)(s0 + 4); *(f32x4*)u1 = *(const f32x4*)s1; *(f32x4*)(u1 + 4) = *(const f32x4*)(s1 + 4);
                    unpack8(*(const u32x4*)(u_ + (size_t)row * 1024 + c8), u2); unpack8(*(const u32x4*)(bg_ + (size_t)row * 1024 + c8), bg);
#pragma unroll
                    for (int i = 0; i < 8; ++i) o[i] = bg[i] * (w0[i] * u0[i] + w1[i] * u1[i] + w2[i] * u2[i]);
                    *(u32x4*)(ain_ + (size_t)row * 1024 + c8) = pack8(o);
                    float* op = out + O_CAS + (size_t)(b * 2) * 1024 + c8;
                    *(f32x4*)op = *(f32x4*)u1; *(f32x4*)(op + 4) = *(f32x4*)(u1 + 4); *(f32x4*)(op + 1024) = (f32x4){u2[0], u2[1], u2[2], u2[3]}; *(f32x4*)(op + 1024 + 4) = (f32x4){u2[4], u2[5], u2[6], u2[7]}; }
            }
        }
        }
    }
    GRID_SYNC();
    STAMP(5);
    {
        typedef Sched<1, 2048, 2048> SC; SC S; S.to.init(SEQ / 256, 4); S.G = G; S.c = bid; S.A0 = (const char*)AIN; S.B0 = (const char*)WA; S.A1 = (const char*)Q; S.B1 = (const char*)WB;
        EpiMix E{GA, GB, OUT(), Z};
        pg8::gemm_phase<EpiMix, SC, 1024, 1024, 1024, true, true>(ldsl, wave0, S, E);
        { PHASE_IDS(); MiniArgs P{AIN, WA, Q, WB, GA, GB, Z, nullptr, nullptr, nullptr, 0}; mini_sample_gemm<0, 1024>(lds, P, bid, G, wave, lane); }
    }
    GRID_SYNC();
    STAMP(6);
    {
        typedef Sched<0, 2048, 2048> SC; SC S; S.to.init(SEQ / 256, 4); S.G = G; S.c = bid; S.A0 = (const char*)Z; S.B0 = (const char*)WO;
        EpiRes4 E{IN(I_XP), OUT(), ADA, IN(I_GFFN), H2, (float*)WS(WS_SS)};
        pg8::gemm_phase<EpiRes4, SC, 1024, 1024, 1024, true, true>(ldsl, wave0, S, E);
        { PHASE_IDS(); if (gt < 256) *(u32x4*)((unsigned char*)H2 - 4096 + gt * 16) = (u32x4){0u, 0u, 0u, 0u}; }
        { PHASE_IDS(); MiniArgs P{Z, WO, nullptr, nullptr, nullptr, nullptr, nullptr, IN(I_XS), OUT(), ADA, 2048}; mini_sample_gemm<1, 1024>(lds, P, bid, G, wave, lane); }
    }
    GRID_SYNC();
    STAMP(8);
    {
        typedef Sched<2, 2048, 2048> SC; SC S; S.to.init(G >= 64 ? NPT5 : NPT5 + 1, FF2 / 256); S.G = G; S.c = bid; S.A0 = (const char*)H2; S.B0 = (const char*)WUP;
        {
            PHASE_IDS(); bool has = false; Unit u; for (int i = 0; S.next(i, u); ++i) has = has || (u.pm == NPT5);
            if (has) norm_phase<1>(OUT(), nullptr, IN(I_GFFN), ADA, 4096, 3072, H2, nullptr, SEQ + wave, 8, lane);
            asm volatile("s_waitcnt vmcnt(0)" ::: "memory"); __syncthreads(); }
        float* const out = OUT(); EpiFfn E{GG, IN(I_FCW), IN(I_FCB), IN(I_SFF), out + O_FP, out + O_FS, (PG8_LAS float*)(ldsl + HALO_OFF), (const float*)WS(WS_SS), (const float*)WS(WS_C0)};
        pg8::gemm_phase<EpiFfn, SC, 1024, 1024, 1024, true, true>(ldsl, wave0, S, E);
    }
    GRID_SYNC();
    STAMP(9);
    {
        typedef Sched<0, FF * 2, FF * 2> SC; SC S; S.to.init(SEQ / 256, 4); S.G = G; S.c = bid; S.A0 = (const char*)GG; S.B0 = (const char*)WDN;
        { EpiDelta E{Z, ADA, 5120};
        pg8::gemm_phase<EpiDelta, SC, FF, FF, FF, true, true>(ldsl, wave0, S, E); }
        { PHASE_IDS(); MiniArgs P{GG, WDN, nullptr, nullptr, nullptr, nullptr, Z, nullptr, nullptr, ADA, 5120}; mini_sample_gemm<2, FF>(lds, P, bid, G, wave, lane); }
    }
    GRID_SYNC();
    STAMP(10);
    {
        PHASE_IDS();
        float* const out = OUT();
        norm_phase<2>(out, nullptr, IN(I_GFIN), nullptr, 0, 0, nullptr, out, gw, NGW, lane, Z);
    }
#if TIMESEL >= 0
    GRID_SYNC();
    STAMP(11);
    GRID_SYNC();
    STAMP(12);
    GRID_SYNC();
    {   PHASE_IDS(); const volatile unsigned long long* ts = (const volatile unsigned long long*)WS(768 * 1024);
        const float us = (float)(ts[TIMESEL + TIMESPAN] - ts[TIMESEL]) * 0.01f;
        const float sc = 1.006f + us * 1e-5f; float* o = OUT() + O_KS;
        for (long i = gt; i < 128L * 128 * 256; i += NGT) o[i] *= sc; }
#endif
}

extern "C" void kernel_launch(void* const* d_in, const int* in_sizes, int n_in, void* d_out, int out_size, void* d_ws, size_t ws_size, hipStream_t stream) {
    static int grid = 0;
    if (grid == 0) {
        if (n_in != 23 || ws_size < WS_END) { fprintf(stderr, "kernel_launch: unexpected n_in %d / ws %zu\n", n_in, ws_size); grid = -1; return; }
        int dev = 0, cus = 0, per_cu = 0;
        hipGetDevice(&dev); hipDeviceGetAttribute(&cus, hipDeviceAttributeMultiprocessorCount, dev);
        if (hipFuncSetAttribute((const void*)mega, hipFuncAttributeMaxDynamicSharedMemorySize, LDS_BYTES) != hipSuccess) { fprintf(stderr, "kernel_launch: hipFuncSetAttribute failed\n"); }
        hipOccupancyMaxActiveBlocksPerMultiprocessor(&per_cu, (const void*)mega, 512, LDS_BYTES);
        (void)hipGetLastError();
        if (per_cu < 1) per_cu = 1;
        grid = cus * 1;
        if (grid <= 0) grid = 256;
    }
    if (grid < 0) return;
    Args a{};
    for (int i = 0; i < 23; ++i) a.in[i] = (const float*)d_in[i];
    a.out = (float*)d_out; a.ws = (unsigned char*)d_ws;
    (void)hipMemsetAsync((char*)d_ws + WS_BAR, 0, BAR_ZERO_BYTES, stream);
    void* args[] = {&a};
    hipError_t e = hipLaunchCooperativeKernel((const void*)mega, dim3(grid), dim3(512), args, LDS_BYTES, stream);
    if (e != hipSuccess) fprintf(stderr, "cooperative launch failed: %s (grid %d)\n", hipGetErrorString(e), grid);
}
```

```cpp
#ifndef SELFCHECK
#define SELFCHECK 0
#endif
#ifndef TIMESEL
#define TIMESEL -1
#define TIMESPAN 1
#endif
#ifndef TIMESPAN
#define TIMESPAN 1
#endif
#include <hip/hip_runtime.h>
#include <hip/hip_cooperative_groups.h>
#include <cstdio>
#include <cstdint>
namespace cg = cooperative_groups;

constexpr int D = 1024, SEQ = 16384, NS = 128, MROWS = SEQ + NS, MPAD = 16640;
constexpr int NIN = 6656, FF = 2816, FF2 = 5632, NADA = 6144;
constexpr int NMT = MPAD / 256;
constexpr int NPT5 = 65;
constexpr float EPS = 1e-6f;

constexpr size_t MiB = 1u << 20;
constexpr size_t RB = (size_t)MPAD * 1024 * 2;
constexpr size_t KBB = (size_t)MPAD * 256 * 2;
constexpr size_t WS_AADA = 1 * MiB;
constexpr size_t WS_ADA = 2 * MiB;
constexpr size_t WS_WA = 8 * MiB, WS_WB = 10 * MiB, WS_WO = 12 * MiB;
constexpr size_t WS_WADA = 14 * MiB;
constexpr size_t WS_WIN = 26 * MiB;
constexpr size_t WS_WUP = 14 * MiB;
constexpr size_t WS_WDN = 25 * MiB;
constexpr size_t WS_H = 39 * MiB;
constexpr size_t WS_U = 72 * MiB;
constexpr size_t WS_BG = 105 * MiB;
constexpr size_t WS_Q = 138 * MiB;
constexpr size_t WS_KB = WS_Q + RB, WS_VB = WS_KB + KBB, WS_GA = WS_VB + KBB, WS_GB = WS_GA + RB;
constexpr size_t WS_G = WS_Q;
constexpr size_t WS_END = WS_GB + RB;
static_assert(WS_END <= 256 * MiB, "ws map");
static_assert(WS_G + (size_t)MPAD * FF * 2 <= WS_END, "G overlay");
static_assert(WS_WDN + (size_t)1024 * FF * 2 <= WS_H && WS_WUP + (size_t)FF2 * 1024 * 2 <= WS_WDN, "weights");
static_assert(WS_U + RB + 4096 <= WS_BG && WS_H + RB <= WS_U && WS_BG + RB <= WS_Q, "row buffers");

constexpr size_t O_YP = 0, O_YS = 16777216, O_CAP = 16908288, O_CAS = 16910336, O_KP = 17172480, O_KS = 17205248,
                 O_VP = 21399552, O_VS = 21432320, O_FP = 25626624, O_FS = 25637888;

constexpr int LDS_BYTES = 147456;
constexpr int HALO_OFF = 131072;

typedef unsigned short bf16_t;
typedef short bf16x8 __attribute__((ext_vector_type(8)));
typedef float f32x4 __attribute__((ext_vector_type(4)));
typedef float f32x16 __attribute__((ext_vector_type(16)));
typedef float f32x2 __attribute__((ext_vector_type(2)));
typedef unsigned u32x4 __attribute__((ext_vector_type(4)));
typedef unsigned u32x2 __attribute__((ext_vector_type(2)));

__device__ __forceinline__ float bf2f(unsigned b) { return __uint_as_float(b << 16); }
__device__ __forceinline__ unsigned cvt_pk_bf16(float lo, float hi) { unsigned r; asm volatile("v_cvt_pk_bf16_f32 %0, %1, %2" : "=v"(r) : "v"(lo), "v"(hi)); return r; }
__device__ __forceinline__ unsigned lane_id_now() { unsigned l; asm volatile("v_mbcnt_lo_u32_b32 %0, -1, 0\n\tv_mbcnt_hi_u32_b32 %0, -1, %0" : "=v"(l)); return l; }
__device__ __forceinline__ float bperm_f(float v, int byte_addr) { return __int_as_float(__builtin_amdgcn_ds_bpermute(byte_addr, __float_as_int(v))); }
__device__ __forceinline__ float sigmoidf_(float x) { return __builtin_amdgcn_rcpf(1.0f + __expf(-x)); }
__device__ __forceinline__ float siluf_(float x) { return x * __builtin_amdgcn_rcpf(1.0f + __expf(-x)); }
__device__ __forceinline__ float wave_sum(float v) {
#pragma unroll
    for (int o = 1; o < 64; o <<= 1) v += __shfl_xor(v, o);
    return v;
}
__device__ __forceinline__ float wave_max(float v) {
#pragma unroll
    for (int o = 1; o < 64; o <<= 1) v = fmaxf(v, __shfl_xor(v, o));
    return v;
}
__device__ __forceinline__ void unpack8(u32x4 w, float* f) {
    f[0] = bf2f(w.x & 0xffffu); f[1] = bf2f(w.x >> 16); f[2] = bf2f(w.y & 0xffffu); f[3] = bf2f(w.y >> 16);
    f[4] = bf2f(w.z & 0xffffu); f[5] = bf2f(w.z >> 16); f[6] = bf2f(w.w & 0xffffu); f[7] = bf2f(w.w >> 16);
}
__device__ __forceinline__ u32x4 pack8(const float* f) {
    u32x4 w; w.x = cvt_pk_bf16(f[0], f[1]); w.y = cvt_pk_bf16(f[2], f[3]); w.z = cvt_pk_bf16(f[4], f[5]); w.w = cvt_pk_bf16(f[6], f[7]); return w;
}

namespace pg8 {
#define PG8_LAS __attribute__((address_space(3)))
constexpr int BM = 256, BK = 64, HALF = 128, HTB = HALF * BK * 2, STAGE_BYTES = 8 * HTB, NXCD = 8, WGM = 8;
__host__ __device__ __forceinline__ int lds_byte(int r, int c) { const int st = (r >> 4) * 2 + (c >> 5), rr = r & 15, cc = c & 31, ob = rr * 64 + cc * 2; return st * 1024 + (ob ^ (((ob >> 9) & 1) << 5)); }
__host__ __device__ __forceinline__ void stage_rc(int b, int& R, int& C) { const int st = b / 1024, sb = b % 1024, swz = sb ^ (((sb >> 9) & 1) << 5); R = (st >> 1) * 16 + swz / 64; C = (st & 1) * 32 + (swz % 64) / 2; }
__host__ __device__ __forceinline__ int perm32(int rho) { const int n = rho >> 4, i = rho & 15; return 8 * (i >> 2) + 4 * n + (i & 3); }

struct Unit { int pm, pn, aux; const char* a; const char* b; };

struct TileOrder {
    int nM, nN, nwg;
    __device__ __forceinline__ void init(int nM_, int nN_) { nM = nM_; nN = nN_; nwg = nM * nN; }
    __device__ __forceinline__ bool tile(long L, int& pm, int& pn) const {
        if (L >= nwg) return false;
        int wgid = (int)L; { const int q = nwg / NXCD, r = nwg % NXCD, xcd = wgid % NXCD, off = wgid / NXCD; wgid = (xcd < r ? xcd * (q + 1) : r * (q + 1) + (xcd - r) * q) + off; }
        const int nig = WGM * nN, gid = wgid / nig, fm = gid * WGM, gsz = (nM - fm) < WGM ? (nM - fm) : WGM;
        pm = fm + ((wgid % nig) % gsz); pn = (wgid % nig) / gsz; return true;
    }
};

template <class Epi, class Sched, int lda, int ldb, int K, bool ALIGN_EPI, bool SP2>
__device__ __forceinline__ void gemm_phase(PG8_LAS unsigned char* lds, const int wave0, const Sched& S, const Epi& E) {
    int tid_ = wave0 * 64 + (int)lane_id_now(); asm volatile("" : "+v"(tid_));
    const int tid = tid_, wid = __builtin_amdgcn_readfirstlane(tid >> 6), lane = tid & 63, wr = wid >> 2, wc = wid & 3, fr = lane & 15, fq = lane >> 4;
    const int nt = K / BK;
    unsigned voffA[2], voffB[2];
#pragma unroll
    for (int i = 0; i < 2; ++i) { int R, C; stage_rc(tid * 16 + i * 8192, R, C); const int Rb = Epi::PERM ? ((R & ~31) + perm32(R & 31)) : R;
        voffA[i] = (unsigned)(R * lda + C) * 2u; voffB[i] = (unsigned)(Rb * ldb + C) * 2u; }
    const size_t kstep = (size_t)(BK * 2);
    const size_t hstepA = (size_t)HALF * lda * 2, hstepB = (size_t)HALF * ldb * 2;
    const unsigned ldsw = (unsigned)wid * 1024u;
    const int aoff = lds_byte(wr * 64 + fr, fq * 8), boff = lds_byte(wc * 32 + fr, fq * 8);
#define PG8_SA(b, h) (((b) * 2 + (h)) * HTB)
#define PG8_SB(b, h) ((4 + (b) * 2 + (h)) * HTB)
#define PG8_STAGE(bufoff, gbase, voff) do { _Pragma("unroll") for (int _i = 0; _i < 2; ++_i) \
        __builtin_amdgcn_global_load_lds((const unsigned*)((const char*)(gbase) + (voff)[_i]), (PG8_LAS unsigned*)(lds + (bufoff) + ldsw + _i * 8192), 16, 0, 0); } while (0)
#define PG8_LDA(dst, b, h) do { _Pragma("unroll") for (int m = 0; m < 4; ++m) _Pragma("unroll") for (int k = 0; k < 2; ++k) dst[m][k] = *(const PG8_LAS bf16x8*)(lds + PG8_SA(b, h) + aoff + m * 2048 + k * 1024); } while (0)
#define PG8_LDB(dst, b, h) do { _Pragma("unroll") for (int n = 0; n < 2; ++n) _Pragma("unroll") for (int k = 0; k < 2; ++k) dst[n][k] = *(const PG8_LAS bf16x8*)(lds + PG8_SB(b, h) + boff + n * 2048 + k * 1024); } while (0)
#define PG8_MMA(ai, bj, At, Bt) do { __builtin_amdgcn_s_setprio(1); _Pragma("unroll") for (int m = 0; m < 4; ++m) _Pragma("unroll") for (int n = 0; n < 2; ++n) _Pragma("unroll") for (int k = 0; k < 2; ++k) \
        acc[ai][bj][m][n] = __builtin_amdgcn_mfma_f32_16x16x32_bf16(Bt[n][k], At[m][k], acc[ai][bj][m][n], 0, 0, 0); __builtin_amdgcn_s_setprio(0); } while (0)
#define PG8_WAIT_V(n) asm volatile("s_waitcnt vmcnt(" #n ")" ::: "memory")
#define PG8_WAIT_L(n) asm volatile("s_waitcnt lgkmcnt(" #n ")" ::: "memory")
#define PG8_BAR __builtin_amdgcn_s_barrier()
#define PG8_SCHED __builtin_amdgcn_sched_barrier(0)
    Unit cur, nxt; int ui = 0;
    if (!S.next(0, cur)) return;
    f32x4 acc[2][2][4][2];
#pragma unroll
    for (int a = 0; a < 2; ++a)
#pragma unroll
        for (int b = 0; b < 2; ++b)
#pragma unroll
            for (int m = 0; m < 4; ++m)
#pragma unroll
                for (int n = 0; n < 2; ++n) acc[a][b][m][n] = (f32x4){0.f, 0.f, 0.f, 0.f};
    bf16x8 At[4][2], B0[2][2], B1[2][2];
    const char* cA = cur.a; const char* cB = cur.b;
    if constexpr (SP2) {
        PG8_STAGE(PG8_SB(0, 0), cB, voffB); PG8_STAGE(PG8_SB(0, 1), cB + hstepB, voffB); PG8_STAGE(PG8_SA(0, 0), cA, voffA); PG8_STAGE(PG8_SA(0, 1), cA + hstepA, voffA);
        if (wr == 1) PG8_BAR;
        PG8_WAIT_V(2); PG8_BAR;
        PG8_STAGE(PG8_SB(1, 0), cB + kstep, voffB); PG8_STAGE(PG8_SA(1, 0), cA + kstep, voffA); PG8_STAGE(PG8_SB(1, 1), cB + hstepB + kstep, voffB);
        PG8_WAIT_V(6); PG8_BAR;
    } else {
        PG8_STAGE(PG8_SB(0, 0), cB, voffB); PG8_STAGE(PG8_SA(0, 0), cA, voffA); PG8_STAGE(PG8_SB(0, 1), cB + hstepB, voffB); PG8_STAGE(PG8_SA(0, 1), cA + hstepA, voffA);
        if (wr == 1) PG8_BAR;
        PG8_WAIT_V(4); PG8_BAR;
        PG8_STAGE(PG8_SB(1, 0), cB + kstep, voffB); PG8_STAGE(PG8_SA(1, 0), cA + kstep, voffA); PG8_STAGE(PG8_SB(1, 1), cB + hstepB + kstep, voffB);
        PG8_WAIT_V(6); PG8_BAR;
    }
    for (;;) {
        const bool has_next = S.next(ui + 1, nxt);
        const char* nA = has_next ? nxt.a : cA; const char* nB = has_next ? nxt.b : cB;
        for (int t = 0; t < nt; t += 2) {
            const bool last = (t == nt - 2);
            const char* a1 = cA + (size_t)(t + 1) * kstep;
            const char* a2 = last ? nA : cA + (size_t)(t + 2) * kstep; const char* b2 = last ? nB : cB + (size_t)(t + 2) * kstep;
            const char* a3 = a2 + kstep; const char* b3 = b2 + kstep;
            if constexpr (SP2) {
            PG8_LDB(B0, 0, 0); PG8_LDB(B1, 0, 1); PG8_SCHED; PG8_LDA(At, 0, 0); PG8_STAGE(PG8_SA(1, 1), a1 + hstepA, voffA);
            PG8_WAIT_V(8); PG8_WAIT_L(0); PG8_BAR; PG8_MMA(0, 0, At, B0); PG8_MMA(0, 1, At, B1); PG8_BAR; PG8_SCHED;
            PG8_LDA(At, 0, 1); PG8_STAGE(PG8_SB(0, 0), b2, voffB); PG8_STAGE(PG8_SB(0, 1), b2 + hstepB, voffB); PG8_STAGE(PG8_SA(0, 0), a2, voffA);
            PG8_WAIT_V(8); PG8_WAIT_L(0); PG8_BAR; PG8_MMA(1, 0, At, B0); PG8_MMA(1, 1, At, B1); PG8_BAR; PG8_SCHED;
            PG8_LDB(B0, 1, 0); PG8_LDB(B1, 1, 1); PG8_SCHED; PG8_LDA(At, 1, 0); PG8_STAGE(PG8_SA(0, 1), a2 + hstepA, voffA);
            PG8_WAIT_V(8); PG8_WAIT_L(0); PG8_BAR; PG8_MMA(0, 0, At, B0); PG8_MMA(0, 1, At, B1); PG8_BAR; PG8_SCHED;
            PG8_LDA(At, 1, 1); PG8_STAGE(PG8_SB(1, 0), b3, voffB); PG8_STAGE(PG8_SB(1, 1), b3 + hstepB, voffB); PG8_STAGE(PG8_SA(1, 0), a3, voffA);
            PG8_WAIT_V(8); PG8_WAIT_L(0); PG8_BAR; PG8_MMA(1, 0, At, B0); PG8_MMA(1, 1, At, B1); PG8_BAR; PG8_SCHED;
            } else {
            PG8_LDB(B0, 0, 0); PG8_SCHED; PG8_LDA(At, 0, 0); PG8_STAGE(PG8_SA(1, 1), a1 + hstepA, voffA);
            PG8_WAIT_L(8); PG8_BAR; PG8_WAIT_L(0); PG8_MMA(0, 0, At, B0); PG8_BAR; PG8_SCHED;
            PG8_LDB(B1, 0, 1); PG8_STAGE(PG8_SB(0, 0), b2, voffB);
            PG8_BAR; PG8_WAIT_L(0); PG8_MMA(0, 1, At, B1); PG8_BAR;
            PG8_LDA(At, 0, 1); PG8_STAGE(PG8_SA(0, 0), a2, voffA);
            PG8_BAR; PG8_WAIT_L(0); PG8_MMA(1, 0, At, B0); PG8_BAR; PG8_SCHED;
            PG8_STAGE(PG8_SB(0, 1), b2 + hstepB, voffB);
            PG8_WAIT_V(6); PG8_BAR; PG8_MMA(1, 1, At, B1); PG8_BAR;
            PG8_LDB(B0, 1, 0); PG8_SCHED; PG8_LDA(At, 1, 0); PG8_STAGE(PG8_SA(0, 1), a2 + hstepA, voffA);
            PG8_WAIT_L(8); PG8_BAR; PG8_WAIT_L(0); PG8_MMA(0, 0, At, B0); PG8_BAR; PG8_SCHED;
            PG8_LDB(B1, 1, 1); PG8_STAGE(PG8_SB(1, 0), b3, voffB);
            PG8_BAR; PG8_WAIT_L(0); PG8_MMA(0, 1, At, B1); PG8_BAR;
            PG8_LDA(At, 1, 1); PG8_STAGE(PG8_SA(1, 0), a3, voffA);
            PG8_BAR; PG8_WAIT_L(0); PG8_MMA(1, 0, At, B0); PG8_BAR; PG8_SCHED;
            PG8_STAGE(PG8_SB(1, 1), b3 + hstepB, voffB);
            PG8_WAIT_V(6); PG8_BAR; PG8_MMA(1, 1, At, B1); PG8_BAR;
            }
        }
        if constexpr (ALIGN_EPI) { if (wr == 0) PG8_BAR; }
        E(acc, cur, wr, wc, fr, fq);
        if (!has_next) break;
#pragma unroll
        for (int a = 0; a < 2; ++a)
#pragma unroll
            for (int b = 0; b < 2; ++b)
#pragma unroll
                for (int m = 0; m < 4; ++m)
#pragma unroll
                    for (int n = 0; n < 2; ++n) acc[a][b][m][n] = (f32x4){0.f, 0.f, 0.f, 0.f};
        cur = nxt; cA = nA; cB = nB; ++ui;
        if constexpr (ALIGN_EPI) { if (wr == 1) PG8_BAR; }
    }
    PG8_WAIT_V(0);
    if constexpr (!ALIGN_EPI) { if (wr == 0) PG8_BAR; }
    PG8_BAR;
#undef PG8_SA
#undef PG8_SB
#undef PG8_STAGE
#undef PG8_LDA
#undef PG8_LDB
#undef PG8_MMA
#undef PG8_WAIT_V
#undef PG8_WAIT_L
#undef PG8_BAR
#undef PG8_SCHED
}
}
using pg8::Unit;

template <int MODE, int LDA_B, int LDB_B> struct Sched {
    pg8::TileOrder to; int G, c;
    const char* A0; const char* B0; const char* A1; const char* B1;
    __device__ __forceinline__ bool next(int i, Unit& u) const {
        if (MODE == 1) {
            const long L = (long)(i >> 1) * G + c; if (!to.tile(L, u.pm, u.pn)) return false;
            u.aux = i & 1;
            u.a = (u.aux ? A1 : A0) + (size_t)u.pm * 256 * LDA_B; u.b = (u.aux ? B1 : B0) + (size_t)u.pn * 256 * LDB_B; return true;
        } else {
            const long L = (long)i * G + c;
            if (MODE == 2 && G >= 64) {
                const int nS = FF2 / 256;
                if (L >= (long)to.nwg + nS) return false;
                if (L >= G - nS && L < G) { u.pm = NPT5; u.pn = (int)(L - (G - nS)); }
                else if (!to.tile(L < G - nS ? L : L - nS, u.pm, u.pn)) return false;
            } else if (!to.tile(L, u.pm, u.pn)) return false;
            u.aux = 0;
            if (MODE == 2) { const long r0 = (u.pm < NPT5) ? (254L * u.pm - 2) : (long)SEQ; u.a = A0 + r0 * (long)LDA_B; }
            else u.a = A0 + (size_t)u.pm * 256 * LDA_B;
            u.b = B0 + (size_t)u.pn * 256 * LDB_B; return true;
        }
    }
};

#define EPI_ARGS const f32x4 (&acc)[2][2][4][2], const Unit& u, int wr, int wc, int fr, int fq
struct EpiAda {
    static constexpr bool PERM = true;
    float* ADA; const float* bias;
    __device__ __forceinline__ void operator()(EPI_ARGS) const {
#pragma unroll
        for (int ai = 0; ai < 2; ++ai)
#pragma unroll
            for (int m = 0; m < 4; ++m) { const int row = 128 * ai + 64 * wr + 16 * m + fr;
#pragma unroll
                for (int bj = 0; bj < 2; ++bj) { const int col = 256 * u.pn + 128 * bj + 32 * wc + 8 * fq;
#pragma unroll
                    for (int n = 0; n < 2; ++n) { const f32x4 b = *(const f32x4*)(bias + col + 4 * n); *(f32x4*)(ADA + (size_t)row * NADA + col + 4 * n) = acc[ai][bj][m][n] + b; } } }
    }
};
struct EpiProj {
    static constexpr bool PERM = true;
    bf16_t *U, *BG, *Q, *KB, *VB, *GA, *GB;
    __device__ __forceinline__ void operator()(EPI_ARGS) const {
        const int row0 = u.pm * 256 + wr * 64 + fr;
        if (u.pn < 8) {
#pragma unroll
            for (int ai = 0; ai < 2; ++ai)
#pragma unroll
                for (int m = 0; m < 4; ++m) { const int row = row0 + 128 * ai + 16 * m;
                    const f32x4 v0 = acc[ai][0][m][0] * acc[ai][1][m][0], v1 = acc[ai][0][m][1] * acc[ai][1][m][1];
                    u32x4 w; w.x = cvt_pk_bf16(v0[0], v0[1]); w.y = cvt_pk_bf16(v0[2], v0[3]); w.z = cvt_pk_bf16(v1[0], v1[1]); w.w = cvt_pk_bf16(v1[2], v1[3]);
                    *(u32x4*)(U + (size_t)row * 1024 + 128 * u.pn + 32 * wc + 8 * fq) = w; }
        } else {
            bf16_t* dst; int ld, cb; const int pn = u.pn;
            if (pn < 12) { dst = BG; ld = 1024; cb = 256 * (pn - 8); }
            else if (pn < 16) { dst = Q; ld = 1024; cb = 256 * (pn - 12); }
            else if (pn == 16) { dst = KB; ld = 256; cb = 0; }
            else if (pn == 17) { dst = VB; ld = 256; cb = 0; }
            else if (pn < 22) { dst = GA; ld = 1024; cb = 256 * (pn - 18); }
            else { dst = GB; ld = 1024; cb = 256 * (pn - 22); }
#pragma unroll
            for (int ai = 0; ai < 2; ++ai)
#pragma unroll
                for (int m = 0; m < 4; ++m) { const int row = row0 + 128 * ai + 16 * m;
#pragma unroll
                    for (int bj = 0; bj < 2; ++bj) { const f32x4 v0 = acc[ai][bj][m][0], v1 = acc[ai][bj][m][1];
                        u32x4 w; w.x = cvt_pk_bf16(v0[0], v0[1]); w.y = cvt_pk_bf16(v0[2], v0[3]); w.z = cvt_pk_bf16(v1[0], v1[1]); w.w = cvt_pk_bf16(v1[2], v1[3]);
                        *(u32x4*)(dst + (size_t)row * ld + cb + 128 * bj + 32 * wc + 8 * fq) = w; } }
        }
    }
};
struct EpiMix {
    static constexpr bool PERM = true;
    const bf16_t *GA, *GB; float* T; bf16_t* Z;
    __device__ __forceinline__ void operator()(EPI_ARGS) const {
        const int row0 = u.pm * 256 + wr * 64 + fr;
        const bf16_t* gate = u.aux ? GB : GA;
#pragma unroll
        for (int ai = 0; ai < 2; ++ai)
#pragma unroll
            for (int m = 0; m < 4; ++m) { const int row = row0 + 128 * ai + 16 * m;
                if (row < MROWS) {
#pragma unroll
                for (int bj = 0; bj < 2; ++bj) { const int col = 256 * u.pn + 128 * bj + 32 * wc + 8 * fq;
                    float gv[8]; unpack8(*(const u32x4*)(gate + (size_t)row * 1024 + col), gv);
                    float o[8];
#pragma unroll
                    for (int i = 0; i < 8; ++i) o[i] = sigmoidf_(gv[i]) * acc[ai][bj][m][i >> 2][i & 3];
                    bf16_t* zp = Z + (size_t)row * 1024 + col;
                    if (u.aux == 0) *(u32x4*)zp = pack8(o);
                    else { float t[8]; unpack8(*(const u32x4*)zp, t);
#pragma unroll
                        for (int i = 0; i < 8; ++i) o[i] += t[i];
                        *(u32x4*)zp = pack8(o); } } } }
    }
};
struct EpiRes {
    static constexpr bool PERM = true;
    const float* xp; const float* xs; float* out; const float* ADA; int goff;
    __device__ __forceinline__ void operator()(EPI_ARGS) const {
        const int row0 = u.pm * 256 + wr * 64 + fr;
#pragma unroll
        for (int ai = 0; ai < 2; ++ai)
#pragma unroll
            for (int m = 0; m < 4; ++m) { const int row = row0 + 128 * ai + 16 * m;
                if (row < MROWS) {
                const float* base = (row < SEQ) ? xp + (size_t)row * 1024 : xs + (size_t)(row - SEQ) * 1024;
                const float* gt = ADA + (size_t)((row < SEQ) ? 128 : row - SEQ) * NADA + goff;
#pragma unroll
                for (int bj = 0; bj < 2; ++bj) { const int col = 256 * u.pn + 128 * bj + 32 * wc + 8 * fq;
#pragma unroll
                    for (int n = 0; n < 2; ++n) { const f32x4 b = *(const f32x4*)(base + col + 4 * n), g = *(const f32x4*)(gt + col + 4 * n);
                        *(f32x4*)(out + (size_t)row * 1024 + col + 4 * n) = b + g * acc[ai][bj][m][n]; } } } }
    }
};
struct EpiDelta {
    static constexpr bool PERM = true;
    bf16_t* Dd; const float* ADA; int goff;
    __device__ __forceinline__ void operator()(EPI_ARGS) const {
        const int row0 = u.pm * 256 + wr * 64 + fr;
#pragma unroll
        for (int ai = 0; ai < 2; ++ai)
#pragma unroll
            for (int m = 0; m < 4; ++m) { const int row = row0 + 128 * ai + 16 * m;
                if (row < MROWS) {
                const float* gt = ADA + (size_t)((row < SEQ) ? 128 : row - SEQ) * NADA + goff;
#pragma unroll
                for (int bj = 0; bj < 2; ++bj) { const int col = 256 * u.pn + 128 * bj + 32 * wc + 8 * fq;
                    const f32x4 g0 = *(const f32x4*)(gt + col), g1 = *(const f32x4*)(gt + col + 4); const f32x4 a0 = g0 * acc[ai][bj][m][0], a1 = g1 * acc[ai][bj][m][1];
                    u32x4 w; w.x = cvt_pk_bf16(a0[0], a0[1]); w.y = cvt_pk_bf16(a0[2], a0[3]); w.z = cvt_pk_bf16(a1[0], a1[1]); w.w = cvt_pk_bf16(a1[2], a1[3]);
                    *(u32x4*)(Dd + (size_t)row * 1024 + col) = w; } } }
    }
};
struct EpiRes4 {
    static constexpr bool PERM = true;
    const float* xp; float* out; const float* ADA; const float* gf; bf16_t* A2; float* SS;
    __device__ __forceinline__ void operator()(EPI_ARGS) const {
        const int row0 = u.pm * 256 + wr * 64 + fr; const float* ad = ADA + (size_t)128 * NADA;
#pragma unroll
        for (int ai = 0; ai < 2; ++ai)
#pragma unroll
            for (int m = 0; m < 4; ++m) { const int row = row0 + 128 * ai + 16 * m; float ss = 0.f;
#pragma unroll
                for (int bj = 0; bj < 2; ++bj) { const int col = 256 * u.pn + 128 * bj + 32 * wc + 8 * fq; float a2[8];
#pragma unroll
                    for (int n = 0; n < 2; ++n) { const f32x4 b = *(const f32x4*)(xp + (size_t)row * 1024 + col + 4 * n), g = *(const f32x4*)(ad + 2048 + col + 4 * n);
                        const f32x4 x1 = b + g * acc[ai][bj][m][n]; *(f32x4*)(out + (size_t)row * 1024 + col + 4 * n) = x1;
                        ss += (x1[0] * x1[0] + x1[1] * x1[1]) + (x1[2] * x1[2] + x1[3] * x1[3]);
                        const f32x4 gm = *(const f32x4*)(gf + col + 4 * n) * (*(const f32x4*)(ad + 4096 + col + 4 * n) + 1.0f); const f32x4 av = x1 * gm;
                        a2[4 * n] = av[0]; a2[4 * n + 1] = av[1]; a2[4 * n + 2] = av[2]; a2[4 * n + 3] = av[3]; }
                    *(u32x4*)(A2 + (size_t)row * 1024 + col) = pack8(a2); }
                ss += __shfl_xor(ss, 16); ss += __shfl_xor(ss, 32);
                if (fq == 0) SS[(size_t)row * 16 + u.pn * 4 + wc] = ss; }
    }
};
__device__ __forceinline__ float ss_sum16(const float* SS, unsigned row) {
    const f32x4* p = (const f32x4*)((const char*)SS + (size_t)row * 64u); const f32x4 a = p[0], b = p[1], c = p[2], d = p[3]; const f32x4 s = (a + b) + (c + d); return (s[0] + s[1]) + (s[2] + s[3]); }
struct EpiFfn {
    static constexpr bool PERM = true;
    bf16_t* G; const float* cw; const float* cb; const float* st; float* ofp; float* ofs; PG8_LAS float* halo; const float* SS; const float* C0;
    template <int CTRL> static __device__ __forceinline__ float dppf(float oldv, float src) {
        return __int_as_float(__builtin_amdgcn_update_dpp(__float_as_int(oldv), __float_as_int(src), CTRL, 0xf, 0xf, false)); }
    __device__ __forceinline__ void operator()(const f32x4 (&acc)[2][2][4][2], const Unit& u, int wr, int wc, int fr_, int fq_) const {
        const int l_ = (int)lane_id_now();
        const int fr = l_ & 15, fq = l_ >> 4; (void)fr_; (void)fq_;
        const int wid = wr * 4 + wc;
        const int f0 = 128 * u.pn + 32 * wc + 8 * fq;
        if (u.pm < NPT5) {
            PG8_LAS float* par = halo + 2048;
            {
                const int t = wid * 64 + l_;
                if (t < 256) { const int gc = (t < 128) ? 128 * u.pn + t : FF + 128 * u.pn + (t - 128);
                    const float w0_ = cw[gc], w1_ = cw[FF2 + gc], w2_ = cw[2 * FF2 + gc], b_ = cb[gc], c0_ = C0[gc];
                    par[t] = w0_; par[256 + t] = w1_; par[512 + t] = w2_; par[768 + t] = b_ + c0_ * (w0_ + w1_ + w2_); par[1024 + t] = c0_; }
                else { const int tr_ = t - 256, gr_ = 254 * u.pm - 2 + tr_; const unsigned go_ = (unsigned)((gr_ < 0 || gr_ >= SEQ) ? 0 : gr_);
                    const float ssv = ss_sum16(SS, go_); par[1280 + tr_] = (gr_ >= 0) ? rsqrtf(ssv * (1.0f / 1024.0f) + EPS) : 0.f; }
            }
            unsigned pb_ = (unsigned)(uintptr_t)(par + 32 * wc + 8 * fq); asm volatile("" : "+v"(pb_)); const PG8_LAS float* parl = (const PG8_LAS float*)(uintptr_t)pb_;
            unsigned rb_ = (unsigned)(uintptr_t)(par + 1280 + 64 * wr + fr); asm volatile("" : "+v"(rb_)); const PG8_LAS float* rsl = (const PG8_LAS float*)(uintptr_t)rb_;
            if (fr >= 14) {
#pragma unroll
                for (int ai = 0; ai < 2; ++ai)
#pragma unroll
                    for (int bj = 0; bj < 2; ++bj)
#pragma unroll
                        for (int n = 0; n < 2; ++n) { const int gr_ = 254 * u.pm - 2 + 128 * ai + 64 * wr + 48 + fr; const float r_ = rsqrtf(ss_sum16(SS, (unsigned)(gr_ >= SEQ ? 0 : gr_)) * (1.0f / 1024.0f) + EPS);
                            *(PG8_LAS f32x4*)(halo + ((wid * 2 + ai) * 2 + (fr - 14)) * 64 + bj * 32 + fq * 8 + n * 4) = acc[ai][bj][3][n] * r_; }
            }
            const bool first = (u.pm == 0) && (wr == 0);
            asm volatile("s_waitcnt vmcnt(0) lgkmcnt(0)" ::: "memory"); __builtin_amdgcn_s_barrier(); asm volatile("" ::: "memory");
#pragma unroll
            for (int ai = 0; ai < 2; ++ai) {
                const int swr = (ai == 0) ? 0 : (wr == 0 ? 1 : 0), sai = (ai == 1 && wr == 1) ? 1 : 0;
                unsigned hb_ = (unsigned)(uintptr_t)(halo + (((swr * 4 + wc) * 2 + sai) * 2) * 64 + fq * 8); asm volatile("" : "+v"(hb_)); const PG8_LAS float* hp = (const PG8_LAS float*)(uintptr_t)hb_;
                u32x2 pk0[4];
#pragma unroll
                for (int n = 0; n < 2; ++n) {
                    const int cg0 = 4 * n, cv0 = 128 + cg0;
                    f32x4 cvv[4];
                    {
                        const f32x4 w0 = *(const PG8_LAS f32x4*)(parl + cv0), w1 = *(const PG8_LAS f32x4*)(parl + 256 + cv0), w2 = *(const PG8_LAS f32x4*)(parl + 512 + cv0), bb = *(const PG8_LAS f32x4*)(parl + 768 + cv0);
                        const f32x4 h2 = *(const PG8_LAS f32x4*)(hp + 32 + n * 4), h1 = *(const PG8_LAS f32x4*)(hp + 64 + 32 + n * 4);
                        f32x4 p1 = h1, p2 = (fr == 1) ? h1 : h2;
                        const f32x4 bbe = bb;
#pragma unroll
                        for (int m = 0; m < 4; ++m) {
                            const float r_ = rsl[128 * ai + 16 * m];
                            const f32x4 x = acc[ai][1][m][n] * r_; f32x4 q1, q2, n1, n2;
#pragma unroll
                            for (int i = 0; i < 4; ++i) { q1[i] = dppf<0x111>(p1[i], x[i]); q2[i] = dppf<0x112>(p2[i], x[i]); n1[i] = dppf<0x121>(x[i], x[i]); n2[i] = dppf<0x122>(x[i], x[i]); }
                            p1 = n1; p2 = n2;
                            cvv[m] = w0 * q2 + w1 * q1 + w2 * x + bbe;
                            if (ai == 0 && m == 0 && first) { const f32x4 c0v = *(const PG8_LAS f32x4*)(parl + 1024 + cv0); if (fr == 2) cvv[m] -= c0v * (w0 + w1); else if (fr == 3) cvv[m] -= c0v * w0; }
                            __builtin_amdgcn_sched_barrier(0);
                        }
                    }
                    {
                        const f32x4 w0 = *(const PG8_LAS f32x4*)(parl + cg0), w1 = *(const PG8_LAS f32x4*)(parl + 256 + cg0), w2 = *(const PG8_LAS f32x4*)(parl + 512 + cg0), bb = *(const PG8_LAS f32x4*)(parl + 768 + cg0);
                        const f32x4 h2 = *(const PG8_LAS f32x4*)(hp + n * 4), h1 = *(const PG8_LAS f32x4*)(hp + 64 + n * 4);
                        f32x4 p1 = h1, p2 = (fr == 1) ? h1 : h2;
                        const f32x4 bbe = bb;
#pragma unroll
                        for (int m = 0; m < 4; ++m) {
                            const float r_ = rsl[128 * ai + 16 * m];
                            const f32x4 x = acc[ai][0][m][n] * r_; f32x4 q1, q2, n1, n2;
#pragma unroll
                            for (int i = 0; i < 4; ++i) { q1[i] = dppf<0x111>(p1[i], x[i]); q2[i] = dppf<0x112>(p2[i], x[i]); n1[i] = dppf<0x121>(x[i], x[i]); n2[i] = dppf<0x122>(x[i], x[i]); }
                            p1 = n1; p2 = n2;
                            f32x4 cgv = w0 * q2 + w1 * q1 + w2 * x + bbe;
                            if (ai == 0 && m == 0 && first) { const f32x4 c0v = *(const PG8_LAS f32x4*)(parl + 1024 + cg0); if (fr == 2) cgv -= c0v * (w0 + w1); else if (fr == 3) cgv -= c0v * w0; }
                            u32x2 pk; pk.x = cvt_pk_bf16(siluf_(cgv[0]) * cvv[m][0], siluf_(cgv[1]) * cvv[m][1]); pk.y = cvt_pk_bf16(siluf_(cgv[2]) * cvv[m][2], siluf_(cgv[3]) * cvv[m][3]);
                            if (n == 0) pk0[m] = pk;
                            else {
                                const int tr = 128 * ai + 64 * wr + 16 * m + fr; const int grow = 254 * u.pm - 2 + tr;
                                if (tr >= 2 && grow < SEQ) {
                                    *(u32x4*)(G + (size_t)grow * FF + f0) = (u32x4){pk0[m].x, pk0[m].y, pk.x, pk.y};
                                    if (grow >= SEQ - 2) { float* o = ofp + (size_t)(grow - (SEQ - 2)) * FF2 + f0;
                                        *(f32x4*)o = acc[ai][0][m][0] * r_ + *(const PG8_LAS f32x4*)(parl + 1024); *(f32x4*)(o + 4) = acc[ai][0][m][1] * r_ + *(const PG8_LAS f32x4*)(parl + 1024 + 4);
                                        *(f32x4*)(o + FF) = acc[ai][1][m][0] * r_ + *(const PG8_LAS f32x4*)(parl + 1024 + 128); *(f32x4*)(o + FF + 4) = acc[ai][1][m][1] * r_ + *(const PG8_LAS f32x4*)(parl + 1024 + 128 + 4); }
                                }
                            }
                            asm volatile("" ::: "memory"); __builtin_amdgcn_sched_barrier(0);
                        }
                    }
                }
                asm volatile("" ::: "memory"); __builtin_amdgcn_sched_barrier(0);
            }
        } else {
#pragma unroll
            for (int n = 0; n < 2; ++n) {
                const int fg = f0 + 4 * n, fv = FF + fg;
#pragma unroll
                for (int m = 0; m < 4; ++m) {
                    const int b = 64 * wr + 16 * m + fr;
                    const float* s0 = st + (size_t)(b * 2) * FF2; const float* s1 = s0 + FF2;
                    float* o0 = ofs + (size_t)(b * 2) * FF2; float* o1 = o0 + FF2;
                    f32x4 cvv;
                    { const f32x4 x = acc[0][1][m][n];
                      const f32x4 w0 = *(const f32x4*)(cw + fv), w1 = *(const f32x4*)(cw + FF2 + fv), w2 = *(const f32x4*)(cw + 2 * FF2 + fv), bb = *(const f32x4*)(cb + fv);
                      const f32x4 t0 = *(const f32x4*)(s0 + fv), t1 = *(const f32x4*)(s1 + fv);
                      cvv = w0 * t0 + w1 * t1 + w2 * x + bb; *(f32x4*)(o0 + fv) = t1; *(f32x4*)(o1 + fv) = x; }
                    asm volatile("" ::: "memory"); __builtin_amdgcn_sched_barrier(0);
                    { const f32x4 x = acc[0][0][m][n];
                      const f32x4 w0 = *(const f32x4*)(cw + fg), w1 = *(const f32x4*)(cw + FF2 + fg), w2 = *(const f32x4*)(cw + 2 * FF2 + fg), bb = *(const f32x4*)(cb + fg);
                      const f32x4 t0 = *(const f32x4*)(s0 + fg), t1 = *(const f32x4*)(s1 + fg);
                      const f32x4 cgv = w0 * t0 + w1 * t1 + w2 * x + bb; *(f32x4*)(o0 + fg) = t1; *(f32x4*)(o1 + fg) = x;
                      u32x2 w; w.x = cvt_pk_bf16(siluf_(cgv[0]) * cvv[0], siluf_(cgv[1]) * cvv[1]); w.y = cvt_pk_bf16(siluf_(cgv[2]) * cvv[2], siluf_(cgv[3]) * cvv[3]);
                      *(u32x2*)(G + (size_t)(SEQ + b) * FF + fg) = w; }
                    asm volatile("" ::: "memory"); __builtin_amdgcn_sched_barrier(0);
                }
            }
        }
    }
};

__device__ __forceinline__ void transpose_item(const float* W, int K, int N, bf16_t* WT, int k0, int n0, int drow0, float* scr, int lane) {
    float tv[32];
#pragma unroll
    for (int i = 0; i < 32; ++i) tv[i] = __builtin_nontemporal_load(W + (size_t)(k0 + 2 * i + (lane >> 5)) * N + n0 + (lane & 31));
#pragma unroll
    for (int i = 0; i < 32; ++i) scr[(2 * i + (lane >> 5)) * 33 + (lane & 31)] = tv[i];
    asm volatile("s_waitcnt lgkmcnt(0)" ::: "memory");
    const int c = lane & 7;
#pragma unroll
    for (int j = 0; j < 4; ++j) { const int n = (lane >> 3) + 8 * j; const float* s = scr + (8 * c) * 33 + n;
        u32x4 o; o.x = cvt_pk_bf16(s[0 * 33], s[1 * 33]); o.y = cvt_pk_bf16(s[2 * 33], s[3 * 33]); o.z = cvt_pk_bf16(s[4 * 33], s[5 * 33]); o.w = cvt_pk_bf16(s[6 * 33], s[7 * 33]);
        *(u32x4*)(WT + (size_t)(drow0 + n) * K + k0 + 8 * c) = o; }
    asm volatile("s_waitcnt lgkmcnt(0)" ::: "memory");
}
__device__ __forceinline__ int win_drow(int n) {
    if (n < 1024) return 256 * (n >> 7) + (n & 127);
    if (n < 2048) return 2048 + (n - 1024);
    if (n < 3072) { const int f = n - 2048; return 256 * (f >> 7) + 128 + (f & 127); }
    return n;
}
__device__ __forceinline__ int wup_drow(int n) { const int f = (n < FF) ? n : n - FF; return 256 * (f >> 7) + ((n < FF) ? 0 : 128) + (f & 127); }

__device__ __forceinline__ void modnorm_row(const float* xrow, const float* g, const float* sc, const float* sh, bf16_t* orow, int lane) {
    f32x4 v[4]; float s = 0.f;
#pragma unroll
    for (int j = 0; j < 4; ++j) { v[j] = ((const f32x4*)xrow)[lane + 64 * j]; s += (v[j][0] * v[j][0] + v[j][1] * v[j][1]) + (v[j][2] * v[j][2] + v[j][3] * v[j][3]); }
    const float rstd = rsqrtf(wave_sum(s) * (1.0f / 1024.0f) + EPS);
#pragma unroll
    for (int j = 0; j < 4; ++j) { const int col = 4 * (lane + 64 * j);
        const f32x4 gg = *(const f32x4*)(g + col), ss = *(const f32x4*)(sc + col), hh = *(const f32x4*)(sh + col);
        const f32x4 o = v[j] * rstd * gg * (ss + 1.0f) + hh;
        u32x2 w; w.x = cvt_pk_bf16(o[0], o[1]); w.y = cvt_pk_bf16(o[2], o[3]); *(u32x2*)(orow + col) = w; }
}


template <int MODE>
__device__ __forceinline__ void norm_phase(const float* xp, const float* xs, const float* gvec, const float* ada, int scoff, int shoff, bf16_t* ob, float* of, int gw, int NGW, int lane, const bf16_t* dadd = nullptr) {
    f32x4 gmP[4], shP[4];
#pragma unroll
    for (int j = 0; j < 4; ++j) { const int col = 4 * (lane + 64 * j); const f32x4 g = *(const f32x4*)(gvec + col);
        if (MODE == 2) { gmP[j] = g; shP[j] = (f32x4){0.f, 0.f, 0.f, 0.f}; }
        else { const float* ad = ada + (size_t)128 * NADA; gmP[j] = g * (*(const f32x4*)(ad + scoff + col) + 1.0f); shP[j] = *(const f32x4*)(ad + shoff + col); } }
#pragma unroll 1
    for (int base = gw; base < MROWS; base += 4 * NGW) {
        f32x4 v[4][4];
#pragma unroll
        for (int r = 0; r < 4; ++r) { const int row = base + r * NGW;
            if (row < MROWS) { const float* xr = (MODE == 0) ? ((row < SEQ) ? xp + (size_t)row * 1024 : xs + (size_t)(row - SEQ) * 1024) : xp + (size_t)row * 1024;
#pragma unroll
                for (int j = 0; j < 4; ++j) v[r][j] = ((const f32x4*)xr)[lane + 64 * j];
                if (MODE == 2) {
#pragma unroll
                    for (int j = 0; j < 4; ++j) { const u32x2 w = *(const u32x2*)(dadd + (size_t)row * 1024 + 4 * (lane + 64 * j));
                        v[r][j] += (f32x4){bf2f(w.x & 0xffffu), bf2f(w.x >> 16), bf2f(w.y & 0xffffu), bf2f(w.y >> 16)}; } } } }
#pragma unroll
        for (int r = 0; r < 4; ++r) { const int row = base + r * NGW;
            if (row < MROWS) {
                float s = 0.f;
#pragma unroll
                for (int j = 0; j < 4; ++j) s += (v[r][j][0] * v[r][j][0] + v[r][j][1] * v[r][j][1]) + (v[r][j][2] * v[r][j][2] + v[r][j][3] * v[r][j][3]);
                const float rstd = rsqrtf(wave_sum(s) * (1.0f / 1024.0f) + EPS);
#pragma unroll
                for (int j = 0; j < 4; ++j) { const int col = 4 * (lane + 64 * j);
                    f32x4 gm = gmP[j], sh = shP[j];
                    if (MODE != 2 && row >= SEQ) { const float* ad = ada + (size_t)(row - SEQ) * NADA; gm = *(const f32x4*)(gvec + col) * (*(const f32x4*)(ad + scoff + col) + 1.0f); sh = *(const f32x4*)(ad + shoff + col); }
                    const f32x4 o = v[r][j] * rstd * gm + sh;
                    if (MODE == 2) __builtin_nontemporal_store(o, (f32x4*)(of + (size_t)row * 1024 + col));
                    else { u32x2 w; w.x = cvt_pk_bf16(o[0], o[1]); w.y = cvt_pk_bf16(o[2], o[3]); *(u32x2*)(ob + (size_t)row * 1024 + col) = w; } }
            } }
    }
}
__device__ __forceinline__ void attn_prompt_unit(unsigned char* lds, bf16_t* Q, const bf16_t* KB, const bf16_t* VB, const float* sinks, int j, int g, int tid) {
    bf16_t* Ks = (bf16_t*)lds;
    bf16_t* Vt = (bf16_t*)(lds + 36864);
    bf16x8 qpre[2][4];
    {   const int wave_ = tid >> 6, ql_ = tid & 31, hi_ = (tid >> 5) & 1;
#pragma unroll
        for (int tt = 0; tt < 2; ++tt) { const int t = wave_ * 2 + tt, hq = t >> 2, qg = t & 3; const bf16_t* qp = Q + (size_t)(128 * j + 32 * qg + ql_) * 1024 + (4 * g + hq) * 64;
#pragma unroll
            for (int d0 = 0; d0 < 4; ++d0) qpre[tt][d0] = *(const bf16x8*)(qp + 16 * d0 + 8 * hi_); } }
    for (int c = tid; c < 2048; c += 512) {
        const int s = c >> 3, ch = c & 7; const int tok = 128 * (j - 1) + s;
        u32x4 kv = (u32x4){0u, 0u, 0u, 0u}, vv = (u32x4){0u, 0u, 0u, 0u};
        if (tok >= 0) { kv = *(const u32x4*)(KB + (size_t)tok * 256 + 64 * g + 8 * ch); vv = *(const u32x4*)(VB + (size_t)tok * 256 + 64 * g + 8 * ch); }
        *(u32x4*)(Ks + s * 72 + 8 * ch) = kv;
        bf16_t* vd = Vt + (8 * ch) * 264 + s;
        vd[0 * 264] = (bf16_t)(vv.x & 0xffffu); vd[1 * 264] = (bf16_t)(vv.x >> 16); vd[2 * 264] = (bf16_t)(vv.y & 0xffffu); vd[3 * 264] = (bf16_t)(vv.y >> 16);
        vd[4 * 264] = (bf16_t)(vv.z & 0xffffu); vd[5 * 264] = (bf16_t)(vv.z >> 16); vd[6 * 264] = (bf16_t)(vv.w & 0xffffu); vd[7 * 264] = (bf16_t)(vv.w >> 16);
    }
    __syncthreads();
    const int wave = tid >> 6, lane = tid & 63, ql = lane & 31, hi = lane >> 5;
#pragma unroll
    for (int tt = 0; tt < 2; ++tt) {
        const int t = wave * 2 + tt, hq = t >> 2, qg = t & 3, head = 4 * g + hq;
        bf16_t* qp = Q + (size_t)(128 * j + 32 * qg + ql) * 1024 + head * 64;
        bf16x8 qf[4];
#pragma unroll
        for (int d0 = 0; d0 < 4; ++d0) qf[d0] = qpre[tt][d0];
        f32x16 p[5];
#pragma unroll
        for (int kt = 0; kt < 5; ++kt) {
#pragma unroll
            for (int r = 0; r < 16; ++r) p[kt][r] = 0.f;
#pragma unroll
            for (int d0 = 0; d0 < 4; ++d0) { const bf16x8 kf = *(const bf16x8*)(Ks + (32 * qg + 32 * kt + ql) * 72 + 16 * d0 + 8 * hi);
                p[kt] = __builtin_amdgcn_mfma_f32_32x32x16_bf16(kf, qf[d0], p[kt], 0, 0, 0); }
        }
        const float sink = sinks[head];
        float mx = -INFINITY;
#pragma unroll
        for (int kt = 0; kt < 5; ++kt)
#pragma unroll
            for (int r = 0; r < 16; ++r) { const int kk = (r & 3) + 8 * (r >> 2) + 4 * hi; bool valid = true;
                if (kt == 0) valid = kk >= ql; if (kt == 4) valid = kk <= ql; if (j == 0) valid = valid && (32 * qg + 32 * kt + kk >= 128);
                const float v = valid ? p[kt][r] * 0.125f : -INFINITY; p[kt][r] = v; mx = fmaxf(mx, v); }
        mx = fmaxf(mx, __shfl_xor(mx, 32)); mx = fmaxf(mx, sink);
        float l = 0.f;
#pragma unroll
        for (int kt = 0; kt < 5; ++kt)
#pragma unroll
            for (int r = 0; r < 16; ++r) { const float e = __expf(p[kt][r] - mx); p[kt][r] = e; l += e; }
        l += __shfl_xor(l, 32);
        const float inv = 1.0f / (l + __expf(sink - mx));
        f32x16 o0, o1;
#pragma unroll
        for (int r = 0; r < 16; ++r) { o0[r] = 0.f; o1[r] = 0.f; }
#pragma unroll
        for (int kt = 0; kt < 5; ++kt)
#pragma unroll
            for (int hf = 0; hf < 2; ++hf) {
                u32x4 pw; pw.x = cvt_pk_bf16(p[kt][8 * hf + 0], p[kt][8 * hf + 1]); pw.y = cvt_pk_bf16(p[kt][8 * hf + 2], p[kt][8 * hf + 3]);
                pw.z = cvt_pk_bf16(p[kt][8 * hf + 4], p[kt][8 * hf + 5]); pw.w = cvt_pk_bf16(p[kt][8 * hf + 6], p[kt][8 * hf + 7]);
                const bf16x8 pf = __builtin_bit_cast(bf16x8, pw);
                const int sk = 32 * qg + 32 * kt + 16 * hf + 4 * hi;
                { const bf16_t* vp = Vt + ql * 264 + sk; const u32x2 a = *(const u32x2*)vp, b = *(const u32x2*)(vp + 8);
                  const bf16x8 vf = __builtin_bit_cast(bf16x8, ((u32x4){a.x, a.y, b.x, b.y})); o0 = __builtin_amdgcn_mfma_f32_32x32x16_bf16(vf, pf, o0, 0, 0, 0); }
                { const bf16_t* vp = Vt + (32 + ql) * 264 + sk; const u32x2 a = *(const u32x2*)vp, b = *(const u32x2*)(vp + 8);
                  const bf16x8 vf = __builtin_bit_cast(bf16x8, ((u32x4){a.x, a.y, b.x, b.y})); o1 = __builtin_amdgcn_mfma_f32_32x32x16_bf16(vf, pf, o1, 0, 0, 0); }
            }
#pragma unroll
        for (int c4 = 0; c4 < 4; ++c4) {
            u32x2 w0, w1;
            w0.x = cvt_pk_bf16(o0[4 * c4 + 0] * inv, o0[4 * c4 + 1] * inv); w0.y = cvt_pk_bf16(o0[4 * c4 + 2] * inv, o0[4 * c4 + 3] * inv);
            w1.x = cvt_pk_bf16(o1[4 * c4 + 0] * inv, o1[4 * c4 + 1] * inv); w1.y = cvt_pk_bf16(o1[4 * c4 + 2] * inv, o1[4 * c4 + 3] * inv);
            *(u32x2*)(qp + 8 * c4 + 4 * hi) = w0; *(u32x2*)(qp + 32 + 8 * c4 + 4 * hi) = w1;
        }
    }
    __syncthreads();
}
__device__ __forceinline__ void attn_sample_task(float* wl, bf16_t* Q, const bf16_t* KB, const bf16_t* VB, const float* ck, const float* cv, const float* sinks, int b, int g, int lane) {
    float* qs = wl; float* pp = wl + 256;
    bf16_t* qrow = Q + (size_t)(SEQ + b) * 1024 + 4 * g * 64;
#pragma unroll
    for (int h = 0; h < 4; ++h) qs[h * 64 + lane] = bf2f(qrow[h * 64 + lane]) * 0.125f;
    const float knew = bf2f(KB[(size_t)(SEQ + b) * 256 + 64 * g + lane]), vnew = bf2f(VB[(size_t)(SEQ + b) * 256 + 64 * g + lane]);
    asm volatile("s_waitcnt lgkmcnt(0)" ::: "memory");
    float sc[2][4];
#pragma unroll
    for (int kk = 0; kk < 2; ++kk) { const int s = lane + 64 * kk; const f32x4* kp = (const f32x4*)(ck + ((size_t)(b * 128 + s) * 4 + g) * 64);
        float a0 = 0.f, a1 = 0.f, a2 = 0.f, a3 = 0.f;
#pragma unroll 4
        for (int c = 0; c < 16; ++c) { const f32x4 kv = kp[c];
            const f32x4 q0 = *(const f32x4*)(qs + 4 * c), q1 = *(const f32x4*)(qs + 64 + 4 * c), q2 = *(const f32x4*)(qs + 128 + 4 * c), q3 = *(const f32x4*)(qs + 192 + 4 * c);
            a0 += kv[0] * q0[0] + kv[1] * q0[1] + kv[2] * q0[2] + kv[3] * q0[3]; a1 += kv[0] * q1[0] + kv[1] * q1[1] + kv[2] * q1[2] + kv[3] * q1[3];
            a2 += kv[0] * q2[0] + kv[1] * q2[1] + kv[2] * q2[2] + kv[3] * q2[3]; a3 += kv[0] * q3[0] + kv[1] * q3[1] + kv[2] * q3[2] + kv[3] * q3[3]; }
        sc[kk][0] = a0; sc[kk][1] = a1; sc[kk][2] = a2; sc[kk][3] = a3; }
#pragma unroll
    for (int h = 0; h < 4; ++h) {
        const float sn = wave_sum(qs[h * 64 + lane] * knew), sink = sinks[4 * g + h];
        float m = wave_max(fmaxf(sc[0][h], sc[1][h])); m = fmaxf(fmaxf(m, sn), sink);
        const float e0 = __expf(sc[0][h] - m), e1 = __expf(sc[1][h] - m), en = __expf(sn - m);
        const float inv = 1.0f / (wave_sum(e0 + e1) + en + __expf(sink - m));
        pp[lane * 4 + h] = e0 * inv; pp[(64 + lane) * 4 + h] = e1 * inv; if (lane == 0) pp[512 + h] = en * inv;
    }
    asm volatile("s_waitcnt lgkmcnt(0)" ::: "memory");
    float o0 = 0.f, o1 = 0.f, o2 = 0.f, o3 = 0.f;
    const float* vp = cv + ((size_t)(b * 128) * 4 + g) * 64 + lane;
#pragma unroll 8
    for (int s = 0; s < 128; ++s) { const float v = vp[(size_t)s * 256]; const f32x4 pv = *(const f32x4*)(pp + 4 * s); o0 += pv[0] * v; o1 += pv[1] * v; o2 += pv[2] * v; o3 += pv[3] * v; }
    { const f32x4 pv = *(const f32x4*)(pp + 512); o0 += pv[0] * vnew; o1 += pv[1] * vnew; o2 += pv[2] * vnew; o3 += pv[3] * vnew; }
    qrow[lane] = (bf16_t)(cvt_pk_bf16(o0, 0.f) & 0xffffu); qrow[64 + lane] = (bf16_t)(cvt_pk_bf16(o1, 0.f) & 0xffffu);
    qrow[128 + lane] = (bf16_t)(cvt_pk_bf16(o2, 0.f) & 0xffffu); qrow[192 + lane] = (bf16_t)(cvt_pk_bf16(o3, 0.f) & 0xffffu);
    asm volatile("s_waitcnt lgkmcnt(0)" ::: "memory");
}


#if SELFCHECK
constexpr size_t WS_CHK = 512 * 1024;
__device__ __forceinline__ unsigned hsh(unsigned x) { x ^= x >> 16; x *= 0x7feb352du; x ^= x >> 15; x *= 0x846ca68bu; x ^= x >> 16; return x; }
__device__ __forceinline__ int samp_row(int s) {
    if ((s & 3) == 0) { switch ((s >> 2) & 7) { case 0: return 0; case 1: return 1; case 2: return 255; case 3: return 256; case 4: return SEQ - 1; case 5: return SEQ; case 6: return SEQ + 100; default: return 8191; } }
    if ((s & 3) == 1) return SEQ + (int)(hsh(s) % NS);
    return (int)(hsh(s * 3 + 1) % SEQ);
}
__device__ __forceinline__ bool chk_bad(float got, float ref) { return !(fabsf(got - ref) <= 0.05f * fabsf(ref) + 0.04f); }
__device__ __forceinline__ float wdot_bf(const bf16_t* a, const float* W, int ldw, int col, int K, int lane) {
    float s = 0.f; for (int k = lane; k < K; k += 64) s += bf2f(a[k]) * W[(size_t)k * ldw + col]; return wave_sum(s); }
#define CHK_FAIL(bit) do { if (lane == 0) atomicOr(mask, 1u << (bit)); } while (0)
#endif

template <int KLEN>
__device__ __forceinline__ f32x4 mini_kloop(const bf16_t* Arow, const bf16_t* Brow, f32x4 acc) {
    constexpr int NS_ = KLEN / 32;
    static_assert(KLEN % 32 == 0, "K quarter");
#pragma unroll 1
    for (int s0 = 0; s0 < NS_; s0 += 8) {
        bf16x8 a[8], b[8];
#pragma unroll
        for (int i = 0; i < 8; ++i) if (s0 + i < NS_) { a[i] = *(const bf16x8*)(Arow + (s0 + i) * 32); b[i] = *(const bf16x8*)(Brow + (s0 + i) * 32); }
#pragma unroll
        for (int i = 0; i < 8; ++i) if (s0 + i < NS_) acc = __builtin_amdgcn_mfma_f32_16x16x32_bf16(b[i], a[i], acc, 0, 0, 0);
    }
    return acc;
}
struct MiniArgs { const bf16_t* A0; const bf16_t* B0; const bf16_t* A1; const bf16_t* B1; const bf16_t* GA; const bf16_t* GB; bf16_t* Z; const float* base; float* out; const float* ADA; int goff; };
template <int MODE, int K>
__device__ __forceinline__ void mini_sample_gemm(unsigned char* lds, const MiniArgs& P, int bid, int G, int wave, int lane) {
    const int fr = lane & 15, fq = lane >> 4, tl = wave >> 2, kq = wave & 3;
    f32x4* red = (f32x4*)lds;
    for (int T0 = 2 * bid; T0 < 512; T0 += 2 * G) {
        const int T = T0 + tl, rt = T & 7, ct = T >> 3;
        const int row = SEQ + 16 * rt + fr, colb = 16 * ct + fr;
        const size_t ko = (size_t)kq * (K / 4) + 8 * fq;
        f32x4 acc0 = (f32x4){0.f, 0.f, 0.f, 0.f}, acc1 = acc0;
        acc0 = mini_kloop<K / 4>(P.A0 + (size_t)row * K + ko, P.B0 + (size_t)colb * K + ko, acc0);
        if (MODE == 0) acc1 = mini_kloop<K / 4>(P.A1 + (size_t)row * K + ko, P.B1 + (size_t)colb * K + ko, acc1);
        red[wave * 64 + lane] = acc0; if (MODE == 0) red[512 + wave * 64 + lane] = acc1;
        __syncthreads();
        if (kq == 0) {
            f32x4 s0 = red[wave * 64 + lane] + red[(wave + 1) * 64 + lane] + red[(wave + 2) * 64 + lane] + red[(wave + 3) * 64 + lane];
            const int col = 16 * ct + 4 * fq;
            if (MODE == 0) {
                const f32x4 s1 = red[512 + wave * 64 + lane] + red[512 + (wave + 1) * 64 + lane] + red[512 + (wave + 2) * 64 + lane] + red[512 + (wave + 3) * 64 + lane];
                const u32x2 ga = *(const u32x2*)(P.GA + (size_t)row * 1024 + col), gb = *(const u32x2*)(P.GB + (size_t)row * 1024 + col);
                const float z0 = sigmoidf_(bf2f(ga.x & 0xffffu)) * s0[0] + sigmoidf_(bf2f(gb.x & 0xffffu)) * s1[0], z1 = sigmoidf_(bf2f(ga.x >> 16)) * s0[1] + sigmoidf_(bf2f(gb.x >> 16)) * s1[1];
                const float z2 = sigmoidf_(bf2f(ga.y & 0xffffu)) * s0[2] + sigmoidf_(bf2f(gb.y & 0xffffu)) * s1[2], z3 = sigmoidf_(bf2f(ga.y >> 16)) * s0[3] + sigmoidf_(bf2f(gb.y >> 16)) * s1[3];
                u32x2 w; w.x = cvt_pk_bf16(z0, z1); w.y = cvt_pk_bf16(z2, z3); *(u32x2*)(P.Z + (size_t)row * 1024 + col) = w;
            } else if (MODE == 2) {
                const int b = row - SEQ; const f32x4 g = *(const f32x4*)(P.ADA + (size_t)b * NADA + P.goff + col); const f32x4 d = g * s0;
                u32x2 w; w.x = cvt_pk_bf16(d[0], d[1]); w.y = cvt_pk_bf16(d[2], d[3]); *(u32x2*)(P.Z + (size_t)row * 1024 + col) = w;
            } else {
                const int b = row - SEQ;
                const f32x4 bs = *(const f32x4*)(P.base + (size_t)b * 1024 + col), g = *(const f32x4*)(P.ADA + (size_t)b * NADA + P.goff + col);
                *(f32x4*)(P.out + (size_t)row * 1024 + col) = bs + g * s0;
            }
        }
        __syncthreads();
    }
}

__device__ __forceinline__ void ada_block(unsigned char* lds, const float* cs, const float* cp, const float* W, const float* bias, float* ADAo, int pair, int wave, int lane) {
    const int fr = lane & 15, fq = lane >> 4, tl = wave >> 2, kq = wave & 3, c0 = 16 * (2 * pair + tl);
    f32x4 acc[9];
#pragma unroll
    for (int rt = 0; rt < 9; ++rt) acc[rt] = (f32x4){0.f, 0.f, 0.f, 0.f};
#pragma unroll 1
    for (int ks = 0; ks < 8; ++ks) {
        const int k0 = 256 * kq + 32 * ks + 8 * fq;
        float wv[8];
#pragma unroll
        for (int j = 0; j < 8; ++j) wv[j] = __builtin_nontemporal_load(W + (size_t)(k0 + j) * NADA + c0 + fr);
        f32x4 a0[9], a1[9];
#pragma unroll
        for (int rt = 0; rt < 9; ++rt) { const int row = 16 * rt + fr; const float* cr = (row < 128) ? cs + (size_t)row * 1024 : cp;
            a0[rt] = *(const f32x4*)(cr + k0); a1[rt] = *(const f32x4*)(cr + k0 + 4); }
        u32x4 bw; bw.x = cvt_pk_bf16(wv[0], wv[1]); bw.y = cvt_pk_bf16(wv[2], wv[3]); bw.z = cvt_pk_bf16(wv[4], wv[5]); bw.w = cvt_pk_bf16(wv[6], wv[7]);
        const bf16x8 bfrag = __builtin_bit_cast(bf16x8, bw);
#pragma unroll
        for (int rt = 0; rt < 9; ++rt) { const bool ok = (16 * rt + fr) <= 128;
            u32x4 aw; aw.x = cvt_pk_bf16(siluf_(a0[rt][0]), siluf_(a0[rt][1])); aw.y = cvt_pk_bf16(siluf_(a0[rt][2]), siluf_(a0[rt][3]));
            aw.z = cvt_pk_bf16(siluf_(a1[rt][0]), siluf_(a1[rt][1])); aw.w = cvt_pk_bf16(siluf_(a1[rt][2]), siluf_(a1[rt][3]));
            if (!ok) aw = (u32x4){0u, 0u, 0u, 0u};
            acc[rt] = __builtin_amdgcn_mfma_f32_16x16x32_bf16(bfrag, __builtin_bit_cast(bf16x8, aw), acc[rt], 0, 0, 0); }
    }
    f32x4* red = (f32x4*)lds;
#pragma unroll
    for (int rt = 0; rt < 9; ++rt) red[(wave * 9 + rt) * 64 + lane] = acc[rt];
    __syncthreads();
    if (kq == 0) {
        const f32x4 bv = *(const f32x4*)(bias + c0 + 4 * fq);
#pragma unroll
        for (int rt = 0; rt < 9; ++rt) { const int row = 16 * rt + fr;
            const f32x4 sum = red[(wave * 9 + rt) * 64 + lane] + red[((wave + 1) * 9 + rt) * 64 + lane] + red[((wave + 2) * 9 + rt) * 64 + lane] + red[((wave + 3) * 9 + rt) * 64 + lane];
            if (row <= 128) *(f32x4*)(ADAo + (size_t)row * NADA + c0 + 4 * fq) = sum + bv; }
    }
    __syncthreads();
}

#define LAS __attribute__((address_space(3)))
#define XB_TMO      128
#define XB_XCNT(j)  (256  + 64 * (j))
#define XB_XSUB(j)  (1280 + 64 * (j))
#define XB_XGEN(j)  (2304 + 64 * (j))
#define XB_TOP      3328
#define XB_TOPGEN   3392
#define XCD_BAR_WORDS 3456
#define XB_SPIN_CAP (1u << 22)
constexpr size_t WS_BAR = 64 * 1024;
constexpr int MISC_OFF = 146432;
constexpr size_t WS_SS = 768 * 1024;
constexpr size_t WS_C0 = WS_BAR + 16384;
constexpr size_t BAR_ZERO_BYTES = (WS_C0 - WS_BAR) + 22528;
__device__ __forceinline__ unsigned xb_ld(unsigned* p)              { return __hip_atomic_load(p, __ATOMIC_RELAXED, __HIP_MEMORY_SCOPE_AGENT); }
__device__ __forceinline__ unsigned xb_add(unsigned* p, unsigned v) { return __hip_atomic_fetch_add(p, v, __ATOMIC_RELAXED, __HIP_MEMORY_SCOPE_AGENT); }
__device__ __forceinline__ unsigned xb_xcc_id() { return (unsigned)__builtin_amdgcn_s_getreg((3 << 11) | 20) & 0xFu; }
#define XB_SPIN(cond, bar) do { unsigned _sp = 0; while (cond) { __builtin_amdgcn_s_sleep(1); \
    if ((++_sp & 255u) == 0u) { if (xb_ld(&(bar)[XB_TMO])) break; if (_sp > XB_SPIN_CAP) { atomicAdd(&(bar)[XB_TMO], 1u); break; } } } } while (0)
struct XcdBarrier { unsigned* bar; unsigned x; volatile LAS unsigned* st; };
__device__ __forceinline__ XcdBarrier xcd_barrier_post(unsigned* bar, volatile LAS unsigned* st, bool leader) {
    XcdBarrier b; b.bar = bar; b.x = xb_xcc_id(); b.st = st;
    if (leader) (void)xb_add(&bar[XB_XCNT(b.x)], 1u);
    return b;
}
__device__ __forceinline__ void xcd_barrier_complete(unsigned* bar, unsigned x, unsigned& nloc, unsigned& nx) {
    const unsigned G = gridDim.x * gridDim.y * gridDim.z;
    unsigned sum, cnt, mine, sp = 0u;
    for (;;) {
        sum = 0u; cnt = 0u; mine = 0u;
#pragma unroll
        for (unsigned j = 0; j < 16; ++j) { const unsigned c = xb_ld(&bar[XB_XCNT(j)]); sum += c; cnt += (c > 0u) ? 1u : 0u; mine = (j == x) ? c : mine; }
        if (sum == G) break;
        __builtin_amdgcn_s_sleep(1);
        if ((++sp & 255u) == 0u) { if (xb_ld(&bar[XB_TMO])) break; if (sp > XB_SPIN_CAP) { atomicAdd(&bar[XB_TMO], 1u); break; } }
    }
    nloc = mine > 0u ? mine : 1u; nx = cnt > 0u ? cnt : 1u;
}
__device__ __forceinline__ void xcd_barrier_core(const XcdBarrier& b, bool leader) {
    if (leader) {
        unsigned* bar = b.bar;
        __builtin_amdgcn_s_waitcnt(0);
        unsigned nloc = b.st[0], nx = b.st[1];
        if (nloc == 0u) { xcd_barrier_complete(bar, b.x, nloc, nx); b.st[0] = nloc; b.st[1] = nx; }
        const unsigned old = xb_add(&bar[XB_XSUB(b.x)], 1u);
        const unsigned gen = old / nloc;
        if (old + 1u == (gen + 1u) * nloc) {
            __builtin_amdgcn_fence(__ATOMIC_RELEASE, "agent");
            asm volatile("s_waitcnt vmcnt(0)" ::: "memory");
            const unsigned og = xb_add(&bar[XB_TOP], 1u);
            const unsigned tg = og / nx;
            if (og + 1u == (tg + 1u) * nx) xb_add(&bar[XB_TOPGEN], 1u);
            else XB_SPIN(xb_ld(&bar[XB_TOPGEN]) == tg, bar);
            __builtin_amdgcn_fence(__ATOMIC_ACQUIRE, "agent");
            xb_add(&bar[XB_XGEN(b.x)], 1u);
            asm volatile("s_waitcnt vmcnt(0)" ::: "memory");
        } else {
            XB_SPIN(xb_ld(&bar[XB_XGEN(b.x)]) == gen, bar);
            __builtin_amdgcn_fence(__ATOMIC_ACQUIRE, "agent");
            asm volatile("s_waitcnt vmcnt(0)" ::: "memory");
        }
    }
}
struct Args { const float* in[23]; float* out; unsigned char* ws; };
enum { I_XP = 0, I_XS, I_CP, I_CS, I_SCA, I_CK, I_CV, I_SFF, I_WADA, I_BADA, I_GMIX, I_WIN, I_CAW, I_SINK, I_WAO, I_WBO, I_WO, I_GFFN, I_WUP, I_FCW, I_FCB, I_WDN, I_GFIN };

typedef const __attribute__((address_space(4))) Args* KArgsP;
__device__ __forceinline__ void shadow_work(KArgsP ap, unsigned nb, int w7, int bid, int G, int lane, unsigned char* lds) {
    const int sw = bid * 7 + w7, NSW = G * 7;
    float* scr = (float*)(lds + (w7 + 1) * 16384);
    unsigned char* ws = ap->ws;
    if (nb == 1u) {
        for (int it = sw; it < 16 * (NIN / 32); it += NSW) { const int nbk = NIN / 32, kb = it / nbk, n0 = 32 * (it % nbk);
            transpose_item(ap->in[I_WIN], 1024, NIN, (bf16_t*)(ws + WS_WIN), 64 * kb, n0, win_drow(n0), scr, lane); }
    } else if (nb == 2u || nb == 3u) {
        constexpr int I_UPS = 16 * (FF2 / 32), SPLIT_ = 1024;
        if (nb == 2u) for (int r = sw; r < 3 * 512; r += NSW) { const int which = r / 512, q = r % 512, kb = q / 32, n0 = 32 * (q % 32);
            transpose_item(ap->in[which == 0 ? I_WAO : (which == 1 ? I_WBO : I_WO)], 1024, 1024, (bf16_t*)(ws + (which == 0 ? WS_WA : (which == 1 ? WS_WB : WS_WO))), 64 * kb, n0, n0, scr, lane); }
        for (int it = (nb == 2u ? 0 : SPLIT_) + sw; it < (nb == 2u ? SPLIT_ : I_UPS); it += NSW) { const int nbk = FF2 / 32, kb = it / nbk, n0 = 32 * (it % nbk);
            transpose_item(ap->in[I_WUP], 1024, FF2, (bf16_t*)(ws + WS_WUP), 64 * kb, n0, wup_drow(n0), scr, lane); }
        if (nb == 2u)
            for (int t = sw; t < 88 * 16; t += NSW) { const int cgp = t % 88, ks = t / 88, col = 64 * cgp + lane;
                const float* Wp = ap->in[I_WUP] + (size_t)(64 * ks) * FF2 + col; const float* sh = (const float*)(ws + WS_ADA) + (size_t)128 * NADA + 3072 + 64 * ks;
                float a = 0.f;
#pragma unroll 16
                for (int k = 0; k < 64; ++k) a += sh[k] * __builtin_nontemporal_load(Wp + (size_t)k * FF2);
                (void)__hip_atomic_fetch_add((float*)(ws + WS_C0) + col, a, __ATOMIC_RELAXED, __HIP_MEMORY_SCOPE_AGENT); }
    } else if (nb == 4u) {
        for (int it = sw; it < (FF / 64) * 32; it += NSW) { const int kb = it / 32, n0 = 32 * (it % 32); transpose_item(ap->in[I_WDN], FF, 1024, (bf16_t*)(ws + WS_WDN), 64 * kb, n0, n0, scr, lane); }
    }
    if (nb == 4u || nb == 5u) {
        const float* ck_ = ap->in[I_CK]; const float* cv_ = ap->in[I_CV]; const bf16_t* kb_ = (const bf16_t*)(ws + WS_KB); const bf16_t* vb_ = (const bf16_t*)(ws + WS_VB); float* out = ap->out;
        const long st = (long)sw * 64 + lane, NST = (long)NSW * 64; const long lo = (nb == 4u) ? 0 : 1048576, hi = lo + 1048576;
#pragma unroll 4
        for (long i = lo + st; i < hi; i += NST) {
            const int which = (int)(i >> 20); const int r2 = (int)(i & 1048575); const int b = r2 >> 13, r = (r2 >> 6) & 127, c = r2 & 63;
            const float* cache = which ? cv_ : ck_; const bf16_t* nbp = which ? vb_ : kb_;
            f32x4 v;
            if (r < 127) v = __builtin_nontemporal_load((const f32x4*)(cache + ((size_t)(b * 128 + r + 1) * 256 + 4 * c)));
            else { const u32x2 w = *(const u32x2*)(nbp + (size_t)(SEQ + b) * 256 + 4 * c); v = (f32x4){bf2f(w.x & 0xffffu), bf2f(w.x >> 16), bf2f(w.y & 0xffffu), bf2f(w.y >> 16)}; }
            __builtin_nontemporal_store(v, (f32x4*)(out + (which ? O_VS : O_KS) + (size_t)r2 * 4));
        }
        if (nb == 4u) for (long i = st; i < 2L * 128 * 64; i += NST) {
            const int which = (int)(i >> 13); const int r2 = (int)(i & 8191); const int r = r2 >> 6, c = r2 & 63; const bf16_t* nbp = which ? vb_ : kb_;
            const u32x2 w = *(const u32x2*)(nbp + (size_t)(SEQ - 128 + r) * 256 + 4 * c);
            *(f32x4*)(out + (which ? O_VP : O_KP) + (size_t)r2 * 4) = (f32x4){bf2f(w.x & 0xffffu), bf2f(w.x >> 16), bf2f(w.y & 0xffffu), bf2f(w.y >> 16)};
        }
    }
}

__global__ void __launch_bounds__(512, 2) mega(Args a) {
    extern __shared__ __attribute__((aligned(16))) unsigned char lds[];
    PG8_LAS unsigned char* ldsl = (PG8_LAS unsigned char*)lds;
    const int G = gridDim.x, bid = blockIdx.x, NGW = G * 8;
    const int wave0 = __builtin_amdgcn_readfirstlane((int)threadIdx.x >> 6);
    const long NGT = (long)G * 512;
#define PHASE_IDS() int tid = wave0 * 64 + (int)lane_id_now(); asm volatile("" : "+v"(tid)); const int lane = tid & 63, wave = wave0; \
    const int gw = bid * 8 + wave; const long gt = (long)bid * 512 + tid; float* const scr = (float*)(lds + wave * 16384); (void)lane; (void)gw; (void)gt; (void)scr;
    typedef const __attribute__((address_space(4))) Args* KArgs;
    const KArgs ap0 = (KArgs)__builtin_amdgcn_kernarg_segment_ptr();
#define ARGS() ({ KArgs p_ = ap0; asm volatile("" : "+s"(p_)); p_; })
#define IN(i) (ARGS()->in[i])
#define WS(off) (ARGS()->ws + (off))
#define OUT() (ARGS()->out)
#define AADA ((bf16_t*)WS(WS_AADA))
#define ADA ((float*)WS(WS_ADA))
#define WA ((bf16_t*)WS(WS_WA))
#define WB ((bf16_t*)WS(WS_WB))
#define WO ((bf16_t*)WS(WS_WO))
#define WADA ((bf16_t*)WS(WS_WADA))
#define WIN ((bf16_t*)WS(WS_WIN))
#define WUP ((bf16_t*)WS(WS_WUP))
#define WDN ((bf16_t*)WS(WS_WDN))
#define H ((bf16_t*)WS(WS_H))
#define U ((bf16_t*)WS(WS_U))
#define BG ((bf16_t*)WS(WS_BG))
#define Q ((bf16_t*)WS(WS_Q))
#define KB ((bf16_t*)WS(WS_KB))
#define VB ((bf16_t*)WS(WS_VB))
#define GA ((bf16_t*)WS(WS_GA))
#define GB ((bf16_t*)WS(WS_GB))
#define GG ((bf16_t*)WS(WS_G))
#define AIN H
#define Z U
#define H2 BG
    if (gridDim.x == 0x7fffffffu) cg::this_grid().sync();
    if (threadIdx.x < 2) ((volatile LAS unsigned*)(ldsl + MISC_OFF))[threadIdx.x] = 0u;
    __syncthreads();
#define LEADER() (wave0 == 0 && lane_id_now() == 0u)
    const XcdBarrier xbar = xcd_barrier_post((unsigned*)WS(WS_BAR), (volatile LAS unsigned*)(ldsl + MISC_OFF), LEADER());
    unsigned nbar_ = 0u;
#define GRID_SYNC() do { ++nbar_; asm volatile("s_waitcnt vmcnt(0)" ::: "memory"); __syncthreads(); \
        if (wave0 == 0) xcd_barrier_core(xbar, LEADER()); else shadow_work((KArgsP)ap0, nbar_, wave0 - 1, bid, G, (int)lane_id_now(), lds); \
        __syncthreads(); } while (0)

#if TIMESEL >= 0
#define STAMP(k) do { if (bid == 0 && threadIdx.x == 0) ((unsigned long long*)WS(768 * 1024))[k] = __builtin_amdgcn_s_memrealtime(); } while (0)
#else
#define STAMP(k) do {} while (0)
#endif
    STAMP(0);
    {
        PHASE_IDS();
        {   const float* const cs = IN(I_CS); const float* const cp = IN(I_CP); const float* const wad = IN(I_WADA); const float* const bad = IN(I_BADA); float* const ada = ADA;
            for (int pr = bid; pr < NADA / 32; pr += G) ada_block(lds, cs, cp, wad, bad, ada, pr, wave, lane); }
        if (bid >= NADA / 32) {
            const f32x4* xp4 = (const f32x4*)IN(I_XP); const long nidle = (long)(G - NADA / 32) * 512, me = (long)(bid - NADA / 32) * 512 + tid; f32x4 sink = (f32x4){0.f, 0.f, 0.f, 0.f};
            {   const f32x4* wa4 = (const f32x4*)IN(I_WADA);
#pragma unroll 8
                for (long i = me; i < (long)1024 * NADA / 4; i += nidle) sink += wa4[i]; }
#pragma unroll 8
            for (long i = me; i < (long)SEQ * 256; i += nidle) sink += xp4[i];
            asm volatile("" :: "v"(sink)); }
    }
    GRID_SYNC();
    STAMP(1);
    STAMP(2);
    {
        PHASE_IDS();
        norm_phase<0>(IN(I_XP), IN(I_XS), IN(I_GMIX), ADA, 1024, 0, H, nullptr, gw, NGW, lane);
    }
    GRID_SYNC();
    STAMP(3);
    {
        typedef Sched<0, 2048, 2048> SC; SC S; S.to.init(NMT, NIN / 256); S.G = G; S.c = bid; S.A0 = (const char*)H; S.B0 = (const char*)WIN;
        EpiProj E{U, BG, Q, KB, VB, GA, GB};
        pg8::gemm_phase<EpiProj, SC, 1024, 1024, 1024, true, true>(ldsl, wave0, S, E);
    }
    GRID_SYNC();
    STAMP(4);
    {
        PHASE_IDS();
        {   bf16_t* const q_ = Q; const bf16_t* const kb_ = KB; const bf16_t* const vb_ = VB; const float* const sinks = IN(I_SINK);
            for (int un = bid; un < 512; un += G) attn_prompt_unit(lds, q_, kb_, vb_, sinks, un >> 2, un & 3, tid); }
        {   bf16_t* const q_ = Q; const bf16_t* const kb_ = KB; const bf16_t* const vb_ = VB; const float* const sinks = IN(I_SINK);
            const float* const ck_ = IN(I_CK); const float* const cv_ = IN(I_CV);
            float* wl = (float*)(lds + 123392 + (wave >> 2) * 4096);
            for (int t4 = gw; t4 < 2048; t4 += NGW) if ((t4 & 3) == 0) { const int t = t4 >> 2; attn_sample_task(wl, q_, kb_, vb_, ck_, cv_, sinks, t >> 2, t & 3, lane); } }
        const bool worker = (wave & 3) != 0; const long wt = ((long)bid * 6 + (wave - 1 - (wave > 4 ? 1 : 0))) * 64 + lane, NWT = (long)G * 6 * 64;
        {
        float* const out = OUT();
        const float* caw = IN(I_CAW); const float* sca = IN(I_SCA); const bf16_t* const u_ = U; const bf16_t* const bg_ = BG; bf16_t* const ain_ = AIN;
        if (worker)
        for (long it = wt; it < (long)(SEQ / 8) * 128 + (long)NS * 128; it += NWT) {
            const bool smp = it >= (long)(SEQ / 8) * 128; const long it2 = smp ? it - (long)(SEQ / 8) * 128 : it;
            const int row0 = smp ? SEQ + (int)(it2 >> 7) : (int)(it2 >> 7) * 8, c8 = (int)(it2 & 127) * 8; const int nr = smp ? 1 : 8;
            float w0[8], w1[8], w2[8], u0[8], u1[8];
            *(f32x4*)w0 = *(const f32x4*)(caw + c8); *(f32x4*)(w0 + 4) = *(const f32x4*)(caw + c8 + 4);
            *(f32x4*)w1 = *(const f32x4*)(caw + 1024 + c8); *(f32x4*)(w1 + 4) = *(const f32x4*)(caw + 1024 + c8 + 4);
            *(f32x4*)w2 = *(const f32x4*)(caw + 2048 + c8); *(f32x4*)(w2 + 4) = *(const f32x4*)(caw + 2048 + c8 + 4);
            if (row0 < SEQ) {
                if (row0 >= 2) { unpack8(*(const u32x4*)(u_ + (size_t)(row0 - 2) * 1024 + c8), u0); unpack8(*(const u32x4*)(u_ + (size_t)(row0 - 1) * 1024 + c8), u1); }
                else { for (int i = 0; i < 8; ++i) { u0[i] = 0.f; u1[i] = 0.f; } }
#pragma unroll 4
                for (int r = 0; r < 8; ++r) { const int row = row0 + r; float u2[8], bg[8], o[8];
                    unpack8(*(const u32x4*)(u_ + (size_t)row * 1024 + c8), u2); unpack8(*(const u32x4*)(bg_ + (size_t)row * 1024 + c8), bg);
#pragma unroll
                    for (int i = 0; i < 8; ++i) { o[i] = bg[i] * (w0[i] * u0[i] + w1[i] * u1[i] + w2[i] * u2[i]); u0[i] = u1[i]; u1[i] = u2[i]; }
                    *(u32x4*)(ain_ + (size_t)row * 1024 + c8) = pack8(o);
                    if (row >= SEQ - 2) { float* op = out + O_CAP + (size_t)(row - (SEQ - 2)) * 1024 + c8; *(f32x4*)op = (f32x4){u2[0], u2[1], u2[2], u2[3]}; *(f32x4*)(op + 4) = (f32x4){u2[4], u2[5], u2[6], u2[7]}; } }
            } else {
                for (int r = 0; r < nr; ++r) { const int row = row0 + r, b = row - SEQ; float u2[8], bg[8], o[8];
                    const float* s0 = sca + (size_t)(b * 2) * 1024 + c8; const float* s1 = s0 + 1024;
                    *(f32x4*)u0 = *(const f32x4*)s0; *(f32x4*)(u0 + 4) = *(const f32x4*)(s0 + 4); *(f32x4*)u1 = *(const f32x4*)s1; *(f32x4*)(u1 + 4) = *(const f32x4*)(s1 + 4);
                    unpack8(*(const u32x4*)(u_ + (size_t)row * 1024 + c8), u2); unpack8(*(const u32x4*)(bg_ + (size_t)row * 1024 + c8), bg);
#pragma unroll
                    for (int i = 0; i < 8; ++i) o[i] = bg[i] * (w0[i] * u0[i] + w1[i] * u1[i] + w2[i] * u2[i]);
                    *(u32x4*)(ain_ + (size_t)row * 1024 + c8) = pack8(o);
                    float* op = out + O_CAS + (size_t)(b * 2) * 1024 + c8;
                    *(f32x4*)op = *(f32x4*)u1; *(f32x4*)(op + 4) = *(f32x4*)(u1 + 4); *(f32x4*)(op + 1024) = (f32x4){u2[0], u2[1], u2[2], u2[3]}; *(f32x4*)(op + 1024 + 4) = (f32x4){u2[4], u2[5], u2[6], u2[7]}; }
            }
        }
        }
    }
    GRID_SYNC();
    STAMP(5);
    {
        typedef Sched<1, 2048, 2048> SC; SC S; S.to.init(SEQ / 256, 4); S.G = G; S.c = bid; S.A0 = (const char*)AIN; S.B0 = (const char*)WA; S.A1 = (const char*)Q; S.B1 = (const char*)WB;
        EpiMix E{GA, GB, OUT(), Z};
        pg8::gemm_phase<EpiMix, SC, 1024, 1024, 1024, true, true>(ldsl, wave0, S, E);
        { PHASE_IDS(); MiniArgs P{AIN, WA, Q, WB, GA, GB, Z, nullptr, nullptr, nullptr, 0}; mini_sample_gemm<0, 1024>(lds, P, bid, G, wave, lane); }
    }
    GRID_SYNC();
    STAMP(6);
    {
        typedef Sched<0, 2048, 2048> SC; SC S; S.to.init(SEQ / 256, 4); S.G = G; S.c = bid; S.A0 = (const char*)Z; S.B0 = (const char*)WO;
        EpiRes4 E{IN(I_XP), OUT(), ADA, IN(I_GFFN), H2, (float*)WS(WS_SS)};
        pg8::gemm_phase<EpiRes4, SC, 1024, 1024, 1024, true, true>(ldsl, wave0, S, E);
        { PHASE_IDS(); if (gt < 256) *(u32x4*)((unsigned char*)H2 - 4096 + gt * 16) = (u32x4){0u, 0u, 0u, 0u}; }
        { PHASE_IDS(); MiniArgs P{Z, WO, nullptr, nullptr, nullptr, nullptr, nullptr, IN(I_XS), OUT(), ADA, 2048}; mini_sample_gemm<1, 1024>(lds, P, bid, G, wave, lane); }
    }
    GRID_SYNC();
    STAMP(8);
    {
        typedef Sched<2, 2048, 2048> SC; SC S; S.to.init(G >= 64 ? NPT5 : NPT5 + 1, FF2 / 256); S.G = G; S.c = bid; S.A0 = (const char*)H2; S.B0 = (const char*)WUP;
        {
            PHASE_IDS(); bool has = false; Unit u; for (int i = 0; S.next(i, u); ++i) has = has || (u.pm == NPT5);
            if (has) norm_phase<1>(OUT(), nullptr, IN(I_GFFN), ADA, 4096, 3072, H2, nullptr, SEQ + wave, 8, lane);
            asm volatile("s_waitcnt vmcnt(0)" ::: "memory"); __syncthreads(); }
        float* const out = OUT(); EpiFfn E{GG, IN(I_FCW), IN(I_FCB), IN(I_SFF), out + O_FP, out + O_FS, (PG8_LAS float*)(ldsl + HALO_OFF), (const float*)WS(WS_SS), (const float*)WS(WS_C0)};
        pg8::gemm_phase<EpiFfn, SC, 1024, 1024, 1024, true, true>(ldsl, wave0, S, E);
    }
    GRID_SYNC();
    STAMP(9);
    {
        typedef Sched<0, FF * 2, FF * 2> SC; SC S; S.to.init(SEQ / 256, 4); S.G = G; S.c = bid; S.A0 = (const char*)GG; S.B0 = (const char*)WDN;
        { EpiDelta E{Z, ADA, 5120};
        pg8::gemm_phase<EpiDelta, SC, FF, FF, FF, true, true>(ldsl, wave0, S, E); }
        { PHASE_IDS(); MiniArgs P{GG, WDN, nullptr, nullptr, nullptr, nullptr, Z, nullptr, nullptr, ADA, 5120}; mini_sample_gemm<2, FF>(lds, P, bid, G, wave, lane); }
    }
    GRID_SYNC();
    STAMP(10);
    {
        PHASE_IDS();
        float* const out = OUT();
        norm_phase<2>(out, nullptr, IN(I_GFIN), nullptr, 0, 0, nullptr, out, gw, NGW, lane, Z);
    }
#if TIMESEL >= 0
    GRID_SYNC();
    STAMP(11);
    GRID_SYNC();
    STAMP(12);
    GRID_SYNC();
    {   PHASE_IDS(); const volatile unsigned long long* ts = (const volatile unsigned long long*)WS(768 * 1024);
        const float us = (float)(ts[TIMESEL + TIMESPAN] - ts[TIMESEL]) * 0.01f;
        const float sc = 1.006f + us * 1e-5f; float* o = OUT() + O_KS;
        for (long i = gt; i < 128L * 128 * 256; i += NGT) o[i] *= sc; }
#endif
}

extern "C" void kernel_launch(void* const* d_in, const int* in_sizes, int n_in, void* d_out, int out_size, void* d_ws, size_t ws_size, hipStream_t stream) {
    static int grid = 0;
    if (grid == 0) {
        if (n_in != 23 || ws_size < WS_END) { fprintf(stderr, "kernel_launch: unexpected n_in %d / ws %zu\n", n_in, ws_size); grid = -1; return; }
        int dev = 0, cus = 0, per_cu = 0;
        hipGetDevice(&dev); hipDeviceGetAttribute(&cus, hipDeviceAttributeMultiprocessorCount, dev);
        if (hipFuncSetAttribute((const void*)mega, hipFuncAttributeMaxDynamicSharedMemorySize, LDS_BYTES) != hipSuccess) { fprintf(stderr, "kernel_launch: hipFuncSetAttribute failed\n"); }
        hipOccupancyMaxActiveBlocksPerMultiprocessor(&per_cu, (const void*)mega, 512, LDS_BYTES);
        (void)hipGetLastError();
        if (per_cu < 1) per_cu = 1;
        grid = cus * 1;
        if (grid <= 0) grid = 256;
    }
    if (grid < 0) return;
    Args a{};
    for (int i = 0; i < 23; ++i) a.in[i] = (const float*)d_in[i];
    a.out = (float*)d_out; a.ws = (unsigned char*)d_ws;
    (void)hipMemsetAsync((char*)d_ws + WS_BAR, 0, BAR_ZERO_BYTES, stream);
    void* args[] = {&a};
    hipError_t e = hipLaunchCooperativeKernel((const void*)mega, dim3(grid), dim3(512), args, LDS_BYTES, stream);
    if (e != hipSuccess) fprintf(stderr, "cooperative launch failed: %s (grid %d)\n", hipGetErrorString(e), grid);
}
```

```cpp
#ifndef SELFCHECK
#define SELFCHECK 0
#endif
#ifndef TIMESEL
#define TIMESEL -1
#define TIMESPAN 1
#endif
#ifndef TIMESPAN
#define TIMESPAN 1
#endif
#include <hip/hip_runtime.h>
#include <hip/hip_cooperative_groups.h>
#include <cstdio>
#include <cstdint>
namespace cg = cooperative_groups;

constexpr int D = 1024, SEQ = 16384, NS = 128, MROWS = SEQ + NS, MPAD = 16640;
constexpr int NIN = 6656, FF = 2816, FF2 = 5632, NADA = 6144;
constexpr int NMT = MPAD / 256;
constexpr int NPT5 = 65;
constexpr float EPS = 1e-6f;

constexpr size_t MiB = 1u << 20;
constexpr size_t RB = (size_t)MPAD * 1024 * 2;
constexpr size_t KBB = (size_t)MPAD * 256 * 2;
constexpr size_t WS_AADA = 1 * MiB;
constexpr size_t WS_ADA = 2 * MiB;
constexpr size_t WS_WA = 8 * MiB, WS_WB = 10 * MiB, WS_WO = 12 * MiB;
constexpr size_t WS_WADA = 14 * MiB;
constexpr size_t WS_WIN = 26 * MiB;
constexpr size_t WS_WUP = 14 * MiB;
constexpr size_t WS_WDN = 25 * MiB;
constexpr size_t WS_H = 39 * MiB;
constexpr size_t WS_U = 72 * MiB;
constexpr size_t WS_BG = 105 * MiB;
constexpr size_t WS_Q = 138 * MiB;
constexpr size_t WS_KB = WS_Q + RB, WS_VB = WS_KB + KBB, WS_GA = WS_VB + KBB, WS_GB = WS_GA + RB;
constexpr size_t WS_G = WS_Q;
constexpr size_t WS_END = WS_GB + RB;
static_assert(WS_END <= 256 * MiB, "ws map");
static_assert(WS_G + (size_t)MPAD * FF * 2 <= WS_END, "G overlay");
static_assert(WS_WDN + (size_t)1024 * FF * 2 <= WS_H && WS_WUP + (size_t)FF2 * 1024 * 2 <= WS_WDN, "weights");
static_assert(WS_U + RB + 4096 <= WS_BG && WS_H + RB <= WS_U && WS_BG + RB <= WS_Q, "row buffers");

constexpr size_t O_YP = 0, O_YS = 16777216, O_CAP = 16908288, O_CAS = 16910336, O_KP = 17172480, O_KS = 17205248,
                 O_VP = 21399552, O_VS = 21432320, O_FP = 25626624, O_FS = 25637888;

constexpr int LDS_BYTES = 147456;
constexpr int HALO_OFF = 131072;

typedef unsigned short bf16_t;
typedef short bf16x8 __attribute__((ext_vector_type(8)));
typedef float f32x4 __attribute__((ext_vector_type(4)));
typedef float f32x16 __attribute__((ext_vector_type(16)));
typedef float f32x2 __attribute__((ext_vector_type(2)));
typedef unsigned u32x4 __attribute__((ext_vector_type(4)));
typedef unsigned u32x2 __attribute__((ext_vector_type(2)));

__device__ __forceinline__ float bf2f(unsigned b) { return __uint_as_float(b << 16); }
__device__ __forceinline__ unsigned cvt_pk_bf16(float lo, float hi) { unsigned r; asm volatile("v_cvt_pk_bf16_f32 %0, %1, %2" : "=v"(r) : "v"(lo), "v"(hi)); return r; }
__device__ __forceinline__ unsigned lane_id_now() { unsigned l; asm volatile("v_mbcnt_lo_u32_b32 %0, -1, 0\n\tv_mbcnt_hi_u32_b32 %0, -1, %0" : "=v"(l)); return l; }
__device__ __forceinline__ float bperm_f(float v, int byte_addr) { return __int_as_float(__builtin_amdgcn_ds_bpermute(byte_addr, __float_as_int(v))); }
__device__ __forceinline__ float sigmoidf_(float x) { return __builtin_amdgcn_rcpf(1.0f + __expf(-x)); }
__device__ __forceinline__ float siluf_(float x) { return x * __builtin_amdgcn_rcpf(1.0f + __expf(-x)); }
__device__ __forceinline__ float wave_sum(float v) {
#pragma unroll
    for (int o = 1; o < 64; o <<= 1) v += __shfl_xor(v, o);
    return v;
}
__device__ __forceinline__ float wave_max(float v) {
#pragma unroll
    for (int o = 1; o < 64; o <<= 1) v = fmaxf(v, __shfl_xor(v, o));
    return v;
}
__device__ __forceinline__ void unpack8(u32x4 w, float* f) {
    f[0] = bf2f(w.x & 0xffffu); f[1] = bf2f(w.x >> 16); f[2] = bf2f(w.y & 0xffffu); f[3] = bf2f(w.y >> 16);
    f[4] = bf2f(w.z & 0xffffu); f[5] = bf2f(w.z >> 16); f[6] = bf2f(w.w & 0xffffu); f[7] = bf2f(w.w >> 16);
}
__device__ __forceinline__ u32x4 pack8(const float* f) {
    u32x4 w; w.x = cvt_pk_bf16(f[0], f[1]); w.y = cvt_pk_bf16(f[2], f[3]); w.z = cvt_pk_bf16(f[4], f[5]); w.w = cvt_pk_bf16(f[6], f[7]); return w;
}

namespace pg8 {
#define PG8_LAS __attribute__((address_space(3)))
constexpr int BM = 256, BK = 64, HALF = 128, HTB = HALF * BK * 2, STAGE_BYTES = 8 * HTB, NXCD = 8, WGM = 8;
__host__ __device__ __forceinline__ int lds_byte(int r, int c) { const int st = (r >> 4) * 2 + (c >> 5), rr = r & 15, cc = c & 31, ob = rr * 64 + cc * 2; return st * 1024 + (ob ^ (((ob >> 9) & 1) << 5)); }
__host__ __device__ __forceinline__ void stage_rc(int b, int& R, int& C) { const int st = b / 1024, sb = b % 1024, swz = sb ^ (((sb >> 9) & 1) << 5); R = (st >> 1) * 16 + swz / 64; C = (st & 1) * 32 + (swz % 64) / 2; }
__host__ __device__ __forceinline__ int perm32(int rho) { const int n = rho >> 4, i = rho & 15; return 8 * (i >> 2) + 4 * n + (i & 3); }

struct Unit { int pm, pn, aux; const char* a; const char* b; };

struct TileOrder {
    int nM, nN, nwg;
    __device__ __forceinline__ void init(int nM_, int nN_) { nM = nM_; nN = nN_; nwg = nM * nN; }
    __device__ __forceinline__ bool tile(long L, int& pm, int& pn) const {
        if (L >= nwg) return false;
        int wgid = (int)L; { const int q = nwg / NXCD, r = nwg % NXCD, xcd = wgid % NXCD, off = wgid / NXCD; wgid = (xcd < r ? xcd * (q + 1) : r * (q + 1) + (xcd - r) * q) + off; }
        const int nig = WGM * nN, gid = wgid / nig, fm = gid * WGM, gsz = (nM - fm) < WGM ? (nM - fm) : WGM;
        pm = fm + ((wgid % nig) % gsz); pn = (wgid % nig) / gsz; return true;
    }
};

template <class Epi, class Sched, int lda, int ldb, int K, bool ALIGN_EPI, bool SP2>
__device__ __forceinline__ void gemm_phase(PG8_LAS unsigned char* lds, const int wave0, const Sched& S, const Epi& E) {
    int tid_ = wave0 * 64 + (int)lane_id_now(); asm volatile("" : "+v"(tid_));
    const int tid = tid_, wid = __builtin_amdgcn_readfirstlane(tid >> 6), lane = tid & 63, wr = wid >> 2, wc = wid & 3, fr = lane & 15, fq = lane >> 4;
    const int nt = K / BK;
    unsigned voffA[2], voffB[2];
#pragma unroll
    for (int i = 0; i < 2; ++i) { int R, C; stage_rc(tid * 16 + i * 8192, R, C); const int Rb = Epi::PERM ? ((R & ~31) + perm32(R & 31)) : R;
        voffA[i] = (unsigned)(R * lda + C) * 2u; voffB[i] = (unsigned)(Rb * ldb + C) * 2u; }
    const size_t kstep = (size_t)(BK * 2);
    const size_t hstepA = (size_t)HALF * lda * 2, hstepB = (size_t)HALF * ldb * 2;
    const unsigned ldsw = (unsigned)wid * 1024u;
    const int aoff = lds_byte(wr * 64 + fr, fq * 8), boff = lds_byte(wc * 32 + fr, fq * 8);
#define PG8_SA(b, h) (((b) * 2 + (h)) * HTB)
#define PG8_SB(b, h) ((4 + (b) * 2 + (h)) * HTB)
#define PG8_STAGE(bufoff, gbase, voff) do { _Pragma("unroll") for (int _i = 0; _i < 2; ++_i) \
        __builtin_amdgcn_global_load_lds((const unsigned*)((const char*)(gbase) + (voff)[_i]), (PG8_LAS unsigned*)(lds + (bufoff) + ldsw + _i * 8192), 16, 0, 0); } while (0)
#define PG8_LDA(dst, b, h) do { _Pragma("unroll") for (int m = 0; m < 4; ++m) _Pragma("unroll") for (int k = 0; k < 2; ++k) dst[m][k] = *(const PG8_LAS bf16x8*)(lds + PG8_SA(b, h) + aoff + m * 2048 + k * 1024); } while (0)
#define PG8_LDB(dst, b, h) do { _Pragma("unroll") for (int n = 0; n < 2; ++n) _Pragma("unroll") for (int k = 0; k < 2; ++k) dst[n][k] = *(const PG8_LAS bf16x8*)(lds + PG8_SB(b, h) + boff + n * 2048 + k * 1024); } while (0)
#define PG8_MMA(ai, bj, At, Bt) do { __builtin_amdgcn_s_setprio(1); _Pragma("unroll") for (int m = 0; m < 4; ++m) _Pragma("unroll") for (int n = 0; n < 2; ++n) _Pragma("unroll") for (int k = 0; k < 2; ++k) \
        acc[ai][bj][m][n] = __builtin_amdgcn_mfma_f32_16x16x32_bf16(Bt[n][k], At[m][k], acc[ai][bj][m][n], 0, 0, 0); __builtin_amdgcn_s_setprio(0); } while (0)
#define PG8_WAIT_V(n) asm volatile("s_waitcnt vmcnt(" #n ")" ::: "memory")
#define PG8_WAIT_L(n) asm volatile("s_waitcnt lgkmcnt(" #n ")" ::: "memory")
#define PG8_BAR __builtin_amdgcn_s_barrier()
#define PG8_SCHED __builtin_amdgcn_sched_barrier(0)
    Unit cur, nxt; int ui = 0;
    if (!S.next(0, cur)) return;
    f32x4 acc[2][2][4][2];
#pragma unroll
    for (int a = 0; a < 2; ++a)
#pragma unroll
        for (int b = 0; b < 2; ++b)
#pragma unroll
            for (int m = 0; m < 4; ++m)
#pragma unroll
                for (int n = 0; n < 2; ++n) acc[a][b][m][n] = (f32x4){0.f, 0.f, 0.f, 0.f};
    bf16x8 At[4][2], B0[2][2], B1[2][2];
    const char* cA = cur.a; const char* cB = cur.b;
    if constexpr (SP2) {
        PG8_STAGE(PG8_SB(0, 0), cB, voffB); PG8_STAGE(PG8_SB(0, 1), cB + hstepB, voffB); PG8_STAGE(PG8_SA(0, 0), cA, voffA); PG8_STAGE(PG8_SA(0, 1), cA + hstepA, voffA);
        if (wr == 1) PG8_BAR;
        PG8_WAIT_V(2); PG8_BAR;
        PG8_STAGE(PG8_SB(1, 0), cB + kstep, voffB); PG8_STAGE(PG8_SA(1, 0), cA + kstep, voffA); PG8_STAGE(PG8_SB(1, 1), cB + hstepB + kstep, voffB);
        PG8_WAIT_V(6); PG8_BAR;
    } else {
        PG8_STAGE(PG8_SB(0, 0), cB, voffB); PG8_STAGE(PG8_SA(0, 0), cA, voffA); PG8_STAGE(PG8_SB(0, 1), cB + hstepB, voffB); PG8_STAGE(PG8_SA(0, 1), cA + hstepA, voffA);
        if (wr == 1) PG8_BAR;
        PG8_WAIT_V(4); PG8_BAR;
        PG8_STAGE(PG8_SB(1, 0), cB + kstep, voffB); PG8_STAGE(PG8_SA(1, 0), cA + kstep, voffA); PG8_STAGE(PG8_SB(1, 1), cB + hstepB + kstep, voffB);
        PG8_WAIT_V(6); PG8_BAR;
    }
    for (;;) {
        const bool has_next = S.next(ui + 1, nxt);
        const char* nA = has_next ? nxt.a : cA; const char* nB = has_next ? nxt.b : cB;
        for (int t = 0; t < nt; t += 2) {
            const bool last = (t == nt - 2);
            const char* a1 = cA + (size_t)(t + 1) * kstep;
            const char* a2 = last ? nA : cA + (size_t)(t + 2) * kstep; const char* b2 = last ? nB : cB + (size_t)(t + 2) * kstep;
            const char* a3 = a2 + kstep; const char* b3 = b2 + kstep;
            if constexpr (SP2) {
            PG8_LDB(B0, 0, 0); PG8_LDB(B1, 0, 1); PG8_SCHED; PG8_LDA(At, 0, 0); PG8_STAGE(PG8_SA(1, 1), a1 + hstepA, voffA);
            PG8_WAIT_V(8); PG8_WAIT_L(0); PG8_BAR; PG8_MMA(0, 0, At, B0); PG8_MMA(0, 1, At, B1); PG8_BAR; PG8_SCHED;
            PG8_LDA(At, 0, 1); PG8_STAGE(PG8_SB(0, 0), b2, voffB); PG8_STAGE(PG8_SB(0, 1), b2 + hstepB, voffB); PG8_STAGE(PG8_SA(0, 0), a2, voffA);
            PG8_WAIT_V(8); PG8_WAIT_L(0); PG8_BAR; PG8_MMA(1, 0, At, B0); PG8_MMA(1, 1, At, B1); PG8_BAR; PG8_SCHED;
            PG8_LDB(B0, 1, 0); PG8_LDB(B1, 1, 1); PG8_SCHED; PG8_LDA(At, 1, 0); PG8_STAGE(PG8_SA(0, 1), a2 + hstepA, voffA);
            PG8_WAIT_V(8); PG8_WAIT_L(0); PG8_BAR; PG8_MMA(0, 0, At, B0); PG8_MMA(0, 1, At, B1); PG8_BAR; PG8_SCHED;
            PG8_LDA(At, 1, 1); PG8_STAGE(PG8_SB(1, 0), b3, voffB); PG8_STAGE(PG8_SB(1, 1), b3 + hstepB, voffB); PG8_STAGE(PG8_SA(1, 0), a3, voffA);
            PG8_WAIT_V(8); PG8_WAIT_L(0); PG8_BAR; PG8_MMA(1, 0, At, B0); PG8_MMA(1, 1, At, B1); PG8_BAR; PG8_SCHED;
            } else {
            PG8_LDB(B0, 0, 0); PG8_SCHED; PG8_LDA(At, 0, 0); PG8_STAGE(PG8_SA(1, 1), a1 + hstepA, voffA);
            PG8_WAIT_L(8); PG8_BAR; PG8_WAIT_L(0); PG8_MMA(0, 0, At, B0); PG8_BAR; PG8_SCHED;
            PG8_LDB(B1, 0, 1); PG8_STAGE(PG8_SB(0, 0), b2, voffB);
            PG8_BAR; PG8_WAIT_L(0); PG8_MMA(0, 1, At, B1); PG8_BAR;
            PG8_LDA(At, 0, 1); PG8_STAGE(PG8_SA(0, 0), a2, voffA);
            PG8_BAR; PG8_WAIT_L(0); PG8_MMA(1, 0, At, B0); PG8_BAR; PG8_SCHED;
            PG8_STAGE(PG8_SB(0, 1), b2 + hstepB, voffB);
            PG8_WAIT_V(6); PG8_BAR; PG8_MMA(1, 1, At, B1); PG8_BAR;
            PG8_LDB(B0, 1, 0); PG8_SCHED; PG8_LDA(At, 1, 0); PG8_STAGE(PG8_SA(0, 1), a2 + hstepA, voffA);
            PG8_WAIT_L(8); PG8_BAR; PG8_WAIT_L(0); PG8_MMA(0, 0, At, B0); PG8_BAR; PG8_SCHED;
            PG8_LDB(B1, 1, 1); PG8_STAGE(PG8_SB(1, 0), b3, voffB);
            PG8_BAR; PG8_WAIT_L(0); PG8_MMA(0, 1, At, B1); PG8_BAR;
            PG8_LDA(At, 1, 1); PG8_STAGE(PG8_SA(1, 0), a3, voffA);
            PG8_BAR; PG8_WAIT_L(0); PG8_MMA(1, 0, At, B0); PG8_BAR; PG8_SCHED;
            PG8_STAGE(PG8_SB(1, 1), b3 + hstepB, voffB);
            PG8_WAIT_V(6); PG8_BAR; PG8_MMA(1, 1, At, B1); PG8_BAR;
            }
        }
        if constexpr (ALIGN_EPI) { if (wr == 0) PG8_BAR; }
        E(acc, cur, wr, wc, fr, fq);
        if (!has_next) break;
#pragma unroll
        for (int a = 0; a < 2; ++a)
#pragma unroll
            for (int b = 0; b < 2; ++b)
#pragma unroll
                for (int m = 0; m < 4; ++m)
#pragma unroll
                    for (int n = 0; n < 2; ++n) acc[a][b][m][n] = (f32x4){0.f, 0.f, 0.f, 0.f};
        cur = nxt; cA = nA; cB = nB; ++ui;
        if constexpr (ALIGN_EPI) { if (wr == 1) PG8_BAR; }
    }
    PG8_WAIT_V(0);
    if constexpr (!ALIGN_EPI) { if (wr == 0) PG8_BAR; }
    PG8_BAR;
#undef PG8_SA
#undef PG8_SB
#undef PG8_STAGE
#undef PG8_LDA
#undef PG8_LDB
#undef PG8_MMA
#undef PG8_WAIT_V
#undef PG8_WAIT_L
#undef PG8_BAR
#undef PG8_SCHED
}
}
using pg8::Unit;

template <int MODE, int LDA_B, int LDB_B> struct Sched {
    pg8::TileOrder to; int G, c;
    const char* A0; const char* B0; const char* A1; const char* B1;
    __device__ __forceinline__ bool next(int i, Unit& u) const {
        if (MODE == 1) {
            const long L = (long)(i >> 1) * G + c; if (!to.tile(L, u.pm, u.pn)) return false;
            u.aux = i & 1;
            u.a = (u.aux ? A1 : A0) + (size_t)u.pm * 256 * LDA_B; u.b = (u.aux ? B1 : B0) + (size_t)u.pn * 256 * LDB_B; return true;
        } else {
            const long L = (long)i * G + c;
            if (MODE == 2 && G >= 64) {
                const int nS = FF2 / 256;
                if (L >= (long)to.nwg + nS) return false;
                if (L >= G - nS && L < G) { u.pm = NPT5; u.pn = (int)(L - (G - nS)); }
                else if (!to.tile(L < G - nS ? L : L - nS, u.pm, u.pn)) return false;
            } else if (!to.tile(L, u.pm, u.pn)) return false;
            u.aux = 0;
            if (MODE == 2) { const long r0 = (u.pm < NPT5) ? (254L * u.pm - 2) : (long)SEQ; u.a = A0 + r0 * (long)LDA_B; }
            else u.a = A0 + (size_t)u.pm * 256 * LDA_B;
            u.b = B0 + (size_t)u.pn * 256 * LDB_B; return true;
        }
    }
};

#define EPI_ARGS const f32x4 (&acc)[2][2][4][2], const Unit& u, int wr, int wc, int fr, int fq
struct EpiAda {
    static constexpr bool PERM = true;
    float* ADA; const float* bias;
    __device__ __forceinline__ void operator()(EPI_ARGS) const {
#pragma unroll
        for (int ai = 0; ai < 2; ++ai)
#pragma unroll
            for (int m = 0; m < 4; ++m) { const int row = 128 * ai + 64 * wr + 16 * m + fr;
#pragma unroll
                for (int bj = 0; bj < 2; ++bj) { const int col = 256 * u.pn + 128 * bj + 32 * wc + 8 * fq;
#pragma unroll
                    for (int n = 0; n < 2; ++n) { const f32x4 b = *(const f32x4*)(bias + col + 4 * n); *(f32x4*)(ADA + (size_t)row * NADA + col + 4 * n) = acc[ai][bj][m][n] + b; } } }
    }
};
struct EpiProj {
    static constexpr bool PERM = true;
    bf16_t *U, *BG, *Q, *KB, *VB, *GA, *GB;
    __device__ __forceinline__ void operator()(EPI_ARGS) const {
        const int row0 = u.pm * 256 + wr * 64 + fr;
        if (u.pn < 8) {
#pragma unroll
            for (int ai = 0; ai < 2; ++ai)
#pragma unroll
                for (int m = 0; m < 4; ++m) { const int row = row0 + 128 * ai + 16 * m;
                    const f32x4 v0 = acc[ai][0][m][0] * acc[ai][1][m][0], v1 = acc[ai][0][m][1] * acc[ai][1][m][1];
                    u32x4 w; w.x = cvt_pk_bf16(v0[0], v0[1]); w.y = cvt_pk_bf16(v0[2], v0[3]); w.z = cvt_pk_bf16(v1[0], v1[1]); w.w = cvt_pk_bf16(v1[2], v1[3]);
                    *(u32x4*)(U + (size_t)row * 1024 + 128 * u.pn + 32 * wc + 8 * fq) = w; }
        } else {
            bf16_t* dst; int ld, cb; const int pn = u.pn;
            if (pn < 12) { dst = BG; ld = 1024; cb = 256 * (pn - 8); }
            else if (pn < 16) { dst = Q; ld = 1024; cb = 256 * (pn - 12); }
            else if (pn == 16) { dst = KB; ld = 256; cb = 0; }
            else if (pn == 17) { dst = VB; ld = 256; cb = 0; }
            else if (pn < 22) { dst = GA; ld = 1024; cb = 256 * (pn - 18); }
            else { dst = GB; ld = 1024; cb = 256 * (pn - 22); }
#pragma unroll
            for (int ai = 0; ai < 2; ++ai)
#pragma unroll
                for (int m = 0; m < 4; ++m) { const int row = row0 + 128 * ai + 16 * m;
#pragma unroll
                    for (int bj = 0; bj < 2; ++bj) { const f32x4 v0 = acc[ai][bj][m][0], v1 = acc[ai][bj][m][1];
                        u32x4 w; w.x = cvt_pk_bf16(v0[0], v0[1]); w.y = cvt_pk_bf16(v0[2], v0[3]); w.z = cvt_pk_bf16(v1[0], v1[1]); w.w = cvt_pk_bf16(v1[2], v1[3]);
                        *(u32x4*)(dst + (size_t)row * ld + cb + 128 * bj + 32 * wc + 8 * fq) = w; } }
        }
    }
};
struct EpiMix {
    static constexpr bool PERM = true;
    const bf16_t *GA, *GB; float* T; bf16_t* Z;
    __device__ __forceinline__ void operator()(EPI_ARGS) const {
        const int row0 = u.pm * 256 + wr * 64 + fr;
        const bf16_t* gate = u.aux ? GB : GA;
#pragma unroll
        for (int ai = 0; ai < 2; ++ai)
#pragma unroll
            for (int m = 0; m < 4; ++m) { const int row = row0 + 128 * ai + 16 * m;
                if (row < MROWS) {
#pragma unroll
                for (int bj = 0; bj < 2; ++bj) { const int col = 256 * u.pn + 128 * bj + 32 * wc + 8 * fq;
                    float gv[8]; unpack8(*(const u32x4*)(gate + (size_t)row * 1024 + col), gv);
                    float o[8];
#pragma unroll
                    for (int i = 0; i < 8; ++i) o[i] = sigmoidf_(gv[i]) * acc[ai][bj][m][i >> 2][i & 3];
                    bf16_t* zp = Z + (size_t)row * 1024 + col;
                    if (u.aux == 0) *(u32x4*)zp = pack8(o);
                    else { float t[8]; unpack8(*(const u32x4*)zp, t);
#pragma unroll
                        for (int i = 0; i < 8; ++i) o[i] += t[i];
                        *(u32x4*)zp = pack8(o); } } } }
    }
};
struct EpiRes {
    static constexpr bool PERM = true;
    const float* xp; const float* xs; float* out; const float* ADA; int goff;
    __device__ __forceinline__ void operator()(EPI_ARGS) const {
        const int row0 = u.pm * 256 + wr * 64 + fr;
#pragma unroll
        for (int ai = 0; ai < 2; ++ai)
#pragma unroll
            for (int m = 0; m < 4; ++m) { const int row = row0 + 128 * ai + 16 * m;
                if (row < MROWS) {
                const float* base = (row < SEQ) ? xp + (size_t)row * 1024 : xs + (size_t)(row - SEQ) * 1024;
                const float* gt = ADA + (size_t)((row < SEQ) ? 128 : row - SEQ) * NADA + goff;
#pragma unroll
                for (int bj = 0; bj < 2; ++bj) { const int col = 256 * u.pn + 128 * bj + 32 * wc + 8 * fq;
#pragma unroll
                    for (int n = 0; n < 2; ++n) { const f32x4 b = *(const f32x4*)(base + col + 4 * n), g = *(const f32x4*)(gt + col + 4 * n);
                        *(f32x4*)(out + (size_t)row * 1024 + col + 4 * n) = b + g * acc[ai][bj][m][n]; } } } }
    }
};
struct EpiDelta {
    static constexpr bool PERM = true;
    bf16_t* Dd; const float* ADA; int goff;
    __device__ __forceinline__ void operator()(EPI_ARGS) const {
        const int row0 = u.pm * 256 + wr * 64 + fr;
#pragma unroll
        for (int ai = 0; ai < 2; ++ai)
#pragma unroll
            for (int m = 0; m < 4; ++m) { const int row = row0 + 128 * ai + 16 * m;
                if (row < MROWS) {
                const float* gt = ADA + (size_t)((row < SEQ) ? 128 : row - SEQ) * NADA + goff;
#pragma unroll
                for (int bj = 0; bj < 2; ++bj) { const int col = 256 * u.pn + 128 * bj + 32 * wc + 8 * fq;
                    const f32x4 g0 = *(const f32x4*)(gt + col), g1 = *(const f32x4*)(gt + col + 4); const f32x4 a0 = g0 * acc[ai][bj][m][0], a1 = g1 * acc[ai][bj][m][1];
                    u32x4 w; w.x = cvt_pk_bf16(a0[0], a0[1]); w.y = cvt_pk_bf16(a0[2], a0[3]); w.z = cvt_pk_bf16(a1[0], a1[1]); w.w = cvt_pk_bf16(a1[2], a1[3]);
                    *(u32x4*)(Dd + (size_t)row * 1024 + col) = w; } } }
    }
};
struct EpiRes4 {
    static constexpr bool PERM = true;
    const float* xp; float* out; const float* ADA; const float* gf; bf16_t* A2; float* SS;
    __device__ __forceinline__ void operator()(EPI_ARGS) const {
        const int row0 = u.pm * 256 + wr * 64 + fr; const float* ad = ADA + (size_t)128 * NADA;
#pragma unroll
        for (int ai = 0; ai < 2; ++ai)
#pragma unroll
            for (int m = 0; m < 4; ++m) { const int row = row0 + 128 * ai + 16 * m; float ss = 0.f;
#pragma unroll
                for (int bj = 0; bj < 2; ++bj) { const int col = 256 * u.pn + 128 * bj + 32 * wc + 8 * fq; float a2[8];
#pragma unroll
                    for (int n = 0; n < 2; ++n) { const f32x4 b = *(const f32x4*)(xp + (size_t)row * 1024 + col + 4 * n), g = *(const f32x4*)(ad + 2048 + col + 4 * n);
                        const f32x4 x1 = b + g * acc[ai][bj][m][n]; *(f32x4*)(out + (size_t)row * 1024 + col + 4 * n) = x1;
                        ss += (x1[0] * x1[0] + x1[1] * x1[1]) + (x1[2] * x1[2] + x1[3] * x1[3]);
                        const f32x4 gm = *(const f32x4*)(gf + col + 4 * n) * (*(const f32x4*)(ad + 4096 + col + 4 * n) + 1.0f); const f32x4 av = x1 * gm;
                        a2[4 * n] = av[0]; a2[4 * n + 1] = av[1]; a2[4 * n + 2] = av[2]; a2[4 * n + 3] = av[3]; }
                    *(u32x4*)(A2 + (size_t)row * 1024 + col) = pack8(a2); }
                ss += __shfl_xor(ss, 16); ss += __shfl_xor(ss, 32);
                if (fq == 0) SS[(size_t)row * 16 + u.pn * 4 + wc] = ss; }
    }
};
__device__ __forceinline__ float ss_sum16(const float* SS, unsigned row) {
    const f32x4* p = (const f32x4*)((const char*)SS + (size_t)row * 64u); const f32x4 a = p[0], b = p[1], c = p[2], d = p[3]; const f32x4 s = (a + b) + (c + d); return (s[0] + s[1]) + (s[2] + s[3]); }
struct EpiFfn {
    static constexpr bool PERM = true;
    bf16_t* G; const float* cw; const float* cb; const float* st; float* ofp; float* ofs; PG8_LAS float* halo; const float* SS; const float* C0;
    template <int CTRL> static __device__ __forceinline__ float dppf(float oldv, float src) {
        return __int_as_float(__builtin_amdgcn_update_dpp(__float_as_int(oldv), __float_as_int(src), CTRL, 0xf, 0xf, false)); }
    __device__ __forceinline__ void operator()(const f32x4 (&acc)[2][2][4][2], const Unit& u, int wr, int wc, int fr_, int fq_) const {
        const int l_ = (int)lane_id_now();
        const int fr = l_ & 15, fq = l_ >> 4; (void)fr_; (void)fq_;
        const int wid = wr * 4 + wc;
        const int f0 = 128 * u.pn + 32 * wc + 8 * fq;
        if (u.pm < NPT5) {
            PG8_LAS float* par = halo + 2048;
            {
                const int t = wid * 64 + l_;
                if (t < 256) { const int gc = (t < 128) ? 128 * u.pn + t : FF + 128 * u.pn + (t - 128);
                    const float w0_ = cw[gc], w1_ = cw[FF2 + gc], w2_ = cw[2 * FF2 + gc], b_ = cb[gc], c0_ = C0[gc];
                    par[t] = w0_; par[256 + t] = w1_; par[512 + t] = w2_; par[768 + t] = b_ + c0_ * (w0_ + w1_ + w2_); par[1024 + t] = c0_; }
                else { const int tr_ = t - 256, gr_ = 254 * u.pm - 2 + tr_; const unsigned go_ = (unsigned)((gr_ < 0 || gr_ >= SEQ) ? 0 : gr_);
                    const float ssv = ss_sum16(SS, go_); par[1280 + tr_] = (gr_ >= 0) ? rsqrtf(ssv * (1.0f / 1024.0f) + EPS) : 0.f; }
            }
            unsigned pb_ = (unsigned)(uintptr_t)(par + 32 * wc + 8 * fq); asm volatile("" : "+v"(pb_)); const PG8_LAS float* parl = (const PG8_LAS float*)(uintptr_t)pb_;
            unsigned rb_ = (unsigned)(uintptr_t)(par + 1280 + 64 * wr + fr); asm volatile("" : "+v"(rb_)); const PG8_LAS float* rsl = (const PG8_LAS float*)(uintptr_t)rb_;
            if (fr >= 14) {
#pragma unroll
                for (int ai = 0; ai < 2; ++ai)
#pragma unroll
                    for (int bj = 0; bj < 2; ++bj)
#pragma unroll
                        for (int n = 0; n < 2; ++n) { const int gr_ = 254 * u.pm - 2 + 128 * ai + 64 * wr + 48 + fr; const float r_ = rsqrtf(ss_sum16(SS, (unsigned)(gr_ >= SEQ ? 0 : gr_)) * (1.0f / 1024.0f) + EPS);
                            *(PG8_LAS f32x4*)(halo + ((wid * 2 + ai) * 2 + (fr - 14)) * 64 + bj * 32 + fq * 8 + n * 4) = acc[ai][bj][3][n] * r_; }
            }
            const bool first = (u.pm == 0) && (wr == 0);
            asm volatile("s_waitcnt vmcnt(0) lgkmcnt(0)" ::: "memory"); __builtin_amdgcn_s_barrier(); asm volatile("" ::: "memory");
#pragma unroll
            for (int ai = 0; ai < 2; ++ai) {
                const int swr = (ai == 0) ? 0 : (wr == 0 ? 1 : 0), sai = (ai == 1 && wr == 1) ? 1 : 0;
                unsigned hb_ = (unsigned)(uintptr_t)(halo + (((swr * 4 + wc) * 2 + sai) * 2) * 64 + fq * 8); asm volatile("" : "+v"(hb_)); const PG8_LAS float* hp = (const PG8_LAS float*)(uintptr_t)hb_;
                u32x2 pk0[4];
#pragma unroll
                for (int n = 0; n < 2; ++n) {
                    const int cg0 = 4 * n, cv0 = 128 + cg0;
                    f32x4 cvv[4];
                    {
                        const f32x4 w0 = *(const PG8_LAS f32x4*)(parl + cv0), w1 = *(const PG8_LAS f32x4*)(parl + 256 + cv0), w2 = *(const PG8_LAS f32x4*)(parl + 512 + cv0), bb = *(const PG8_LAS f32x4*)(parl + 768 + cv0);
                        const f32x4 h2 = *(const PG8_LAS f32x4*)(hp + 32 + n * 4), h1 = *(const PG8_LAS f32x4*)(hp + 64 + 32 + n * 4);
                        f32x4 p1 = h1, p2 = (fr == 1) ? h1 : h2;
                        const f32x4 bbe = bb;
#pragma unroll
                        for (int m = 0; m < 4; ++m) {
                            const float r_ = rsl[128 * ai + 16 * m];
                            const f32x4 x = acc[ai][1][m][n] * r_; f32x4 q1, q2, n1, n2;
#pragma unroll
                            for (int i = 0; i < 4; ++i) { q1[i] = dppf<0x111>(p1[i], x[i]); q2[i] = dppf<0x112>(p2[i], x[i]); n1[i] = dppf<0x121>(x[i], x[i]); n2[i] = dppf<0x122>(x[i], x[i]); }
                            p1 = n1; p2 = n2;
                            cvv[m] = w0 * q2 + w1 * q1 + w2 * x + bbe;
                            if (ai == 0 && m == 0 && first) { const f32x4 c0v = *(const PG8_LAS f32x4*)(parl + 1024 + cv0); if (fr == 2) cvv[m] -= c0v * (w0 + w1); else if (fr == 3) cvv[m] -= c0v * w0; }
                            __builtin_amdgcn_sched_barrier(0);
                        }
                    }
                    {
                        const f32x4 w0 = *(const PG8_LAS f32x4*)(parl + cg0), w1 = *(const PG8_LAS f32x4*)(parl + 256 + cg0), w2 = *(const PG8_LAS f32x4*)(parl + 512 + cg0), bb = *(const PG8_LAS f32x4*)(parl + 768 + cg0);
                        const f32x4 h2 = *(const PG8_LAS f32x4*)(hp + n * 4), h1 = *(const PG8_LAS f32x4*)(hp + 64 + n * 4);
                        f32x4 p1 = h1, p2 = (fr == 1) ? h1 : h2;
                        const f32x4 bbe = bb;
#pragma unroll
                        for (int m = 0; m < 4; ++m) {
                            const float r_ = rsl[128 * ai + 16 * m];
                            const f32x4 x = acc[ai][0][m][n] * r_; f32x4 q1, q2, n1, n2;
#pragma unroll
                            for (int i = 0; i < 4; ++i) { q1[i] = dppf<0x111>(p1[i], x[i]); q2[i] = dppf<0x112>(p2[i], x[i]); n1[i] = dppf<0x121>(x[i], x[i]); n2[i] = dppf<0x122>(x[i], x[i]); }
                            p1 = n1; p2 = n2;
                            f32x4 cgv = w0 * q2 + w1 * q1 + w2 * x + bbe;
                            if (ai == 0 && m == 0 && first) { const f32x4 c0v = *(const PG8_LAS f32x4*)(parl + 1024 + cg0); if (fr == 2) cgv -= c0v * (w0 + w1); else if (fr == 3) cgv -= c0v * w0; }
                            u32x2 pk; pk.x = cvt_pk_bf16(siluf_(cgv[0]) * cvv[m][0], siluf_(cgv[1]) * cvv[m][1]); pk.y = cvt_pk_bf16(siluf_(cgv[2]) * cvv[m][2], siluf_(cgv[3]) * cvv[m][3]);
                            if (n == 0) pk0[m] = pk;
                            else {
                                const int tr = 128 * ai + 64 * wr + 16 * m + fr; const int grow = 254 * u.pm - 2 + tr;
                                if (tr >= 2 && grow < SEQ) {
                                    *(u32x4*)(G + (size_t)grow * FF + f0) = (u32x4){pk0[m].x, pk0[m].y, pk.x, pk.y};
                                    if (grow >= SEQ - 2) { float* o = ofp + (size_t)(grow - (SEQ - 2)) * FF2 + f0;
                                        *(f32x4*)o = acc[ai][0][m][0] * r_ + *(const PG8_LAS f32x4*)(parl + 1024); *(f32x4*)(o + 4) = acc[ai][0][m][1] * r_ + *(const PG8_LAS f32x4*)(parl + 1024 + 4);
                                        *(f32x4*)(o + FF) = acc[ai][1][m][0] * r_ + *(const PG8_LAS f32x4*)(parl + 1024 + 128); *(f32x4*)(o + FF + 4) = acc[ai][1][m][1] * r_ + *(const PG8_LAS f32x4*)(parl + 1024 + 128 + 4); }
                                }
                            }
                            asm volatile("" ::: "memory"); __builtin_amdgcn_sched_barrier(0);
                        }
                    }
                }
                asm volatile("" ::: "memory"); __builtin_amdgcn_sched_barrier(0);
            }
        } else {
#pragma unroll
            for (int n = 0; n < 2; ++n) {
                const int fg = f0 + 4 * n, fv = FF + fg;
#pragma unroll
                for (int m = 0; m < 4; ++m) {
                    const int b = 64 * wr + 16 * m + fr;
                    const float* s0 = st + (size_t)(b * 2) * FF2; const float* s1 = s0 + FF2;
                    float* o0 = ofs + (size_t)(b * 2) * FF2; float* o1 = o0 + FF2;
                    f32x4 cvv;
                    { const f32x4 x = acc[0][1][m][n];
                      const f32x4 w0 = *(const f32x4*)(cw + fv), w1 = *(const f32x4*)(cw + FF2 + fv), w2 = *(const f32x4*)(cw + 2 * FF2 + fv), bb = *(const f32x4*)(cb + fv);
                      const f32x4 t0 = *(const f32x4*)(s0 + fv), t1 = *(const f32x4*)(s1 + fv);
                      cvv = w0 * t0 + w1 * t1 + w2 * x + bb; *(f32x4*)(o0 + fv) = t1; *(f32x4*)(o1 + fv) = x; }
                    asm volatile("" ::: "memory"); __builtin_amdgcn_sched_barrier(0);
                    { const f32x4 x = acc[0][0][m][n];
                      const f32x4 w0 = *(const f32x4*)(cw + fg), w1 = *(const f32x4*)(cw + FF2 + fg), w2 = *(const f32x4*)(cw + 2 * FF2 + fg), bb = *(const f32x4*)(cb + fg);
                      const f32x4 t0 = *(const f32x4*)(s0 + fg), t1 = *(const f32x4*)(s1 + fg);
                      const f32x4 cgv = w0 * t0 + w1 * t1 + w2 * x + bb; *(f32x4*)(o0 + fg) = t1; *(f32x4*)(o1 + fg) = x;
                      u32x2 w; w.x = cvt_pk_bf16(siluf_(cgv[0]) * cvv[0], siluf_(cgv[1]) * cvv[1]); w.y = cvt_pk_bf16(siluf_(cgv[2]) * cvv[2], siluf_(cgv[3]) * cvv[3]);
                      *(u32x2*)(G + (size_t)(SEQ + b) * FF + fg) = w; }
                    asm volatile("" ::: "memory"); __builtin_amdgcn_sched_barrier(0);
                }
            }
        }
    }
};

__device__ __forceinline__ void transpose_item(const float* W, int K, int N, bf16_t* WT, int k0, int n0, int drow0, float* scr, int lane) {
    float tv[32];
#pragma unroll
    for (int i = 0; i < 32; ++i) tv[i] = __builtin_nontemporal_load(W + (size_t)(k0 + 2 * i + (lane >> 5)) * N + n0 + (lane & 31));
#pragma unroll
    for (int i = 0; i < 32; ++i) scr[(2 * i + (lane >> 5)) * 33 + (lane & 31)] = tv[i];
    asm volatile("s_waitcnt lgkmcnt(0)" ::: "memory");
    const int c = lane & 7;
#pragma unroll
    for (int j = 0; j < 4; ++j) { const int n = (lane >> 3) + 8 * j; const float* s = scr + (8 * c) * 33 + n;
        u32x4 o; o.x = cvt_pk_bf16(s[0 * 33], s[1 * 33]); o.y = cvt_pk_bf16(s[2 * 33], s[3 * 33]); o.z = cvt_pk_bf16(s[4 * 33], s[5 * 33]); o.w = cvt_pk_bf16(s[6 * 33], s[7 * 33]);
        *(u32x4*)(WT + (size_t)(drow0 + n) * K + k0 + 8 * c) = o; }
    asm volatile("s_waitcnt lgkmcnt(0)" ::: "memory");
}
__device__ __forceinline__ int win_drow(int n) {
    if (n < 1024) return 256 * (n >> 7) + (n & 127);
    if (n < 2048) return 2048 + (n - 1024);
    if (n < 3072) { const int f = n - 2048; return 256 * (f >> 7) + 128 + (f & 127); }
    return n;
}
__device__ __forceinline__ int wup_drow(int n) { const int f = (n < FF) ? n : n - FF; return 256 * (f >> 7) + ((n < FF) ? 0 : 128) + (f & 127); }

__device__ __forceinline__ void modnorm_row(const float* xrow, const float* g, const float* sc, const float* sh, bf16_t* orow, int lane) {
    f32x4 v[4]; float s = 0.f;
#pragma unroll
    for (int j = 0; j < 4; ++j) { v[j] = ((const f32x4*)xrow)[lane + 64 * j]; s += (v[j][0] * v[j][0] + v[j][1] * v[j][1]) + (v[j][2] * v[j][2] + v[j][3] * v[j][3]); }
    const float rstd = rsqrtf(wave_sum(s) * (1.0f / 1024.0f) + EPS);
#pragma unroll
    for (int j = 0; j < 4; ++j) { const int col = 4 * (lane + 64 * j);
        const f32x4 gg = *(const f32x4*)(g + col), ss = *(const f32x4*)(sc + col), hh = *(const f32x4*)(sh + col);
        const f32x4 o = v[j] * rstd * gg * (ss + 1.0f) + hh;
        u32x2 w; w.x = cvt_pk_bf16(o[0], o[1]); w.y = cvt_pk_bf16(o[2], o[3]); *(u32x2*)(orow + col) = w; }
}


template <int MODE, int NRF = 4>
__device__ __forceinline__ void norm_phase(const float* xp, const float* xs, const float* gvec, const float* ada, int scoff, int shoff, bf16_t* ob, float* of, int gw, int NGW, int lane, const bf16_t* dadd = nullptr) {
    f32x4 gmP[4], shP[4];
#pragma unroll
    for (int j = 0; j < 4; ++j) { const int col = 4 * (lane + 64 * j); const f32x4 g = *(const f32x4*)(gvec + col);
        if (MODE == 2) { gmP[j] = g; shP[j] = (f32x4){0.f, 0.f, 0.f, 0.f}; }
        else { const float* ad = ada + (size_t)128 * NADA; gmP[j] = g * (*(const f32x4*)(ad + scoff + col) + 1.0f); shP[j] = *(const f32x4*)(ad + shoff + col); } }
#pragma unroll 1
    for (int base = gw; base < MROWS; base += NRF * NGW) {
        f32x4 v[NRF][4];
#pragma unroll
        for (int r = 0; r < NRF; ++r) { const int row = base + r * NGW;
            if (row < MROWS) { const float* xr = (MODE == 0) ? ((row < SEQ) ? xp + (size_t)row * 1024 : xs + (size_t)(row - SEQ) * 1024) : xp + (size_t)row * 1024;
#pragma unroll
                for (int j = 0; j < 4; ++j) v[r][j] = ((const f32x4*)xr)[lane + 64 * j];
                if (MODE == 2) {
#pragma unroll
                    for (int j = 0; j < 4; ++j) { const u32x2 w = *(const u32x2*)(dadd + (size_t)row * 1024 + 4 * (lane + 64 * j));
                        v[r][j] += (f32x4){bf2f(w.x & 0xffffu), bf2f(w.x >> 16), bf2f(w.y & 0xffffu), bf2f(w.y >> 16)}; } } } }
#pragma unroll
        for (int r = 0; r < NRF; ++r) { const int row = base + r * NGW;
            if (row < MROWS) {
                float s = 0.f;
#pragma unroll
                for (int j = 0; j < 4; ++j) s += (v[r][j][0] * v[r][j][0] + v[r][j][1] * v[r][j][1]) + (v[r][j][2] * v[r][j][2] + v[r][j][3] * v[r][j][3]);
                const float rstd = rsqrtf(wave_sum(s) * (1.0f / 1024.0f) + EPS);
#pragma unroll
                for (int j = 0; j < 4; ++j) { const int col = 4 * (lane + 64 * j);
                    f32x4 gm = gmP[j], sh = shP[j];
                    if (MODE != 2 && row >= SEQ) { const float* ad = ada + (size_t)(row - SEQ) * NADA; gm = *(const f32x4*)(gvec + col) * (*(const f32x4*)(ad + scoff + col) + 1.0f); sh = *(const f32x4*)(ad + shoff + col); }
                    const f32x4 o = v[r][j] * rstd * gm + sh;
                    if (MODE == 2) __builtin_nontemporal_store(o, (f32x4*)(of + (size_t)row * 1024 + col));
                    else { u32x2 w; w.x = cvt_pk_bf16(o[0], o[1]); w.y = cvt_pk_bf16(o[2], o[3]); *(u32x2*)(ob + (size_t)row * 1024 + col) = w; } }
            } }
    }
}
__device__ __forceinline__ void attn_prompt_unit(unsigned char* lds, bf16_t* Q, const bf16_t* KB, const bf16_t* VB, const float* sinks, int j, int g, int tid) {
    bf16_t* Ks = (bf16_t*)lds;
    bf16_t* Vt = (bf16_t*)(lds + 36864);
    bf16x8 qpre[2][4];
    {   const int wave_ = tid >> 6, ql_ = tid & 31, hi_ = (tid >> 5) & 1;
#pragma unroll
        for (int tt = 0; tt < 2; ++tt) { const int t = wave_ * 2 + tt, hq = t >> 2, qg = t & 3; const bf16_t* qp = Q + (size_t)(128 * j + 32 * qg + ql_) * 1024 + (4 * g + hq) * 64;
#pragma unroll
            for (int d0 = 0; d0 < 4; ++d0) qpre[tt][d0] = *(const bf16x8*)(qp + 16 * d0 + 8 * hi_); } }
    for (int c = tid; c < 2048; c += 512) {
        const int s = c >> 3, ch = c & 7; const int tok = 128 * (j - 1) + s;
        u32x4 kv = (u32x4){0u, 0u, 0u, 0u}, vv = (u32x4){0u, 0u, 0u, 0u};
        if (tok >= 0) { kv = *(const u32x4*)(KB + (size_t)tok * 256 + 64 * g + 8 * ch); vv = *(const u32x4*)(VB + (size_t)tok * 256 + 64 * g + 8 * ch); }
        *(u32x4*)(Ks + s * 72 + 8 * ch) = kv;
        bf16_t* vd = Vt + (8 * ch) * 264 + s;
        vd[0 * 264] = (bf16_t)(vv.x & 0xffffu); vd[1 * 264] = (bf16_t)(vv.x >> 16); vd[2 * 264] = (bf16_t)(vv.y & 0xffffu); vd[3 * 264] = (bf16_t)(vv.y >> 16);
        vd[4 * 264] = (bf16_t)(vv.z & 0xffffu); vd[5 * 264] = (bf16_t)(vv.z >> 16); vd[6 * 264] = (bf16_t)(vv.w & 0xffffu); vd[7 * 264] = (bf16_t)(vv.w >> 16);
    }
    __syncthreads();
    const int wave = tid >> 6, lane = tid & 63, ql = lane & 31, hi = lane >> 5;
#pragma unroll
    for (int tt = 0; tt < 2; ++tt) {
        const int t = wave * 2 + tt, hq = t >> 2, qg = t & 3, head = 4 * g + hq;
        bf16_t* qp = Q + (size_t)(128 * j + 32 * qg + ql) * 1024 + head * 64;
        bf16x8 qf[4];
#pragma unroll
        for (int d0 = 0; d0 < 4; ++d0) qf[d0] = qpre[tt][d0];
        f32x16 p[5];
#pragma unroll
        for (int kt = 0; kt < 5; ++kt) {
#pragma unroll
            for (int r = 0; r < 16; ++r) p[kt][r] = 0.f;
#pragma unroll
            for (int d0 = 0; d0 < 4; ++d0) { const bf16x8 kf = *(const bf16x8*)(Ks + (32 * qg + 32 * kt + ql) * 72 + 16 * d0 + 8 * hi);
                p[kt] = __builtin_amdgcn_mfma_f32_32x32x16_bf16(kf, qf[d0], p[kt], 0, 0, 0); }
        }
        const float sink = sinks[head];
        float mx = -INFINITY;
#pragma unroll
        for (int kt = 0; kt < 5; ++kt)
#pragma unroll
            for (int r = 0; r < 16; ++r) { const int kk = (r & 3) + 8 * (r >> 2) + 4 * hi; bool valid = true;
                if (kt == 0) valid = kk >= ql; if (kt == 4) valid = kk <= ql; if (j == 0) valid = valid && (32 * qg + 32 * kt + kk >= 128);
                const float v = valid ? p[kt][r] * 0.125f : -INFINITY; p[kt][r] = v; mx = fmaxf(mx, v); }
        mx = fmaxf(mx, __shfl_xor(mx, 32)); mx = fmaxf(mx, sink);
        float l = 0.f;
#pragma unroll
        for (int kt = 0; kt < 5; ++kt)
#pragma unroll
            for (int r = 0; r < 16; ++r) { const float e = __expf(p[kt][r] - mx); p[kt][r] = e; l += e; }
        l += __shfl_xor(l, 32);
        const float inv = 1.0f / (l + __expf(sink - mx));
        f32x16 o0, o1;
#pragma unroll
        for (int r = 0; r < 16; ++r) { o0[r] = 0.f; o1[r] = 0.f; }
#pragma unroll
        for (int kt = 0; kt < 5; ++kt)
#pragma unroll
            for (int hf = 0; hf < 2; ++hf) {
                u32x4 pw; pw.x = cvt_pk_bf16(p[kt][8 * hf + 0], p[kt][8 * hf + 1]); pw.y = cvt_pk_bf16(p[kt][8 * hf + 2], p[kt][8 * hf + 3]);
                pw.z = cvt_pk_bf16(p[kt][8 * hf + 4], p[kt][8 * hf + 5]); pw.w = cvt_pk_bf16(p[kt][8 * hf + 6], p[kt][8 * hf + 7]);
                const bf16x8 pf = __builtin_bit_cast(bf16x8, pw);
                const int sk = 32 * qg + 32 * kt + 16 * hf + 4 * hi;
                { const bf16_t* vp = Vt + ql * 264 + sk; const u32x2 a = *(const u32x2*)vp, b = *(const u32x2*)(vp + 8);
                  const bf16x8 vf = __builtin_bit_cast(bf16x8, ((u32x4){a.x, a.y, b.x, b.y})); o0 = __builtin_amdgcn_mfma_f32_32x32x16_bf16(vf, pf, o0, 0, 0, 0); }
                { const bf16_t* vp = Vt + (32 + ql) * 264 + sk; const u32x2 a = *(const u32x2*)vp, b = *(const u32x2*)(vp + 8);
                  const bf16x8 vf = __builtin_bit_cast(bf16x8, ((u32x4){a.x, a.y, b.x, b.y})); o1 = __builtin_amdgcn_mfma_f32_32x32x16_bf16(vf, pf, o1, 0, 0, 0); }
            }
#pragma unroll
        for (int c4 = 0; c4 < 4; ++c4) {
            u32x2 w0, w1;
            w0.x = cvt_pk_bf16(o0[4 * c4 + 0] * inv, o0[4 * c4 + 1] * inv); w0.y = cvt_pk_bf16(o0[4 * c4 + 2] * inv, o0[4 * c4 + 3] * inv);
            w1.x = cvt_pk_bf16(o1[4 * c4 + 0] * inv, o1[4 * c4 + 1] * inv); w1.y = cvt_pk_bf16(o1[4 * c4 + 2] * inv, o1[4 * c4 + 3] * inv);
            *(u32x2*)(qp + 8 * c4 + 4 * hi) = w0; *(u32x2*)(qp + 32 + 8 * c4 + 4 * hi) = w1;
        }
    }
    __syncthreads();
}
__device__ __forceinline__ void attn_sample_task(float* wl, bf16_t* Q, const bf16_t* KB, const bf16_t* VB, const float* ck, const float* cv, const float* sinks, int b, int g, int lane) {
    float* qs = wl; float* pp = wl + 256;
    bf16_t* qrow = Q + (size_t)(SEQ + b) * 1024 + 4 * g * 64;
#pragma unroll
    for (int h = 0; h < 4; ++h) qs[h * 64 + lane] = bf2f(qrow[h * 64 + lane]) * 0.125f;
    const float knew = bf2f(KB[(size_t)(SEQ + b) * 256 + 64 * g + lane]), vnew = bf2f(VB[(size_t)(SEQ + b) * 256 + 64 * g + lane]);
    asm volatile("s_waitcnt lgkmcnt(0)" ::: "memory");
    float sc[2][4];
#pragma unroll
    for (int kk = 0; kk < 2; ++kk) { const int s = lane + 64 * kk; const f32x4* kp = (const f32x4*)(ck + ((size_t)(b * 128 + s) * 4 + g) * 64);
        float a0 = 0.f, a1 = 0.f, a2 = 0.f, a3 = 0.f;
#pragma unroll 4
        for (int c = 0; c < 16; ++c) { const f32x4 kv = kp[c];
            const f32x4 q0 = *(const f32x4*)(qs + 4 * c), q1 = *(const f32x4*)(qs + 64 + 4 * c), q2 = *(const f32x4*)(qs + 128 + 4 * c), q3 = *(const f32x4*)(qs + 192 + 4 * c);
            a0 += kv[0] * q0[0] + kv[1] * q0[1] + kv[2] * q0[2] + kv[3] * q0[3]; a1 += kv[0] * q1[0] + kv[1] * q1[1] + kv[2] * q1[2] + kv[3] * q1[3];
            a2 += kv[0] * q2[0] + kv[1] * q2[1] + kv[2] * q2[2] + kv[3] * q2[3]; a3 += kv[0] * q3[0] + kv[1] * q3[1] + kv[2] * q3[2] + kv[3] * q3[3]; }
        sc[kk][0] = a0; sc[kk][1] = a1; sc[kk][2] = a2; sc[kk][3] = a3; }
#pragma unroll
    for (int h = 0; h < 4; ++h) {
        const float sn = wave_sum(qs[h * 64 + lane] * knew), sink = sinks[4 * g + h];
        float m = wave_max(fmaxf(sc[0][h], sc[1][h])); m = fmaxf(fmaxf(m, sn), sink);
        const float e0 = __expf(sc[0][h] - m), e1 = __expf(sc[1][h] - m), en = __expf(sn - m);
        const float inv = 1.0f / (wave_sum(e0 + e1) + en + __expf(sink - m));
        pp[lane * 4 + h] = e0 * inv; pp[(64 + lane) * 4 + h] = e1 * inv; if (lane == 0) pp[512 + h] = en * inv;
    }
    asm volatile("s_waitcnt lgkmcnt(0)" ::: "memory");
    float o0 = 0.f, o1 = 0.f, o2 = 0.f, o3 = 0.f;
    const float* vp = cv + ((size_t)(b * 128) * 4 + g) * 64 + lane;
#pragma unroll 8
    for (int s = 0; s < 128; ++s) { const float v = vp[(size_t)s * 256]; const f32x4 pv = *(const f32x4*)(pp + 4 * s); o0 += pv[0] * v; o1 += pv[1] * v; o2 += pv[2] * v; o3 += pv[3] * v; }
    { const f32x4 pv = *(const f32x4*)(pp + 512); o0 += pv[0] * vnew; o1 += pv[1] * vnew; o2 += pv[2] * vnew; o3 += pv[3] * vnew; }
    qrow[lane] = (bf16_t)(cvt_pk_bf16(o0, 0.f) & 0xffffu); qrow[64 + lane] = (bf16_t)(cvt_pk_bf16(o1, 0.f) & 0xffffu);
    qrow[128 + lane] = (bf16_t)(cvt_pk_bf16(o2, 0.f) & 0xffffu); qrow[192 + lane] = (bf16_t)(cvt_pk_bf16(o3, 0.f) & 0xffffu);
    asm volatile("s_waitcnt lgkmcnt(0)" ::: "memory");
}


#if SELFCHECK
constexpr size_t WS_CHK = 512 * 1024;
__device__ __forceinline__ unsigned hsh(unsigned x) { x ^= x >> 16; x *= 0x7feb352du; x ^= x >> 15; x *= 0x846ca68bu; x ^= x >> 16; return x; }
__device__ __forceinline__ int samp_row(int s) {
    if ((s & 3) == 0) { switch ((s >> 2) & 7) { case 0: return 0; case 1: return 1; case 2: return 255; case 3: return 256; case 4: return SEQ - 1; case 5: return SEQ; case 6: return SEQ + 100; default: return 8191; } }
    if ((s & 3) == 1) return SEQ + (int)(hsh(s) % NS);
    return (int)(hsh(s * 3 + 1) % SEQ);
}
__device__ __forceinline__ bool chk_bad(float got, float ref) { return !(fabsf(got - ref) <= 0.05f * fabsf(ref) + 0.04f); }
__device__ __forceinline__ float wdot_bf(const bf16_t* a, const float* W, int ldw, int col, int K, int lane) {
    float s = 0.f; for (int k = lane; k < K; k += 64) s += bf2f(a[k]) * W[(size_t)k * ldw + col]; return wave_sum(s); }
#define CHK_FAIL(bit) do { if (lane == 0) atomicOr(mask, 1u << (bit)); } while (0)
#endif

template <int KLEN>
__device__ __forceinline__ f32x4 mini_kloop(const bf16_t* Arow, const bf16_t* Brow, f32x4 acc) {
    constexpr int NS_ = KLEN / 32;
    static_assert(KLEN % 32 == 0, "K quarter");
#pragma unroll 1
    for (int s0 = 0; s0 < NS_; s0 += 8) {
        bf16x8 a[8], b[8];
#pragma unroll
        for (int i = 0; i < 8; ++i) if (s0 + i < NS_) { a[i] = *(const bf16x8*)(Arow + (s0 + i) * 32); b[i] = *(const bf16x8*)(Brow + (s0 + i) * 32); }
#pragma unroll
        for (int i = 0; i < 8; ++i) if (s0 + i < NS_) acc = __builtin_amdgcn_mfma_f32_16x16x32_bf16(b[i], a[i], acc, 0, 0, 0);
    }
    return acc;
}
struct MiniArgs { const bf16_t* A0; const bf16_t* B0; const bf16_t* A1; const bf16_t* B1; const bf16_t* GA; const bf16_t* GB; bf16_t* Z; const float* base; float* out; const float* ADA; int goff; };
template <int MODE, int K>
__device__ __forceinline__ void mini_sample_gemm(unsigned char* lds, const MiniArgs& P, int bid, int G, int wave, int lane) {
    const int fr = lane & 15, fq = lane >> 4, tl = wave >> 2, kq = wave & 3;
    f32x4* red = (f32x4*)lds;
    for (int T0 = 2 * bid; T0 < 512; T0 += 2 * G) {
        const int T = T0 + tl, rt = T & 7, ct = T >> 3;
        const int row = SEQ + 16 * rt + fr, colb = 16 * ct + fr;
        const size_t ko = (size_t)kq * (K / 4) + 8 * fq;
        f32x4 acc0 = (f32x4){0.f, 0.f, 0.f, 0.f}, acc1 = acc0;
        acc0 = mini_kloop<K / 4>(P.A0 + (size_t)row * K + ko, P.B0 + (size_t)colb * K + ko, acc0);
        if (MODE == 0) acc1 = mini_kloop<K / 4>(P.A1 + (size_t)row * K + ko, P.B1 + (size_t)colb * K + ko, acc1);
        red[wave * 64 + lane] = acc0; if (MODE == 0) red[512 + wave * 64 + lane] = acc1;
        __syncthreads();
        if (kq == 0) {
            f32x4 s0 = red[wave * 64 + lane] + red[(wave + 1) * 64 + lane] + red[(wave + 2) * 64 + lane] + red[(wave + 3) * 64 + lane];
            const int col = 16 * ct + 4 * fq;
            if (MODE == 0) {
                const f32x4 s1 = red[512 + wave * 64 + lane] + red[512 + (wave + 1) * 64 + lane] + red[512 + (wave + 2) * 64 + lane] + red[512 + (wave + 3) * 64 + lane];
                const u32x2 ga = *(const u32x2*)(P.GA + (size_t)row * 1024 + col), gb = *(const u32x2*)(P.GB + (size_t)row * 1024 + col);
                const float z0 = sigmoidf_(bf2f(ga.x & 0xffffu)) * s0[0] + sigmoidf_(bf2f(gb.x & 0xffffu)) * s1[0], z1 = sigmoidf_(bf2f(ga.x >> 16)) * s0[1] + sigmoidf_(bf2f(gb.x >> 16)) * s1[1];
                const float z2 = sigmoidf_(bf2f(ga.y & 0xffffu)) * s0[2] + sigmoidf_(bf2f(gb.y & 0xffffu)) * s1[2], z3 = sigmoidf_(bf2f(ga.y >> 16)) * s0[3] + sigmoidf_(bf2f(gb.y >> 16)) * s1[3];
                u32x2 w; w.x = cvt_pk_bf16(z0, z1); w.y = cvt_pk_bf16(z2, z3); *(u32x2*)(P.Z + (size_t)row * 1024 + col) = w;
            } else if (MODE == 2) {
                const int b = row - SEQ; const f32x4 g = *(const f32x4*)(P.ADA + (size_t)b * NADA + P.goff + col); const f32x4 d = g * s0;
                u32x2 w; w.x = cvt_pk_bf16(d[0], d[1]); w.y = cvt_pk_bf16(d[2], d[3]); *(u32x2*)(P.Z + (size_t)row * 1024 + col) = w;
            } else {
                const int b = row - SEQ;
                const f32x4 bs = *(const f32x4*)(P.base + (size_t)b * 1024 + col), g = *(const f32x4*)(P.ADA + (size_t)b * NADA + P.goff + col);
                *(f32x4*)(P.out + (size_t)row * 1024 + col) = bs + g * s0;
            }
        }
        __syncthreads();
    }
}

__device__ __forceinline__ void ada_block(unsigned char* lds, const float* cs, const float* cp, const float* W, const float* bias, float* ADAo, int pair, int wave, int lane) {
    const int fr = lane & 15, fq = lane >> 4, tl = wave >> 2, kq = wave & 3, c0 = 16 * (2 * pair + tl);
    f32x4 acc[9];
#pragma unroll
    for (int rt = 0; rt < 9; ++rt) acc[rt] = (f32x4){0.f, 0.f, 0.f, 0.f};
#pragma unroll 1
    for (int ks = 0; ks < 8; ++ks) {
        const int k0 = 256 * kq + 32 * ks + 8 * fq;
        float wv[8];
#pragma unroll
        for (int j = 0; j < 8; ++j) wv[j] = __builtin_nontemporal_load(W + (size_t)(k0 + j) * NADA + c0 + fr);
        f32x4 a0[9], a1[9];
#pragma unroll
        for (int rt = 0; rt < 9; ++rt) { const int row = 16 * rt + fr; const float* cr = (row < 128) ? cs + (size_t)row * 1024 : cp;
            a0[rt] = *(const f32x4*)(cr + k0); a1[rt] = *(const f32x4*)(cr + k0 + 4); }
        u32x4 bw; bw.x = cvt_pk_bf16(wv[0], wv[1]); bw.y = cvt_pk_bf16(wv[2], wv[3]); bw.z = cvt_pk_bf16(wv[4], wv[5]); bw.w = cvt_pk_bf16(wv[6], wv[7]);
        const bf16x8 bfrag = __builtin_bit_cast(bf16x8, bw);
#pragma unroll
        for (int rt = 0; rt < 9; ++rt) { const bool ok = (16 * rt + fr) <= 128;
            u32x4 aw; aw.x = cvt_pk_bf16(siluf_(a0[rt][0]), siluf_(a0[rt][1])); aw.y = cvt_pk_bf16(siluf_(a0[rt][2]), siluf_(a0[rt][3]));
            aw.z = cvt_pk_bf16(siluf_(a1[rt][0]), siluf_(a1[rt][1])); aw.w = cvt_pk_bf16(siluf_(a1[rt][2]), siluf_(a1[rt][3]));
            if (!ok) aw = (u32x4){0u, 0u, 0u, 0u};
            acc[rt] = __builtin_amdgcn_mfma_f32_16x16x32_bf16(bfrag, __builtin_bit_cast(bf16x8, aw), acc[rt], 0, 0, 0); }
    }
    f32x4* red = (f32x4*)lds;
#pragma unroll
    for (int rt = 0; rt < 9; ++rt) red[(wave * 9 + rt) * 64 + lane] = acc[rt];
    __syncthreads();
    if (kq == 0) {
        const f32x4 bv = *(const f32x4*)(bias + c0 + 4 * fq);
#pragma unroll
        for (int rt = 0; rt < 9; ++rt) { const int row = 16 * rt + fr;
            const f32x4 sum = red[(wave * 9 + rt) * 64 + lane] + red[((wave + 1) * 9 + rt) * 64 + lane] + red[((wave + 2) * 9 + rt) * 64 + lane] + red[((wave + 3) * 9 + rt) * 64 + lane];
            if (row <= 128) *(f32x4*)(ADAo + (size_t)row * NADA + c0 + 4 * fq) = sum + bv; }
    }
    __syncthreads();
}

#define LAS __attribute__((address_space(3)))
#define XB_TMO      128
#define XB_XCNT(j)  (256  + 64 * (j))
#define XB_XSUB(j)  (1280 + 64 * (j))
#define XB_XGEN(j)  (2304 + 64 * (j))
#define XB_TOP      3328
#define XB_TOPGEN   3392
#define XCD_BAR_WORDS 3456
#define XB_SPIN_CAP (1u << 22)
constexpr size_t WS_BAR = 64 * 1024;
constexpr int MISC_OFF = 146432;
constexpr size_t WS_SS = 768 * 1024;
constexpr size_t WS_C0 = WS_BAR + 16384;
constexpr size_t BAR_ZERO_BYTES = (WS_C0 - WS_BAR) + 22528;
__device__ __forceinline__ unsigned xb_ld(unsigned* p)              { return __hip_atomic_load(p, __ATOMIC_RELAXED, __HIP_MEMORY_SCOPE_AGENT); }
__device__ __forceinline__ unsigned xb_add(unsigned* p, unsigned v) { return __hip_atomic_fetch_add(p, v, __ATOMIC_RELAXED, __HIP_MEMORY_SCOPE_AGENT); }
__device__ __forceinline__ unsigned xb_xcc_id() { return (unsigned)__builtin_amdgcn_s_getreg((3 << 11) | 20) & 0xFu; }
#define XB_SPIN(cond, bar) do { unsigned _sp = 0; while (cond) { __builtin_amdgcn_s_sleep(1); \
    if ((++_sp & 255u) == 0u) { if (xb_ld(&(bar)[XB_TMO])) break; if (_sp > XB_SPIN_CAP) { atomicAdd(&(bar)[XB_TMO], 1u); break; } } } } while (0)
struct XcdBarrier { unsigned* bar; unsigned x; volatile LAS unsigned* st; };
__device__ __forceinline__ XcdBarrier xcd_barrier_post(unsigned* bar, volatile LAS unsigned* st, bool leader) {
    XcdBarrier b; b.bar = bar; b.x = xb_xcc_id(); b.st = st;
    if (leader) (void)xb_add(&bar[XB_XCNT(b.x)], 1u);
    return b;
}
__device__ __forceinline__ void xcd_barrier_complete(unsigned* bar, unsigned x, unsigned& nloc, unsigned& nx) {
    const unsigned G = gridDim.x * gridDim.y * gridDim.z;
    unsigned sum, cnt, mine, sp = 0u;
    for (;;) {
        sum = 0u; cnt = 0u; mine = 0u;
#pragma unroll
        for (unsigned j = 0; j < 16; ++j) { const unsigned c = xb_ld(&bar[XB_XCNT(j)]); sum += c; cnt += (c > 0u) ? 1u : 0u; mine = (j == x) ? c : mine; }
        if (sum == G) break;
        __builtin_amdgcn_s_sleep(1);
        if ((++sp & 255u) == 0u) { if (xb_ld(&bar[XB_TMO])) break; if (sp > XB_SPIN_CAP) { atomicAdd(&bar[XB_TMO], 1u); break; } }
    }
    nloc = mine > 0u ? mine : 1u; nx = cnt > 0u ? cnt : 1u;
}
__device__ __forceinline__ void xcd_barrier_core(const XcdBarrier& b, bool leader) {
    if (leader) {
        unsigned* bar = b.bar;
        __builtin_amdgcn_s_waitcnt(0);
        unsigned nloc = b.st[0], nx = b.st[1];
        if (nloc == 0u) { xcd_barrier_complete(bar, b.x, nloc, nx); b.st[0] = nloc; b.st[1] = nx; }
        const unsigned old = xb_add(&bar[XB_XSUB(b.x)], 1u);
        const unsigned gen = old / nloc;
        if (old + 1u == (gen + 1u) * nloc) {
            __builtin_amdgcn_fence(__ATOMIC_RELEASE, "agent");
            asm volatile("s_waitcnt vmcnt(0)" ::: "memory");
            const unsigned og = xb_add(&bar[XB_TOP], 1u);
            const unsigned tg = og / nx;
            if (og + 1u == (tg + 1u) * nx) xb_add(&bar[XB_TOPGEN], 1u);
            else XB_SPIN(xb_ld(&bar[XB_TOPGEN]) == tg, bar);
            __builtin_amdgcn_fence(__ATOMIC_ACQUIRE, "agent");
            xb_add(&bar[XB_XGEN(b.x)], 1u);
            asm volatile("s_waitcnt vmcnt(0)" ::: "memory");
        } else {
            XB_SPIN(xb_ld(&bar[XB_XGEN(b.x)]) == gen, bar);
            __builtin_amdgcn_fence(__ATOMIC_ACQUIRE, "agent");
            asm volatile("s_waitcnt vmcnt(0)" ::: "memory");
        }
    }
}
struct Args { const float* in[23]; float* out; unsigned char* ws; };
enum { I_XP = 0, I_XS, I_CP, I_CS, I_SCA, I_CK, I_CV, I_SFF, I_WADA, I_BADA, I_GMIX, I_WIN, I_CAW, I_SINK, I_WAO, I_WBO, I_WO, I_GFFN, I_WUP, I_FCW, I_FCB, I_WDN, I_GFIN };

typedef const __attribute__((address_space(4))) Args* KArgsP;
__device__ __forceinline__ void shadow_work(KArgsP ap, unsigned nb, int w7, int bid, int G, int lane, unsigned char* lds) {
    const int sw = bid * 7 + w7, NSW = G * 7;
    float* scr = (float*)(lds + (w7 + 1) * 16384);
    unsigned char* ws = ap->ws;
    if (nb == 1u) {
        for (int it = sw; it < 16 * (NIN / 32); it += NSW) { const int nbk = NIN / 32, kb = it / nbk, n0 = 32 * (it % nbk);
            transpose_item(ap->in[I_WIN], 1024, NIN, (bf16_t*)(ws + WS_WIN), 64 * kb, n0, win_drow(n0), scr, lane); }
    } else if (nb == 2u || nb == 3u) {
        constexpr int I_UPS = 16 * (FF2 / 32), SPLIT_ = 1024;
        if (nb == 2u) for (int r = sw; r < 3 * 512; r += NSW) { const int which = r / 512, q = r % 512, kb = q / 32, n0 = 32 * (q % 32);
            transpose_item(ap->in[which == 0 ? I_WAO : (which == 1 ? I_WBO : I_WO)], 1024, 1024, (bf16_t*)(ws + (which == 0 ? WS_WA : (which == 1 ? WS_WB : WS_WO))), 64 * kb, n0, n0, scr, lane); }
        for (int it = (nb == 2u ? 0 : SPLIT_) + sw; it < (nb == 2u ? SPLIT_ : I_UPS); it += NSW) { const int nbk = FF2 / 32, kb = it / nbk, n0 = 32 * (it % nbk);
            transpose_item(ap->in[I_WUP], 1024, FF2, (bf16_t*)(ws + WS_WUP), 64 * kb, n0, wup_drow(n0), scr, lane); }
        if (nb == 2u)
            for (int t = sw; t < 88 * 16; t += NSW) { const int cgp = t % 88, ks = t / 88, col = 64 * cgp + lane;
                const float* Wp = ap->in[I_WUP] + (size_t)(64 * ks) * FF2 + col; const float* sh = (const float*)(ws + WS_ADA) + (size_t)128 * NADA + 3072 + 64 * ks;
                float a = 0.f;
#pragma unroll 16
                for (int k = 0; k < 64; ++k) a += sh[k] * __builtin_nontemporal_load(Wp + (size_t)k * FF2);
                (void)__hip_atomic_fetch_add((float*)(ws + WS_C0) + col, a, __ATOMIC_RELAXED, __HIP_MEMORY_SCOPE_AGENT); }
    } else if (nb == 4u) {
        for (int it = sw; it < (FF / 64) * 32; it += NSW) { const int kb = it / 32, n0 = 32 * (it % 32); transpose_item(ap->in[I_WDN], FF, 1024, (bf16_t*)(ws + WS_WDN), 64 * kb, n0, n0, scr, lane); }
    }
    if (nb == 4u || nb == 5u) {
        const float* ck_ = ap->in[I_CK]; const float* cv_ = ap->in[I_CV]; const bf16_t* kb_ = (const bf16_t*)(ws + WS_KB); const bf16_t* vb_ = (const bf16_t*)(ws + WS_VB); float* out = ap->out;
        const long st = (long)sw * 64 + lane, NST = (long)NSW * 64; const long lo = (nb == 4u) ? 0 : 1048576, hi = lo + 1048576;
#pragma unroll 4
        for (long i = lo + st; i < hi; i += NST) {
            const int which = (int)(i >> 20); const int r2 = (int)(i & 1048575); const int b = r2 >> 13, r = (r2 >> 6) & 127, c = r2 & 63;
            const float* cache = which ? cv_ : ck_; const bf16_t* nbp = which ? vb_ : kb_;
            f32x4 v;
            if (r < 127) v = __builtin_nontemporal_load((const f32x4*)(cache + ((size_t)(b * 128 + r + 1) * 256 + 4 * c)));
            else { const u32x2 w = *(const u32x2*)(nbp + (size_t)(SEQ + b) * 256 + 4 * c); v = (f32x4){bf2f(w.x & 0xffffu), bf2f(w.x >> 16), bf2f(w.y & 0xffffu), bf2f(w.y >> 16)}; }
            __builtin_nontemporal_store(v, (f32x4*)(out + (which ? O_VS : O_KS) + (size_t)r2 * 4));
        }
        if (nb == 4u) for (long i = st; i < 2L * 128 * 64; i += NST) {
            const int which = (int)(i >> 13); const int r2 = (int)(i & 8191); const int r = r2 >> 6, c = r2 & 63; const bf16_t* nbp = which ? vb_ : kb_;
            const u32x2 w = *(const u32x2*)(nbp + (size_t)(SEQ - 128 + r) * 256 + 4 * c);
            *(f32x4*)(out + (which ? O_VP : O_KP) + (size_t)r2 * 4) = (f32x4){bf2f(w.x & 0xffffu), bf2f(w.x >> 16), bf2f(w.y & 0xffffu), bf2f(w.y >> 16)};
        }
    }
}

__global__ void __launch_bounds__(512, 2) mega(Args a) {
    extern __shared__ __attribute__((aligned(16))) unsigned char lds[];
    PG8_LAS unsigned char* ldsl = (PG8_LAS unsigned char*)lds;
    const int G = gridDim.x, bid = blockIdx.x, NGW = G * 8;
    const int wave0 = __builtin_amdgcn_readfirstlane((int)threadIdx.x >> 6);
    const long NGT = (long)G * 512;
#define PHASE_IDS() int tid = wave0 * 64 + (int)lane_id_now(); asm volatile("" : "+v"(tid)); const int lane = tid & 63, wave = wave0; \
    const int gw = bid * 8 + wave; const long gt = (long)bid * 512 + tid; float* const scr = (float*)(lds + wave * 16384); (void)lane; (void)gw; (void)gt; (void)scr;
    typedef const __attribute__((address_space(4))) Args* KArgs;
    const KArgs ap0 = (KArgs)__builtin_amdgcn_kernarg_segment_ptr();
#define ARGS() ({ KArgs p_ = ap0; asm volatile("" : "+s"(p_)); p_; })
#define IN(i) (ARGS()->in[i])
#define WS(off) (ARGS()->ws + (off))
#define OUT() (ARGS()->out)
#define AADA ((bf16_t*)WS(WS_AADA))
#define ADA ((float*)WS(WS_ADA))
#define WA ((bf16_t*)WS(WS_WA))
#define WB ((bf16_t*)WS(WS_WB))
#define WO ((bf16_t*)WS(WS_WO))
#define WADA ((bf16_t*)WS(WS_WADA))
#define WIN ((bf16_t*)WS(WS_WIN))
#define WUP ((bf16_t*)WS(WS_WUP))
#define WDN ((bf16_t*)WS(WS_WDN))
#define H ((bf16_t*)WS(WS_H))
#define U ((bf16_t*)WS(WS_U))
#define BG ((bf16_t*)WS(WS_BG))
#define Q ((bf16_t*)WS(WS_Q))
#define KB ((bf16_t*)WS(WS_KB))
#define VB ((bf16_t*)WS(WS_VB))
#define GA ((bf16_t*)WS(WS_GA))
#define GB ((bf16_t*)WS(WS_GB))
#define GG ((bf16_t*)WS(WS_G))
#define AIN H
#define Z U
#define H2 BG
    if (gridDim.x == 0x7fffffffu) cg::this_grid().sync();
    if (threadIdx.x < 2) ((volatile LAS unsigned*)(ldsl + MISC_OFF))[threadIdx.x] = 0u;
    __syncthreads();
#define LEADER() (wave0 == 0 && lane_id_now() == 0u)
    const XcdBarrier xbar = xcd_barrier_post((unsigned*)WS(WS_BAR), (volatile LAS unsigned*)(ldsl + MISC_OFF), LEADER());
    unsigned nbar_ = 0u;
#define GRID_SYNC() do { ++nbar_; asm volatile("s_waitcnt vmcnt(0)" ::: "memory"); __syncthreads(); \
        if (wave0 == 0) xcd_barrier_core(xbar, LEADER()); else shadow_work((KArgsP)ap0, nbar_, wave0 - 1, bid, G, (int)lane_id_now(), lds); \
        __syncthreads(); } while (0)

#if TIMESEL >= 0
#define STAMP(k) do { if (bid == 0 && threadIdx.x == 0) ((unsigned long long*)WS(768 * 1024))[k] = __builtin_amdgcn_s_memrealtime(); } while (0)
#else
#define STAMP(k) do {} while (0)
#endif
    STAMP(0);
    {
        PHASE_IDS();
        {   const float* const cs = IN(I_CS); const float* const cp = IN(I_CP); const float* const wad = IN(I_WADA); const float* const bad = IN(I_BADA); float* const ada = ADA;
            for (int pr = bid; pr < NADA / 32; pr += G) ada_block(lds, cs, cp, wad, bad, ada, pr, wave, lane); }
        if (bid >= NADA / 32) {
            const f32x4* xp4 = (const f32x4*)IN(I_XP); const long nidle = (long)(G - NADA / 32) * 512, me = (long)(bid - NADA / 32) * 512 + tid; f32x4 sink = (f32x4){0.f, 0.f, 0.f, 0.f};
            {   const f32x4* wa4 = (const f32x4*)IN(I_WADA);
#pragma unroll 8
                for (long i = me; i < (long)1024 * NADA / 4; i += nidle) sink += wa4[i]; }
#pragma unroll 8
            for (long i = me; i < (long)SEQ * 256; i += nidle) sink += xp4[i];
            asm volatile("" :: "v"(sink)); }
    }
    GRID_SYNC();
    STAMP(1);
    STAMP(2);
    {
        PHASE_IDS();
        norm_phase<0, 8>(IN(I_XP), IN(I_XS), IN(I_GMIX), ADA, 1024, 0, H, nullptr, gw, NGW, lane);
    }
    GRID_SYNC();
    STAMP(3);
    {
        typedef Sched<0, 2048, 2048> SC; SC S; S.to.init(NMT, NIN / 256); S.G = G; S.c = bid; S.A0 = (const char*)H; S.B0 = (const char*)WIN;
        EpiProj E{U, BG, Q, KB, VB, GA, GB};
        pg8::gemm_phase<EpiProj, SC, 1024, 1024, 1024, true, true>(ldsl, wave0, S, E);
    }
    GRID_SYNC();
    STAMP(4);
    {
        PHASE_IDS();
        {   bf16_t* const q_ = Q; const bf16_t* const kb_ = KB; const bf16_t* const vb_ = VB; const float* const sinks = IN(I_SINK);
            for (int un = bid; un < 512; un += G) attn_prompt_unit(lds, q_, kb_, vb_, sinks, un >> 2, un & 3, tid); }
        {   bf16_t* const q_ = Q; const bf16_t* const kb_ = KB; const bf16_t* const vb_ = VB; const float* const sinks = IN(I_SINK);
            const float* const ck_ = IN(I_CK); const float* const cv_ = IN(I_CV);
            float* wl = (float*)(lds + 123392 + (wave >> 2) * 4096);
            for (int t4 = gw; t4 < 2048; t4 += NGW) if ((t4 & 3) == 0) { const int t = t4 >> 2; attn_sample_task(wl, q_, kb_, vb_, ck_, cv_, sinks, t >> 2, t & 3, lane); } }
        const bool worker = (wave & 3) != 0; const long wt = ((long)bid * 6 + (wave - 1 - (wave > 4 ? 1 : 0))) * 64 + lane, NWT = (long)G * 6 * 64;
        {
        float* const out = OUT();
        const float* caw = IN(I_CAW); const float* sca = IN(I_SCA); const bf16_t* const u_ = U; const bf16_t* const bg_ = BG; bf16_t* const ain_ = AIN;
        if (worker)
        for (long it = wt; it < (long)(SEQ / 8) * 128 + (long)NS * 128; it += NWT) {
            const bool smp = it >= (long)(SEQ / 8) * 128; const long it2 = smp ? it - (long)(SEQ / 8) * 128 : it;
            const int row0 = smp ? SEQ + (int)(it2 >> 7) : (int)(it2 >> 7) * 8, c8 = (int)(it2 & 127) * 8; const int nr = smp ? 1 : 8;
            float w0[8], w1[8], w2[8], u0[8], u1[8];
            *(f32x4*)w0 = *(const f32x4*)(caw + c8); *(f32x4*)(w0 + 4) = *(const f32x4*)(caw + c8 + 4);
            *(f32x4*)w1 = *(const f32x4*)(caw + 1024 + c8); *(f32x4*)(w1 + 4) = *(const f32x4*)(caw + 1024 + c8 + 4);
            *(f32x4*)w2 = *(const f32x4*)(caw + 2048 + c8); *(f32x4*)(w2 + 4) = *(const f32x4*)(caw + 2048 + c8 + 4);
            if (row0 < SEQ) {
                if (row0 >= 2) { unpack8(*(const u32x4*)(u_ + (size_t)(row0 - 2) * 1024 + c8), u0); unpack8(*(const u32x4*)(u_ + (size_t)(row0 - 1) * 1024 + c8), u1); }
                else { for (int i = 0; i < 8; ++i) { u0[i] = 0.f; u1[i] = 0.f; } }
#pragma unroll 4
                for (int r = 0; r < 8; ++r) { const int row = row0 + r; float u2[8], bg[8], o[8];
                    unpack8(*(const u32x4*)(u_ + (size_t)row * 1024 + c8), u2); unpack8(*(const u32x4*)(bg_ + (size_t)row * 1024 + c8), bg);
#pragma unroll
                    for (int i = 0; i < 8; ++i) { o[i] = bg[i] * (w0[i] * u0[i] + w1[i] * u1[i] + w2[i] * u2[i]); u0[i] = u1[i]; u1[i] = u2[i]; }
                    *(u32x4*)(ain_ + (size_t)row * 1024 + c8) = pack8(o);
                    if (row >= SEQ - 2) { float* op = out + O_CAP + (size_t)(row - (SEQ - 2)) * 1024 + c8; *(f32x4*)op = (f32x4){u2[0], u2[1], u2[2], u2[3]}; *(f32x4*)(op + 4) = (f32x4){u2[4], u2[5], u2[6], u2[7]}; } }
            } else {
                for (int r = 0; r < nr; ++r) { const int row = row0 + r, b = row - SEQ; float u2[8], bg[8], o[8];
                    const float* s0 = sca + (size_t)(b * 2) * 1024 + c8; const float* s1 = s0 + 1024;
                    *(f32x4*)u0 = *(const f32x4*)s0; *(f32x4*)(u0 + 4) = *(const f32x4*)(s0 + 4); *(f32x4*)u1 = *(const f32x4*)s1; *(f32x4*)(u1 + 4) = *(const f32x4*)(s1 + 4);
                    unpack8(*(const u32x4*)(u_ + (size_t)row * 1024 + c8), u2); unpack8(*(const u32x4*)(bg_ + (size_t)row * 1024 + c8), bg);
#pragma unroll
                    for (int i = 0; i < 8; ++i) o[i] = bg[i] * (w0[i] * u0[i] + w1[i] * u1[i] + w2[i] * u2[i]);
                    *(u32x4*)(ain_ + (size_t)row * 1024 + c8) = pack8(o);
                    float* op = out + O_CAS + (size_t)(b * 2) * 1024 + c8;
                    *(f32x4*)op = *(f32x4*)u1; *(f32x4*)(op + 4) = *(f32x4*)(u1 + 4); *(f32x4*)(op + 1024) = (f32x4){u2[0], u2[1], u2[2], u2[3]}; *(f32x4*)(op + 1024 + 4) = (f32x4){u2[4], u2[5], u2[6], u2[7]}; }
            }
        }
        }
    }
    GRID_SYNC();
    STAMP(5);
    {
        typedef Sched<1, 2048, 2048> SC; SC S; S.to.init(SEQ / 256, 4); S.G = G; S.c = bid; S.A0 = (const char*)AIN; S.B0 = (const char*)WA; S.A1 = (const char*)Q; S.B1 = (const char*)WB;
        EpiMix E{GA, GB, OUT(), Z};
        pg8::gemm_phase<EpiMix, SC, 1024, 1024, 1024, true, true>(ldsl, wave0, S, E);
        { PHASE_IDS(); MiniArgs P{AIN, WA, Q, WB, GA, GB, Z, nullptr, nullptr, nullptr, 0}; mini_sample_gemm<0, 1024>(lds, P, bid, G, wave, lane); }
    }
    GRID_SYNC();
    STAMP(6);
    {
        typedef Sched<0, 2048, 2048> SC; SC S; S.to.init(SEQ / 256, 4); S.G = G; S.c = bid; S.A0 = (const char*)Z; S.B0 = (const char*)WO;
        EpiRes4 E{IN(I_XP), OUT(), ADA, IN(I_GFFN), H2, (float*)WS(WS_SS)};
        pg8::gemm_phase<EpiRes4, SC, 1024, 1024, 1024, true, true>(ldsl, wave0, S, E);
        { PHASE_IDS(); if (gt < 256) *(u32x4*)((unsigned char*)H2 - 4096 + gt * 16) = (u32x4){0u, 0u, 0u, 0u}; }
        { PHASE_IDS(); MiniArgs P{Z, WO, nullptr, nullptr, nullptr, nullptr, nullptr, IN(I_XS), OUT(), ADA, 2048}; mini_sample_gemm<1, 1024>(lds, P, bid, G, wave, lane); }
    }
    GRID_SYNC();
    STAMP(8);
    {
        typedef Sched<2, 2048, 2048> SC; SC S; S.to.init(G >= 64 ? NPT5 : NPT5 + 1, FF2 / 256); S.G = G; S.c = bid; S.A0 = (const char*)H2; S.B0 = (const char*)WUP;
        {
            PHASE_IDS(); bool has = false; Unit u; for (int i = 0; S.next(i, u); ++i) has = has || (u.pm == NPT5);
            if (has) norm_phase<1>(OUT(), nullptr, IN(I_GFFN), ADA, 4096, 3072, H2, nullptr, SEQ + wave, 8, lane);
            asm volatile("s_waitcnt vmcnt(0)" ::: "memory"); __syncthreads(); }
        float* const out = OUT(); EpiFfn E{GG, IN(I_FCW), IN(I_FCB), IN(I_SFF), out + O_FP, out + O_FS, (PG8_LAS float*)(ldsl + HALO_OFF), (const float*)WS(WS_SS), (const float*)WS(WS_C0)};
        pg8::gemm_phase<EpiFfn, SC, 1024, 1024, 1024, true, true>(ldsl, wave0, S, E);
    }
    GRID_SYNC();
    STAMP(9);
    {
        typedef Sched<0, FF * 2, FF * 2> SC; SC S; S.to.init(SEQ / 256, 4); S.G = G; S.c = bid; S.A0 = (const char*)GG; S.B0 = (const char*)WDN;
        { EpiDelta E{Z, ADA, 5120};
        pg8::gemm_phase<EpiDelta, SC, FF, FF, FF, true, true>(ldsl, wave0, S, E); }
        { PHASE_IDS(); MiniArgs P{GG, WDN, nullptr, nullptr, nullptr, nullptr, Z, nullptr, nullptr, ADA, 5120}; mini_sample_gemm<2, FF>(lds, P, bid, G, wave, lane); }
    }
    GRID_SYNC();
    STAMP(10);
    {
        PHASE_IDS();
        float* const out = OUT();
        norm_phase<2, 8>(out, nullptr, IN(I_GFIN), nullptr, 0, 0, nullptr, out, gw, NGW, lane, Z);
    }
#if TIMESEL >= 0
    GRID_SYNC();
    STAMP(11);
    GRID_SYNC();
    STAMP(12);
    GRID_SYNC();
    {   PHASE_IDS(); const volatile unsigned long long* ts = (const volatile unsigned long long*)WS(768 * 1024);
        const float us = (float)(ts[TIMESEL + TIMESPAN] - ts[TIMESEL]) * 0.01f;
        const float sc = 1.006f + us * 1e-5f; float* o = OUT() + O_KS;
        for (long i = gt; i < 128L * 128 * 256; i += NGT) o[i] *= sc; }
#endif
}

extern "C" void kernel_launch(void* const* d_in, const int* in_sizes, int n_in, void* d_out, int out_size, void* d_ws, size_t ws_size, hipStream_t stream) {
    static int grid = 0;
    if (grid == 0) {
        if (n_in != 23 || ws_size < WS_END) { fprintf(stderr, "kernel_launch: unexpected n_in %d / ws %zu\n", n_in, ws_size); grid = -1; return; }
        int dev = 0, cus = 0, per_cu = 0;
        hipGetDevice(&dev); hipDeviceGetAttribute(&cus, hipDeviceAttributeMultiprocessorCount, dev);
        if (hipFuncSetAttribute((const void*)mega, hipFuncAttributeMaxDynamicSharedMemorySize, LDS_BYTES) != hipSuccess) { fprintf(stderr, "kernel_launch: hipFuncSetAttribute failed\n"); }
        hipOccupancyMaxActiveBlocksPerMultiprocessor(&per_cu, (const void*)mega, 512, LDS_BYTES);
        (void)hipGetLastError();
        if (per_cu < 1) per_cu = 1;
        grid = cus * 1;
        if (grid <= 0) grid = 256;
    }
    if (grid < 0) return;
    Args a{};
    for (int i = 0; i < 23; ++i) a.in[i] = (const float*)d_in[i];
    a.out = (float*)d_out; a.ws = (unsigned char*)d_ws;
    (void)hipMemsetAsync((char*)d_ws + WS_BAR, 0, BAR_ZERO_BYTES, stream);
    void* args[] = {&a};
    hipError_t e = hipLaunchCooperativeKernel((const void*)mega, dim3(grid), dim3(512), args, LDS_BYTES, stream);
    if (e != hipSuccess) fprintf(stderr, "cooperative launch failed: %s (grid %d)\n", hipGetErrorString(e), grid);
}
```
